# Optimizing an MI355X kernel written in HIP

```python
import math
import jax, jax.numpy as jnp
from jax import lax
import numpy as np

D_MODEL = 1024
BATCH = 16
SEQ = 2048
DEPTH = 1

CTX_LEN = 256
GRID_W = 64
HEAD_DIM = 64
ROPE_BASE = 10000.0
LN_EPS = 1e-6
RET_HEADS = 4
RET_DK = 64
RET_DV = 128
RET_CHUNK = 128
ATT_HEADS = 8
ATT_KV_HEADS = 2
ATT_GROUP = ATT_HEADS // ATT_KV_HEADS
Q_BLOCK = 128
RET_Q_W = RET_HEADS * RET_DK
RET_K_W = RET_HEADS * RET_DK
RET_V_W = RET_HEADS * RET_DV
RET_G_W = RET_HEADS * RET_DV
ATT_Q_W = ATT_HEADS * HEAD_DIM
ATT_K_W = ATT_KV_HEADS * HEAD_DIM
ATT_V_W = ATT_KV_HEADS * HEAD_DIM
IN_WIDTHS = (RET_Q_W, RET_K_W, RET_V_W, RET_G_W, ATT_Q_W, ATT_K_W, ATT_V_W)
IN_WIDTH = sum(IN_WIDTHS)
IN_SPLITS = [sum(IN_WIDTHS[:i + 1]) for i in range(len(IN_WIDTHS) - 1)]
MIX_WIDTH = RET_V_W + ATT_Q_W
N_EXPERTS = 32
TOP_K = 4
D_FF = D_MODEL
SWIGLU_LIMIT = 7.0
SWIGLU_ALPHA = 1.702
MOE_BLOCK = 512
DN_ALPHA = (2.0 * DEPTH) ** 0.25
DN_BETA = (8.0 * DEPTH) ** -0.25

kernel_name = "hybrid_retention_gqa_moe_diffusion_block"


def layer_norm(x, g, b):
    xf = x.astype(jnp.float32)
    mu = jnp.mean(xf, -1, keepdims=True)
    var = jnp.mean(jnp.square(xf - mu), -1, keepdims=True)
    return ((xf - mu) * lax.rsqrt(var + LN_EPS) * g + b).astype(x.dtype)


def rms_norm(x, g):
    xf = x.astype(jnp.float32)
    return (xf * lax.rsqrt(jnp.mean(xf * xf, -1, keepdims=True) + LN_EPS) * g).astype(x.dtype)


def axial_rope_tables(rows, cols, dim):
    n_freq = dim // 4
    inv = ROPE_BASE ** (-jnp.arange(n_freq, dtype=jnp.float32) / n_freq)
    ang_r = rows.astype(jnp.float32)[:, None] * inv
    ang_c = cols.astype(jnp.float32)[:, None] * inv
    ang = jnp.concatenate([ang_r, ang_r, ang_c, ang_c], -1)
    return jnp.cos(ang), jnp.sin(ang)


def apply_rope(x, cos, sin):
    x1, x2, x3, x4 = jnp.split(x, 4, axis=-1)
    rotated = jnp.concatenate([-x2, x1, -x4, x3], -1)
    return (x * cos[None, :, None, :] + rotated * sin[None, :, None, :]).astype(x.dtype)


def ret_heads(rq, rk, rv, cos=None, sin=None):
    B, T, _ = rq.shape
    q = rq.reshape(B, T, RET_HEADS, RET_DK)
    k = rk.reshape(B, T, RET_HEADS, RET_DK)
    v = rv.reshape(B, T, RET_HEADS, RET_DV)
    if cos is not None:
        q = apply_rope(q, cos, sin)
        k = apply_rope(k, cos, sin)
    k = k * (RET_DK ** -0.5)
    to_bhtd = lambda t: jnp.transpose(t, (0, 2, 1, 3)).astype(jnp.float32)
    return to_bhtd(q), to_bhtd(k), to_bhtd(v)


def retention_scan(q, k, v, log_gamma, s0):
    B, H, T, dk = q.shape
    dv = v.shape[-1]
    n = T // RET_CHUNK
    qc = q.reshape(B, H, n, RET_CHUNK, dk)
    kc = k.reshape(B, H, n, RET_CHUNK, dk)
    vc = v.reshape(B, H, n, RET_CHUNK, dv)
    lg = log_gamma.astype(jnp.float32)
    pos = jnp.arange(RET_CHUNK, dtype=jnp.float32)
    diff = pos[:, None] - pos[None, :]
    decay = jnp.where(diff >= 0, jnp.exp(lg[:, None, None] * jnp.maximum(diff, 0.0)), 0.0)
    scores = jnp.einsum('bhncd,bhnjd->bhncj', qc, kc) * decay[None, :, None]
    y_inner = jnp.einsum('bhncj,bhnje->bhnce', scores, vc)
    k_decay = jnp.exp(lg[:, None] * (RET_CHUNK - 1 - pos)[None, :])
    kv_chunk = jnp.einsum('bhncd,hc,bhnce->nbhde', kc, k_decay, vc)
    gamma_c = jnp.exp(lg * RET_CHUNK)[None, :, None, None]

    def step(state, kv):
        return gamma_c * state + kv, state

    s_final, s_prev = lax.scan(step, s0, kv_chunk)
    q_decay = jnp.exp(lg[:, None] * (pos + 1.0)[None, :])
    y_cross = jnp.einsum('bhncd,hc,nbhde->bhnce', qc, q_decay, s_prev)
    return (y_inner + y_cross).reshape(B, H, T, dv), s_final


def retention_output(y, gate, gn_g, gn_b):
    B, H, T, dv = y.shape
    yt = jnp.transpose(y, (0, 2, 1, 3))
    mu = jnp.mean(yt, -1, keepdims=True)
    var = jnp.mean(jnp.square(yt - mu), -1, keepdims=True)
    yn = ((yt - mu) * lax.rsqrt(var + LN_EPS)).reshape(B, T, H * dv) * gn_g + gn_b
    return (yn * jax.nn.silu(gate.astype(jnp.float32))).astype(gate.dtype)


def block_attention(q, k, v):
    B, Tq, _, dh = q.shape
    nb = Tq // Q_BLOCK
    qb = q.reshape(B, nb, Q_BLOCK, ATT_KV_HEADS, ATT_GROUP, dh).transpose(1, 0, 2, 3, 4, 5)
    scale = dh ** -0.5

    def one_block(qblk):
        s = jnp.einsum('bqhgd,bkhd->bhgqk', qblk, k).astype(jnp.float32) * scale
        p = jax.nn.softmax(s, axis=-1).astype(v.dtype)
        return jnp.einsum('bhgqk,bkhd->bqhgd', p, v)

    o = lax.map(one_block, qb)
    return o.transpose(1, 0, 2, 3, 4, 5).reshape(B, Tq, ATT_HEADS * dh)


def mixer(h, hc, w_in_l, lg_f, lg_b, gn_g, gn_b, qn_g, kn_g, w_o_l, cos, sin, with_ctx_out):
    B, T, _ = h.shape
    L = hc.shape[1]
    rq, rk, rv, rg, aq, ak, av = jnp.split(h @ w_in_l, IN_SPLITS, axis=-1)
    rqc, rkc, rvc, rgc, aqc, akc, avc = jnp.split(hc @ w_in_l, IN_SPLITS, axis=-1)
    flip = lambda t: t[:, :, ::-1]

    q, k, v = ret_heads(rq, rk, rv, cos, sin)
    qc, kc, vc = ret_heads(rqc, rkc, rvc)
    s0 = jnp.zeros((B, RET_HEADS, RET_DK, RET_DV), jnp.float32)
    yc_f, s_ctx_f = retention_scan(qc, kc, vc, lg_f, s0)
    yc_b, s_ctx_b = retention_scan(flip(qc), flip(kc), flip(vc), lg_b, s0)
    y_f, _ = retention_scan(q, k, v, lg_f, s_ctx_f)
    y_b, _ = retention_scan(flip(q), flip(k), flip(v), lg_b, s_ctx_b)
    ret_out = retention_output(y_f + flip(y_b), rg, gn_g, gn_b)

    aq = apply_rope(rms_norm(aq.reshape(B, T, ATT_HEADS, HEAD_DIM), qn_g), cos, sin)
    ak = apply_rope(rms_norm(ak.reshape(B, T, ATT_KV_HEADS, HEAD_DIM), kn_g), cos, sin)
    av = av.reshape(B, T, ATT_KV_HEADS, HEAD_DIM)
    aqc = rms_norm(aqc.reshape(B, L, ATT_HEADS, HEAD_DIM), qn_g)
    akc = rms_norm(akc.reshape(B, L, ATT_KV_HEADS, HEAD_DIM), kn_g)
    avc = avc.reshape(B, L, ATT_KV_HEADS, HEAD_DIM)
    k_all = jnp.concatenate([akc, ak], axis=1)
    v_all = jnp.concatenate([avc, av], axis=1)
    att_out = block_attention(aq, k_all, v_all)

    y = jnp.concatenate([ret_out, att_out], -1) @ w_o_l
    yc = None
    if with_ctx_out:
        ret_c = retention_output(yc_f + flip(yc_b), rgc, gn_g, gn_b)
        att_c = block_attention(aqc, akc, avc)
        yc = jnp.concatenate([ret_c, att_c], -1) @ w_o_l
    return y, yc


def moe_ffn(h, router_w, router_b, w_up, b_up, w_down, b_down):
    n_tok, d = h.shape
    logits = (h @ router_w + router_b).astype(jnp.float32)
    top_logit, top_idx = lax.top_k(logits, TOP_K)
    gates = jax.nn.softmax(top_logit, axis=-1).astype(h.dtype)
    n_assign = n_tok * TOP_K
    flat_e = top_idx.reshape(-1)
    flat_tok = jnp.repeat(jnp.arange(n_tok, dtype=jnp.int32), TOP_K)
    order = jnp.argsort(flat_e)
    e_sorted = flat_e[order]
    tok_sorted = flat_tok[order]
    gate_sorted = gates.reshape(-1)[order]
    counts = jnp.bincount(flat_e, length=N_EXPERTS)
    padded = (counts + MOE_BLOCK - 1) // MOE_BLOCK * MOE_BLOCK
    start = jnp.cumsum(counts) - counts
    pad_end = jnp.cumsum(padded)
    pad_start = pad_end - padded
    dest = pad_start[e_sorted] + (jnp.arange(n_assign, dtype=jnp.int32) - start[e_sorted])
    n_blocks = -(-n_assign // MOE_BLOCK) + N_EXPERTS
    slot_tok = jnp.full((n_blocks * MOE_BLOCK,), n_tok, jnp.int32).at[dest].set(tok_sorted)
    block_start = jnp.arange(n_blocks, dtype=jnp.int32) * MOE_BLOCK
    block_expert = jnp.minimum(jnp.searchsorted(pad_end, block_start, side='right'), N_EXPERTS - 1)
    h_pad = jnp.concatenate([h, jnp.zeros((1, d), h.dtype)], axis=0)

    def expert_block(args):
        toks, e = args
        u = h_pad[toks] @ w_up[e] + b_up[e]
        glu, lin = jnp.split(u, 2, axis=-1)
        glu = jnp.minimum(glu, SWIGLU_LIMIT)
        lin = jnp.clip(lin, -SWIGLU_LIMIT, SWIGLU_LIMIT)
        act = glu * jax.nn.sigmoid(SWIGLU_ALPHA * glu) * (lin + 1.0)
        return act @ w_down[e] + b_down[e]

    y = lax.map(expert_block, (slot_tok.reshape(n_blocks, MOE_BLOCK), block_expert))
    y_assign = y.reshape(-1, d)[dest] * gate_sorted[:, None]
    return jax.ops.segment_sum(y_assign, tok_sorted, num_segments=n_tok)


def setup_inputs(seed: int = 0) -> dict:
    key = jax.random.key(seed)
    ks = jax.random.split(key, 32)
    nrm = lambda k, shape, scale: jax.random.normal(k, shape, jnp.float32) * scale
    L, D = DEPTH, D_MODEL
    in_scales = (1.0, 1.0, DN_BETA, 1.0, 1.0, 1.0, DN_BETA)
    col_scale = jnp.concatenate([jnp.full((w,), s, jnp.float32) for w, s in zip(IN_WIDTHS, in_scales)])
    base_decay = jnp.log(1.0 - 2.0 ** (-5.0 - jnp.arange(RET_HEADS, dtype=jnp.float32)))
    return {
        "x": nrm(ks[0], (BATCH, SEQ, D), 1.0),
        "c": nrm(ks[1], (BATCH, D), 1.0),
        "ctx": nrm(ks[2], (BATCH, CTX_LEN, D), 1.0),
        "c_ctx": nrm(ks[3], (D,), 1.0),
        "ln_in_g": 1.0 + nrm(ks[4], (D,), 0.02),
        "ln_in_b": nrm(ks[5], (D,), 0.02),
        "w_ada": nrm(ks[6], (L, D, 6 * D), D ** -0.5),
        "b_ada": nrm(ks[7], (L, 6 * D), 0.02),
        "w_in": nrm(ks[8], (L, D, IN_WIDTH), D ** -0.5) * col_scale,
        "ret_log_decay_f": base_decay * (1.0 + nrm(ks[9], (L, RET_HEADS), 0.05)),
        "ret_log_decay_b": base_decay * (1.0 + nrm(ks[10], (L, RET_HEADS), 0.05)),
        "ret_gn_g": 1.0 + nrm(ks[11], (L, RET_V_W), 0.02),
        "ret_gn_b": nrm(ks[12], (L, RET_V_W), 0.02),
        "q_norm_g": 1.0 + nrm(ks[13], (L, HEAD_DIM), 0.02),
        "k_norm_g": 1.0 + nrm(ks[14], (L, HEAD_DIM), 0.02),
        "w_o": nrm(ks[15], (L, MIX_WIDTH, D), MIX_WIDTH ** -0.5 * DN_BETA),
        "ln1_g": 1.0 + nrm(ks[16], (L, D), 0.02),
        "ln1_b": nrm(ks[17], (L, D), 0.02),
        "router_w": nrm(ks[18], (L, D, N_EXPERTS), D ** -0.5),
        "router_b": nrm(ks[19], (L, N_EXPERTS), 0.01),
        "w_up": nrm(ks[20], (L, N_EXPERTS, D, 2 * D_FF), D ** -0.5 * DN_BETA),
        "b_up": nrm(ks[21], (L, N_EXPERTS, 2 * D_FF), 0.01),
        "w_down": nrm(ks[22], (L, N_EXPERTS, D_FF, D), D_FF ** -0.5 * DN_BETA),
        "b_down": nrm(ks[23], (L, N_EXPERTS, D), 0.01),
        "ln2_g": 1.0 + nrm(ks[24], (L, D), 0.02),
        "ln2_b": nrm(ks[25], (L, D), 0.02),
    }


def reference(x, c, ctx, c_ctx, ln_in_g, ln_in_b, w_ada, b_ada, w_in, ret_log_decay_f, ret_log_decay_b,
              ret_gn_g, ret_gn_b, q_norm_g, k_norm_g, w_o, ln1_g, ln1_b, router_w, router_b,
              w_up, b_up, w_down, b_down, ln2_g, ln2_b):
    B, T, D = x.shape
    ROWS = T // GRID_W
    rows = jnp.repeat(jnp.arange(ROWS, dtype=jnp.int32), GRID_W)
    cols = jnp.tile(jnp.arange(GRID_W, dtype=jnp.int32), ROWS)
    cos, sin = axial_rope_tables(rows, cols, HEAD_DIM)

    x = layer_norm(x, ln_in_g, ln_in_b)
    ctx = layer_norm(ctx, ln_in_g, ln_in_b)
    for l in range(DEPTH):
        update_ctx = l < DEPTH - 1
        sh1, sc1, g1, sh2, sc2, g2 = jnp.split(jax.nn.silu(c) @ w_ada[l] + b_ada[l], 6, axis=-1)
        csh1, csc1, cg1, csh2, csc2, cg2 = jnp.split(jax.nn.silu(c_ctx) @ w_ada[l] + b_ada[l], 6, axis=-1)

        h = x * (1.0 + sc1[:, None]) + sh1[:, None]
        hc = ctx * (1.0 + csc1) + csh1
        y, yc = mixer(h, hc, w_in[l], ret_log_decay_f[l], ret_log_decay_b[l], ret_gn_g[l], ret_gn_b[l],
                      q_norm_g[l], k_norm_g[l], w_o[l], cos, sin, update_ctx)
        x = layer_norm(DN_ALPHA * x + g1[:, None] * y, ln1_g[l], ln1_b[l])
        if update_ctx:
            ctx = layer_norm(DN_ALPHA * ctx + cg1 * yc, ln1_g[l], ln1_b[l])

        h2 = x * (1.0 + sc2[:, None]) + sh2[:, None]
        f = moe_ffn(h2.reshape(B * T, D), router_w[l], router_b[l], w_up[l], b_up[l], w_down[l], b_down[l])
        x = layer_norm(DN_ALPHA * x + g2[:, None] * f.reshape(B, T, D), ln2_g[l], ln2_b[l])
        if update_ctx:
            hc2 = ctx * (1.0 + csc2) + csh2
            Lc = ctx.shape[1]
            fc = moe_ffn(hc2.reshape(B * Lc, D), router_w[l], router_b[l], w_up[l], b_up[l], w_down[l], b_down[l])
            ctx = layer_norm(DN_ALPHA * ctx + cg2 * fc.reshape(B, Lc, D), ln2_g[l], ln2_b[l])
    return x
```

```cpp
#include <hip/hip_runtime.h>
#include <cstdio>
#include <cstdint>

constexpr int BATCH = 16, SEQ = 2048, DM = 1024, CTX = 256, SU = SEQ + CTX;
constexpr int NTOK = BATCH * SEQ, NROW = BATCH * SU;
constexpr int NIN = 2304, NEXP = 32, LISTCAP = 32768;
constexpr float LN_EPS = 1e-6f, DN_ALPHA = 1.189207115002721f;
constexpr float C2 = 0.125f * 1.4426950408889634f;
constexpr int NWAVES = 8, NTHR = 512;

constexpr size_t MiB = 1u << 20;
constexpr size_t WS_CTL = 0, CTL_ZERO_BYTES = 1 * MiB;
constexpr size_t WS_ADA = 1 * MiB, WS_ROPE = 1 * MiB + 512 * 1024, WS_STATS = 2 * MiB, WS_LIST = 4 * MiB;
constexpr size_t WS_RWT = 12 * MiB;
constexpr size_t WS_WIN = 16 * MiB, WS_WO = 22 * MiB, WS_WUP = 32 * MiB, WS_WDN = 160 * MiB;
constexpr size_t WS_X1 = 224 * MiB, WS_H2 = 352 * MiB, WS_ACT = 416 * MiB;
constexpr size_t WS_MIX = 416 * MiB, WS_Y1 = 480 * MiB, WS_YRET = 544 * MiB;
constexpr size_t WS_YE = 688 * MiB;
constexpr size_t WS_H = 688 * MiB, WS_RQ = 760 * MiB, WS_RK = 776 * MiB, WS_RV = 794 * MiB, WS_RG = 830 * MiB, WS_AQ = 862 * MiB, WS_AK = 894 * MiB, WS_AV = 903 * MiB;
constexpr size_t WS_ST = 912 * MiB;
constexpr size_t WS_END = 944 * MiB;
constexpr int CW_TMO = 0, CW_CNT = 256, CW_BAR = 4096;

#define GAS __attribute__((address_space(1)))
#define LAS __attribute__((address_space(3)))
typedef unsigned short bf16_t;
typedef unsigned v4u __attribute__((ext_vector_type(4)));
typedef unsigned v2u __attribute__((ext_vector_type(2)));
typedef float f32x4 __attribute__((ext_vector_type(4)));

__device__ __forceinline__ float bf2f(unsigned v) { return __uint_as_float(v << 16); }
__device__ __forceinline__ unsigned f2bf(float f) { unsigned u = __float_as_uint(f); return (u + 0x7fffu + ((u >> 16) & 1u)) >> 16; }
__device__ __forceinline__ unsigned pk2(float lo, float hi) { return f2bf(lo) | (f2bf(hi) << 16); }
__device__ __forceinline__ float bflo(unsigned w) { return __uint_as_float(w << 16); }
__device__ __forceinline__ float bfhi(unsigned w) { return __uint_as_float(w & 0xffff0000u); }
__device__ __forceinline__ float wave_sum(float v) {
#pragma unroll
    for (int o = 1; o < 64; o <<= 1) v += __shfl_xor(v, o);
    return v;
}
__device__ __forceinline__ float dot8(v4u a, v4u w, float acc) {
    acc = fmaf(bflo(a.x), bflo(w.x), acc); acc = fmaf(bfhi(a.x), bfhi(w.x), acc);
    acc = fmaf(bflo(a.y), bflo(w.y), acc); acc = fmaf(bfhi(a.y), bfhi(w.y), acc);
    acc = fmaf(bflo(a.z), bflo(w.z), acc); acc = fmaf(bfhi(a.z), bfhi(w.z), acc);
    acc = fmaf(bflo(a.w), bflo(w.w), acc); acc = fmaf(bfhi(a.w), bfhi(w.w), acc);
    return acc;
}

#define XB_TMO      128
#define XB_XCNT(j)  (256  + 64 * (j))
#define XB_XSUB(j)  (1280 + 64 * (j))
#define XB_XGEN(j)  (2304 + 64 * (j))
#define XB_TOP      3328
#define XB_TOPGEN   3392
#define XCD_BAR_WORDS 3456
#define XB_SPIN_CAP (1u << 24)
__device__ __forceinline__ unsigned xb_ld(unsigned* p)              { return __hip_atomic_load(p, __ATOMIC_RELAXED, __HIP_MEMORY_SCOPE_AGENT); }
__device__ __forceinline__ unsigned xb_add(unsigned* p, unsigned v) { return __hip_atomic_fetch_add(p, v, __ATOMIC_RELAXED, __HIP_MEMORY_SCOPE_AGENT); }
__device__ __forceinline__ unsigned xb_xcc_id() { return (unsigned)__builtin_amdgcn_s_getreg((3 << 11) | 20) & 0xFu; }
#define XB_SPIN(cond, bar) do { unsigned _sp = 0; while (cond) { __builtin_amdgcn_s_sleep(1); \
    if ((++_sp & 255u) == 0u) { if (xb_ld(&(bar)[XB_TMO])) break; if (_sp > XB_SPIN_CAP) { atomicAdd(&(bar)[XB_TMO], 1u); break; } } } } while (0)
struct XcdBarrier { unsigned* bar; unsigned x; volatile LAS unsigned* st; };
__device__ __forceinline__ XcdBarrier xcd_barrier_post(unsigned* bar, volatile LAS unsigned* st) {
    XcdBarrier b; b.bar = bar; b.x = xb_xcc_id(); b.st = st;
    if (threadIdx.x == 0) (void)xb_add(&bar[XB_XCNT(b.x)], 1u);
    return b;
}
__device__ __forceinline__ void xcd_barrier_complete(unsigned* bar, unsigned x, unsigned& nloc, unsigned& nx) {
    const unsigned G = gridDim.x * gridDim.y * gridDim.z;
    unsigned sum, cnt, mine, sp = 0u;
    for (;;) {
        sum = 0u; cnt = 0u; mine = 0u;
#pragma unroll
        for (unsigned j = 0; j < 16; ++j) { const unsigned c = xb_ld(&bar[XB_XCNT(j)]); sum += c; cnt += (c > 0u) ? 1u : 0u; mine = (j == x) ? c : mine; }
        if (sum == G) break;
        __builtin_amdgcn_s_sleep(1);
        if ((++sp & 255u) == 0u) { if (xb_ld(&bar[XB_TMO])) break; if (sp > XB_SPIN_CAP) { atomicAdd(&bar[XB_TMO], 1u); break; } }
    }
    nloc = mine > 0u ? mine : 1u; nx = cnt > 0u ? cnt : 1u;
}
__device__ __forceinline__ void xcd_barrier(const XcdBarrier& b) {
    asm volatile("s_waitcnt vmcnt(0)" ::: "memory");
    __syncthreads();
    if (threadIdx.x == 0) {
        unsigned* bar = b.bar;
        __builtin_amdgcn_s_waitcnt(0);
        unsigned nloc = b.st[0], nx = b.st[1];
        if (nloc == 0u) { xcd_barrier_complete(bar, b.x, nloc, nx); b.st[0] = nloc; b.st[1] = nx; }
        const unsigned old = xb_add(&bar[XB_XSUB(b.x)], 1u);
        const unsigned gen = old / nloc;
        if (old + 1u == (gen + 1u) * nloc) {
            __builtin_amdgcn_fence(__ATOMIC_RELEASE, "agent");
            asm volatile("s_waitcnt vmcnt(0)" ::: "memory");
            const unsigned og = xb_add(&bar[XB_TOP], 1u);
            const unsigned tg = og / nx;
            if (og + 1u == (tg + 1u) * nx) xb_add(&bar[XB_TOPGEN], 1u);
            else XB_SPIN(xb_ld(&bar[XB_TOPGEN]) == tg, bar);
            __builtin_amdgcn_fence(__ATOMIC_ACQUIRE, "agent");
            xb_add(&bar[XB_XGEN(b.x)], 1u);
            asm volatile("s_waitcnt vmcnt(0)" ::: "memory");
        } else {
            XB_SPIN(xb_ld(&bar[XB_XGEN(b.x)]) == gen, bar);
            __builtin_amdgcn_fence(__ATOMIC_ACQUIRE, "agent");
            asm volatile("s_waitcnt vmcnt(0)" ::: "memory");
        }
    }
    __syncthreads();
}

namespace pg8 {
typedef short bf16x8 __attribute__((ext_vector_type(8)));
typedef int v4i __attribute__((ext_vector_type(4)));
typedef int v8i __attribute__((ext_vector_type(8)));
constexpr int BM = 256, BK = 64, HALF = 128, HTB = HALF * BK * 2, NXCD = 8, WGM = 1, KD = 1024, NT = KD / BK;
__device__ __forceinline__ int lds_byte(int r, int c) { const int st = (r >> 4) * 2 + (c >> 5), rr = r & 15, cc = c & 31, ob = rr * 64 + cc * 2; return st * 1024 + (ob ^ (((ob >> 9) & 1) << 5)); }
__device__ __forceinline__ void stage_rc(int b, int& R, int& C) { const int st = b / 1024, sb = b % 1024, swz = sb ^ (((sb >> 9) & 1) << 5); R = (st >> 1) * 16 + swz / 64; C = (st & 1) * 32 + (swz % 64) / 2; }
__device__ __forceinline__ int perm32(int rho) { const int n = rho >> 4, i = rho & 15; return 8 * (i >> 2) + 4 * n + (i & 3); }
__device__ __forceinline__ unsigned cvt_pk_bf16(float lo, float hi) { unsigned r; asm volatile("v_cvt_pk_bf16_f32 %0, %1, %2" : "=v"(r) : "v"(lo), "v"(hi)); return r; }

struct Unit { int pm, pn, brow, e, r0, cnt; };

__device__ __forceinline__ void tile_order(int L, int nM, int nN, int& pm, int& pn) {
    const int nwg = nM * nN; int wgid = L; { const int q = nwg / NXCD, r = nwg % NXCD, xcd = wgid % NXCD, off = wgid / NXCD; wgid = (xcd < r ? xcd * (q + 1) : r * (q + 1) + (xcd - r) * q) + off; }
    const int nig = WGM * nN, gid = wgid / nig, fm = gid * WGM, gsz = (nM - fm) < WGM ? (nM - fm) : WGM;
    pm = fm + ((wgid % nig) % gsz); pn = (wgid % nig) / gsz;
}
struct SchedDense {
    int nM, nN, G, c;
    __device__ __forceinline__ bool next(int i, Unit& u) const { const long L = (long)i * G + c; if (L >= (long)nM * nN) return false; tile_order((int)L, nM, nN, u.pm, u.pn); u.brow = u.pn * BM; u.e = 0; u.r0 = 0; u.cnt = 0; return true; }
    __device__ __forceinline__ unsigned arow_tok(const Unit&, int) const { return 0u; }
};

template <class Epi, class Sched, bool GATHER, bool F8 = false>
__device__ __forceinline__ void gemm_phase(LAS unsigned char* lds, const bf16_t* A, const bf16_t* Bt, const Sched& S, const Epi& E) {
    const int tid = threadIdx.x, wid = __builtin_amdgcn_readfirstlane(tid >> 6), lane = tid & 63, wr = wid >> 2, wc = wid & 3, fr = lane & 15, fq = lane >> 4;
    constexpr int K = F8 ? KD / 2 : KD, nt = F8 ? NT / 2 : NT;
    unsigned voffA[2], voffB[2];
#pragma unroll
    for (int i = 0; i < 2; ++i) { int R, C; stage_rc(tid * 16 + i * 8192, R, C); const int Rb = Epi::PERM ? ((R & ~31) + perm32(R & 31)) : R;
        voffA[i] = GATHER ? (unsigned)(C * 2) : (unsigned)(R * K + C) * 2u; voffB[i] = (unsigned)(Rb * K + C) * 2u; }
    constexpr size_t kstep = (size_t)(BK * 2), hstep = (size_t)HALF * K * 2, tstep = 2 * hstep;
    const unsigned ldsw = (unsigned)wid * 1024u;
    const int aoff = lds_byte(wr * 64 + fr, fq * 8), boff = lds_byte(wc * 32 + fr, fq * 8);
#define PG8_SA(b, h) (((b) * 2 + (h)) * HTB)
#define PG8_SB(b, h) ((4 + (b) * 2 + (h)) * HTB)
#define PG8_STAGE_B(bufoff, gbase) do { _Pragma("unroll") for (int _i = 0; _i < 2; ++_i) \
        __builtin_amdgcn_global_load_lds((const unsigned*)((const char*)(gbase) + voffB[_i]), (LAS unsigned*)(lds + (bufoff) + ldsw + _i * 8192), 16, 0, 0); } while (0)
#define PG8_STAGE_A(bufoff, h, kb, nx) do { _Pragma("unroll") for (int _i = 0; _i < 2; ++_i) { \
        const char* _src = GATHER ? (const char*)A + (((((nx) ? ron[h] : roc[h]) >> (16 * _i)) & 0xffffu) << (F8 ? 10 : 11)) + voffA[0] + (kb) : ((nx) ? nA : cA) + (size_t)(h) * hstep + (kb) + voffA[_i]; \
        __builtin_amdgcn_global_load_lds((const unsigned*)_src, (LAS unsigned*)(lds + (bufoff) + ldsw + _i * 8192), 16, 0, 0); } } while (0)
#define PG8_LDA(dst, b, h) do { _Pragma("unroll") for (int m = 0; m < 4; ++m) { if constexpr (F8) { dst##8[m].lo = *(const LAS v4i*)(lds + PG8_SA(b, h) + aoff + m * 2048); dst##8[m].hi = *(const LAS v4i*)(lds + PG8_SA(b, h) + aoff + m * 2048 + 1024); } \
        else { _Pragma("unroll") for (int k = 0; k < 2; ++k) dst[m][k] = *(const LAS bf16x8*)(lds + PG8_SA(b, h) + aoff + m * 2048 + k * 1024); } } } while (0)
#define PG8_LDB(dst, b, h) do { _Pragma("unroll") for (int n = 0; n < 2; ++n) { if constexpr (F8) { dst##8[n].lo = *(const LAS v4i*)(lds + PG8_SB(b, h) + boff + n * 2048); dst##8[n].hi = *(const LAS v4i*)(lds + PG8_SB(b, h) + boff + n * 2048 + 1024); } \
        else { _Pragma("unroll") for (int k = 0; k < 2; ++k) dst[n][k] = *(const LAS bf16x8*)(lds + PG8_SB(b, h) + boff + n * 2048 + k * 1024); } } } while (0)
#define PG8_MMA(ai, bj, At, Bt_) do { __builtin_amdgcn_s_setprio(1); _Pragma("unroll") for (int m = 0; m < 4; ++m) _Pragma("unroll") for (int n = 0; n < 2; ++n) { \
        if constexpr (F8) { asm volatile("v_mfma_scale_f32_16x16x128_f8f6f4 %0, %1, %2, %0, %3, %3 op_sel_hi:[0,0,0]" : "+v"(acc[ai][bj][m][n]) : "v"(Bt_##8[n]), "v"(At##8[m]), "v"(sc8)); } \
        else { _Pragma("unroll") for (int k = 0; k < 2; ++k) acc[ai][bj][m][n] = __builtin_amdgcn_mfma_f32_16x16x32_bf16(Bt_[n][k], At[m][k], acc[ai][bj][m][n], 0, 0, 0); } } \
        __builtin_amdgcn_s_setprio(0); } while (0)
#define PG8_WAIT_V(n) asm volatile("s_waitcnt vmcnt(" #n ")" ::: "memory")
#define PG8_WAIT_L(n) asm volatile("s_waitcnt lgkmcnt(" #n ")" ::: "memory")
#define PG8_BAR __builtin_amdgcn_s_barrier()
#define PG8_SCHED __builtin_amdgcn_sched_barrier(0)
#define PG8_LOAD_RO(dst, unit) do { int _R, _C; stage_rc((int)threadIdx.x * 16, _R, _C); _Pragma("unroll") for (int _h = 0; _h < 2; ++_h) dst[_h] = S.arow_tok(unit, _h * HALF + _R) | (S.arow_tok(unit, _h * HALF + _R + 64) << 16); } while (0)
    Unit cur, nxt; int ui = 0;
    if (!S.next(0, cur)) return;
    f32x4 acc[2][2][4][2];
#pragma unroll
    for (int a = 0; a < 2; ++a)
#pragma unroll
        for (int b = 0; b < 2; ++b)
#pragma unroll
            for (int m = 0; m < 4; ++m)
#pragma unroll
                for (int n = 0; n < 2; ++n) acc[a][b][m][n] = (f32x4){0.f, 0.f, 0.f, 0.f};
    if (Epi::HAS_INIT) { const typename Epi::Init i0 = E.init(cur, wr, wc, fr, fq);
#pragma unroll
      for (int a = 0; a < 2; ++a)
#pragma unroll
        for (int b = 0; b < 2; ++b)
#pragma unroll
            for (int m = 0; m < 4; ++m)
#pragma unroll
                for (int n = 0; n < 2; ++n) acc[a][b][m][n] = i0.v[b][n]; }
    unsigned sc8 = 0x7c7c7c7cu; asm volatile("" : "+v"(sc8));
    bf16x8 At[4][2], B0[2][2], B1[2][2]; v8i At8[4], B08[2], B18[2];
    unsigned roc[2] = {0u, 0u}, ron[2] = {0u, 0u};
    bool has_next = S.next(1, nxt);
    if (GATHER) { PG8_LOAD_RO(roc, cur); if (has_next) { PG8_LOAD_RO(ron, nxt); } else { ron[0] = roc[0]; ron[1] = roc[1]; } }
    const char* cA = (const char*)A + (GATHER ? (size_t)0 : (size_t)cur.pm * tstep); const char* cB = (const char*)Bt + (size_t)cur.brow * K * 2;
    const char* nA = cA;
    PG8_STAGE_B(PG8_SB(0, 0), cB); PG8_STAGE_B(PG8_SB(0, 1), cB + hstep); PG8_STAGE_A(PG8_SA(0, 0), 0, 0, false); PG8_STAGE_A(PG8_SA(0, 1), 1, 0, false);
    if (wr == 1) PG8_BAR;
    PG8_WAIT_V(2); PG8_BAR;
    PG8_STAGE_B(PG8_SB(1, 0), cB + kstep); PG8_STAGE_A(PG8_SA(1, 0), 0, kstep, false); PG8_STAGE_B(PG8_SB(1, 1), cB + hstep + kstep);
    PG8_WAIT_V(6); PG8_BAR;
    for (;;) {
        nA = (has_next && !GATHER) ? (const char*)A + (size_t)nxt.pm * tstep : cA;
        const char* nB = has_next ? (const char*)Bt + (size_t)nxt.brow * K * 2 : cB;
#pragma unroll 1
        for (int t = 0; t < nt; t += 2) {
            const bool last = (t == nt - 2);
            const size_t k1 = (size_t)(t + 1) * kstep, k2 = last ? (size_t)0 : (size_t)(t + 2) * kstep, k3 = k2 + kstep;
            const char* b2 = last ? nB : cB + (size_t)(t + 2) * kstep; const char* b3 = b2 + kstep;
            PG8_LDB(B0, 0, 0); PG8_LDB(B1, 0, 1); PG8_SCHED; PG8_LDA(At, 0, 0); PG8_STAGE_A(PG8_SA(1, 1), 1, k1, false);
            PG8_WAIT_V(8); PG8_WAIT_L(0); PG8_BAR; PG8_MMA(0, 0, At, B0); PG8_MMA(0, 1, At, B1); PG8_BAR; PG8_SCHED;
            PG8_LDA(At, 0, 1); PG8_STAGE_B(PG8_SB(0, 0), b2); PG8_STAGE_B(PG8_SB(0, 1), b2 + hstep); PG8_STAGE_A(PG8_SA(0, 0), 0, k2, last);
            PG8_WAIT_V(8); PG8_WAIT_L(0); PG8_BAR; PG8_MMA(1, 0, At, B0); PG8_MMA(1, 1, At, B1); PG8_BAR; PG8_SCHED;
            PG8_LDB(B0, 1, 0); PG8_LDB(B1, 1, 1); PG8_SCHED; PG8_LDA(At, 1, 0); PG8_STAGE_A(PG8_SA(0, 1), 1, k2, last);
            PG8_WAIT_V(8); PG8_WAIT_L(0); PG8_BAR; PG8_MMA(0, 0, At, B0); PG8_MMA(0, 1, At, B1); PG8_BAR; PG8_SCHED;
            PG8_LDA(At, 1, 1); PG8_STAGE_B(PG8_SB(1, 0), b3); PG8_STAGE_B(PG8_SB(1, 1), b3 + hstep); PG8_STAGE_A(PG8_SA(1, 0), 0, k3, last);
            PG8_WAIT_V(8); PG8_WAIT_L(0); PG8_BAR; PG8_MMA(1, 0, At, B0); PG8_MMA(1, 1, At, B1); PG8_BAR; PG8_SCHED;
        }
        const typename Epi::Pre pre = E.pre(cur, wr, wc, fr, fq);
        typename Epi::Init inx = typename Epi::Init(); if (Epi::HAS_INIT && has_next) inx = E.init(nxt, wr, wc, fr, fq);
        Unit nn; bool has_nn = false; unsigned rnn[2] = {0u, 0u};
        if (has_next) { has_nn = S.next(ui + 2, nn); if (GATHER && has_nn) { PG8_LOAD_RO(rnn, nn); } }
        if (wr == 0) PG8_BAR;
        if constexpr (F8) asm volatile("s_nop 15\n\ts_nop 15" ::: "memory");
        E(acc, cur, wr, wc, fr, fq, pre);
        if (!has_next) break;
#pragma unroll
        for (int a = 0; a < 2; ++a)
#pragma unroll
            for (int b = 0; b < 2; ++b)
#pragma unroll
                for (int m = 0; m < 4; ++m)
#pragma unroll
                    for (int n = 0; n < 2; ++n) acc[a][b][m][n] = Epi::HAS_INIT ? inx.v[b][n] : (f32x4){0.f, 0.f, 0.f, 0.f};
        cur = nxt; cA = nA; cB = nB; ++ui;
        has_next = has_nn; nxt = nn;
        if (GATHER) { roc[0] = ron[0]; roc[1] = ron[1]; if (has_next) { ron[0] = rnn[0]; ron[1] = rnn[1]; } }
        if (wr == 1) PG8_BAR;
    }
    PG8_WAIT_V(0);
    PG8_BAR;
#undef PG8_SA
#undef PG8_SB
#undef PG8_STAGE_A
#undef PG8_STAGE_B
#undef PG8_LDA
#undef PG8_LDB
#undef PG8_MMA
#undef PG8_WAIT_V
#undef PG8_WAIT_L
#undef PG8_BAR
#undef PG8_SCHED
#undef PG8_LOAD_RO
}

struct EpiPlainBf16 {
    static constexpr bool PERM = true;
    bf16_t* O; int ldc;
    static constexpr bool HAS_INIT = false; struct Init { f32x4 v[2][2]; };
    __device__ __forceinline__ Init init(const Unit&, int, int, int, int) const { return Init(); }
    struct Pre {};
    __device__ __forceinline__ Pre pre(const Unit&, int, int, int, int) const { return Pre{}; }
    __device__ __forceinline__ void operator()(const f32x4 (&acc)[2][2][4][2], const Unit& u, int wr, int wc, int fr, int fq, const Pre&) const {
        const int row0 = u.pm * BM + wr * 64 + fr, col0 = u.pn * BM + wc * 32 + 8 * fq;
#pragma unroll
        for (int ai = 0; ai < 2; ++ai)
#pragma unroll
            for (int m = 0; m < 4; ++m) { bf16_t* rowp = O + (size_t)(row0 + ai * HALF + m * 16) * ldc + col0;
#pragma unroll
                for (int bj = 0; bj < 2; ++bj) { const f32x4 v0 = acc[ai][bj][m][0], v1 = acc[ai][bj][m][1];
                    v4u w; w.x = cvt_pk_bf16(v0[0], v0[1]); w.y = cvt_pk_bf16(v0[2], v0[3]); w.z = cvt_pk_bf16(v1[0], v1[1]); w.w = cvt_pk_bf16(v1[2], v1[3]);
                    *(v4u*)(rowp + bj * HALF) = w; } }
    }
};

struct SchedInProj {
    int G, c;
    __device__ __forceinline__ bool next(int i, Unit& u) const {
        const int L = i * G + c;
        if (L < 1152) { int lt, pn; tile_order(L, 128, 9, lt, pn); u.pm = (lt >> 3) * 9 + 1 + (lt & 7); u.pn = pn; }
        else if (L < 1216) { const int q = L - 1152, ct = q >> 2, j = q & 3; u.pm = ct * 9; u.pn = (j == 3) ? 8 : 1 + j; }
        else return false;
        u.brow = u.pn * BM; u.e = 0; u.r0 = 0; u.cnt = 0; return true;
    }
    __device__ __forceinline__ unsigned arow_tok(const Unit&, int) const { return 0u; }
};
struct EpiInProj {
    static constexpr bool PERM = false;
    unsigned char* ws; const float* qng; const float* kng; const float* rope;
    static constexpr bool HAS_INIT = false; struct Init { f32x4 v[2][2]; };
    __device__ __forceinline__ Init init(const Unit&, int, int, int, int) const { return Init(); }
    struct Pre {};
    __device__ __forceinline__ Pre pre(const Unit&, int, int, int, int) const { return Pre{}; }
    __device__ __forceinline__ void operator()(const f32x4 (&acc)[2][2][4][2], const Unit& u, int wr, int wc, int fr, int fq, const Pre&) const {
        const int g = u.pn * 4 + wc, bt = u.pm / 9, pt = u.pm % 9; const bool isctx = (pt == 0);
        const int blk = fq >> 1, f1 = fq & 1, dbase = 32 * blk + 8 * f1;
        const bool do_rms = (g >= 24 && g < 34), do_rope = !isctx && (g < 8 || (g >= 24 && g < 34)), latrows = (g < 4) || (g >= 16 && g < 32);
        const float scale = (g >= 4 && g < 8) ? 0.125f : ((g >= 24 && g < 32) ? C2 : 1.0f);
        bf16_t* dst; int pitch;
        if (g < 4) { dst = (bf16_t*)(ws + WS_RQ) + g * 64; pitch = 256; }
        else if (g < 8) { dst = (bf16_t*)(ws + WS_RK) + (g - 4) * 64; pitch = 256; }
        else if (g < 16) { dst = (bf16_t*)(ws + WS_RV) + (g - 8) * 64; pitch = 512; }
        else if (g < 24) { dst = (bf16_t*)(ws + WS_RG) + (g - 16) * 64; pitch = 512; }
        else if (g < 32) { dst = (bf16_t*)(ws + WS_AQ) + (g - 24) * 64; pitch = 512; }
        else if (g < 34) { dst = (bf16_t*)(ws + WS_AK) + (g - 32) * 64; pitch = 128; }
        else { dst = (bf16_t*)(ws + WS_AV) + (g - 34) * 64; pitch = 128; }
        const int rowbase = latrows ? bt * SEQ + (pt - 1) * 256 : u.pm * 256;
        dst += dbase;
        f32x4 gv[2][2];
#pragma unroll
        for (int bj = 0; bj < 2; ++bj)
#pragma unroll
            for (int n = 0; n < 2; ++n) gv[bj][n] = do_rms ? *(const f32x4*)((g < 32 ? qng : kng) + dbase + 16 * bj + 4 * n) : (f32x4){1.f, 1.f, 1.f, 1.f};
#pragma unroll
        for (int ai = 0; ai < 2; ++ai)
#pragma unroll
            for (int m = 0; m < 4; ++m) {
                const int r = ai * HALF + wr * 64 + m * 16 + fr;
                f32x4 v[2][2];
#pragma unroll
                for (int bj = 0; bj < 2; ++bj)
#pragma unroll
                    for (int n = 0; n < 2; ++n) v[bj][n] = acc[ai][bj][m][n];
                if (do_rms) {
                    float ss = 0.f;
#pragma unroll
                    for (int bj = 0; bj < 2; ++bj)
#pragma unroll
                        for (int n = 0; n < 2; ++n) ss += (v[bj][n][0] * v[bj][n][0] + v[bj][n][1] * v[bj][n][1]) + (v[bj][n][2] * v[bj][n][2] + v[bj][n][3] * v[bj][n][3]);
                    ss += __shfl_xor(ss, 16); ss += __shfl_xor(ss, 32);
                    const float rinv = 1.0f / sqrtf(ss * (1.0f / 64.0f) + LN_EPS);
#pragma unroll
                    for (int bj = 0; bj < 2; ++bj)
#pragma unroll
                        for (int n = 0; n < 2; ++n) v[bj][n] = v[bj][n] * rinv * gv[bj][n];
                }
                if (do_rope) {
                    const int t = (pt - 1) * 256 + r, pos = blk ? (t & 63) : (t >> 6);
                    const f32x4* rp = (const f32x4*)(rope + pos * 32 + 16 * f1);
#pragma unroll
                    for (int n = 0; n < 2; ++n) { const f32x4 p0 = rp[2 * n], p1 = rp[2 * n + 1];
                        const f32x4 lo = v[0][n], hi = v[1][n];
                        const f32x4 cs = {p0[0], p0[2], p1[0], p1[2]}, sn = {p0[1], p0[3], p1[1], p1[3]};
                        v[0][n] = lo * cs - hi * sn; v[1][n] = hi * cs + lo * sn; }
                }
                bf16_t* rowp = dst + (size_t)(rowbase + r) * pitch;
#pragma unroll
                for (int bj = 0; bj < 2; ++bj) { const f32x4 v0 = v[bj][0] * scale, v1 = v[bj][1] * scale;
                    v4u w; w.x = cvt_pk_bf16(v0[0], v0[1]); w.y = cvt_pk_bf16(v0[2], v0[3]); w.z = cvt_pk_bf16(v1[0], v1[1]); w.w = cvt_pk_bf16(v1[2], v1[3]);
                    *(v4u*)(rowp + 16 * bj) = w; }
            }
    }
};

struct SchedMoE {
    int nN, NB, G, c; const LAS int* tab; const v2u* LIST;
    __device__ __forceinline__ bool next(int i, Unit& u) const {
        const int ntiles = __builtin_amdgcn_readfirstlane(tab[32]); const long L = (long)i * G + c; if (L >= (long)ntiles * nN) return false;
        tile_order((int)L, ntiles, nN, u.pm, u.pn);
        const int ln = (int)(threadIdx.x & 63u); const int tq = (ln >= 1 && ln < 32) ? tab[ln] : 0x7fffffff;
        const int e = __builtin_popcountll(__ballot(u.pm >= tq));
        u.e = e; u.r0 = (u.pm - __builtin_amdgcn_readfirstlane(tab[e])) * 256; u.cnt = __builtin_amdgcn_readfirstlane(tab[33 + e]); u.brow = e * NB + u.pn * BM; return true;
    }
    __device__ __forceinline__ unsigned arow_tok(const Unit& u, int r) const { int rr = u.r0 + r; rr = rr < u.cnt ? rr : u.cnt - 1; return LIST[(size_t)u.e * LISTCAP + rr].x >> 2; }
};
__device__ __forceinline__ void moe_build_tab(LAS int* tab, const unsigned* CNT) {
    if (threadIdx.x == 0) { int st = 0; for (int e = 0; e < 32; ++e) { const int c = (int)CNT[e]; tab[e] = st; tab[33 + e] = c; st += (c + 255) >> 8; } tab[32] = st; }
    __syncthreads();
}
struct EpiUp {
    static constexpr bool PERM = true;
    unsigned char* ACT; const float* bup;
    static constexpr bool HAS_INIT = true; struct Init { f32x4 v[2][2]; };
    __device__ __forceinline__ Init init(const Unit& u, int wr, int wc, int fr, int fq) const {
        const float* bg = bup + (size_t)u.e * 2048 + u.pn * 128 + wc * 32 + 8 * fq; Init i; i.v[0][0] = *(const f32x4*)bg; i.v[0][1] = *(const f32x4*)(bg + 4); i.v[1][0] = *(const f32x4*)(bg + 1024) + 1.0f; i.v[1][1] = *(const f32x4*)(bg + 1028) + 1.0f; return i; }
    struct Pre {};
    __device__ __forceinline__ Pre pre(const Unit&, int, int, int, int) const { return Pre{}; }
    __device__ __forceinline__ void operator()(const f32x4 (&acc)[2][2][4][2], const Unit& u, int wr, int wc, int fr, int fq, const Pre&) const {
        const int colt = u.pn * 128 + wc * 32 + 8 * fq;
#pragma unroll
        for (int ai = 0; ai < 2; ++ai)
#pragma unroll
            for (int m = 0; m < 4; ++m) {
                const int row = u.pm * BM + ai * HALF + wr * 64 + m * 16 + fr;
                f32x4 ag[2] = {acc[ai][0][m][0], acc[ai][0][m][1]}, al[2] = {acc[ai][1][m][0], acc[ai][1][m][1]};
                asm volatile("" : "+v"(ag[0]), "+v"(ag[1]), "+v"(al[0]), "+v"(al[1]));
                float o[8];
#pragma unroll
                for (int n = 0; n < 2; ++n)
#pragma unroll
                    for (int j = 0; j < 4; ++j) { const float gl = fminf(ag[n][j], 7.0f); const float l1 = __builtin_amdgcn_fmed3f(al[n][j], -6.0f, 8.0f);
                        o[4 * n + j] = (gl * l1) * __builtin_amdgcn_rcpf(1.0f + __builtin_amdgcn_exp2f(-1.702f * 1.4426950408889634f * gl)); }
                v2u w; w.x = 0u; w.y = 0u;
                w.x = __builtin_amdgcn_cvt_pk_fp8_f32(o[0], o[1], w.x, false); w.x = __builtin_amdgcn_cvt_pk_fp8_f32(o[2], o[3], w.x, true);
                w.y = __builtin_amdgcn_cvt_pk_fp8_f32(o[4], o[5], w.y, false); w.y = __builtin_amdgcn_cvt_pk_fp8_f32(o[6], o[7], w.y, true);
                *(v2u*)(ACT + (size_t)row * 1024 + colt) = w;
            }
    }
};
struct EpiDown {
    static constexpr bool PERM = true;
    bf16_t* YE; const float* bdn; const v2u* LIST;
    static constexpr bool HAS_INIT = true; struct Init { f32x4 v[2][2]; };
    __device__ __forceinline__ Init init(const Unit& u, int wr, int wc, int fr, int fq) const {
        Init i; const float* bb = bdn + (size_t)u.e * 1024 + u.pn * BM + wc * 32 + 8 * fq;
#pragma unroll
        for (int bj = 0; bj < 2; ++bj)
#pragma unroll
            for (int n = 0; n < 2; ++n) i.v[bj][n] = *(const f32x4*)(bb + bj * HALF + 4 * n);
        return i; }
    struct Pre { v2u ent[2][4]; };
    __device__ __forceinline__ Pre pre(const Unit& u, int wr, int wc, int fr, int fq) const {
        Pre p;
#pragma unroll
        for (int ai = 0; ai < 2; ++ai)
#pragma unroll
            for (int m = 0; m < 4; ++m) { const int rr = u.r0 + ai * HALF + wr * 64 + m * 16 + fr; p.ent[ai][m] = LIST[(size_t)u.e * LISTCAP + (rr < u.cnt ? rr : u.cnt - 1)]; }
        return p;
    }
    __device__ __forceinline__ void operator()(const f32x4 (&acc)[2][2][4][2], const Unit& u, int wr, int wc, int fr, int fq, const Pre& P) const {
        const int col0 = u.pn * BM + wc * 32 + 8 * fq;
#pragma unroll
        for (int ai = 0; ai < 2; ++ai)
#pragma unroll
            for (int m = 0; m < 4; ++m) {
                const int rr = u.r0 + ai * HALF + wr * 64 + m * 16 + fr; const bool valid = rr < u.cnt;
                const v2u ent = P.ent[ai][m]; const float gate = __uint_as_float(ent.y);
                unsigned char* rowp = (unsigned char*)YE + (size_t)ent.x * 1024 + col0;
                const float g64 = gate * 64.0f;
#pragma unroll
                for (int bj = 0; bj < 2; ++bj) { f32x4 a0 = acc[ai][bj][m][0], a1 = acc[ai][bj][m][1]; asm volatile("" : "+v"(a0), "+v"(a1));
                    const f32x4 v0 = a0 * g64, v1 = a1 * g64;
                    v2u w; w.x = 0u; w.y = 0u;
                    w.x = __builtin_amdgcn_cvt_pk_fp8_f32(v0[0], v0[1], w.x, false); w.x = __builtin_amdgcn_cvt_pk_fp8_f32(v0[2], v0[3], w.x, true);
                    w.y = __builtin_amdgcn_cvt_pk_fp8_f32(v1[0], v1[1], w.y, false); w.y = __builtin_amdgcn_cvt_pk_fp8_f32(v1[2], v1[3], w.y, true);
                    if (valid) *(v2u*)(rowp + bj * HALF) = w; }
            }
    }
};
}

#include <hip/hip_bf16.h>
#include <cmath>
namespace attn_body {
using bf16=__hip_bfloat16;
using bf16x8=__attribute__((ext_vector_type(8)))short;
using s16x4=__attribute__((ext_vector_type(4)))short;
using f32x16=__attribute__((ext_vector_type(16)))float;
using u32x4=__attribute__((ext_vector_type(4)))unsigned;
constexpr int D=64,QP=512,KP=128,OP=1024,SEQQ=2048,SEQK=2304;
constexpr int NW=8,QBLK=32,QB=QBLK*NW,KVBLK=64,NQB=SEQQ/QB;
constexpr int ATTN_UNIT_ROWS=QB;
__device__ __forceinline__ int crow(int r,int hi){return (r&3)+8*(r>>2)+4*hi;}
#define SBAR() __builtin_amdgcn_sched_barrier(0)
__device__ __forceinline__ void cmask(f32x16&p0,f32x16&p1,int jb,int qrel,int hi){
  const float NEG=-INFINITY; int kb=64*jb+4*hi;
  #pragma unroll
  for(int r=0;r<16;++r){int kv=kb+(r&3)+8*(r>>2); if(kv>qrel)p0[r]=NEG; if(kv+32>qrel)p1[r]=NEG;}
}

constexpr int NSLOT=3, SLOTB=8192;
constexpr int LDS_K=0, LDS_V=NSLOT*SLOTB, LDS_WS=2*NSLOT*SLOTB, LDS_OST=LDS_WS+NW*64*4, LDS_BYTES=LDS_OST+NW*4096;
constexpr float C2=0.125f*1.4426950408889634f;
__device__ __forceinline__ void glds16(const void*gsrc,unsigned lds_dst){unsigned keep;
  asm volatile("s_mov_b32 %0, m0\n\ts_mov_b32 m0, %2\n\ts_nop 0\n\tglobal_load_lds_dwordx4 %1, off\n\ts_mov_b32 m0, %0":"=&s"(keep):"v"(gsrc),"s"(lds_dst):"memory");}
__device__ __forceinline__ float max3f(float a,float b,float c){float r;asm("v_max3_f32 %0, %1, %2, %3":"=v"(r):"v"(a),"v"(b),"v"(c));return r;}
__device__ __forceinline__ float max2f(float a,float b){float r;asm("v_max_f32_e32 %0, %1, %2":"=v"(r):"v"(a),"v"(b));return r;}
__device__ __forceinline__ float fadd_s(float a,float b){float r;asm("v_add_f32_e32 %0, %1, %2":"=v"(r):"v"(a),"v"(b));return r;}
__device__ __forceinline__ float fsub_s(float a,float b){float r;asm("v_sub_f32_e32 %0, %1, %2":"=v"(r):"v"(a),"v"(b));return r;}
typedef float f32x2_t __attribute__((ext_vector_type(2))); typedef __bf16 bf16x2_t __attribute__((ext_vector_type(2)));
__device__ __forceinline__ unsigned cvtpk_s(float lo,float hi){f32x2_t v={lo,hi};bf16x2_t b=__builtin_convertvector(v,bf16x2_t);return __builtin_bit_cast(unsigned,b);}
#define WAIT_BAR(N) asm volatile("s_waitcnt vmcnt(" #N ") lgkmcnt(0)\n\ts_barrier":::"memory")

__device__ __forceinline__ void qkt(f32x16&p0,f32x16&p1,const char*Kslot,const bf16x8*qr,const f32x16&negm,int r32,int hi){
  const char*kb=Kslot+hi*1024+r32*16;
  #pragma unroll
  for(int d0=0;d0<4;++d0){
    const bf16x8 b0=*reinterpret_cast<const bf16x8*>(kb+d0*2048);
    const bf16x8 b1=*reinterpret_cast<const bf16x8*>(kb+d0*2048+512);
    if(d0==0){p0=__builtin_amdgcn_mfma_f32_32x32x16_bf16(b0,qr[0],negm,0,0,0);p1=__builtin_amdgcn_mfma_f32_32x32x16_bf16(b1,qr[0],negm,0,0,0);}
    else{p0=__builtin_amdgcn_mfma_f32_32x32x16_bf16(b0,qr[d0],p0,0,0,0);p1=__builtin_amdgcn_mfma_f32_32x32x16_bf16(b1,qr[d0],p1,0,0,0);}}
}
typedef __attribute__((address_space(3))) const char* lds_cptr;
typedef short v4i16_t __attribute__((ext_vector_type(4)));
__device__ __forceinline__ void kload8(bf16x8*kf,lds_cptr kp){
  kf[0]=*(const __attribute__((address_space(3))) bf16x8*)(kp);      kf[1]=*(const __attribute__((address_space(3))) bf16x8*)(kp+512);
  kf[2]=*(const __attribute__((address_space(3))) bf16x8*)(kp+2048); kf[3]=*(const __attribute__((address_space(3))) bf16x8*)(kp+2560);
  kf[4]=*(const __attribute__((address_space(3))) bf16x8*)(kp+4096); kf[5]=*(const __attribute__((address_space(3))) bf16x8*)(kp+4608);
  kf[6]=*(const __attribute__((address_space(3))) bf16x8*)(kp+6144); kf[7]=*(const __attribute__((address_space(3))) bf16x8*)(kp+6656);
}
__device__ __forceinline__ void kload2(bf16x8*kf,lds_cptr kp,int j){ kf[2*j]=*(const __attribute__((address_space(3))) bf16x8*)(kp+j*2048); kf[2*j+1]=*(const __attribute__((address_space(3))) bf16x8*)(kp+j*2048+512); }
__device__ __forceinline__ s16x4 vtr(lds_cptr p){ return __builtin_bit_cast(s16x4,__builtin_amdgcn_ds_read_tr16_b64_v4i16((__attribute__((address_space(3))) v4i16_t*)p)); }
__device__ __forceinline__ float rowmax(const f32x16&p0,const f32x16&p1){
  float a=max3f(p0[0],p0[1],p1[0]),b=max3f(p0[2],p0[3],p1[1]);a=max3f(a,p1[2],p1[3]);
  #pragma unroll
  for(int r=4;r<16;r+=4){a=max3f(a,p0[r],p0[r+1]);b=max3f(b,p0[r+2],p0[r+3]);a=max3f(a,p1[r],p1[r+1]);b=max3f(b,p1[r+2],p1[r+3]);}
  const float m=max2f(a,b);
  auto rr=__builtin_amdgcn_permlane32_swap(__float_as_uint(m),__float_as_uint(m),false,false);
  return max2f(__uint_as_float(rr[0]),__uint_as_float(rr[1]));
}
__device__ __forceinline__ void pv(f32x16*o,int vb,bf16x8 pa0,bf16x8 pa1,bf16x8 pa2,bf16x8 pa3){
  #pragma unroll
  for(int d0=0;d0<2;++d0){s16x4 lo[4],hi[4];
    #pragma unroll
    for(int ks=0;ks<4;++ks){
      asm volatile("ds_read_b64_tr_b16 %0,%1 offset:%c2":"=&v"(lo[ks]):"v"(vb),"i"(d0*4096+ks*1024):"memory");
      asm volatile("ds_read_b64_tr_b16 %0,%1 offset:%c2":"=&v"(hi[ks]):"v"(vb),"i"(d0*4096+ks*1024+512):"memory");}
    asm volatile("s_waitcnt lgkmcnt(0)":::"memory");SBAR();
    #define PK(k) (bf16x8){lo[k][0],lo[k][1],lo[k][2],lo[k][3],hi[k][0],hi[k][1],hi[k][2],hi[k][3]}
    o[d0]=__builtin_amdgcn_mfma_f32_32x32x16_bf16(pa0,PK(0),o[d0],0,0,0);
    o[d0]=__builtin_amdgcn_mfma_f32_32x32x16_bf16(pa1,PK(1),o[d0],0,0,0);
    o[d0]=__builtin_amdgcn_mfma_f32_32x32x16_bf16(pa2,PK(2),o[d0],0,0,0);
    o[d0]=__builtin_amdgcn_mfma_f32_32x32x16_bf16(pa3,PK(3),o[d0],0,0,0);
    #undef PK
  }
}

#ifndef ATTN_STORE16
#define ATTN_STORE16(p,v) (*(u32x4*)(p)=(v))
#endif
template<int THRL> __device__ __forceinline__ void attn_unit(int b,int h,int qb,const bf16*Q,const bf16*__restrict__ K,const bf16*__restrict__ V,bf16*O,char*shm,float refB){
  const int tid=threadIdx.x,lane=tid&63,r32=lane&31,hi=lane>>5; const int wid=__builtin_amdgcn_readfirstlane(tid>>6);
  const long rowq=(long)b*SEQQ,rowk=(long)b*SEQK; const int q0=qb*QB;
  const bf16*Qw=Q+(rowq+q0+wid*QBLK)*QP+h*D;
  const bf16*Kh=K+rowk*KP+(h>>2)*D,*Vh=V+rowk*KP+(h>>2)*D;
  const unsigned lds0=(unsigned)(uintptr_t)shm;
  float*wsf=(float*)(shm+LDS_WS)+wid*64;
  const bf16*ksrc=Kh+(long)lane*KP+wid*8;
  const bf16*vsrc=Vh+(long)(16*(wid&3)+(lane>>2))*KP+(wid>>2)*32+(lane&3)*8;
  const unsigned kdst=lds0+LDS_K+wid*1024, vdst=lds0+LDS_V+wid*1024;
  #define DMA_K(t,slot) glds16(ksrc+(long)(t)*KVBLK*KP,(unsigned)__builtin_amdgcn_readfirstlane(kdst+(slot)))
  #define DMA_V(t,slot) glds16(vsrc+(long)(t)*KVBLK*KP,(unsigned)__builtin_amdgcn_readfirstlane(vdst+(slot)))
  const int vb0=(int)(lds0+LDS_V)+((lane>>4)&1)*32+(lane&3)*8+(4*hi+((lane&15)>>2))*64;
  const char*Kbase=shm+LDS_K; bf16x8 kf[8];
  const lds_cptr shm3=(lds_cptr)shm; const lds_cptr kp0=shm3+LDS_K+hi*1024+r32*16; const lds_cptr vp0=shm3+LDS_V+((lane>>4)&1)*32+(lane&3)*8+(4*hi+((lane&15)>>2))*64;
  const int NT=SEQK/KVBLK;
  DMA_K(0,0);DMA_V(0,0);DMA_K(1,SLOTB);
  bf16x8 qr[4];
  #pragma unroll
  for(int d0=0;d0<4;++d0)qr[d0]=*reinterpret_cast<const bf16x8*>(&Qw[(long)r32*QP+d0*16+hi*8]);
  float mhat=refB,l_reg=0.f;f32x16 o[2];o[0]=f32x16{};o[1]=f32x16{};f32x16 negm; _Pragma("unroll") for(int r=0;r<16;++r)negm[r]=-refB; asm volatile("":"+v"(negm));

  #define CMASK(P0,P1,t) do{}while(0)
  bool resc=false;
  #define START(P0,P1) do{ resc=false; \
    _Pragma("unroll") for(int r=0;r<16;++r)P0[r]=__builtin_amdgcn_exp2f(P0[r]); }while(0)
  #define RESC() do{ if(resc){ asm volatile("s_waitcnt lgkmcnt(0)":::"memory"); \
      _Pragma("unroll") for(int d_=0;d_<2;++d_) _Pragma("unroll") for(int r=0;r<16;++r)o[d_][r]*=wsf[crow(r,hi)]; } }while(0)
  f32x16 pA0,pA1,pB0,pB1;
  int sl_prev=0,sl_cur=0,sl_next=SLOTB;
  #define ROT() do{sl_prev=sl_cur;sl_cur=sl_next;sl_next=(sl_next==(NSLOT-1)*SLOTB)?0:sl_next+SLOTB;}while(0)
  DMA_K(2,2*SLOTB);
  WAIT_BAR(3);
  qkt(pA0,pA1,Kbase,qr,negm,r32,hi);asm volatile("s_nop 15\n\ts_nop 7":"+v"(pA0),"+v"(pA1));CMASK(pA0,pA1,0);
  START(pA0,pA1);
  _Pragma("unroll") for(int r=0;r<16;++r)pA1[r]=__builtin_amdgcn_exp2f(pA1[r]);
  WAIT_BAR(0);
  DMA_K(3,0);DMA_V(1,SLOTB);
  ROT();
  kload8(kf,kp0+sl_cur);
  WAIT_BAR(2);
  s16x4 vlo[8],vhi[8]; u32x4 pw0,pw1,pw2,pw3;
  #define PKW(P,B) cvtpk_s(P[B],P[B+1])
  #define PAF(k) __builtin_bit_cast(bf16x8,pw##k)
  #define VFR(i) (bf16x8){vlo[i][0],vlo[i][1],vlo[i][2],vlo[i][3],vhi[i][0],vhi[i][1],vhi[i][2],vhi[i][3]}
  #define PIN(x) asm volatile("":"+v"(x))
  #define MX3(a,b,c) __builtin_fmaxf(__builtin_fmaxf((a),(b)),(c))
  #define GAPA(MF,A0,A1,A2,A3,W0,W1,PW) do{ MF; sacc+=A0; sacc+=A1; sacc+=A2; sacc+=A3; PIN(sacc); W0; W1; PIN(PW); SBAR(); }while(0)
  #define EX(v) __builtin_amdgcn_exp2f(v)
  #define GAPB(MF,X,B) do{ MF; X[B]=EX(X[B]); X[B+1]=EX(X[B+1]); X[B+2]=EX(X[B+2]); X[B+3]=EX(X[B+3]); PIN(X); SBAR(); }while(0)
  #define VRD(i) do{ vlo[i]=vtr(vp_+(((i)>>2)*4096+((i)&3)*1024)); vhi[i]=vtr(vp_+(((i)>>2)*4096+((i)&3)*1024+512)); }while(0)
  #define KRD(G,j) do{ if(G){ kload2(kf,kp0+sl_next,j); SBAR(); } }while(0)
  #define STEP(C0,C1,P0,P1,t,GK,GV,GL) do{ SBAR(); \
    const lds_cptr vp_=vp0+sl_prev; \
    VRD(0); SBAR(); float sacc=(P0[0]+P0[1]); \
    GAPA(C0=__builtin_amdgcn_mfma_f32_32x32x16_bf16(kf[0],qr[0],negm,0,0,0), P0[2],P0[3],P0[4],P0[5],     pw0[0]=PKW(P0,0), pw0[1]=PKW(P0,2), pw0); \
    VRD(4); SBAR(); GAPA(C1=__builtin_amdgcn_mfma_f32_32x32x16_bf16(kf[1],qr[0],negm,0,0,0), P0[6],P0[7],P0[8],P0[9],     pw0[2]=PKW(P0,4), pw0[3]=PKW(P0,6), pw0); \
    VRD(1); SBAR(); GAPA(C0=__builtin_amdgcn_mfma_f32_32x32x16_bf16(kf[2],qr[1],C0,0,0,0),   P0[10],P0[11],P0[12],P0[13], pw1[0]=PKW(P0,8), pw1[1]=PKW(P0,10), pw1); \
    VRD(5); SBAR(); GAPA(C1=__builtin_amdgcn_mfma_f32_32x32x16_bf16(kf[3],qr[1],C1,0,0,0),   P0[14],P0[15],P1[0],P1[1],   pw1[2]=PKW(P0,12),pw1[3]=PKW(P0,14), pw1); \
    VRD(2); SBAR(); GAPA(C0=__builtin_amdgcn_mfma_f32_32x32x16_bf16(kf[4],qr[2],C0,0,0,0),   P1[2],P1[3],P1[4],P1[5],     pw2[0]=PKW(P1,0), pw2[1]=PKW(P1,2), pw2); \
    VRD(6); SBAR(); GAPA(C1=__builtin_amdgcn_mfma_f32_32x32x16_bf16(kf[5],qr[2],C1,0,0,0),   P1[6],P1[7],P1[8],P1[9],     pw2[2]=PKW(P1,4), pw2[3]=PKW(P1,6), pw2); \
    VRD(3); SBAR(); GAPA(C0=__builtin_amdgcn_mfma_f32_32x32x16_bf16(kf[6],qr[3],C0,0,0,0),   P1[10],P1[11],P1[12],P1[13], pw3[0]=PKW(P1,8), pw3[1]=PKW(P1,10), pw3); \
    VRD(7); SBAR(); GAPA(C1=__builtin_amdgcn_mfma_f32_32x32x16_bf16(kf[7],qr[3],C1,0,0,0),   P1[14],P1[15],0.f,0.f,       pw3[2]=PKW(P1,12),pw3[3]=PKW(P1,14), pw3); \
    l_reg+=sacc; \
    if(GK){DMA_K((t)+3,sl_cur);} if(GV){DMA_V((t)+1,sl_next);} \
    CMASK(C0,C1,t); \
    resc=false; \
    SBAR(); \
    GAPB(o[0]=__builtin_amdgcn_mfma_f32_32x32x16_bf16(PAF(0),VFR(0),o[0],0,0,0), C0,0); \
    GAPB(o[1]=__builtin_amdgcn_mfma_f32_32x32x16_bf16(PAF(0),VFR(4),o[1],0,0,0), C0,4); \
    KRD(GL,0); GAPB(o[0]=__builtin_amdgcn_mfma_f32_32x32x16_bf16(PAF(1),VFR(1),o[0],0,0,0), C0,8); \
    KRD(GL,1); GAPB(o[1]=__builtin_amdgcn_mfma_f32_32x32x16_bf16(PAF(1),VFR(5),o[1],0,0,0), C0,12); \
    KRD(GL,2); GAPB(o[0]=__builtin_amdgcn_mfma_f32_32x32x16_bf16(PAF(2),VFR(2),o[0],0,0,0), C1,0); \
    KRD(GL,3); GAPB(o[1]=__builtin_amdgcn_mfma_f32_32x32x16_bf16(PAF(2),VFR(6),o[1],0,0,0), C1,4); \
    GAPB(o[0]=__builtin_amdgcn_mfma_f32_32x32x16_bf16(PAF(3),VFR(3),o[0],0,0,0), C1,8); \
    GAPB(o[1]=__builtin_amdgcn_mfma_f32_32x32x16_bf16(PAF(3),VFR(7),o[1],0,0,0), C1,12); \
    }while(0)
  int t=1;
  #undef CMASK
  #define CMASK(P0,P1,t) do{}while(0)
  for(;t+5<NT;t+=2){
    STEP(pB0,pB1,pA0,pA1,t,true,true,true);     WAIT_BAR(2); RESC(); ROT();
    STEP(pA0,pA1,pB0,pB1,t+1,true,true,true);   WAIT_BAR(2); RESC(); ROT();
  }
  #undef CMASK
  #define CMASK(P0,P1,t) do{}while(0)
  #define ENDW(tt) do{ if((tt)+3<NT){WAIT_BAR(2);} else if((tt)+2<NT){WAIT_BAR(1);} else {WAIT_BAR(0);} }while(0)
  for(;t+1<NT;t+=2){
    STEP(pB0,pB1,pA0,pA1,t,(t+3<NT),(t+1<NT),(t+1<NT));       ENDW(t);   RESC(); ROT();
    STEP(pA0,pA1,pB0,pB1,t+1,(t+4<NT),(t+2<NT),(t+2<NT));     ENDW(t+1); RESC(); ROT();
  }
  STEP(pB0,pB1,pA0,pA1,NT-1,false,false,false); RESC();
  { float sacc=pB0[0]+pB0[1]; _Pragma("unroll") for(int r=2;r<16;++r)sacc+=pB0[r]; _Pragma("unroll") for(int r=0;r<16;++r)sacc+=pB1[r]; l_reg+=sacc;
    pw0=(u32x4){PKW(pB0,0),PKW(pB0,2),PKW(pB0,4),PKW(pB0,6)};pw1=(u32x4){PKW(pB0,8),PKW(pB0,10),PKW(pB0,12),PKW(pB0,14)};pw2=(u32x4){PKW(pB1,0),PKW(pB1,2),PKW(pB1,4),PKW(pB1,6)};pw3=(u32x4){PKW(pB1,8),PKW(pB1,10),PKW(pB1,12),PKW(pB1,14)};
    SBAR(); pv(o,vb0+sl_cur,PAF(0),PAF(1),PAF(2),PAF(3)); }
  #undef PKW
  #undef PAF
  #undef VFR
  #undef PIN
  #undef MX3
  #undef GAPA
  #undef GAPB
  #undef EX
  #undef VRD
  #undef KRD
  #undef STEP
  #undef ENDW
  {auto rr=__builtin_amdgcn_permlane32_swap(__float_as_uint(l_reg),__float_as_uint(l_reg),false,false);l_reg=__uint_as_float(rr[0])+__uint_as_float(rr[1]);}
  if(hi==0)wsf[32+r32]=l_reg;asm volatile("s_waitcnt lgkmcnt(0)":::"memory");
  float rli[16];
  #pragma unroll
  for(int r=0;r<16;++r)rli[r]=__builtin_amdgcn_rcpf(wsf[32+crow(r,hi)]);
  bf16*Ow=O+(rowq+q0+wid*QBLK)*OP+h*D;
  { bf16*stg=(bf16*)(shm+LDS_OST)+wid*2048;
    #pragma unroll
    for(int r=0;r<16;++r){const int orow=crow(r,hi);
      #pragma unroll
      for(int d0=0;d0<2;++d0)stg[orow*64+d0*32+r32]=__float2bfloat16(o[d0][r]*rli[r]);}
    asm volatile("s_waitcnt lgkmcnt(0)":::"memory");
    #pragma unroll
    for(int i=0;i<4;++i){const int row=i*8+(lane>>3),ch=lane&7; const u32x4 v=*(const u32x4*)(stg+row*64+ch*8); ATTN_STORE16(Ow+(long)row*OP+ch*8,v);} }
  asm volatile("s_waitcnt lgkmcnt(0)\n\ts_barrier":::"memory");
  #undef DMA_K
  #undef DMA_V
  #undef CMASK
  #undef START
  #undef RESC
  #undef ROT
}
constexpr int ATTN_LDS_BYTES=LDS_BYTES;
struct AttnTensors { const bf16* Q; const bf16* K; const bf16* V; bf16* O; };
struct AttnUnit { int b, h, qb; };
struct StaticOrder {
  int vcu;
  __device__ __forceinline__ explicit StaticOrder(int grid,int block):vcu((block%8)*(grid/8)+block/8){}
  __device__ __forceinline__ bool next(int i,AttnUnit&u)const{ const int p=8*i+(vcu>>5); if(p>=32)return false; const int w=vcu&31; u.b=p>>1; u.h=(p&1)*4+(w>>3); u.qb=w&7; return true; }
};
template<class Sched,int THRL=8> __device__ __forceinline__ void attn_phase(char*lds,const AttnTensors&T,const Sched&S){
  AttnUnit u;
  for(int i=0;S.next(i,u);++i){ attn_unit<THRL>(u.b,u.h,u.qb,T.Q,T.K,T.V,T.O,lds,64.0f); }
}
#undef SBAR
#undef WAIT_BAR
}

namespace ret {
typedef short bf16x8 __attribute__((ext_vector_type(8)));
typedef short s16x4 __attribute__((ext_vector_type(4)));
typedef float f32x16 __attribute__((ext_vector_type(16)));
constexpr int VP = 160, KPT = 48;
constexpr int VB = 128 * VP * 2, KB = 128 * KPT * 2, BUF = VB + KB;
__device__ __forceinline__ int crow(int r, int hi) { return (r & 3) + 8 * (r >> 2) + 4 * hi; }
__device__ __forceinline__ s16x4 trd(const LAS unsigned char* p) { return __builtin_bit_cast(s16x4, __builtin_amdgcn_ds_read_tr16_b64_v4i16((LAS s16x4*)p)); }
__device__ __forceinline__ bf16x8 cat(s16x4 a, s16x4 b) { return (bf16x8){a[0], a[1], a[2], a[3], b[0], b[1], b[2], b[3]}; }
__device__ __forceinline__ v4u scale8(v4u w, float s) {
    v4u o; o.x = pk2(bflo(w.x) * s, bfhi(w.x) * s); o.y = pk2(bflo(w.y) * s, bfhi(w.y) * s); o.z = pk2(bflo(w.z) * s, bfhi(w.z) * s); o.w = pk2(bflo(w.w) * s, bfhi(w.w) * s); return o;
}
constexpr int RAP = 96, RAB = 128 * RAP * 2, RABUF = 2 * RAB;
__device__ __forceinline__ void state_unit(int b, int h, int dir, int dvh, const bf16_t* RK, const bf16_t* RV, bf16_t* ST, float lg2, LAS unsigned char* lds) {
    const int tid = threadIdx.x, lane = tid & 63, wid = __builtin_amdgcn_readfirstlane(tid >> 6), r32 = lane & 31, hi = lane >> 5, dvt = wid & 1, dkt = (wid >> 1) & 1;
    const float g128 = exp2f(lg2 * 128.0f);
    const int prow = tid >> 3, pc8 = tid & 7;
    const float kw0 = dir ? exp2f(lg2 * (float)prow) : exp2f(lg2 * (float)(127 - prow)), kw1 = dir ? exp2f(lg2 * (float)(prow + 64)) : exp2f(lg2 * (float)(63 - prow));
    v4u vreg[2], kreg[2];
    auto chunk_of = [&](int s) { return dir ? (s == 0 ? 1 : (s == 1 ? 0 : 19 - s)) : s; };
    auto load = [&](int s) {
        const size_t urow = (size_t)b * SU + (size_t)chunk_of(s) * 128;
#pragma unroll
        for (int i = 0; i < 2; ++i) { vreg[i] = *(const v4u*)(RV + (urow + prow + 64 * i) * 512 + h * 128 + dvh * 64 + pc8 * 8); kreg[i] = *(const v4u*)(RK + (urow + prow + 64 * i) * 256 + h * 64 + pc8 * 8); }
    };
    load(0);
    f32x16 acc = {};
    const int gq = lane >> 4, colblk = gq & 1, q4 = (lane >> 2) & 3, p4 = lane & 3;
    for (int s = 0; s < 18; ++s) {
        LAS unsigned char* buf = lds + (s & 1) * RABUF;
#pragma unroll
        for (int i = 0; i < 2; ++i) { *(LAS v4u*)(buf + (prow + 64 * i) * (RAP * 2) + pc8 * 16) = vreg[i]; *(LAS v4u*)(buf + RAB + (prow + 64 * i) * (RAP * 2) + pc8 * 16) = scale8(kreg[i], i ? kw1 : kw0); }
        __syncthreads();
        if (s + 1 < 18) load(s + 1);
        if (wid < 4) {
            if (s >= 2) {
                const int n = dir ? 17 - s : s - 2;
                bf16_t* st = ST + ((((size_t)b * 4 + h) * 2 + dir) * 16 + n) * (128 * 64) + dkt * 32 + r32;
#pragma unroll
                for (int r = 0; r < 16; ++r) st[(size_t)(64 * dvh + 32 * dvt + crow(r, hi)) * 64] = (bf16_t)f2bf(acc[r]);
            }
            if (s < 17) {
#pragma unroll
                for (int r = 0; r < 16; ++r) acc[r] *= g128;
                const LAS unsigned char* va = buf + (8 * hi + q4) * (RAP * 2) + (32 * dvt + 16 * colblk + 4 * p4) * 2;
                const LAS unsigned char* ka = buf + RAB + (8 * hi + q4) * (RAP * 2) + (32 * dkt + 16 * colblk + 4 * p4) * 2;
#pragma unroll
                for (int ks = 0; ks < 8; ++ks) {
                    const bf16x8 af = cat(trd(va + ks * 16 * RAP * 2), trd(va + (ks * 16 + 4) * RAP * 2));
                    const bf16x8 bfm = cat(trd(ka + ks * 16 * RAP * 2), trd(ka + (ks * 16 + 4) * RAP * 2));
                    acc = __builtin_amdgcn_mfma_f32_32x32x16_bf16(af, bfm, acc, 0, 0, 0);
                }
            }
        }
    }
    __syncthreads();
}
constexpr int QP2 = 72, GP2 = 136;
constexpr int OFF_Q = VB, OFF_K = OFF_Q + 128 * QP2 * 2, OFF_G = OFF_K + 128 * QP2 * 2, OFF_RED = OFF_G + 128 * GP2 * 2;
struct OutRegs { v4u vv[4], qq[2], kk[2]; };
__device__ __forceinline__ void out_load(OutRegs& R, int u, const bf16_t* RQ, const bf16_t* RK, const bf16_t* RV, const bf16_t* RG) {
    const int tid = threadIdx.x, n = u & 15, h = (u >> 4) & 3, b = u >> 6;
    const size_t m0 = (size_t)b * SEQ + 128 * n, u0 = (size_t)b * SU + CTX + 128 * n;
#pragma unroll
    for (int i = 0; i < 4; ++i) { const int pc = tid + 512 * i; R.vv[i] = *(const v4u*)(RV + (u0 + (pc >> 4)) * 512 + h * 128 + (pc & 15) * 8); }
#pragma unroll
    for (int i = 0; i < 2; ++i) { const int pc = tid + 512 * i; R.qq[i] = *(const v4u*)(RQ + (m0 + (pc >> 3)) * 256 + h * 64 + (pc & 7) * 8); R.kk[i] = *(const v4u*)(RK + (u0 + (pc >> 3)) * 256 + h * 64 + (pc & 7) * 8); }
}
__device__ __forceinline__ void out_unit(OutRegs& R, int u, int unext, const bf16_t* RQ, const bf16_t* RK, const bf16_t* RV, const bf16_t* RG, const bf16_t* ST, const float* gng, const float* gnb, const float* ldf, const float* ldb, bf16_t* MIX, LAS unsigned char* lds) {
    const int n = u & 15, h = (u >> 4) & 3, b = u >> 6; const float lgf = ldf[h] * 1.4426950408889634f, lgb = ldb[h] * 1.4426950408889634f;
    const int tid = threadIdx.x, lane = tid & 63, wid = __builtin_amdgcn_readfirstlane(tid >> 6), r32 = lane & 31, hi = lane >> 5, rg = wid & 3, dvh = wid >> 2;
    const size_t m0 = (size_t)b * SEQ + 128 * n, u0 = (size_t)b * SU + CTX + 128 * n;
    LAS float* red = (LAS float*)(lds + OFF_RED);
    {
        __syncthreads();
#pragma unroll
        for (int i = 0; i < 4; ++i) { const int pc = tid + 512 * i; *(LAS v4u*)(lds + (pc >> 4) * (VP * 2) + (pc & 15) * 16) = R.vv[i]; }
#pragma unroll
        for (int i = 0; i < 2; ++i) { const int pc = tid + 512 * i; *(LAS v4u*)(lds + OFF_Q + (pc >> 3) * (QP2 * 2) + (pc & 7) * 16) = R.qq[i]; *(LAS v4u*)(lds + OFF_K + (pc >> 3) * (QP2 * 2) + (pc & 7) * 16) = R.kk[i]; }
    }
    __syncthreads();
    out_load(R, unext >= 0 ? unext : u, RQ, RK, RV, RG);
    bf16x8 qf[4];
#pragma unroll
    for (int ks = 0; ks < 4; ++ks) qf[ks] = *(const LAS bf16x8*)(lds + OFF_Q + (32 * rg + r32) * (QP2 * 2) + (16 * ks + 8 * hi) * 2);
    f32x16 st[4];
#pragma unroll
    for (int kt = 0; kt < 4; ++kt) { st[kt] = (f32x16){};
#pragma unroll
        for (int ks = 0; ks < 4; ++ks) { const bf16x8 kf = *(const LAS bf16x8*)(lds + OFF_K + (32 * kt + r32) * (QP2 * 2) + (16 * ks + 8 * hi) * 2); st[kt] = __builtin_amdgcn_mfma_f32_32x32x16_bf16(kf, qf[ks], st[kt], 0, 0, 0); } }
    const int c = 32 * rg + r32;
    bf16x8 pa[4][2];
#pragma unroll
    for (int kt = 0; kt < 4; ++kt) {
#pragma unroll
        for (int r = 0; r < 16; ++r) { const int d = c - (32 * kt + crow(r, hi)); const float w = d > 0 ? __builtin_amdgcn_exp2f(lgf * (float)d) : (d < 0 ? __builtin_amdgcn_exp2f(lgb * (float)(-d)) : 2.0f); st[kt][r] *= w; }
#pragma unroll
        for (int s2 = 0; s2 < 2; ++s2) { v4u w; w.x = pk2(st[kt][8 * s2], st[kt][8 * s2 + 1]); w.y = pk2(st[kt][8 * s2 + 2], st[kt][8 * s2 + 3]); w.z = pk2(st[kt][8 * s2 + 4], st[kt][8 * s2 + 5]); w.w = pk2(st[kt][8 * s2 + 6], st[kt][8 * s2 + 7]); pa[kt][s2] = __builtin_bit_cast(bf16x8, w); }
    }
    asm volatile("" ::: "memory");
    v4u gg[4];
#pragma unroll
    for (int i = 0; i < 4; ++i) { const int pc = tid + 512 * i; gg[i] = *(const v4u*)(RG + (m0 + (pc >> 4)) * 512 + h * 128 + (pc & 15) * 8); }
    f32x16 ot[2] = {(f32x16){}, (f32x16){}};
    const int gq = lane >> 4, colblk = gq & 1, q4 = (lane >> 2) & 3, p4 = lane & 3;
#pragma unroll
    for (int dt = 0; dt < 2; ++dt) {
        const LAS unsigned char* va = lds + (4 * hi + q4) * (VP * 2) + (64 * dvh + 32 * dt + 16 * colblk + 4 * p4) * 2;
#pragma unroll
        for (int kt = 0; kt < 4; ++kt)
#pragma unroll
            for (int s2 = 0; s2 < 2; ++s2) { const int kb = 32 * kt + 16 * s2; const bf16x8 vf = cat(trd(va + kb * VP * 2), trd(va + (kb + 8) * VP * 2)); ot[dt] = __builtin_amdgcn_mfma_f32_32x32x16_bf16(vf, pa[kt][s2], ot[dt], 0, 0, 0); }
    }
    {
        const float decf = __builtin_amdgcn_exp2f(lgf * (float)(c + 1)), decb = __builtin_amdgcn_exp2f(lgb * (float)(128 - c));
        const bf16_t* sf = ST + ((((size_t)b * 4 + h) * 2 + 0) * 16 + n) * (128 * 64); const bf16_t* sb = sf + (size_t)16 * 128 * 64;
#pragma unroll
        for (int ks = 0; ks < 4; ++ks) {
            const v4u qw = __builtin_bit_cast(v4u, qf[ks]); const bf16x8 qdf = __builtin_bit_cast(bf16x8, scale8(qw, decf)), qdb = __builtin_bit_cast(bf16x8, scale8(qw, decb));
#pragma unroll
            for (int dt = 0; dt < 2; ++dt) { const size_t so = (size_t)(64 * dvh + 32 * dt + r32) * 64 + 16 * ks + 8 * hi;
                ot[dt] = __builtin_amdgcn_mfma_f32_32x32x16_bf16(*(const bf16x8*)(sf + so), qdf, ot[dt], 0, 0, 0);
                ot[dt] = __builtin_amdgcn_mfma_f32_32x32x16_bf16(*(const bf16x8*)(sb + so), qdb, ot[dt], 0, 0, 0); }
        }
    }
#pragma unroll
    for (int i = 0; i < 4; ++i) { const int pc = tid + 512 * i; *(LAS v4u*)(lds + OFF_G + (pc >> 4) * (GP2 * 2) + (pc & 15) * 16) = gg[i]; }
    float s1 = 0.f;
#pragma unroll
    for (int dt = 0; dt < 2; ++dt)
#pragma unroll
        for (int r = 0; r < 16; ++r) s1 += ot[dt][r];
    s1 += __shfl_xor(s1, 32);
    if (hi == 0) red[wid * 32 + r32] = s1;
    __syncthreads();
    const float mu = (red[wid * 32 + r32] + red[(wid ^ 4) * 32 + r32]) * (1.0f / 128.0f);
    float s2 = 0.f;
#pragma unroll
    for (int dt = 0; dt < 2; ++dt)
#pragma unroll
        for (int r = 0; r < 16; ++r) { const float d = ot[dt][r] - mu; s2 = fmaf(d, d, s2); }
    s2 += __shfl_xor(s2, 32);
    __syncthreads();
    if (hi == 0) red[wid * 32 + r32] = s2;
    __syncthreads();
    const float rs = 1.0f / sqrtf((red[wid * 32 + r32] + red[(wid ^ 4) * 32 + r32]) * (1.0f / 128.0f) + LN_EPS);
    LAS unsigned char* grow = lds + OFF_G + (32 * rg + r32) * (GP2 * 2);
#pragma unroll
    for (int dt = 0; dt < 2; ++dt)
#pragma unroll
        for (int rq = 0; rq < 4; ++rq) {
            const int dv = 64 * dvh + 32 * dt + 8 * rq + 4 * hi;
            const f32x4 gg = *(const f32x4*)(gng + h * 128 + dv), gb = *(const f32x4*)(gnb + h * 128 + dv);
            const v2u gw = *(const LAS v2u*)(grow + dv * 2);
            const float g0 = bflo(gw.x), g1 = bfhi(gw.x), g2 = bflo(gw.y), g3 = bfhi(gw.y);
            const float y0 = ((ot[dt][4 * rq] - mu) * rs * gg[0] + gb[0]) * (g0 * __builtin_amdgcn_rcpf(1.0f + __builtin_amdgcn_exp2f(-1.4426950408889634f * g0)));
            const float y1 = ((ot[dt][4 * rq + 1] - mu) * rs * gg[1] + gb[1]) * (g1 * __builtin_amdgcn_rcpf(1.0f + __builtin_amdgcn_exp2f(-1.4426950408889634f * g1)));
            const float y2 = ((ot[dt][4 * rq + 2] - mu) * rs * gg[2] + gb[2]) * (g2 * __builtin_amdgcn_rcpf(1.0f + __builtin_amdgcn_exp2f(-1.4426950408889634f * g2)));
            const float y3 = ((ot[dt][4 * rq + 3] - mu) * rs * gg[3] + gb[3]) * (g3 * __builtin_amdgcn_rcpf(1.0f + __builtin_amdgcn_exp2f(-1.4426950408889634f * g3)));
            v2u w; w.x = pk2(y0, y1); w.y = pk2(y2, y3);
            *(LAS v2u*)(grow + dv * 2) = w;
        }
    __syncthreads();
#pragma unroll
    for (int i = 0; i < 4; ++i) { const int pc = tid + 512 * i; *(v4u*)(MIX + (m0 + (pc >> 4)) * DM + h * 128 + (pc & 15) * 8) = *(const LAS v4u*)(lds + OFF_G + (pc >> 4) * (GP2 * 2) + (pc & 15) * 16); }
}
}

struct Args {
    const float* in[26]; float* out; unsigned char* ws; int ph_lo, ph_hi, li, pad;
};
enum { I_X = 0, I_C, I_CTX, I_CCTX, I_LNING, I_LNINB, I_WADA, I_BADA, I_WIN, I_LDF, I_LDB, I_GNG, I_GNB, I_QNG, I_KNG, I_WO, I_LN1G, I_LN1B, I_RW, I_RB, I_WUP, I_BUP, I_WDN, I_BDN, I_LN2G, I_LN2B };

struct Frame {
    LAS unsigned char* lds;
    unsigned* ctl;
    int tid, lane, wave, G, gtid, nthreads, gw, ngw;
};

constexpr int LDS_BYTES = 147456, MISC_OFF = 147456 - 1024;

__device__ __forceinline__ int phys_in(int lc) { const int pn = lc >> 8, wc = (lc >> 6) & 3, d = lc & 63; const int blk = d >> 5, bj = (d >> 4) & 1, f1 = (d >> 3) & 1, n = (d >> 2) & 1, j = d & 3;
    return pn * 256 + 128 * bj + 32 * wc + 16 * n + 4 * (2 * blk + f1) + j; }
__device__ __forceinline__ int phys_up(int c) { return 256 * ((c & 1023) >> 7) + 128 * (c >> 10) + (c & 127); }

__device__ __forceinline__ void transpose_load(f32x4 (&v)[16], const float* W, int K, int N, int item, int lane) {
    const int nkb = K / 64, kb = item % nkb, nb = item / nkb, k0 = 64 * kb, n0 = 64 * nb;
    const float* src = W + (size_t)(k0 + (lane >> 4)) * N + n0 + (lane & 15) * 4;
#pragma unroll
    for (int i = 0; i < 16; ++i) v[i] = __builtin_nontemporal_load((const f32x4*)(src + (size_t)(4 * i) * N));
}
__device__ __forceinline__ void transpose_write(const f32x4 (&v)[16], LAS float* scr, int lane) {
#pragma unroll
    for (int i = 0; i < 16; ++i) { LAS float* d = scr + (4 * i + (lane >> 4)) * 65 + (lane & 15) * 4; d[0] = v[i][0]; d[1] = v[i][1]; d[2] = v[i][2]; d[3] = v[i][3]; }
    asm volatile("s_waitcnt lgkmcnt(0)" ::: "memory");
}
template <int MAP, bool F8> __device__ __forceinline__ void transpose_out(int K, void* WT, LAS float* scr, int item, int lane) {
    const int nkb = K / 64, kb = item % nkb, nb = item / nkb, k0 = 64 * kb, n0 = 64 * nb;
    const int c = lane & 7;
#pragma unroll
    for (int j = 0; j < 8; ++j) { const int n = (lane >> 3) + 8 * j; const LAS float* s = scr + (8 * c) * 65 + n;
        const int ln = n0 + n; const int pr = MAP == 1 ? phys_in(ln) : (MAP == 2 ? phys_up(ln) : ln);
        if constexpr (F8) { v2u q; q.x = 0u; q.y = 0u;
            q.x = __builtin_amdgcn_cvt_pk_fp8_f32(64.f * s[0 * 65], 64.f * s[1 * 65], q.x, false); q.x = __builtin_amdgcn_cvt_pk_fp8_f32(64.f * s[2 * 65], 64.f * s[3 * 65], q.x, true);
            q.y = __builtin_amdgcn_cvt_pk_fp8_f32(64.f * s[4 * 65], 64.f * s[5 * 65], q.y, false); q.y = __builtin_amdgcn_cvt_pk_fp8_f32(64.f * s[6 * 65], 64.f * s[7 * 65], q.y, true);
            *(v2u*)((unsigned char*)WT + (size_t)pr * K + k0 + 8 * c) = q; }
        else { v4u o; o.x = pk2(s[0 * 65], s[1 * 65]); o.y = pk2(s[2 * 65], s[3 * 65]); o.z = pk2(s[4 * 65], s[5 * 65]); o.w = pk2(s[6 * 65], s[7 * 65]);
            *(v4u*)((bf16_t*)WT + (size_t)pr * K + k0 + 8 * c) = o; } }
    asm volatile("s_waitcnt lgkmcnt(0)" ::: "memory");
}
__device__ __forceinline__ void transpose8_write(const f32x4 (&v)[16], LAS unsigned* T, int lane) {
#pragma unroll
    for (int i = 0; i < 16; ++i) { unsigned w = 0u; w = __builtin_amdgcn_cvt_pk_fp8_f32(64.f * v[i][0], 64.f * v[i][1], w, false); w = __builtin_amdgcn_cvt_pk_fp8_f32(64.f * v[i][2], 64.f * v[i][3], w, true);
        T[(4 * i + (lane >> 4)) * 17 + (lane & 15)] = w; }
    asm volatile("s_waitcnt lgkmcnt(0)" ::: "memory");
}
template <int MAP> __device__ __forceinline__ void transpose8_out(int K, unsigned char* WT, const LAS unsigned* T, int item, int lane) {
    const int nkb = K / 64, kb = item % nkb, nb = item / nkb, k0 = 64 * kb, n0 = 64 * nb;
    const int c = lane & 7, ng2 = lane >> 3;
#pragma unroll
    for (int j = 0; j < 2; ++j) { const int ng = ng2 + 8 * j; unsigned d[8];
#pragma unroll
        for (int i = 0; i < 8; ++i) d[i] = T[(8 * c + i) * 17 + ng];
        unsigned r[2][4];
#pragma unroll
        for (int h = 0; h < 2; ++h) { const unsigned d0 = d[4 * h], d1 = d[4 * h + 1], d2 = d[4 * h + 2], d3 = d[4 * h + 3];
            const unsigned t0 = __builtin_amdgcn_perm(d1, d0, 0x05010400u), t1 = __builtin_amdgcn_perm(d1, d0, 0x07030602u), t2 = __builtin_amdgcn_perm(d3, d2, 0x05010400u), t3 = __builtin_amdgcn_perm(d3, d2, 0x07030602u);
            r[h][0] = __builtin_amdgcn_perm(t2, t0, 0x05040100u); r[h][1] = __builtin_amdgcn_perm(t2, t0, 0x07060302u); r[h][2] = __builtin_amdgcn_perm(t3, t1, 0x05040100u); r[h][3] = __builtin_amdgcn_perm(t3, t1, 0x07060302u); }
#pragma unroll
        for (int q = 0; q < 4; ++q) { const int ln = n0 + 4 * ng + q; const int pr = MAP == 2 ? phys_up(ln) : ln; v2u o; o.x = r[0][q]; o.y = r[1][q];
            *(v2u*)(WT + (size_t)pr * K + k0 + 8 * c) = o; } }
    asm volatile("s_waitcnt lgkmcnt(0)" ::: "memory");
}
template <int MAP, bool F8> __device__ __forceinline__ void transpose_item(const float* W, int K, int N, void* WT, LAS float* scr, int item, int lane) {
    f32x4 v[16]; transpose_load(v, W, K, N, item, lane); transpose_write(v, scr, lane); transpose_out<MAP, F8>(K, WT, scr, item, lane);
}

__device__ __forceinline__ void p0_prologue(const Args& a, Frame& F) {
    unsigned char* ws = a.ws;
    float* ADA = (float*)(ws + WS_ADA); float* ROPE = (float*)(ws + WS_ROPE);
    for (int idx = F.gtid; idx < 64 * 16; idx += F.nthreads) {
        const int pos = idx >> 4, i = idx & 15;
        const float inv = exp2f(-(float)i * (13.287712379549449f / 16.0f));
        const float ang = (float)pos * inv;
        ROPE[idx * 2] = cosf(ang); ROPE[idx * 2 + 1] = sinf(ang);
    }
    { bf16_t* RWT = (bf16_t*)(ws + WS_RWT);
      for (int idx = F.gtid; idx < 32 * 1024; idx += F.nthreads) { const int e = idx >> 10, k = idx & 1023; const float w = a.in[I_RW][k * 32 + e]; const unsigned hi = f2bf(w); RWT[idx] = (bf16_t)hi; RWT[32768 + idx] = (bf16_t)f2bf(w - bf2f(hi)); } }
    for (int tile = blockIdx.x; tile < 192; tile += F.G) {
        LAS float* SL = (LAS float*)F.lds;
        LAS float* PT = (LAS float*)(F.lds + 17 * 4096);
        for (int i = F.tid; i < 17 * 1024; i += NTHR) { const int r = i >> 10, k = i & 1023; const float s = r < 16 ? a.in[I_C][r * 1024 + k] : a.in[I_CCTX][k]; SL[i] = s / (1.0f + __expf(-s)); }
        __syncthreads();
        const int col = F.lane & 31, kh = F.lane >> 5; const float* w = a.in[I_WADA] + tile * 32 + col; const int k0 = F.wave * 128 + 64 * kh;
        float acc[17];
#pragma unroll
        for (int r = 0; r < 17; ++r) acc[r] = 0.f;
#pragma unroll 1
        for (int kb = 0; kb < 64; kb += 32) {
            float wv[32];
#pragma unroll
            for (int q = 0; q < 32; ++q) wv[q] = __builtin_nontemporal_load(w + (size_t)(k0 + kb + q) * 6144);
#pragma unroll
            for (int k4 = 0; k4 < 32; k4 += 4)
#pragma unroll
                for (int r = 0; r < 17; ++r) { const f32x4 s4 = *(const LAS f32x4*)(SL + r * 1024 + k0 + kb + k4); acc[r] = fmaf(s4[0], wv[k4], acc[r]); acc[r] = fmaf(s4[1], wv[k4 + 1], acc[r]); acc[r] = fmaf(s4[2], wv[k4 + 2], acc[r]); acc[r] = fmaf(s4[3], wv[k4 + 3], acc[r]); }
        }
#pragma unroll
        for (int r = 0; r < 17; ++r) { acc[r] += __shfl_xor(acc[r], 32); if (kh == 0) PT[(F.wave * 17 + r) * 32 + col] = acc[r]; }
        __syncthreads();
        for (int i = F.tid; i < 17 * 32; i += NTHR) { const int r = i >> 5, c = i & 31; float s = a.in[I_BADA][tile * 32 + c];
#pragma unroll
            for (int wv = 0; wv < 8; ++wv) s += PT[(wv * 17 + r) * 32 + c];
            ADA[r * 6144 + tile * 32 + c] = s; }
        __syncthreads();
    }
    LAS float* scr = (LAS float*)(F.lds + F.wave * 16640);
    constexpr int I_IN = 16 * (NIN / 64), I_O = 16 * 16;
    for (int it = F.gw; it < I_IN + I_O; it += F.ngw) {
        if (it < I_IN) transpose_item<1, false>(a.in[I_WIN], 1024, NIN, ws + WS_WIN, scr, it, F.lane);
        else transpose_item<0, false>(a.in[I_WO], 1024, 1024, ws + WS_WO, scr, it - I_IN, F.lane);
    }
}
__device__ __forceinline__ void moe_weights_convert(const Args& a, Frame& F, int first, int last, int wi, int nw) {
    unsigned char* ws = a.ws;
    LAS float* scr = (LAS float*)(F.lds + F.wave * 16640);
    constexpr int I_UP = 16 * 32, I_DN = 16 * 16, NIT = NEXP * (I_UP + I_DN);
#define MW_LD(it_) do { const int _it = (it_); if (_it < NEXP * I_UP) { const int e = _it / I_UP; transpose_load(v, a.in[I_WUP] + (size_t)e * 1024 * 2048, 1024, 2048, _it % I_UP, F.lane); } \
        else { const int r = _it - NEXP * I_UP, e = r / I_DN; transpose_load(v, a.in[I_WDN] + (size_t)e * 1024 * 1024, 1024, 1024, r % I_DN, F.lane); } } while (0)
    { int _l = F.lane; asm volatile("" : "+v"(_l)); F.lane = _l; }
    f32x4 v[16];
    MW_LD(first + wi < last ? first + wi : last - 1);
    for (int it = first + wi; it < last; it += nw) {
        transpose8_write(v, (LAS unsigned*)scr, F.lane);
        MW_LD(it + nw < last ? it + nw : last - 1);
        if (it < NEXP * I_UP) { const int e = it / I_UP; transpose8_out<2>(1024, ws + WS_WUP + (size_t)e * 2048 * 1024, (const LAS unsigned*)scr, it % I_UP, F.lane); }
        else { const int r = it - NEXP * I_UP, e = r / I_DN; transpose8_out<0>(1024, ws + WS_WDN + (size_t)e * 1024 * 1024, (const LAS unsigned*)scr, r % I_DN, F.lane); }
    }
#undef MW_LD
}

__device__ __forceinline__ void p1_ln_mod(const Args& a, Frame& F) {
    unsigned char* ws = a.ws;
    const float* ADA = (const float*)(ws + WS_ADA); float* STATS = (float*)(ws + WS_STATS); bf16_t* H = (bf16_t*)(ws + WS_H);
    const f32x4* g4 = (const f32x4*)a.in[I_LNING] + F.lane; const f32x4* b4 = (const f32x4*)a.in[I_LNINB] + F.lane;
    auto rowsrc = [&](int u) { const int b = u / SU, p = u % SU; return (const f32x4*)(p < CTX ? a.in[I_CTX] + ((size_t)b * CTX + p) * DM : a.in[I_X] + ((size_t)b * SEQ + (p - CTX)) * DM) + F.lane; };
    f32x4 vn[4];
    if (F.gw < NROW) { const f32x4* xr = rowsrc(F.gw);
#pragma unroll
        for (int j = 0; j < 4; ++j) vn[j] = __builtin_nontemporal_load(xr + 64 * j); }
    for (int u = F.gw; u < NROW; u += F.ngw) {
        const int b = u / SU, p = u % SU;
        f32x4 v[4]; float s = 0.f;
#pragma unroll
        for (int j = 0; j < 4; ++j) v[j] = vn[j];
        { const int un = (u + F.ngw < NROW) ? u + F.ngw : u; const f32x4* xr = rowsrc(un);
#pragma unroll
            for (int j = 0; j < 4; ++j) vn[j] = __builtin_nontemporal_load(xr + 64 * j); }
#pragma unroll
        for (int j = 0; j < 4; ++j) s += (v[j].x + v[j].y) + (v[j].z + v[j].w);
        const float mean = wave_sum(s) * (1.f / DM); float s2 = 0.f;
#pragma unroll
        for (int j = 0; j < 4; ++j) { v[j] = v[j] - mean; s2 += (v[j].x * v[j].x + v[j].y * v[j].y) + (v[j].z * v[j].z + v[j].w * v[j].w); }
        const float rstd = 1.f / sqrtf(wave_sum(s2) * (1.f / DM) + LN_EPS);
        const float* ad = ADA + (p < CTX ? 16 : b) * 6144;
        const f32x4* sh4 = (const f32x4*)ad + F.lane; const f32x4* sc4 = (const f32x4*)(ad + 1024) + F.lane;
        v2u* o8 = (v2u*)(H + (size_t)u * DM) + F.lane;
#pragma unroll
        for (int j = 0; j < 4; ++j) {
            const f32x4 g = g4[64 * j], bb = b4[64 * j], sh = sh4[64 * j], sc = sc4[64 * j];
            const f32x4 xl = v[j] * rstd * g + bb; const f32x4 h = xl * (sc + 1.0f) + sh;
            v2u w; w.x = pk2(h.x, h.y); w.y = pk2(h.z, h.w); o8[64 * j] = w;
        }
        if (p >= CTX && F.lane == 0) { const int m = b * SEQ + (p - CTX); STATS[2 * m] = mean; STATS[2 * m + 1] = rstd; }
    }
}

__device__ __forceinline__ void store64(bf16_t* dst, const float (&v)[64]) {
#pragma unroll
    for (int q = 0; q < 8; ++q) { v4u w; w.x = pk2(v[8 * q], v[8 * q + 1]); w.y = pk2(v[8 * q + 2], v[8 * q + 3]); w.z = pk2(v[8 * q + 4], v[8 * q + 5]); w.w = pk2(v[8 * q + 6], v[8 * q + 7]); *(v4u*)(dst + 8 * q) = w; }
}
__device__ __forceinline__ void rope64(float (&v)[64], const float* ROPE, int t) {
    const float* rr = ROPE + (t >> 6) * 32; const float* rc = ROPE + (t & 63) * 32;
#pragma unroll
    for (int i = 0; i < 16; ++i) {
        const float cr = rr[2 * i], sr = rr[2 * i + 1], cc = rc[2 * i], sc = rc[2 * i + 1];
        const float x1 = v[i], x2 = v[16 + i], x3 = v[32 + i], x4 = v[48 + i];
        v[i] = x1 * cr - x2 * sr; v[16 + i] = x2 * cr + x1 * sr; v[32 + i] = x3 * cc - x4 * sc; v[48 + i] = x4 * cc + x3 * sc;
    }
}
__device__ __forceinline__ void rms64(float (&v)[64], const float* g) {
    float ss = 0.f;
#pragma unroll
    for (int d = 0; d < 64; ++d) ss = fmaf(v[d], v[d], ss);
    const float r = 1.0f / sqrtf(ss * (1.0f / 64.0f) + LN_EPS);
#pragma unroll
    for (int d = 0; d < 64; ++d) v[d] = v[d] * r * g[d];
}
__device__ __forceinline__ void p3_attn_scalar(const Args& a, Frame& F) {
    unsigned char* ws = a.ws;
    const bf16_t* AQ = (const bf16_t*)(ws + WS_AQ); const bf16_t* AK = (const bf16_t*)(ws + WS_AK); const bf16_t* AV = (const bf16_t*)(ws + WS_AV); bf16_t* MIX = (bf16_t*)(ws + WS_MIX);
    for (int it = F.gtid; it < BATCH * 8 * SEQ; it += F.nthreads) {
        const int t = it % SEQ, h = (it / SEQ) % 8, b = it / (SEQ * 8); const int m = b * SEQ + t, hk = h >> 2;
        v4u q[8];
#pragma unroll
        for (int i = 0; i < 8; ++i) q[i] = *(const v4u*)(AQ + (size_t)m * 512 + h * 64 + 8 * i);
        float o[64];
#pragma unroll
        for (int d = 0; d < 64; ++d) o[d] = 0.f;
        float mr = -1e30f, l = 0.f;
        const bf16_t* kb = AK + (size_t)b * SU * 128 + hk * 64; const bf16_t* vb = AV + (size_t)b * SU * 128 + hk * 64;
        for (int j = 0; j < SU; ++j) {
            float s = 0.f;
#pragma unroll
            for (int i = 0; i < 8; ++i) s = dot8(q[i], *(const v4u*)(kb + (size_t)j * 128 + 8 * i), s);
            const float mn = fmaxf(mr, s), corr = exp2f(mr - mn), pe = exp2f(s - mn);
            l = l * corr + pe; mr = mn;
#pragma unroll
            for (int i = 0; i < 8; ++i) { const v4u vv = *(const v4u*)(vb + (size_t)j * 128 + 8 * i);
                o[8 * i + 0] = fmaf(pe, bflo(vv.x), o[8 * i + 0] * corr); o[8 * i + 1] = fmaf(pe, bfhi(vv.x), o[8 * i + 1] * corr);
                o[8 * i + 2] = fmaf(pe, bflo(vv.y), o[8 * i + 2] * corr); o[8 * i + 3] = fmaf(pe, bfhi(vv.y), o[8 * i + 3] * corr);
                o[8 * i + 4] = fmaf(pe, bflo(vv.z), o[8 * i + 4] * corr); o[8 * i + 5] = fmaf(pe, bfhi(vv.z), o[8 * i + 5] * corr);
                o[8 * i + 6] = fmaf(pe, bflo(vv.w), o[8 * i + 6] * corr); o[8 * i + 7] = fmaf(pe, bfhi(vv.w), o[8 * i + 7] * corr); }
        }
        const float rl = 1.0f / l;
#pragma unroll
        for (int d = 0; d < 64; ++d) o[d] *= rl;
        store64(MIX + (size_t)m * DM + 512 + h * 64, o);
    }
}
__device__ __forceinline__ void p3_ret_scalar(const Args& a, Frame& F) {
    unsigned char* ws = a.ws;
    const bf16_t* RQ = (const bf16_t*)(ws + WS_RQ); const bf16_t* RK = (const bf16_t*)(ws + WS_RK); const bf16_t* RV = (const bf16_t*)(ws + WS_RV); const bf16_t* RG = (const bf16_t*)(ws + WS_RG);
    bf16_t* MIX = (bf16_t*)(ws + WS_MIX); float* YRET = (float*)(ws + WS_YRET);
    for (int it = F.gtid; it < BATCH * 4 * SEQ; it += F.nthreads) {
        const int t = it % SEQ, h = (it / SEQ) % 4, b = it / (SEQ * 4); const int m = b * SEQ + t;
        const float lgf = a.in[I_LDF][h] * 1.4426950408889634f, lgb = a.in[I_LDB][h] * 1.4426950408889634f;
        v4u q[8];
#pragma unroll
        for (int i = 0; i < 8; ++i) q[i] = *(const v4u*)(RQ + (size_t)m * 256 + h * 64 + 8 * i);
        const bf16_t* kb = RK + (size_t)b * SU * 256 + h * 64; const bf16_t* vb = RV + (size_t)b * SU * 512 + h * 128;
        float* yr = YRET + ((size_t)m * 4 + h) * 128;
        for (int dq = 0; dq < 4; ++dq) {
            float acc[32];
#pragma unroll
            for (int e = 0; e < 32; ++e) acc[e] = 0.f;
            for (int j = 0; j < SU; ++j) {
                float s = 0.f;
#pragma unroll
                for (int i = 0; i < 8; ++i) s = dot8(q[i], *(const v4u*)(kb + (size_t)j * 256 + 8 * i), s);
                float w;
                if (j < CTX) w = exp2f(lgf * (float)(t + CTX - j)) + exp2f(lgb * (float)(SEQ - t + j));
                else { const int tj = j - CTX; w = tj < t ? exp2f(lgf * (float)(t - tj)) : (tj > t ? exp2f(lgb * (float)(tj - t)) : 2.0f); }
                s *= w;
#pragma unroll
                for (int i = 0; i < 4; ++i) { const v4u vv = *(const v4u*)(vb + (size_t)j * 512 + dq * 32 + 8 * i);
                    acc[8 * i + 0] = fmaf(s, bflo(vv.x), acc[8 * i + 0]); acc[8 * i + 1] = fmaf(s, bfhi(vv.x), acc[8 * i + 1]);
                    acc[8 * i + 2] = fmaf(s, bflo(vv.y), acc[8 * i + 2]); acc[8 * i + 3] = fmaf(s, bfhi(vv.y), acc[8 * i + 3]);
                    acc[8 * i + 4] = fmaf(s, bflo(vv.z), acc[8 * i + 4]); acc[8 * i + 5] = fmaf(s, bfhi(vv.z), acc[8 * i + 5]);
                    acc[8 * i + 6] = fmaf(s, bflo(vv.w), acc[8 * i + 6]); acc[8 * i + 7] = fmaf(s, bfhi(vv.w), acc[8 * i + 7]); }
            }
#pragma unroll
            for (int e = 0; e < 32; ++e) yr[dq * 32 + e] = acc[e];
        }
        asm volatile("s_waitcnt vmcnt(0)" ::: "memory");
        float s1 = 0.f;
        for (int e = 0; e < 128; ++e) s1 += yr[e];
        const float mu = s1 * (1.0f / 128.0f); float s2 = 0.f;
        for (int e = 0; e < 128; ++e) { const float d = yr[e] - mu; s2 = fmaf(d, d, s2); }
        const float rs = 1.0f / sqrtf(s2 * (1.0f / 128.0f) + LN_EPS);
        const float* gg = a.in[I_GNG] + h * 128; const float* gb = a.in[I_GNB] + h * 128;
        for (int e = 0; e < 128; e += 2) {
            const unsigned gw = *(const unsigned*)(RG + (size_t)m * 512 + h * 128 + e);
            const float g0 = bflo(gw), g1 = bfhi(gw);
            const float y0 = ((yr[e] - mu) * rs * gg[e] + gb[e]) * (g0 / (1.0f + __expf(-g0)));
            const float y1 = ((yr[e + 1] - mu) * rs * gg[e + 1] + gb[e + 1]) * (g1 / (1.0f + __expf(-g1)));
            *(unsigned*)(MIX + (size_t)m * DM + h * 128 + e) = pk2(y0, y1);
        }
    }
}

__device__ __forceinline__ void p6_ln1_route(const Args& a, Frame& F) {
    typedef short bf16x8 __attribute__((ext_vector_type(8)));
    unsigned char* ws = a.ws;
    const float* ADA = (const float*)(ws + WS_ADA); const float* STATS = (const float*)(ws + WS_STATS); const bf16_t* Y1 = (const bf16_t*)(ws + WS_Y1); const bf16_t* RWT = (const bf16_t*)(ws + WS_RWT);
    float* X1 = (float*)(ws + WS_X1); bf16_t* H2 = (bf16_t*)(ws + WS_H2); unsigned* CNT = F.ctl + CW_CNT; v2u* LIST = (v2u*)(ws + WS_LIST);
    constexpr int HP = 1032;
    LAS bf16_t* HSH = (LAS bf16_t*)F.lds; LAS bf16_t* HSL = (LAS bf16_t*)(F.lds + 16 * HP * 2);
    LAS float* PP = (LAS float*)(F.lds + 2 * 16 * HP * 2);
    LAS float* PRM = PP + 8 * 16 * 32;
    LAS unsigned* SEL = (LAS unsigned*)(PRM + 7 * 1024);
    LAS unsigned* HIST = SEL + 512 * 4;
    const int fr = F.lane & 15, fq = F.lane >> 4;
    bf16x8 bh[2][4], bl[2][4];
#pragma unroll
    for (int eh = 0; eh < 2; ++eh)
#pragma unroll
        for (int ks = 0; ks < 4; ++ks) { const size_t o = (size_t)(16 * eh + fr) * 1024 + 128 * F.wave + 32 * ks + 8 * fq; bh[eh][ks] = *(const bf16x8*)(RWT + o); bl[eh][ks] = *(const bf16x8*)(RWT + 32768 + o); }
    for (int rb = blockIdx.x; rb < NTOK / 128; rb += F.G) {
        const int m0 = rb * 128, b = m0 / SEQ; const float* ad = ADA + b * 6144;
        __syncthreads();
        for (int i = F.tid; i < 1024; i += NTHR) {
            PRM[i] = a.in[I_LNING][i] * DN_ALPHA; PRM[1024 + i] = a.in[I_LNINB][i] * DN_ALPHA; PRM[2048 + i] = ad[2048 + i];
            PRM[3072 + i] = a.in[I_LN1G][i]; PRM[4096 + i] = a.in[I_LN1B][i]; PRM[5120 + i] = ad[4096 + i] + 1.0f; PRM[6144 + i] = ad[3072 + i]; }
        if (F.tid < 64) HIST[F.tid] = 0u;
        __syncthreads();
#define P6_FETCH(m_) do { const int _m = (m_); _Pragma("unroll") for (int j = 0; j < 4; ++j) { xn[j] = __builtin_nontemporal_load((const f32x4*)(a.in[I_X] + (size_t)_m * DM) + F.lane + 64 * j); \
            yn[j] = __builtin_nontemporal_load((const v2u*)(Y1 + (size_t)_m * DM) + F.lane + 64 * j); } mn = STATS[2 * _m]; rn = STATS[2 * _m + 1]; } while (0)
        f32x4 xn[4]; v2u yn[4]; float mn, rn;
        P6_FETCH(m0 + 2 * F.wave);
        for (int it = 0; it < 8; ++it) {
#pragma unroll 1
            for (int rr = 0; rr < 2; ++rr) {
                const int lr = 2 * F.wave + rr, m = m0 + 16 * it + lr; const float mean = mn, rstd = rn;
                f32x4 xc[4]; v2u yc[4];
#pragma unroll
                for (int j = 0; j < 4; ++j) { xc[j] = xn[j]; yc[j] = yn[j]; }
                { const int q = 2 * it + rr + 1; const int mnext = q < 16 ? m0 + 16 * (q >> 1) + 2 * F.wave + (q & 1) : m; P6_FETCH(mnext); }
                f32x4 z[4]; float s = 0.f;
#pragma unroll
                for (int j = 0; j < 4; ++j) {
                    const f32x4 xv = xc[j];
                    const v2u yw = yc[j];
                    const f32x4 y = {bflo(yw.x), bfhi(yw.x), bflo(yw.y), bfhi(yw.y)};
                    const f32x4 p0 = ((const LAS f32x4*)PRM + F.lane)[64 * j], p1 = ((const LAS f32x4*)(PRM + 1024) + F.lane)[64 * j], p2 = ((const LAS f32x4*)(PRM + 2048) + F.lane)[64 * j];
                    z[j] = (xv - mean) * rstd * p0 + p1 + p2 * y;
                    s += (z[j].x + z[j].y) + (z[j].z + z[j].w);
                }
                const float mz = wave_sum(s) * (1.f / DM); float s2 = 0.f;
#pragma unroll
                for (int j = 0; j < 4; ++j) { z[j] = z[j] - mz; s2 += (z[j].x * z[j].x + z[j].y * z[j].y) + (z[j].z * z[j].z + z[j].w * z[j].w); }
                const float rz = 1.f / sqrtf(wave_sum(s2) * (1.f / DM) + LN_EPS);
#pragma unroll
                for (int j = 0; j < 4; ++j) {
                    const f32x4 p3 = ((const LAS f32x4*)(PRM + 3072) + F.lane)[64 * j], p4 = ((const LAS f32x4*)(PRM + 4096) + F.lane)[64 * j], p5 = ((const LAS f32x4*)(PRM + 5120) + F.lane)[64 * j], p6 = ((const LAS f32x4*)(PRM + 6144) + F.lane)[64 * j];
                    const f32x4 x1 = z[j] * rz * p3 + p4; const f32x4 h2 = x1 * p5 + p6;
                    { v2u xw; xw.x = pk2(x1.x, x1.y); xw.y = pk2(x1.z, x1.w); ((v2u*)((bf16_t*)X1 + (size_t)m * DM) + F.lane)[64 * j] = xw; }
                    const unsigned h0 = f2bf(h2.x), h1 = f2bf(h2.y), h2b = f2bf(h2.z), h3 = f2bf(h2.w);
                    v2u w; w.x = h0 | (h1 << 16); w.y = h2b | (h3 << 16);
                    { unsigned q = 0u; q = __builtin_amdgcn_cvt_pk_fp8_f32(h2.x, h2.y, q, false); q = __builtin_amdgcn_cvt_pk_fp8_f32(h2.z, h2.w, q, true); ((unsigned*)((unsigned char*)H2 + (size_t)m * DM) + F.lane)[64 * j] = q; }
                    v2u lo; lo.x = pk2(h2.x - bf2f(h0), h2.y - bf2f(h1)); lo.y = pk2(h2.z - bf2f(h2b), h2.w - bf2f(h3));
                    *(LAS v2u*)(HSH + lr * HP + 4 * F.lane + 256 * j) = w; *(LAS v2u*)(HSL + lr * HP + 4 * F.lane + 256 * j) = lo;
                }
            }
            __syncthreads();
            f32x4 acc[2] = {(f32x4){0.f, 0.f, 0.f, 0.f}, (f32x4){0.f, 0.f, 0.f, 0.f}};
#pragma unroll
            for (int ks = 0; ks < 4; ++ks) {
                const bf16x8 ah = *(const LAS bf16x8*)(HSH + fr * HP + 128 * F.wave + 32 * ks + 8 * fq), al = *(const LAS bf16x8*)(HSL + fr * HP + 128 * F.wave + 32 * ks + 8 * fq);
#pragma unroll
                for (int eh = 0; eh < 2; ++eh) { acc[eh] = __builtin_amdgcn_mfma_f32_16x16x32_bf16(ah, bh[eh][ks], acc[eh], 0, 0, 0); acc[eh] = __builtin_amdgcn_mfma_f32_16x16x32_bf16(ah, bl[eh][ks], acc[eh], 0, 0, 0); acc[eh] = __builtin_amdgcn_mfma_f32_16x16x32_bf16(al, bh[eh][ks], acc[eh], 0, 0, 0); }
            }
#pragma unroll
            for (int eh = 0; eh < 2; ++eh)
#pragma unroll
                for (int r = 0; r < 4; ++r) PP[(F.wave * 16 + 4 * fq + r) * 32 + 16 * eh + fr] = acc[eh][r];
            __syncthreads();
            {
                const int lr = 2 * F.wave + (F.lane >> 5), ex = F.lane & 31;
                float mine = a.in[I_RB][ex];
#pragma unroll
                for (int wv = 0; wv < 8; ++wv) mine += PP[(wv * 16 + lr) * 32 + ex];
                float sv[4]; int si[4];
#pragma unroll
                for (int k = 0; k < 4; ++k) {
                    float v = mine; int ix = ex;
#pragma unroll
                    for (int o = 16; o >= 1; o >>= 1) { const float ov = __shfl_xor(v, o); const int oi = __shfl_xor(ix, o); if (ov > v || (ov == v && oi < ix)) { v = ov; ix = oi; } }
                    sv[k] = v; si[k] = ix; if (ex == ix) mine = -3.0e38f;
                }
                const float e1 = __expf(sv[1] - sv[0]), e2 = __expf(sv[2] - sv[0]), e3 = __expf(sv[3] - sv[0]);
                const float rs = 1.0f / (1.0f + e1 + e2 + e3);
                if (ex < 4) {
                    const int sel = ex == 0 ? si[0] : (ex == 1 ? si[1] : (ex == 2 ? si[2] : si[3]));
                    const float gt = (ex == 0 ? 1.0f : (ex == 1 ? e1 : (ex == 2 ? e2 : e3))) * rs;
                    const unsigned rank = atomicAdd((unsigned*)(HIST + sel), 1u);
                    const int slot = (16 * it + lr) * 4 + ex;
                    SEL[slot * 4] = (unsigned)sel; SEL[slot * 4 + 1] = rank; SEL[slot * 4 + 2] = (unsigned)((m0 + 16 * it + lr) * 4 + ex); SEL[slot * 4 + 3] = __float_as_uint(gt);
                }
            }
        }
        __syncthreads();
        if (F.tid < 32) HIST[32 + F.tid] = atomicAdd(CNT + F.tid, HIST[F.tid]);
        __syncthreads();
        { const unsigned ex = SEL[F.tid * 4], rank = SEL[F.tid * 4 + 1]; v2u ent; ent.x = SEL[F.tid * 4 + 2]; ent.y = SEL[F.tid * 4 + 3]; LIST[(size_t)ex * LISTCAP + HIST[32 + ex] + rank] = ent; }
    }
}

__device__ __forceinline__ void p9_final(const Args& a, Frame& F) {
    unsigned char* ws = a.ws;
    const float* ADA = (const float*)(ws + WS_ADA); const bf16_t* X1 = (const bf16_t*)(ws + WS_X1); const unsigned char* YE = (const unsigned char*)(ws + WS_YE);
    unsigned yn[4][4]; v2u xn[4];
    auto fetch = [&](int m) {
#pragma unroll
        for (int j = 0; j < 4; ++j) {
#pragma unroll
            for (int k = 0; k < 4; ++k) yn[j][k] = __builtin_nontemporal_load((const unsigned*)(YE + ((size_t)m * 4 + k) * DM) + F.lane + 64 * j);
            xn[j] = __builtin_nontemporal_load((const v2u*)(X1 + (size_t)m * DM) + F.lane + 64 * j); } };
    if (F.gw < NTOK) fetch(F.gw);
    for (int m = F.gw; m < NTOK; m += F.ngw) {
        const int b = m / SEQ; const float* ad = ADA + b * 6144;
        f32x4 z[4]; float s = 0.f;
#pragma unroll
        for (int j = 0; j < 4; ++j) {
            f32x4 f = {0.f, 0.f, 0.f, 0.f};
#pragma unroll
            for (int k = 0; k < 4; ++k) { const unsigned yw = yn[j][k];
                f += (f32x4){__builtin_amdgcn_cvt_f32_fp8(yw, 0), __builtin_amdgcn_cvt_f32_fp8(yw, 1), __builtin_amdgcn_cvt_f32_fp8(yw, 2), __builtin_amdgcn_cvt_f32_fp8(yw, 3)}; }
            f = f * (1.0f / 64.0f);
            const v2u xw = xn[j]; const f32x4 x1 = {bflo(xw.x), bfhi(xw.x), bflo(xw.y), bfhi(xw.y)};
            const f32x4 g2 = ((const f32x4*)(ad + 5120) + F.lane)[64 * j];
            z[j] = x1 * DN_ALPHA + g2 * f;
            s += (z[j].x + z[j].y) + (z[j].z + z[j].w);
        }
        fetch((m + F.ngw < NTOK) ? m + F.ngw : m);
        const float mz = wave_sum(s) * (1.f / DM); float s2 = 0.f;
#pragma unroll
        for (int j = 0; j < 4; ++j) { z[j] = z[j] - mz; s2 += (z[j].x * z[j].x + z[j].y * z[j].y) + (z[j].z * z[j].z + z[j].w * z[j].w); }
        const float rz = 1.f / sqrtf(wave_sum(s2) * (1.f / DM) + LN_EPS);
#pragma unroll
        for (int j = 0; j < 4; ++j) {
            const f32x4 g = ((const f32x4*)a.in[I_LN2G] + F.lane)[64 * j], bb = ((const f32x4*)a.in[I_LN2B] + F.lane)[64 * j];
            __builtin_nontemporal_store(z[j] * rz * g + bb, (f32x4*)(a.out + (size_t)m * DM) + F.lane + 64 * j);
        }
    }
}

constexpr int N_PHASES = 10;
constexpr int CONV_NIT = NEXP * (16 * 32 + 16 * 16), CONV_P2 = 64 * 8 * 4;
#ifndef MK_N_LAUNCHES
#define MK_N_LAUNCHES 1
#endif
__global__ void __launch_bounds__(NTHR, 2) fwd_kernel(Args a) {
    extern __shared__ __attribute__((aligned(16))) unsigned char lds[];
    Frame F;
    F.lds = (LAS unsigned char*)lds;
#define REFRESH() do { int _t = threadIdx.x; asm volatile("" : "+v"(_t)); F.tid = _t; F.lane = _t & 63; F.wave = __builtin_amdgcn_readfirstlane(_t >> 6); F.gtid = blockIdx.x * NTHR + _t; F.gw = blockIdx.x * NWAVES + F.wave; } while (0)
    F.G = gridDim.x; F.nthreads = F.G * NTHR; F.ngw = F.G * NWAVES; REFRESH();
    F.ctl = (unsigned*)(a.ws + WS_CTL);
    volatile LAS unsigned* MISC = (volatile LAS unsigned*)(F.lds + MISC_OFF);
    for (int u = F.tid; u < (LDS_BYTES - 131072) / 4; u += NTHR) ((LAS unsigned*)(F.lds + 131072))[u] = 0u;
    __syncthreads();
    XcdBarrier bar; bar.bar = F.ctl + CW_BAR + a.li * XCD_BAR_WORDS; bar.x = 0; bar.st = nullptr;
    if (MK_N_LAUNCHES == 1) bar = xcd_barrier_post(F.ctl + CW_BAR, MISC + 8);
    const int lo = a.ph_lo, hi = a.ph_hi;
#define IN(k) (lo <= (k) && (k) < hi)
#define SEAM(k) do { if (IN(k) && IN((k) + 1)) xcd_barrier(bar); } while (0)
    if (IN(0)) { REFRESH(); p0_prologue(a, F); } SEAM(0);
    if (IN(1)) { REFRESH(); p1_ln_mod(a, F); } SEAM(1);
    if (IN(2)) { REFRESH();
        pg8::SchedInProj S{F.G, (int)blockIdx.x}; pg8::EpiInProj E{a.ws, a.in[I_QNG], a.in[I_KNG], (const float*)(a.ws + WS_ROPE)};
        pg8::gemm_phase<pg8::EpiInProj, pg8::SchedInProj, false>(F.lds, (const bf16_t*)(a.ws + WS_H), (const bf16_t*)(a.ws + WS_WIN), S, E);
        if (F.G == 256) { if (blockIdx.x >= 192) { REFRESH(); __syncthreads(); moe_weights_convert(a, F, 0, CONV_P2, ((int)blockIdx.x - 192) * NWAVES + F.wave, 64 * NWAVES); } }
        else if (blockIdx.x == 0) {   }
    } SEAM(2);
    if (IN(3)) { REFRESH();
        const attn_body::AttnTensors AT{(const attn_body::bf16*)(a.ws + WS_AQ), (const attn_body::bf16*)(a.ws + WS_AK), (const attn_body::bf16*)(a.ws + WS_AV), (attn_body::bf16*)(a.ws + WS_MIX) + 512};
        const attn_body::StaticOrder S((int)F.G, (int)blockIdx.x);
        if ((F.G & 255) == 0) {
            float gqm = 0.f, gkm = 0.f;
            for (int i = 0; i < 64; ++i) { gqm = fmaxf(gqm, fabsf(a.in[I_QNG][i])); gkm = fmaxf(gkm, fabsf(a.in[I_KNG][i])); }
            const float refB = 1.02f * C2 * 64.0f * gqm * gkm;
            const int slot = (int)(blockIdx.x % 5u); attn_body::AttnUnit u;
            for (int i = 0; i < 5; ++i) {
                if (i == slot) { __syncthreads(); moe_weights_convert(a, F, CONV_P2, CONV_NIT, F.gw, F.ngw); __syncthreads(); }
                if (i < 4 && S.next(i, u)) attn_body::attn_unit<8>(u.b, u.h, u.qb, AT.Q, AT.K, AT.V, AT.O, (char*)lds, refB);
            }
        } else { p3_attn_scalar(a, F); __syncthreads(); moe_weights_convert(a, F, 0, CONV_NIT, F.gw, F.ngw); }
        __syncthreads();
        for (int u = blockIdx.x; u < 256; u += F.G) { const int dvh = u & 1, dir = (u >> 1) & 1, h = (u >> 2) & 3, b = u >> 4;
            ret::state_unit(b, h, dir, dvh, (const bf16_t*)(a.ws + WS_RK), (const bf16_t*)(a.ws + WS_RV), (bf16_t*)(a.ws + WS_ST), (dir ? a.in[I_LDB][h] : a.in[I_LDF][h]) * 1.4426950408889634f, F.lds); }
    } SEAM(3);
    if (IN(4)) { REFRESH();
        ret::OutRegs R; int u = blockIdx.x;
        if (u < 1024) ret::out_load(R, u, (const bf16_t*)(a.ws + WS_RQ), (const bf16_t*)(a.ws + WS_RK), (const bf16_t*)(a.ws + WS_RV), (const bf16_t*)(a.ws + WS_RG));
        for (; u < 1024; u += F.G) { const int un = (u + F.G < 1024) ? u + F.G : -1;
            ret::out_unit(R, u, un, (const bf16_t*)(a.ws + WS_RQ), (const bf16_t*)(a.ws + WS_RK), (const bf16_t*)(a.ws + WS_RV), (const bf16_t*)(a.ws + WS_RG), (const bf16_t*)(a.ws + WS_ST), a.in[I_GNG], a.in[I_GNB],
                          a.in[I_LDF], a.in[I_LDB], (bf16_t*)(a.ws + WS_MIX), F.lds); }
    } SEAM(4);
    if (IN(5)) { REFRESH();
        pg8::SchedDense S{NTOK / 256, DM / 256, F.G, (int)blockIdx.x}; pg8::EpiPlainBf16 E{(bf16_t*)(a.ws + WS_Y1), DM};
        pg8::gemm_phase<pg8::EpiPlainBf16, pg8::SchedDense, false>(F.lds, (const bf16_t*)(a.ws + WS_MIX), (const bf16_t*)(a.ws + WS_WO), S, E);
    } SEAM(5);
    if (IN(6)) { REFRESH(); p6_ln1_route(a, F); } SEAM(6);
    if (IN(7)) { REFRESH();
        LAS int* tab = (LAS int*)(F.lds + 131072 + 1024); pg8::moe_build_tab(tab, F.ctl + CW_CNT);
        pg8::SchedMoE S{8, 2048, F.G, (int)blockIdx.x, tab, (const v2u*)(a.ws + WS_LIST)}; pg8::EpiUp E{a.ws + WS_ACT, a.in[I_BUP]};
        pg8::gemm_phase<pg8::EpiUp, pg8::SchedMoE, true, true>(F.lds, (const bf16_t*)(a.ws + WS_H2), (const bf16_t*)(a.ws + WS_WUP), S, E);
    } SEAM(7);
    if (IN(8)) { REFRESH();
        LAS int* tab = (LAS int*)(F.lds + 131072 + 1024); pg8::moe_build_tab(tab, F.ctl + CW_CNT);
        pg8::SchedMoE S{4, 1024, F.G, (int)blockIdx.x, tab, (const v2u*)(a.ws + WS_LIST)}; pg8::EpiDown E{(bf16_t*)(a.ws + WS_YE), a.in[I_BDN], (const v2u*)(a.ws + WS_LIST)};
        pg8::gemm_phase<pg8::EpiDown, pg8::SchedMoE, false, true>(F.lds, (const bf16_t*)(a.ws + WS_ACT), (const bf16_t*)(a.ws + WS_WDN), S, E);
    } SEAM(8);
    if (IN(9)) { REFRESH(); p9_final(a, F); }
#undef IN
#undef SEAM
}

extern "C" void kernel_launch(void* const* d_in, const int* in_sizes, int n_in, void* d_out, int out_size, void* d_ws, size_t ws_size, hipStream_t stream) {
    static int grid = 0;
    if (grid == 0) {
        if (n_in != 26 || out_size != NTOK * DM || ws_size < WS_END) { fprintf(stderr, "kernel_launch: unexpected shapes (n_in %d, out %d, ws %zu); nothing launched\n", n_in, out_size, ws_size); grid = -1; return; }
        int dev = 0, cus = 0;
        if (hipGetDevice(&dev) != hipSuccess || hipDeviceGetAttribute(&cus, hipDeviceAttributeMultiprocessorCount, dev) != hipSuccess) { grid = -1; return; }
        if (hipFuncSetAttribute((const void*)fwd_kernel, hipFuncAttributeMaxDynamicSharedMemorySize, LDS_BYTES) != hipSuccess) { fprintf(stderr, "kernel_launch: hipFuncSetAttribute failed\n"); grid = -1; return; }
        (void)hipGetLastError();
        grid = cus;
    }
    if (grid < 0) return;
    if (hipMemsetAsync((char*)d_ws + WS_CTL, 0, CTL_ZERO_BYTES, stream) != hipSuccess) return;
    Args a{};
    for (int i = 0; i < 26; ++i) a.in[i] = (const float*)d_in[i];
    a.out = (float*)d_out; a.ws = (unsigned char*)d_ws;
    if (MK_N_LAUNCHES == 1) { a.ph_lo = 0; a.ph_hi = N_PHASES; a.li = 0; hipLaunchKernelGGL(fwd_kernel, dim3(grid), dim3(NTHR), LDS_BYTES, stream, a); }
    else for (int p = 0; p < N_PHASES; ++p) { a.ph_lo = p; a.ph_hi = p + 1; a.li = 0; hipLaunchKernelGGL(fwd_kernel, dim3(grid), dim3(NTHR), LDS_BYTES, stream, a); }
}
```

```cpp
#include <hip/hip_runtime.h>
#include <cstdio>
#include <cstdint>

constexpr int BATCH = 16, SEQ = 2048, DM = 1024, CTX = 256, SU = SEQ + CTX;
constexpr int NTOK = BATCH * SEQ, NROW = BATCH * SU;
constexpr int NIN = 2304, NEXP = 32, LISTCAP = 32768;
constexpr float LN_EPS = 1e-6f, DN_ALPHA = 1.189207115002721f;
constexpr float C2 = 0.125f * 1.4426950408889634f;
constexpr int NWAVES = 8, NTHR = 512;

constexpr size_t MiB = 1u << 20;
constexpr size_t WS_CTL = 0, CTL_ZERO_BYTES = 1 * MiB;
constexpr size_t WS_ADA = 1 * MiB, WS_ROPE = 1 * MiB + 512 * 1024, WS_STATS = 2 * MiB, WS_LIST = 4 * MiB;
constexpr size_t WS_RWT = 12 * MiB;
constexpr size_t WS_WIN = 16 * MiB, WS_WO = 22 * MiB, WS_WUP = 32 * MiB, WS_WDN = 160 * MiB;
constexpr size_t WS_X1 = 224 * MiB, WS_H2 = 352 * MiB, WS_ACT = 416 * MiB;
constexpr size_t WS_MIX = 416 * MiB, WS_Y1 = 480 * MiB, WS_YRET = 544 * MiB;
constexpr size_t WS_YE = 688 * MiB;
constexpr size_t WS_H = 688 * MiB, WS_RQ = 760 * MiB, WS_RK = 776 * MiB, WS_RV = 794 * MiB, WS_RG = 830 * MiB, WS_AQ = 862 * MiB, WS_AK = 894 * MiB, WS_AV = 903 * MiB;
constexpr size_t WS_ST = 912 * MiB;
constexpr size_t WS_END = 944 * MiB;
constexpr int CW_TMO = 0, CW_CNT = 256, CW_BAR = 4096;

#define GAS __attribute__((address_space(1)))
#define LAS __attribute__((address_space(3)))
typedef unsigned short bf16_t;
typedef unsigned v4u __attribute__((ext_vector_type(4)));
typedef unsigned v2u __attribute__((ext_vector_type(2)));
typedef float f32x4 __attribute__((ext_vector_type(4)));

__device__ __forceinline__ float bf2f(unsigned v) { return __uint_as_float(v << 16); }
__device__ __forceinline__ unsigned f2bf(float f) { unsigned u = __float_as_uint(f); return (u + 0x7fffu + ((u >> 16) & 1u)) >> 16; }
__device__ __forceinline__ unsigned pk2(float lo, float hi) { return f2bf(lo) | (f2bf(hi) << 16); }
__device__ __forceinline__ float bflo(unsigned w) { return __uint_as_float(w << 16); }
__device__ __forceinline__ float bfhi(unsigned w) { return __uint_as_float(w & 0xffff0000u); }
__device__ __forceinline__ float wave_sum(float v) {
#pragma unroll
    for (int o = 1; o < 64; o <<= 1) v += __shfl_xor(v, o);
    return v;
}
__device__ __forceinline__ float dot8(v4u a, v4u w, float acc) {
    acc = fmaf(bflo(a.x), bflo(w.x), acc); acc = fmaf(bfhi(a.x), bfhi(w.x), acc);
    acc = fmaf(bflo(a.y), bflo(w.y), acc); acc = fmaf(bfhi(a.y), bfhi(w.y), acc);
    acc = fmaf(bflo(a.z), bflo(w.z), acc); acc = fmaf(bfhi(a.z), bfhi(w.z), acc);
    acc = fmaf(bflo(a.w), bflo(w.w), acc); acc = fmaf(bfhi(a.w), bfhi(w.w), acc);
    return acc;
}

#define XB_TMO      128
#define XB_XCNT(j)  (256  + 64 * (j))
#define XB_XSUB(j)  (1280 + 64 * (j))
#define XB_XGEN(j)  (2304 + 64 * (j))
#define XB_TOP      3328
#define XB_TOPGEN   3392
#define XCD_BAR_WORDS 3456
#define XB_SPIN_CAP (1u << 24)
__device__ __forceinline__ unsigned xb_ld(unsigned* p)              { return __hip_atomic_load(p, __ATOMIC_RELAXED, __HIP_MEMORY_SCOPE_AGENT); }
__device__ __forceinline__ unsigned xb_add(unsigned* p, unsigned v) { return __hip_atomic_fetch_add(p, v, __ATOMIC_RELAXED, __HIP_MEMORY_SCOPE_AGENT); }
__device__ __forceinline__ unsigned xb_xcc_id() { return (unsigned)__builtin_amdgcn_s_getreg((3 << 11) | 20) & 0xFu; }
#define XB_SPIN(cond, bar) do { unsigned _sp = 0; while (cond) { __builtin_amdgcn_s_sleep(1); \
    if ((++_sp & 255u) == 0u) { if (xb_ld(&(bar)[XB_TMO])) break; if (_sp > XB_SPIN_CAP) { atomicAdd(&(bar)[XB_TMO], 1u); break; } } } } while (0)
struct XcdBarrier { unsigned* bar; unsigned x; volatile LAS unsigned* st; };
__device__ __forceinline__ XcdBarrier xcd_barrier_post(unsigned* bar, volatile LAS unsigned* st) {
    XcdBarrier b; b.bar = bar; b.x = xb_xcc_id(); b.st = st;
    if (threadIdx.x == 0) (void)xb_add(&bar[XB_XCNT(b.x)], 1u);
    return b;
}
__device__ __forceinline__ void xcd_barrier_complete(unsigned* bar, unsigned x, unsigned& nloc, unsigned& nx) {
    const unsigned G = gridDim.x * gridDim.y * gridDim.z;
    unsigned sum, cnt, mine, sp = 0u;
    for (;;) {
        sum = 0u; cnt = 0u; mine = 0u;
#pragma unroll
        for (unsigned j = 0; j < 16; ++j) { const unsigned c = xb_ld(&bar[XB_XCNT(j)]); sum += c; cnt += (c > 0u) ? 1u : 0u; mine = (j == x) ? c : mine; }
        if (sum == G) break;
        __builtin_amdgcn_s_sleep(1);
        if ((++sp & 255u) == 0u) { if (xb_ld(&bar[XB_TMO])) break; if (sp > XB_SPIN_CAP) { atomicAdd(&bar[XB_TMO], 1u); break; } }
    }
    nloc = mine > 0u ? mine : 1u; nx = cnt > 0u ? cnt : 1u;
}
__device__ __forceinline__ void xcd_barrier(const XcdBarrier& b) {
    asm volatile("s_waitcnt vmcnt(0)" ::: "memory");
    __syncthreads();
    if (threadIdx.x == 0) {
        unsigned* bar = b.bar;
        __builtin_amdgcn_s_waitcnt(0);
        unsigned nloc = b.st[0], nx = b.st[1];
        if (nloc == 0u) { xcd_barrier_complete(bar, b.x, nloc, nx); b.st[0] = nloc; b.st[1] = nx; }
        const unsigned old = xb_add(&bar[XB_XSUB(b.x)], 1u);
        const unsigned gen = old / nloc;
        if (old + 1u == (gen + 1u) * nloc) {
            __builtin_amdgcn_fence(__ATOMIC_RELEASE, "agent");
            asm volatile("s_waitcnt vmcnt(0)" ::: "memory");
            const unsigned og = xb_add(&bar[XB_TOP], 1u);
            const unsigned tg = og / nx;
            if (og + 1u == (tg + 1u) * nx) xb_add(&bar[XB_TOPGEN], 1u);
            else XB_SPIN(xb_ld(&bar[XB_TOPGEN]) == tg, bar);
            __builtin_amdgcn_fence(__ATOMIC_ACQUIRE, "agent");
            xb_add(&bar[XB_XGEN(b.x)], 1u);
            asm volatile("s_waitcnt vmcnt(0)" ::: "memory");
        } else {
            XB_SPIN(xb_ld(&bar[XB_XGEN(b.x)]) == gen, bar);
            __builtin_amdgcn_fence(__ATOMIC_ACQUIRE, "agent");
            asm volatile("s_waitcnt vmcnt(0)" ::: "memory");
        }
    }
    __syncthreads();
}

namespace pg8 {
typedef short bf16x8 __attribute__((ext_vector_type(8)));
typedef int v4i __attribute__((ext_vector_type(4)));
typedef int v8i __attribute__((ext_vector_type(8)));
constexpr int BM = 256, BK = 64, HALF = 128, HTB = HALF * BK * 2, NXCD = 8, WGM = 1, KD = 1024, NT = KD / BK;
__device__ __forceinline__ int lds_byte(int r, int c) { const int st = (r >> 4) * 2 + (c >> 5), rr = r & 15, cc = c & 31, ob = rr * 64 + cc * 2; return st * 1024 + (ob ^ (((ob >> 9) & 1) << 5)); }
__device__ __forceinline__ void stage_rc(int b, int& R, int& C) { const int st = b / 1024, sb = b % 1024, swz = sb ^ (((sb >> 9) & 1) << 5); R = (st >> 1) * 16 + swz / 64; C = (st & 1) * 32 + (swz % 64) / 2; }
__device__ __forceinline__ int perm32(int rho) { const int n = rho >> 4, i = rho & 15; return 8 * (i >> 2) + 4 * n + (i & 3); }
__device__ __forceinline__ unsigned cvt_pk_bf16(float lo, float hi) { unsigned r; asm volatile("v_cvt_pk_bf16_f32 %0, %1, %2" : "=v"(r) : "v"(lo), "v"(hi)); return r; }

struct Unit { int pm, pn, brow, e, r0, cnt; };

__device__ __forceinline__ void tile_order(int L, int nM, int nN, int& pm, int& pn) {
    const int nwg = nM * nN; int wgid = L; { const int q = nwg / NXCD, r = nwg % NXCD, xcd = wgid % NXCD, off = wgid / NXCD; wgid = (xcd < r ? xcd * (q + 1) : r * (q + 1) + (xcd - r) * q) + off; }
    const int nig = WGM * nN, gid = wgid / nig, fm = gid * WGM, gsz = (nM - fm) < WGM ? (nM - fm) : WGM;
    pm = fm + ((wgid % nig) % gsz); pn = (wgid % nig) / gsz;
}
struct SchedDense {
    int nM, nN, G, c;
    __device__ __forceinline__ bool next(int i, Unit& u) const { const long L = (long)i * G + c; if (L >= (long)nM * nN) return false; tile_order((int)L, nM, nN, u.pm, u.pn); u.brow = u.pn * BM; u.e = 0; u.r0 = 0; u.cnt = 0; return true; }
    __device__ __forceinline__ unsigned arow_tok(const Unit&, int) const { return 0u; }
};

template <class Epi, class Sched, bool GATHER, bool F8 = false>
__device__ __forceinline__ void gemm_phase(LAS unsigned char* lds, const bf16_t* A, const bf16_t* Bt, const Sched& S, const Epi& E) {
    const int tid = threadIdx.x, wid = __builtin_amdgcn_readfirstlane(tid >> 6), lane = tid & 63, wr = wid >> 2, wc = wid & 3, fr = lane & 15, fq = lane >> 4;
    constexpr int K = F8 ? KD / 2 : KD, nt = F8 ? NT / 2 : NT;
    unsigned voffA[2], voffB[2];
#pragma unroll
    for (int i = 0; i < 2; ++i) { int R, C; stage_rc(tid * 16 + i * 8192, R, C); const int Rb = Epi::PERM ? ((R & ~31) + perm32(R & 31)) : R;
        voffA[i] = GATHER ? (unsigned)(C * 2) : (unsigned)(R * K + C) * 2u; voffB[i] = (unsigned)(Rb * K + C) * 2u; }
    constexpr size_t kstep = (size_t)(BK * 2), hstep = (size_t)HALF * K * 2, tstep = 2 * hstep;
    const unsigned ldsw = (unsigned)wid * 1024u;
    const int aoff = lds_byte(wr * 64 + fr, fq * 8), boff = lds_byte(wc * 32 + fr, fq * 8);
#define PG8_SA(b, h) (((b) * 2 + (h)) * HTB)
#define PG8_SB(b, h) ((4 + (b) * 2 + (h)) * HTB)
#define PG8_STAGE_B(bufoff, gbase) do { _Pragma("unroll") for (int _i = 0; _i < 2; ++_i) \
        __builtin_amdgcn_global_load_lds((const unsigned*)((const char*)(gbase) + voffB[_i]), (LAS unsigned*)(lds + (bufoff) + ldsw + _i * 8192), 16, 0, 0); } while (0)
#define PG8_STAGE_A(bufoff, h, kb, nx) do { _Pragma("unroll") for (int _i = 0; _i < 2; ++_i) { \
        const char* _src = GATHER ? (const char*)A + (((((nx) ? ron[h] : roc[h]) >> (16 * _i)) & 0xffffu) << (F8 ? 10 : 11)) + voffA[0] + (kb) : ((nx) ? nA : cA) + (size_t)(h) * hstep + (kb) + voffA[_i]; \
        __builtin_amdgcn_global_load_lds((const unsigned*)_src, (LAS unsigned*)(lds + (bufoff) + ldsw + _i * 8192), 16, 0, 0); } } while (0)
#define PG8_LDA(dst, b, h) do { _Pragma("unroll") for (int m = 0; m < 4; ++m) { if constexpr (F8) { dst##8[m].lo = *(const LAS v4i*)(lds + PG8_SA(b, h) + aoff + m * 2048); dst##8[m].hi = *(const LAS v4i*)(lds + PG8_SA(b, h) + aoff + m * 2048 + 1024); } \
        else { _Pragma("unroll") for (int k = 0; k < 2; ++k) dst[m][k] = *(const LAS bf16x8*)(lds + PG8_SA(b, h) + aoff + m * 2048 + k * 1024); } } } while (0)
#define PG8_LDB(dst, b, h) do { _Pragma("unroll") for (int n = 0; n < 2; ++n) { if constexpr (F8) { dst##8[n].lo = *(const LAS v4i*)(lds + PG8_SB(b, h) + boff + n * 2048); dst##8[n].hi = *(const LAS v4i*)(lds + PG8_SB(b, h) + boff + n * 2048 + 1024); } \
        else { _Pragma("unroll") for (int k = 0; k < 2; ++k) dst[n][k] = *(const LAS bf16x8*)(lds + PG8_SB(b, h) + boff + n * 2048 + k * 1024); } } } while (0)
#define PG8_MMA(ai, bj, At, Bt_) do { __builtin_amdgcn_s_setprio(1); _Pragma("unroll") for (int m = 0; m < 4; ++m) _Pragma("unroll") for (int n = 0; n < 2; ++n) { \
        if constexpr (F8) { asm volatile("v_mfma_scale_f32_16x16x128_f8f6f4 %0, %1, %2, %0, %3, %3 op_sel_hi:[0,0,0]" : "+v"(acc[ai][bj][m][n]) : "v"(Bt_##8[n]), "v"(At##8[m]), "v"(sc8)); } \
        else { _Pragma("unroll") for (int k = 0; k < 2; ++k) acc[ai][bj][m][n] = __builtin_amdgcn_mfma_f32_16x16x32_bf16(Bt_[n][k], At[m][k], acc[ai][bj][m][n], 0, 0, 0); } } \
        __builtin_amdgcn_s_setprio(0); } while (0)
#define PG8_WAIT_V(n) asm volatile("s_waitcnt vmcnt(" #n ")" ::: "memory")
#define PG8_WAIT_L(n) asm volatile("s_waitcnt lgkmcnt(" #n ")" ::: "memory")
#define PG8_BAR __builtin_amdgcn_s_barrier()
#define PG8_SCHED __builtin_amdgcn_sched_barrier(0)
#define PG8_LOAD_RO(dst, unit) do { int _R, _C; stage_rc((int)threadIdx.x * 16, _R, _C); _Pragma("unroll") for (int _h = 0; _h < 2; ++_h) dst[_h] = S.arow_tok(unit, _h * HALF + _R) | (S.arow_tok(unit, _h * HALF + _R + 64) << 16); } while (0)
    Unit cur, nxt; int ui = 0;
    if (!S.next(0, cur)) return;
    f32x4 acc[2][2][4][2];
#pragma unroll
    for (int a = 0; a < 2; ++a)
#pragma unroll
        for (int b = 0; b < 2; ++b)
#pragma unroll
            for (int m = 0; m < 4; ++m)
#pragma unroll
                for (int n = 0; n < 2; ++n) acc[a][b][m][n] = (f32x4){0.f, 0.f, 0.f, 0.f};
    if (Epi::HAS_INIT) { const typename Epi::Init i0 = E.init(cur, wr, wc, fr, fq);
#pragma unroll
      for (int a = 0; a < 2; ++a)
#pragma unroll
        for (int b = 0; b < 2; ++b)
#pragma unroll
            for (int m = 0; m < 4; ++m)
#pragma unroll
                for (int n = 0; n < 2; ++n) acc[a][b][m][n] = i0.v[b][n]; }
    unsigned sc8 = 0x7c7c7c7cu; asm volatile("" : "+v"(sc8));
    bf16x8 At[4][2], B0[2][2], B1[2][2]; v8i At8[4], B08[2], B18[2];
    unsigned roc[2] = {0u, 0u}, ron[2] = {0u, 0u};
    bool has_next = S.next(1, nxt);
    if (GATHER) { PG8_LOAD_RO(roc, cur); if (has_next) { PG8_LOAD_RO(ron, nxt); } else { ron[0] = roc[0]; ron[1] = roc[1]; } }
    const char* cA = (const char*)A + (GATHER ? (size_t)0 : (size_t)cur.pm * tstep); const char* cB = (const char*)Bt + (size_t)cur.brow * K * 2;
    const char* nA = cA;
    PG8_STAGE_B(PG8_SB(0, 0), cB); PG8_STAGE_B(PG8_SB(0, 1), cB + hstep); PG8_STAGE_A(PG8_SA(0, 0), 0, 0, false); PG8_STAGE_A(PG8_SA(0, 1), 1, 0, false);
    if (wr == 1) PG8_BAR;
    PG8_WAIT_V(2); PG8_BAR;
    PG8_STAGE_B(PG8_SB(1, 0), cB + kstep); PG8_STAGE_A(PG8_SA(1, 0), 0, kstep, false); PG8_STAGE_B(PG8_SB(1, 1), cB + hstep + kstep);
    PG8_WAIT_V(6); PG8_BAR;
    for (;;) {
        nA = (has_next && !GATHER) ? (const char*)A + (size_t)nxt.pm * tstep : cA;
        const char* nB = has_next ? (const char*)Bt + (size_t)nxt.brow * K * 2 : cB;
#pragma unroll 1
        for (int t = 0; t < nt; t += 2) {
            const bool last = (t == nt - 2);
            const size_t k1 = (size_t)(t + 1) * kstep, k2 = last ? (size_t)0 : (size_t)(t + 2) * kstep, k3 = k2 + kstep;
            const char* b2 = last ? nB : cB + (size_t)(t + 2) * kstep; const char* b3 = b2 + kstep;
            PG8_LDB(B0, 0, 0); PG8_LDB(B1, 0, 1); PG8_SCHED; PG8_LDA(At, 0, 0); PG8_STAGE_A(PG8_SA(1, 1), 1, k1, false);
            PG8_WAIT_V(8); PG8_WAIT_L(0); PG8_BAR; PG8_MMA(0, 0, At, B0); PG8_MMA(0, 1, At, B1); PG8_BAR; PG8_SCHED;
            PG8_LDA(At, 0, 1); PG8_STAGE_B(PG8_SB(0, 0), b2); PG8_STAGE_B(PG8_SB(0, 1), b2 + hstep); PG8_STAGE_A(PG8_SA(0, 0), 0, k2, last);
            PG8_WAIT_V(8); PG8_WAIT_L(0); PG8_BAR; PG8_MMA(1, 0, At, B0); PG8_MMA(1, 1, At, B1); PG8_BAR; PG8_SCHED;
            PG8_LDB(B0, 1, 0); PG8_LDB(B1, 1, 1); PG8_SCHED; PG8_LDA(At, 1, 0); PG8_STAGE_A(PG8_SA(0, 1), 1, k2, last);
            PG8_WAIT_V(8); PG8_WAIT_L(0); PG8_BAR; PG8_MMA(0, 0, At, B0); PG8_MMA(0, 1, At, B1); PG8_BAR; PG8_SCHED;
            PG8_LDA(At, 1, 1); PG8_STAGE_B(PG8_SB(1, 0), b3); PG8_STAGE_B(PG8_SB(1, 1), b3 + hstep); PG8_STAGE_A(PG8_SA(1, 0), 0, k3, last);
            PG8_WAIT_V(8); PG8_WAIT_L(0); PG8_BAR; PG8_MMA(1, 0, At, B0); PG8_MMA(1, 1, At, B1); PG8_BAR; PG8_SCHED;
        }
        const typename Epi::Pre pre = E.pre(cur, wr, wc, fr, fq);
        typename Epi::Init inx = typename Epi::Init(); if (Epi::HAS_INIT && has_next) inx = E.init(nxt, wr, wc, fr, fq);
        Unit nn; bool has_nn = false; unsigned rnn[2] = {0u, 0u};
        if (has_next) { has_nn = S.next(ui + 2, nn); if (GATHER && has_nn) { PG8_LOAD_RO(rnn, nn); } }
        if (wr == 0) PG8_BAR;
        if constexpr (F8) asm volatile("s_nop 15\n\ts_nop 15" ::: "memory");
        E(acc, cur, wr, wc, fr, fq, pre);
        if (!has_next) break;
#pragma unroll
        for (int a = 0; a < 2; ++a)
#pragma unroll
            for (int b = 0; b < 2; ++b)
#pragma unroll
                for (int m = 0; m < 4; ++m)
#pragma unroll
                    for (int n = 0; n < 2; ++n) acc[a][b][m][n] = Epi::HAS_INIT ? inx.v[b][n] : (f32x4){0.f, 0.f, 0.f, 0.f};
        cur = nxt; cA = nA; cB = nB; ++ui;
        has_next = has_nn; nxt = nn;
        if (GATHER) { roc[0] = ron[0]; roc[1] = ron[1]; if (has_next) { ron[0] = rnn[0]; ron[1] = rnn[1]; } }
        if (wr == 1) PG8_BAR;
    }
    PG8_WAIT_V(0);
    PG8_BAR;
#undef PG8_SA
#undef PG8_SB
#undef PG8_STAGE_A
#undef PG8_STAGE_B
#undef PG8_LDA
#undef PG8_LDB
#undef PG8_MMA
#undef PG8_WAIT_V
#undef PG8_WAIT_L
#undef PG8_BAR
#undef PG8_SCHED
#undef PG8_LOAD_RO
}

struct EpiPlainBf16 {
    static constexpr bool PERM = true;
    bf16_t* O; int ldc;
    static constexpr bool HAS_INIT = false; struct Init { f32x4 v[2][2]; };
    __device__ __forceinline__ Init init(const Unit&, int, int, int, int) const { return Init(); }
    struct Pre {};
    __device__ __forceinline__ Pre pre(const Unit&, int, int, int, int) const { return Pre{}; }
    __device__ __forceinline__ void operator()(const f32x4 (&acc)[2][2][4][2], const Unit& u, int wr, int wc, int fr, int fq, const Pre&) const {
        const int row0 = u.pm * BM + wr * 64 + fr, col0 = u.pn * BM + wc * 32 + 8 * fq;
#pragma unroll
        for (int ai = 0; ai < 2; ++ai)
#pragma unroll
            for (int m = 0; m < 4; ++m) { bf16_t* rowp = O + (size_t)(row0 + ai * HALF + m * 16) * ldc + col0;
#pragma unroll
                for (int bj = 0; bj < 2; ++bj) { const f32x4 v0 = acc[ai][bj][m][0], v1 = acc[ai][bj][m][1];
                    v4u w; w.x = cvt_pk_bf16(v0[0], v0[1]); w.y = cvt_pk_bf16(v0[2], v0[3]); w.z = cvt_pk_bf16(v1[0], v1[1]); w.w = cvt_pk_bf16(v1[2], v1[3]);
                    *(v4u*)(rowp + bj * HALF) = w; } }
    }
};

struct SchedInProj {
    int G, c;
    __device__ __forceinline__ bool next(int i, Unit& u) const {
        const int L = i * G + c;
        if (L < 1152) { int lt, pn; tile_order(L, 128, 9, lt, pn); u.pm = (lt >> 3) * 9 + 1 + (lt & 7); u.pn = pn; }
        else if (L < 1216) { const int q = L - 1152, ct = q >> 2, j = q & 3; u.pm = ct * 9; u.pn = (j == 3) ? 8 : 1 + j; }
        else return false;
        u.brow = u.pn * BM; u.e = 0; u.r0 = 0; u.cnt = 0; return true;
    }
    __device__ __forceinline__ unsigned arow_tok(const Unit&, int) const { return 0u; }
};
struct EpiInProj {
    static constexpr bool PERM = false;
    unsigned char* ws; const float* qng; const float* kng; const float* rope;
    static constexpr bool HAS_INIT = false; struct Init { f32x4 v[2][2]; };
    __device__ __forceinline__ Init init(const Unit&, int, int, int, int) const { return Init(); }
    struct Pre {};
    __device__ __forceinline__ Pre pre(const Unit&, int, int, int, int) const { return Pre{}; }
    __device__ __forceinline__ void operator()(const f32x4 (&acc)[2][2][4][2], const Unit& u, int wr, int wc, int fr, int fq, const Pre&) const {
        const int g = u.pn * 4 + wc, bt = u.pm / 9, pt = u.pm % 9; const bool isctx = (pt == 0);
        const int blk = fq >> 1, f1 = fq & 1, dbase = 32 * blk + 8 * f1;
        const bool do_rms = (g >= 24 && g < 34), do_rope = !isctx && (g < 8 || (g >= 24 && g < 34)), latrows = (g < 4) || (g >= 16 && g < 32);
        const float scale = (g >= 4 && g < 8) ? 0.125f : ((g >= 24 && g < 32) ? C2 : 1.0f);
        bf16_t* dst; int pitch;
        if (g < 4) { dst = (bf16_t*)(ws + WS_RQ) + g * 64; pitch = 256; }
        else if (g < 8) { dst = (bf16_t*)(ws + WS_RK) + (g - 4) * 64; pitch = 256; }
        else if (g < 16) { dst = (bf16_t*)(ws + WS_RV) + (g - 8) * 64; pitch = 512; }
        else if (g < 24) { dst = (bf16_t*)(ws + WS_RG) + (g - 16) * 64; pitch = 512; }
        else if (g < 32) { dst = (bf16_t*)(ws + WS_AQ) + (g - 24) * 64; pitch = 512; }
        else if (g < 34) { dst = (bf16_t*)(ws + WS_AK) + (g - 32) * 64; pitch = 128; }
        else { dst = (bf16_t*)(ws + WS_AV) + (g - 34) * 64; pitch = 128; }
        const int rowbase = latrows ? bt * SEQ + (pt - 1) * 256 : u.pm * 256;
        dst += dbase;
        f32x4 gv[2][2];
#pragma unroll
        for (int bj = 0; bj < 2; ++bj)
#pragma unroll
            for (int n = 0; n < 2; ++n) gv[bj][n] = do_rms ? *(const f32x4*)((g < 32 ? qng : kng) + dbase + 16 * bj + 4 * n) : (f32x4){1.f, 1.f, 1.f, 1.f};
#pragma unroll
        for (int ai = 0; ai < 2; ++ai)
#pragma unroll
            for (int m = 0; m < 4; ++m) {
                const int r = ai * HALF + wr * 64 + m * 16 + fr;
                f32x4 v[2][2];
#pragma unroll
                for (int bj = 0; bj < 2; ++bj)
#pragma unroll
                    for (int n = 0; n < 2; ++n) v[bj][n] = acc[ai][bj][m][n];
                if (do_rms) {
                    float ss = 0.f;
#pragma unroll
                    for (int bj = 0; bj < 2; ++bj)
#pragma unroll
                        for (int n = 0; n < 2; ++n) ss += (v[bj][n][0] * v[bj][n][0] + v[bj][n][1] * v[bj][n][1]) + (v[bj][n][2] * v[bj][n][2] + v[bj][n][3] * v[bj][n][3]);
                    ss += __shfl_xor(ss, 16); ss += __shfl_xor(ss, 32);
                    const float rinv = 1.0f / sqrtf(ss * (1.0f / 64.0f) + LN_EPS);
#pragma unroll
                    for (int bj = 0; bj < 2; ++bj)
#pragma unroll
                        for (int n = 0; n < 2; ++n) v[bj][n] = v[bj][n] * rinv * gv[bj][n];
                }
                if (do_rope) {
                    const int t = (pt - 1) * 256 + r, pos = blk ? (t & 63) : (t >> 6);
                    const f32x4* rp = (const f32x4*)(rope + pos * 32 + 16 * f1);
#pragma unroll
                    for (int n = 0; n < 2; ++n) { const f32x4 p0 = rp[2 * n], p1 = rp[2 * n + 1];
                        const f32x4 lo = v[0][n], hi = v[1][n];
                        const f32x4 cs = {p0[0], p0[2], p1[0], p1[2]}, sn = {p0[1], p0[3], p1[1], p1[3]};
                        v[0][n] = lo * cs - hi * sn; v[1][n] = hi * cs + lo * sn; }
                }
                bf16_t* rowp = dst + (size_t)(rowbase + r) * pitch;
#pragma unroll
                for (int bj = 0; bj < 2; ++bj) { const f32x4 v0 = v[bj][0] * scale, v1 = v[bj][1] * scale;
                    v4u w; w.x = cvt_pk_bf16(v0[0], v0[1]); w.y = cvt_pk_bf16(v0[2], v0[3]); w.z = cvt_pk_bf16(v1[0], v1[1]); w.w = cvt_pk_bf16(v1[2], v1[3]);
                    *(v4u*)(rowp + 16 * bj) = w; }
            }
    }
};

struct SchedMoE {
    int nN, NB, G, c; const LAS int* tab; const v2u* LIST;
    __device__ __forceinline__ bool next(int i, Unit& u) const {
        const int ntiles = __builtin_amdgcn_readfirstlane(tab[32]); const long L = (long)i * G + c; if (L >= (long)ntiles * nN) return false;
        tile_order((int)L, ntiles, nN, u.pm, u.pn);
        const int ln = (int)(threadIdx.x & 63u); const int tq = (ln >= 1 && ln < 32) ? tab[ln] : 0x7fffffff;
        const int e = __builtin_popcountll(__ballot(u.pm >= tq));
        u.e = e; u.r0 = (u.pm - __builtin_amdgcn_readfirstlane(tab[e])) * 256; u.cnt = __builtin_amdgcn_readfirstlane(tab[33 + e]); u.brow = e * NB + u.pn * BM; return true;
    }
    __device__ __forceinline__ unsigned arow_tok(const Unit& u, int r) const { int rr = u.r0 + r; rr = rr < u.cnt ? rr : u.cnt - 1; return LIST[(size_t)u.e * LISTCAP + rr].x >> 2; }
};
__device__ __forceinline__ void moe_build_tab(LAS int* tab, const unsigned* CNT) {
    if (threadIdx.x == 0) { int st = 0; for (int e = 0; e < 32; ++e) { const int c = (int)CNT[e]; tab[e] = st; tab[33 + e] = c; st += (c + 255) >> 8; } tab[32] = st; }
    __syncthreads();
}
struct EpiUp {
    static constexpr bool PERM = true;
    unsigned char* ACT; const float* bup;
    static constexpr bool HAS_INIT = true; struct Init { f32x4 v[2][2]; };
    __device__ __forceinline__ Init init(const Unit& u, int wr, int wc, int fr, int fq) const {
        const float* bg = bup + (size_t)u.e * 2048 + u.pn * 128 + wc * 32 + 8 * fq; Init i; i.v[0][0] = *(const f32x4*)bg; i.v[0][1] = *(const f32x4*)(bg + 4); i.v[1][0] = *(const f32x4*)(bg + 1024) + 1.0f; i.v[1][1] = *(const f32x4*)(bg + 1028) + 1.0f; return i; }
    struct Pre {};
    __device__ __forceinline__ Pre pre(const Unit&, int, int, int, int) const { return Pre{}; }
    __device__ __forceinline__ void operator()(const f32x4 (&acc)[2][2][4][2], const Unit& u, int wr, int wc, int fr, int fq, const Pre&) const {
        const int colt = u.pn * 128 + wc * 32 + 8 * fq;
#pragma unroll
        for (int ai = 0; ai < 2; ++ai)
#pragma unroll
            for (int m = 0; m < 4; ++m) {
                const int row = u.pm * BM + ai * HALF + wr * 64 + m * 16 + fr;
                f32x4 ag[2] = {acc[ai][0][m][0], acc[ai][0][m][1]}, al[2] = {acc[ai][1][m][0], acc[ai][1][m][1]};
                asm volatile("" : "+v"(ag[0]), "+v"(ag[1]), "+v"(al[0]), "+v"(al[1]));
                float o[8];
#pragma unroll
                for (int n = 0; n < 2; ++n)
#pragma unroll
                    for (int j = 0; j < 4; ++j) { const float gl = __builtin_amdgcn_fmed3f(ag[n][j], -3.0e38f, 7.0f); const float l1 = __builtin_amdgcn_fmed3f(al[n][j], -6.0f, 8.0f);
                        o[4 * n + j] = (gl * l1) * __builtin_amdgcn_rcpf(1.0f + __builtin_amdgcn_exp2f(-1.702f * 1.4426950408889634f * gl)); }
                v2u w; w.x = 0u; w.y = 0u;
                w.x = __builtin_amdgcn_cvt_pk_fp8_f32(o[0], o[1], w.x, false); w.x = __builtin_amdgcn_cvt_pk_fp8_f32(o[2], o[3], w.x, true);
                w.y = __builtin_amdgcn_cvt_pk_fp8_f32(o[4], o[5], w.y, false); w.y = __builtin_amdgcn_cvt_pk_fp8_f32(o[6], o[7], w.y, true);
                *(v2u*)(ACT + (size_t)row * 1024 + colt) = w;
            }
    }
};
struct EpiDown {
    static constexpr bool PERM = true;
    bf16_t* YE; const float* bdn; const v2u* LIST;
    static constexpr bool HAS_INIT = true; struct Init { f32x4 v[2][2]; };
    __device__ __forceinline__ Init init(const Unit& u, int wr, int wc, int fr, int fq) const {
        Init i; const float* bb = bdn + (size_t)u.e * 1024 + u.pn * BM + wc * 32 + 8 * fq;
#pragma unroll
        for (int bj = 0; bj < 2; ++bj)
#pragma unroll
            for (int n = 0; n < 2; ++n) i.v[bj][n] = *(const f32x4*)(bb + bj * HALF + 4 * n);
        return i; }
    struct Pre { v2u ent[2][4]; };
    __device__ __forceinline__ Pre pre(const Unit& u, int wr, int wc, int fr, int fq) const {
        Pre p;
#pragma unroll
        for (int ai = 0; ai < 2; ++ai)
#pragma unroll
            for (int m = 0; m < 4; ++m) { const int rr = u.r0 + ai * HALF + wr * 64 + m * 16 + fr; p.ent[ai][m] = LIST[(size_t)u.e * LISTCAP + (rr < u.cnt ? rr : u.cnt - 1)]; }
        return p;
    }
    __device__ __forceinline__ void operator()(const f32x4 (&acc)[2][2][4][2], const Unit& u, int wr, int wc, int fr, int fq, const Pre& P) const {
        const int col0 = u.pn * BM + wc * 32 + 8 * fq;
#pragma unroll
        for (int ai = 0; ai < 2; ++ai)
#pragma unroll
            for (int m = 0; m < 4; ++m) {
                const int rr = u.r0 + ai * HALF + wr * 64 + m * 16 + fr; const bool valid = rr < u.cnt;
                const v2u ent = P.ent[ai][m]; const float gate = __uint_as_float(ent.y);
                unsigned char* rowp = (unsigned char*)YE + (size_t)ent.x * 1024 + col0;
                const float g64 = gate * 64.0f;
#pragma unroll
                for (int bj = 0; bj < 2; ++bj) { f32x4 a0 = acc[ai][bj][m][0], a1 = acc[ai][bj][m][1]; asm volatile("" : "+v"(a0), "+v"(a1));
                    const f32x4 v0 = a0 * g64, v1 = a1 * g64;
                    v2u w; w.x = 0u; w.y = 0u;
                    w.x = __builtin_amdgcn_cvt_pk_fp8_f32(v0[0], v0[1], w.x, false); w.x = __builtin_amdgcn_cvt_pk_fp8_f32(v0[2], v0[3], w.x, true);
                    w.y = __builtin_amdgcn_cvt_pk_fp8_f32(v1[0], v1[1], w.y, false); w.y = __builtin_amdgcn_cvt_pk_fp8_f32(v1[2], v1[3], w.y, true);
                    if (valid) *(v2u*)(rowp + bj * HALF) = w; }
            }
    }
};
}

#include <hip/hip_bf16.h>
#include <cmath>
namespace attn_body {
using bf16=__hip_bfloat16;
using bf16x8=__attribute__((ext_vector_type(8)))short;
using s16x4=__attribute__((ext_vector_type(4)))short;
using f32x16=__attribute__((ext_vector_type(16)))float;
using u32x4=__attribute__((ext_vector_type(4)))unsigned;
constexpr int D=64,QP=512,KP=128,OP=1024,SEQQ=2048,SEQK=2304;
constexpr int NW=8,QBLK=32,QB=QBLK*NW,KVBLK=64,NQB=SEQQ/QB;
constexpr int ATTN_UNIT_ROWS=QB;
__device__ __forceinline__ int crow(int r,int hi){return (r&3)+8*(r>>2)+4*hi;}
#define SBAR() __builtin_amdgcn_sched_barrier(0)
__device__ __forceinline__ void cmask(f32x16&p0,f32x16&p1,int jb,int qrel,int hi){
  const float NEG=-INFINITY; int kb=64*jb+4*hi;
  #pragma unroll
  for(int r=0;r<16;++r){int kv=kb+(r&3)+8*(r>>2); if(kv>qrel)p0[r]=NEG; if(kv+32>qrel)p1[r]=NEG;}
}

constexpr int NSLOT=3, SLOTB=8192;
constexpr int LDS_K=0, LDS_V=NSLOT*SLOTB, LDS_WS=2*NSLOT*SLOTB, LDS_OST=LDS_WS+NW*64*4, LDS_BYTES=LDS_OST+NW*4096;
constexpr float C2=0.125f*1.4426950408889634f;
__device__ __forceinline__ void glds16(const void*gsrc,unsigned lds_dst){unsigned keep;
  asm volatile("s_mov_b32 %0, m0\n\ts_mov_b32 m0, %2\n\ts_nop 0\n\tglobal_load_lds_dwordx4 %1, off\n\ts_mov_b32 m0, %0":"=&s"(keep):"v"(gsrc),"s"(lds_dst):"memory");}
__device__ __forceinline__ float max3f(float a,float b,float c){float r;asm("v_max3_f32 %0, %1, %2, %3":"=v"(r):"v"(a),"v"(b),"v"(c));return r;}
__device__ __forceinline__ float max2f(float a,float b){float r;asm("v_max_f32_e32 %0, %1, %2":"=v"(r):"v"(a),"v"(b));return r;}
__device__ __forceinline__ float fadd_s(float a,float b){float r;asm("v_add_f32_e32 %0, %1, %2":"=v"(r):"v"(a),"v"(b));return r;}
__device__ __forceinline__ float fsub_s(float a,float b){float r;asm("v_sub_f32_e32 %0, %1, %2":"=v"(r):"v"(a),"v"(b));return r;}
typedef float f32x2_t __attribute__((ext_vector_type(2))); typedef __bf16 bf16x2_t __attribute__((ext_vector_type(2)));
__device__ __forceinline__ unsigned cvtpk_s(float lo,float hi){f32x2_t v={lo,hi};bf16x2_t b=__builtin_convertvector(v,bf16x2_t);return __builtin_bit_cast(unsigned,b);}
#define WAIT_BAR(N) asm volatile("s_waitcnt vmcnt(" #N ") lgkmcnt(0)\n\ts_barrier":::"memory")

__device__ __forceinline__ void qkt(f32x16&p0,f32x16&p1,const char*Kslot,const bf16x8*qr,const f32x16&negm,int r32,int hi){
  const char*kb=Kslot+hi*1024+r32*16;
  #pragma unroll
  for(int d0=0;d0<4;++d0){
    const bf16x8 b0=*reinterpret_cast<const bf16x8*>(kb+d0*2048);
    const bf16x8 b1=*reinterpret_cast<const bf16x8*>(kb+d0*2048+512);
    if(d0==0){p0=__builtin_amdgcn_mfma_f32_32x32x16_bf16(b0,qr[0],negm,0,0,0);p1=__builtin_amdgcn_mfma_f32_32x32x16_bf16(b1,qr[0],negm,0,0,0);}
    else{p0=__builtin_amdgcn_mfma_f32_32x32x16_bf16(b0,qr[d0],p0,0,0,0);p1=__builtin_amdgcn_mfma_f32_32x32x16_bf16(b1,qr[d0],p1,0,0,0);}}
}
typedef __attribute__((address_space(3))) const char* lds_cptr;
typedef short v4i16_t __attribute__((ext_vector_type(4)));
__device__ __forceinline__ void kload8(bf16x8*kf,lds_cptr kp){
  kf[0]=*(const __attribute__((address_space(3))) bf16x8*)(kp);      kf[1]=*(const __attribute__((address_space(3))) bf16x8*)(kp+512);
  kf[2]=*(const __attribute__((address_space(3))) bf16x8*)(kp+2048); kf[3]=*(const __attribute__((address_space(3))) bf16x8*)(kp+2560);
  kf[4]=*(const __attribute__((address_space(3))) bf16x8*)(kp+4096); kf[5]=*(const __attribute__((address_space(3))) bf16x8*)(kp+4608);
  kf[6]=*(const __attribute__((address_space(3))) bf16x8*)(kp+6144); kf[7]=*(const __attribute__((address_space(3))) bf16x8*)(kp+6656);
}
__device__ __forceinline__ void kload2(bf16x8*kf,lds_cptr kp,int j){ kf[2*j]=*(const __attribute__((address_space(3))) bf16x8*)(kp+j*2048); kf[2*j+1]=*(const __attribute__((address_space(3))) bf16x8*)(kp+j*2048+512); }
__device__ __forceinline__ s16x4 vtr(lds_cptr p){ return __builtin_bit_cast(s16x4,__builtin_amdgcn_ds_read_tr16_b64_v4i16((__attribute__((address_space(3))) v4i16_t*)p)); }
__device__ __forceinline__ float rowmax(const f32x16&p0,const f32x16&p1){
  float a=max3f(p0[0],p0[1],p1[0]),b=max3f(p0[2],p0[3],p1[1]);a=max3f(a,p1[2],p1[3]);
  #pragma unroll
  for(int r=4;r<16;r+=4){a=max3f(a,p0[r],p0[r+1]);b=max3f(b,p0[r+2],p0[r+3]);a=max3f(a,p1[r],p1[r+1]);b=max3f(b,p1[r+2],p1[r+3]);}
  const float m=max2f(a,b);
  auto rr=__builtin_amdgcn_permlane32_swap(__float_as_uint(m),__float_as_uint(m),false,false);
  return max2f(__uint_as_float(rr[0]),__uint_as_float(rr[1]));
}
__device__ __forceinline__ void pv(f32x16*o,int vb,bf16x8 pa0,bf16x8 pa1,bf16x8 pa2,bf16x8 pa3){
  #pragma unroll
  for(int d0=0;d0<2;++d0){s16x4 lo[4],hi[4];
    #pragma unroll
    for(int ks=0;ks<4;++ks){
      asm volatile("ds_read_b64_tr_b16 %0,%1 offset:%c2":"=&v"(lo[ks]):"v"(vb),"i"(d0*4096+ks*1024):"memory");
      asm volatile("ds_read_b64_tr_b16 %0,%1 offset:%c2":"=&v"(hi[ks]):"v"(vb),"i"(d0*4096+ks*1024+512):"memory");}
    asm volatile("s_waitcnt lgkmcnt(0)":::"memory");SBAR();
    #define PK(k) (bf16x8){lo[k][0],lo[k][1],lo[k][2],lo[k][3],hi[k][0],hi[k][1],hi[k][2],hi[k][3]}
    o[d0]=__builtin_amdgcn_mfma_f32_32x32x16_bf16(pa0,PK(0),o[d0],0,0,0);
    o[d0]=__builtin_amdgcn_mfma_f32_32x32x16_bf16(pa1,PK(1),o[d0],0,0,0);
    o[d0]=__builtin_amdgcn_mfma_f32_32x32x16_bf16(pa2,PK(2),o[d0],0,0,0);
    o[d0]=__builtin_amdgcn_mfma_f32_32x32x16_bf16(pa3,PK(3),o[d0],0,0,0);
    #undef PK
  }
}

#ifndef ATTN_STORE16
#define ATTN_STORE16(p,v) (*(u32x4*)(p)=(v))
#endif
template<int THRL> __device__ __forceinline__ void attn_unit(int b,int h,int qb,const bf16*Q,const bf16*__restrict__ K,const bf16*__restrict__ V,bf16*O,char*shm,float refB){
  const int tid=threadIdx.x,lane=tid&63,r32=lane&31,hi=lane>>5; const int wid=__builtin_amdgcn_readfirstlane(tid>>6);
  const long rowq=(long)b*SEQQ,rowk=(long)b*SEQK; const int q0=qb*QB;
  const bf16*Qw=Q+(rowq+q0+wid*QBLK)*QP+h*D;
  const bf16*Kh=K+rowk*KP+(h>>2)*D,*Vh=V+rowk*KP+(h>>2)*D;
  const unsigned lds0=(unsigned)(uintptr_t)shm;
  float*wsf=(float*)(shm+LDS_WS)+wid*64;
  const bf16*ksrc=Kh+(long)lane*KP+wid*8;
  const bf16*vsrc=Vh+(long)(16*(wid&3)+(lane>>2))*KP+(wid>>2)*32+(lane&3)*8;
  const unsigned kdst=lds0+LDS_K+wid*1024, vdst=lds0+LDS_V+wid*1024;
  #define DMA_K(t,slot) glds16(ksrc+(long)(t)*KVBLK*KP,(unsigned)__builtin_amdgcn_readfirstlane(kdst+(slot)))
  #define DMA_V(t,slot) glds16(vsrc+(long)(t)*KVBLK*KP,(unsigned)__builtin_amdgcn_readfirstlane(vdst+(slot)))
  const int vb0=(int)(lds0+LDS_V)+((lane>>4)&1)*32+(lane&3)*8+(4*hi+((lane&15)>>2))*64;
  const char*Kbase=shm+LDS_K; bf16x8 kf[8];
  const lds_cptr shm3=(lds_cptr)shm; const lds_cptr kp0=shm3+LDS_K+hi*1024+r32*16; const lds_cptr vp0=shm3+LDS_V+((lane>>4)&1)*32+(lane&3)*8+(4*hi+((lane&15)>>2))*64;
  const int NT=SEQK/KVBLK;
  DMA_K(0,0);DMA_V(0,0);DMA_K(1,SLOTB);
  bf16x8 qr[4];
  #pragma unroll
  for(int d0=0;d0<4;++d0)qr[d0]=*reinterpret_cast<const bf16x8*>(&Qw[(long)r32*QP+d0*16+hi*8]);
  float mhat=refB,l_reg=0.f;f32x16 o[2];o[0]=f32x16{};o[1]=f32x16{};f32x16 negm; _Pragma("unroll") for(int r=0;r<16;++r)negm[r]=-refB; asm volatile("":"+v"(negm));

  #define CMASK(P0,P1,t) do{}while(0)
  bool resc=false;
  #define START(P0,P1) do{ resc=false; \
    _Pragma("unroll") for(int r=0;r<16;++r)P0[r]=__builtin_amdgcn_exp2f(P0[r]); }while(0)
  #define RESC() do{ if(resc){ asm volatile("s_waitcnt lgkmcnt(0)":::"memory"); \
      _Pragma("unroll") for(int d_=0;d_<2;++d_) _Pragma("unroll") for(int r=0;r<16;++r)o[d_][r]*=wsf[crow(r,hi)]; } }while(0)
  f32x16 pA0,pA1,pB0,pB1;
  int sl_prev=0,sl_cur=0,sl_next=SLOTB;
  #define ROT() do{sl_prev=sl_cur;sl_cur=sl_next;sl_next=(sl_next==(NSLOT-1)*SLOTB)?0:sl_next+SLOTB;}while(0)
  DMA_K(2,2*SLOTB);
  WAIT_BAR(3);
  qkt(pA0,pA1,Kbase,qr,negm,r32,hi);asm volatile("s_nop 15\n\ts_nop 7":"+v"(pA0),"+v"(pA1));CMASK(pA0,pA1,0);
  START(pA0,pA1);
  _Pragma("unroll") for(int r=0;r<16;++r)pA1[r]=__builtin_amdgcn_exp2f(pA1[r]);
  WAIT_BAR(0);
  DMA_K(3,0);DMA_V(1,SLOTB);
  ROT();
  kload8(kf,kp0+sl_cur);
  WAIT_BAR(2);
  s16x4 vlo[8],vhi[8]; u32x4 pw0,pw1,pw2,pw3;
  #define PKW(P,B) cvtpk_s(P[B],P[B+1])
  #define PAF(k) __builtin_bit_cast(bf16x8,pw##k)
  #define VFR(i) (bf16x8){vlo[i][0],vlo[i][1],vlo[i][2],vlo[i][3],vhi[i][0],vhi[i][1],vhi[i][2],vhi[i][3]}
  #define PIN(x) asm volatile("":"+v"(x))
  #define MX3(a,b,c) __builtin_fmaxf(__builtin_fmaxf((a),(b)),(c))
  #define GAPA(MF,A0,A1,A2,A3,W0,W1,PW) do{ MF; sacc+=A0; sacc+=A1; sacc+=A2; sacc+=A3; PIN(sacc); W0; W1; PIN(PW); SBAR(); }while(0)
  #define EX(v) __builtin_amdgcn_exp2f(v)
  #define GAPB(MF,X,B) do{ MF; X[B]=EX(X[B]); X[B+1]=EX(X[B+1]); X[B+2]=EX(X[B+2]); X[B+3]=EX(X[B+3]); PIN(X); SBAR(); }while(0)
  #define VRD(i) do{ vlo[i]=vtr(vp_+(((i)>>2)*4096+((i)&3)*1024)); vhi[i]=vtr(vp_+(((i)>>2)*4096+((i)&3)*1024+512)); }while(0)
  #define KRD(G,j) do{ if(G){ kload2(kf,kp0+sl_next,j); SBAR(); } }while(0)
  #define STEP(C0,C1,P0,P1,t,GK,GV,GL) do{ SBAR(); \
    const lds_cptr vp_=vp0+sl_prev; \
    VRD(0); SBAR(); float sacc=(P0[0]+P0[1]); \
    GAPA(C0=__builtin_amdgcn_mfma_f32_32x32x16_bf16(kf[0],qr[0],negm,0,0,0), P0[2],P0[3],P0[4],P0[5],     pw0[0]=PKW(P0,0), pw0[1]=PKW(P0,2), pw0); \
    VRD(4); SBAR(); GAPA(C1=__builtin_amdgcn_mfma_f32_32x32x16_bf16(kf[1],qr[0],negm,0,0,0), P0[6],P0[7],P0[8],P0[9],     pw0[2]=PKW(P0,4), pw0[3]=PKW(P0,6), pw0); \
    VRD(1); SBAR(); GAPA(C0=__builtin_amdgcn_mfma_f32_32x32x16_bf16(kf[2],qr[1],C0,0,0,0),   P0[10],P0[11],P0[12],P0[13], pw1[0]=PKW(P0,8), pw1[1]=PKW(P0,10), pw1); \
    VRD(5); SBAR(); GAPA(C1=__builtin_amdgcn_mfma_f32_32x32x16_bf16(kf[3],qr[1],C1,0,0,0),   P0[14],P0[15],P1[0],P1[1],   pw1[2]=PKW(P0,12),pw1[3]=PKW(P0,14), pw1); \
    VRD(2); SBAR(); GAPA(C0=__builtin_amdgcn_mfma_f32_32x32x16_bf16(kf[4],qr[2],C0,0,0,0),   P1[2],P1[3],P1[4],P1[5],     pw2[0]=PKW(P1,0), pw2[1]=PKW(P1,2), pw2); \
    VRD(6); SBAR(); GAPA(C1=__builtin_amdgcn_mfma_f32_32x32x16_bf16(kf[5],qr[2],C1,0,0,0),   P1[6],P1[7],P1[8],P1[9],     pw2[2]=PKW(P1,4), pw2[3]=PKW(P1,6), pw2); \
    VRD(3); SBAR(); GAPA(C0=__builtin_amdgcn_mfma_f32_32x32x16_bf16(kf[6],qr[3],C0,0,0,0),   P1[10],P1[11],P1[12],P1[13], pw3[0]=PKW(P1,8), pw3[1]=PKW(P1,10), pw3); \
    VRD(7); SBAR(); GAPA(C1=__builtin_amdgcn_mfma_f32_32x32x16_bf16(kf[7],qr[3],C1,0,0,0),   P1[14],P1[15],0.f,0.f,       pw3[2]=PKW(P1,12),pw3[3]=PKW(P1,14), pw3); \
    l_reg+=sacc; \
    if(GK){DMA_K((t)+3,sl_cur);} if(GV){DMA_V((t)+1,sl_next);} \
    CMASK(C0,C1,t); \
    resc=false; \
    SBAR(); \
    GAPB(o[0]=__builtin_amdgcn_mfma_f32_32x32x16_bf16(PAF(0),VFR(0),o[0],0,0,0), C0,0); \
    GAPB(o[1]=__builtin_amdgcn_mfma_f32_32x32x16_bf16(PAF(0),VFR(4),o[1],0,0,0), C0,4); \
    KRD(GL,0); GAPB(o[0]=__builtin_amdgcn_mfma_f32_32x32x16_bf16(PAF(1),VFR(1),o[0],0,0,0), C0,8); \
    KRD(GL,1); GAPB(o[1]=__builtin_amdgcn_mfma_f32_32x32x16_bf16(PAF(1),VFR(5),o[1],0,0,0), C0,12); \
    KRD(GL,2); GAPB(o[0]=__builtin_amdgcn_mfma_f32_32x32x16_bf16(PAF(2),VFR(2),o[0],0,0,0), C1,0); \
    KRD(GL,3); GAPB(o[1]=__builtin_amdgcn_mfma_f32_32x32x16_bf16(PAF(2),VFR(6),o[1],0,0,0), C1,4); \
    GAPB(o[0]=__builtin_amdgcn_mfma_f32_32x32x16_bf16(PAF(3),VFR(3),o[0],0,0,0), C1,8); \
    GAPB(o[1]=__builtin_amdgcn_mfma_f32_32x32x16_bf16(PAF(3),VFR(7),o[1],0,0,0), C1,12); \
    }while(0)
  int t=1;
  #undef CMASK
  #define CMASK(P0,P1,t) do{}while(0)
  for(;t+5<NT;t+=2){
    STEP(pB0,pB1,pA0,pA1,t,true,true,true);     WAIT_BAR(2); RESC(); ROT();
    STEP(pA0,pA1,pB0,pB1,t+1,true,true,true);   WAIT_BAR(2); RESC(); ROT();
  }
  #undef CMASK
  #define CMASK(P0,P1,t) do{}while(0)
  #define ENDW(tt) do{ if((tt)+3<NT){WAIT_BAR(2);} else if((tt)+2<NT){WAIT_BAR(1);} else {WAIT_BAR(0);} }while(0)
  for(;t+1<NT;t+=2){
    STEP(pB0,pB1,pA0,pA1,t,(t+3<NT),(t+1<NT),(t+1<NT));       ENDW(t);   RESC(); ROT();
    STEP(pA0,pA1,pB0,pB1,t+1,(t+4<NT),(t+2<NT),(t+2<NT));     ENDW(t+1); RESC(); ROT();
  }
  STEP(pB0,pB1,pA0,pA1,NT-1,false,false,false); RESC();
  { float sacc=pB0[0]+pB0[1]; _Pragma("unroll") for(int r=2;r<16;++r)sacc+=pB0[r]; _Pragma("unroll") for(int r=0;r<16;++r)sacc+=pB1[r]; l_reg+=sacc;
    pw0=(u32x4){PKW(pB0,0),PKW(pB0,2),PKW(pB0,4),PKW(pB0,6)};pw1=(u32x4){PKW(pB0,8),PKW(pB0,10),PKW(pB0,12),PKW(pB0,14)};pw2=(u32x4){PKW(pB1,0),PKW(pB1,2),PKW(pB1,4),PKW(pB1,6)};pw3=(u32x4){PKW(pB1,8),PKW(pB1,10),PKW(pB1,12),PKW(pB1,14)};
    SBAR(); pv(o,vb0+sl_cur,PAF(0),PAF(1),PAF(2),PAF(3)); }
  #undef PKW
  #undef PAF
  #undef VFR
  #undef PIN
  #undef MX3
  #undef GAPA
  #undef GAPB
  #undef EX
  #undef VRD
  #undef KRD
  #undef STEP
  #undef ENDW
  {auto rr=__builtin_amdgcn_permlane32_swap(__float_as_uint(l_reg),__float_as_uint(l_reg),false,false);l_reg=__uint_as_float(rr[0])+__uint_as_float(rr[1]);}
  if(hi==0)wsf[32+r32]=l_reg;asm volatile("s_waitcnt lgkmcnt(0)":::"memory");
  float rli[16];
  #pragma unroll
  for(int r=0;r<16;++r)rli[r]=__builtin_amdgcn_rcpf(wsf[32+crow(r,hi)]);
  bf16*Ow=O+(rowq+q0+wid*QBLK)*OP+h*D;
  { bf16*stg=(bf16*)(shm+LDS_OST)+wid*2048;
    #pragma unroll
    for(int r=0;r<16;++r){const int orow=crow(r,hi);
      #pragma unroll
      for(int d0=0;d0<2;++d0)stg[orow*64+d0*32+r32]=__float2bfloat16(o[d0][r]*rli[r]);}
    asm volatile("s_waitcnt lgkmcnt(0)":::"memory");
    #pragma unroll
    for(int i=0;i<4;++i){const int row=i*8+(lane>>3),ch=lane&7; const u32x4 v=*(const u32x4*)(stg+row*64+ch*8); ATTN_STORE16(Ow+(long)row*OP+ch*8,v);} }
  asm volatile("s_waitcnt lgkmcnt(0)\n\ts_barrier":::"memory");
  #undef DMA_K
  #undef DMA_V
  #undef CMASK
  #undef START
  #undef RESC
  #undef ROT
}
constexpr int ATTN_LDS_BYTES=LDS_BYTES;
struct AttnTensors { const bf16* Q; const bf16* K; const bf16* V; bf16* O; };
struct AttnUnit { int b, h, qb; };
struct StaticOrder {
  int vcu;
  __device__ __forceinline__ explicit StaticOrder(int grid,int block):vcu((block%8)*(grid/8)+block/8){}
  __device__ __forceinline__ bool next(int i,AttnUnit&u)const{ const int p=8*i+(vcu>>5); if(p>=32)return false; const int w=vcu&31; u.b=p>>1; u.h=(p&1)*4+(w>>3); u.qb=w&7; return true; }
};
template<class Sched,int THRL=8> __device__ __forceinline__ void attn_phase(char*lds,const AttnTensors&T,const Sched&S){
  AttnUnit u;
  for(int i=0;S.next(i,u);++i){ attn_unit<THRL>(u.b,u.h,u.qb,T.Q,T.K,T.V,T.O,lds,64.0f); }
}
#undef SBAR
#undef WAIT_BAR
}

namespace ret {
typedef short bf16x8 __attribute__((ext_vector_type(8)));
typedef short s16x4 __attribute__((ext_vector_type(4)));
typedef float f32x16 __attribute__((ext_vector_type(16)));
constexpr int VP = 160, KPT = 48;
constexpr int VB = 128 * VP * 2, KB = 128 * KPT * 2, BUF = VB + KB;
__device__ __forceinline__ int crow(int r, int hi) { return (r & 3) + 8 * (r >> 2) + 4 * hi; }
__device__ __forceinline__ s16x4 trd(const LAS unsigned char* p) { return __builtin_bit_cast(s16x4, __builtin_amdgcn_ds_read_tr16_b64_v4i16((LAS s16x4*)p)); }
__device__ __forceinline__ bf16x8 cat(s16x4 a, s16x4 b) { return (bf16x8){a[0], a[1], a[2], a[3], b[0], b[1], b[2], b[3]}; }
__device__ __forceinline__ v4u scale8(v4u w, float s) {
    v4u o; o.x = pk2(bflo(w.x) * s, bfhi(w.x) * s); o.y = pk2(bflo(w.y) * s, bfhi(w.y) * s); o.z = pk2(bflo(w.z) * s, bfhi(w.z) * s); o.w = pk2(bflo(w.w) * s, bfhi(w.w) * s); return o;
}
constexpr int RAP = 96, RAB = 128 * RAP * 2, RABUF = 2 * RAB;
__device__ __forceinline__ void state_unit(int b, int h, int dir, int dvh, const bf16_t* RK, const bf16_t* RV, bf16_t* ST, float lg2, LAS unsigned char* lds) {
    const int tid = threadIdx.x, lane = tid & 63, wid = __builtin_amdgcn_readfirstlane(tid >> 6), r32 = lane & 31, hi = lane >> 5, dvt = wid & 1, dkt = (wid >> 1) & 1;
    const float g128 = exp2f(lg2 * 128.0f);
    const int prow = tid >> 3, pc8 = tid & 7;
    const float kw0 = dir ? exp2f(lg2 * (float)prow) : exp2f(lg2 * (float)(127 - prow)), kw1 = dir ? exp2f(lg2 * (float)(prow + 64)) : exp2f(lg2 * (float)(63 - prow));
    v4u vreg[2], kreg[2];
    auto chunk_of = [&](int s) { return dir ? (s == 0 ? 1 : (s == 1 ? 0 : 19 - s)) : s; };
    auto load = [&](int s) {
        const size_t urow = (size_t)b * SU + (size_t)chunk_of(s) * 128;
#pragma unroll
        for (int i = 0; i < 2; ++i) { vreg[i] = *(const v4u*)(RV + (urow + prow + 64 * i) * 512 + h * 128 + dvh * 64 + pc8 * 8); kreg[i] = *(const v4u*)(RK + (urow + prow + 64 * i) * 256 + h * 64 + pc8 * 8); }
    };
    load(0);
    f32x16 acc = {};
    const int gq = lane >> 4, colblk = gq & 1, q4 = (lane >> 2) & 3, p4 = lane & 3;
    for (int s = 0; s < 18; ++s) {
        LAS unsigned char* buf = lds + (s & 1) * RABUF;
#pragma unroll
        for (int i = 0; i < 2; ++i) { *(LAS v4u*)(buf + (prow + 64 * i) * (RAP * 2) + pc8 * 16) = vreg[i]; *(LAS v4u*)(buf + RAB + (prow + 64 * i) * (RAP * 2) + pc8 * 16) = scale8(kreg[i], i ? kw1 : kw0); }
        __syncthreads();
        if (s + 1 < 18) load(s + 1);
        if (wid < 4) {
            if (s >= 2) {
                const int n = dir ? 17 - s : s - 2;
                bf16_t* st = ST + ((((size_t)b * 4 + h) * 2 + dir) * 16 + n) * (128 * 64) + dkt * 32 + r32;
#pragma unroll
                for (int r = 0; r < 16; ++r) st[(size_t)(64 * dvh + 32 * dvt + crow(r, hi)) * 64] = (bf16_t)f2bf(acc[r]);
            }
            if (s < 17) {
#pragma unroll
                for (int r = 0; r < 16; ++r) acc[r] *= g128;
                const LAS unsigned char* va = buf + (8 * hi + q4) * (RAP * 2) + (32 * dvt + 16 * colblk + 4 * p4) * 2;
                const LAS unsigned char* ka = buf + RAB + (8 * hi + q4) * (RAP * 2) + (32 * dkt + 16 * colblk + 4 * p4) * 2;
#pragma unroll
                for (int ks = 0; ks < 8; ++ks) {
                    const bf16x8 af = cat(trd(va + ks * 16 * RAP * 2), trd(va + (ks * 16 + 4) * RAP * 2));
                    const bf16x8 bfm = cat(trd(ka + ks * 16 * RAP * 2), trd(ka + (ks * 16 + 4) * RAP * 2));
                    acc = __builtin_amdgcn_mfma_f32_32x32x16_bf16(af, bfm, acc, 0, 0, 0);
                }
            }
        }
    }
    __syncthreads();
}
constexpr int QP2 = 72, GP2 = 136;
constexpr int OFF_Q = VB, OFF_K = OFF_Q + 128 * QP2 * 2, OFF_G = OFF_K + 128 * QP2 * 2, OFF_RED = OFF_G + 128 * GP2 * 2;
struct OutRegs { v4u vv[4], qq[2], kk[2]; };
__device__ __forceinline__ void out_load(OutRegs& R, int u, const bf16_t* RQ, const bf16_t* RK, const bf16_t* RV, const bf16_t* RG) {
    const int tid = threadIdx.x, n = u & 15, h = (u >> 4) & 3, b = u >> 6;
    const size_t m0 = (size_t)b * SEQ + 128 * n, u0 = (size_t)b * SU + CTX + 128 * n;
#pragma unroll
    for (int i = 0; i < 4; ++i) { const int pc = tid + 512 * i; R.vv[i] = *(const v4u*)(RV + (u0 + (pc >> 4)) * 512 + h * 128 + (pc & 15) * 8); }
#pragma unroll
    for (int i = 0; i < 2; ++i) { const int pc = tid + 512 * i; R.qq[i] = *(const v4u*)(RQ + (m0 + (pc >> 3)) * 256 + h * 64 + (pc & 7) * 8); R.kk[i] = *(const v4u*)(RK + (u0 + (pc >> 3)) * 256 + h * 64 + (pc & 7) * 8); }
}
__device__ __forceinline__ void out_unit(OutRegs& R, int u, int unext, const bf16_t* RQ, const bf16_t* RK, const bf16_t* RV, const bf16_t* RG, const bf16_t* ST, const float* gng, const float* gnb, const float* ldf, const float* ldb, bf16_t* MIX, LAS unsigned char* lds) {
    const int n = u & 15, h = (u >> 4) & 3, b = u >> 6; const float lgf = ldf[h] * 1.4426950408889634f, lgb = ldb[h] * 1.4426950408889634f;
    const int tid = threadIdx.x, lane = tid & 63, wid = __builtin_amdgcn_readfirstlane(tid >> 6), r32 = lane & 31, hi = lane >> 5, rg = wid & 3, dvh = wid >> 2;
    const size_t m0 = (size_t)b * SEQ + 128 * n, u0 = (size_t)b * SU + CTX + 128 * n;
    LAS float* red = (LAS float*)(lds + OFF_RED);
    {
        __syncthreads();
#pragma unroll
        for (int i = 0; i < 4; ++i) { const int pc = tid + 512 * i; *(LAS v4u*)(lds + (pc >> 4) * (VP * 2) + (pc & 15) * 16) = R.vv[i]; }
#pragma unroll
        for (int i = 0; i < 2; ++i) { const int pc = tid + 512 * i; *(LAS v4u*)(lds + OFF_Q + (pc >> 3) * (QP2 * 2) + (pc & 7) * 16) = R.qq[i]; *(LAS v4u*)(lds + OFF_K + (pc >> 3) * (QP2 * 2) + (pc & 7) * 16) = R.kk[i]; }
    }
    __syncthreads();
    out_load(R, unext >= 0 ? unext : u, RQ, RK, RV, RG);
    bf16x8 qf[4];
#pragma unroll
    for (int ks = 0; ks < 4; ++ks) qf[ks] = *(const LAS bf16x8*)(lds + OFF_Q + (32 * rg + r32) * (QP2 * 2) + (16 * ks + 8 * hi) * 2);
    f32x16 st[4];
#pragma unroll
    for (int kt = 0; kt < 4; ++kt) { st[kt] = (f32x16){};
#pragma unroll
        for (int ks = 0; ks < 4; ++ks) { const bf16x8 kf = *(const LAS bf16x8*)(lds + OFF_K + (32 * kt + r32) * (QP2 * 2) + (16 * ks + 8 * hi) * 2); st[kt] = __builtin_amdgcn_mfma_f32_32x32x16_bf16(kf, qf[ks], st[kt], 0, 0, 0); } }
    const int c = 32 * rg + r32;
    bf16x8 pa[4][2];
#pragma unroll
    for (int kt = 0; kt < 4; ++kt) {
#pragma unroll
        for (int r = 0; r < 16; ++r) { const int d = c - (32 * kt + crow(r, hi)); const float w = d > 0 ? __builtin_amdgcn_exp2f(lgf * (float)d) : (d < 0 ? __builtin_amdgcn_exp2f(lgb * (float)(-d)) : 2.0f); st[kt][r] *= w; }
#pragma unroll
        for (int s2 = 0; s2 < 2; ++s2) { v4u w; w.x = pk2(st[kt][8 * s2], st[kt][8 * s2 + 1]); w.y = pk2(st[kt][8 * s2 + 2], st[kt][8 * s2 + 3]); w.z = pk2(st[kt][8 * s2 + 4], st[kt][8 * s2 + 5]); w.w = pk2(st[kt][8 * s2 + 6], st[kt][8 * s2 + 7]); pa[kt][s2] = __builtin_bit_cast(bf16x8, w); }
    }
    asm volatile("" ::: "memory");
    v4u gg[4];
#pragma unroll
    for (int i = 0; i < 4; ++i) { const int pc = tid + 512 * i; gg[i] = *(const v4u*)(RG + (m0 + (pc >> 4)) * 512 + h * 128 + (pc & 15) * 8); }
    f32x16 ot[2] = {(f32x16){}, (f32x16){}};
    const int gq = lane >> 4, colblk = gq & 1, q4 = (lane >> 2) & 3, p4 = lane & 3;
#pragma unroll
    for (int dt = 0; dt < 2; ++dt) {
        const LAS unsigned char* va = lds + (4 * hi + q4) * (VP * 2) + (64 * dvh + 32 * dt + 16 * colblk + 4 * p4) * 2;
#pragma unroll
        for (int kt = 0; kt < 4; ++kt)
#pragma unroll
            for (int s2 = 0; s2 < 2; ++s2) { const int kb = 32 * kt + 16 * s2; const bf16x8 vf = cat(trd(va + kb * VP * 2), trd(va + (kb + 8) * VP * 2)); ot[dt] = __builtin_amdgcn_mfma_f32_32x32x16_bf16(vf, pa[kt][s2], ot[dt], 0, 0, 0); }
    }
    {
        const float decf = __builtin_amdgcn_exp2f(lgf * (float)(c + 1)), decb = __builtin_amdgcn_exp2f(lgb * (float)(128 - c));
        const bf16_t* sf = ST + ((((size_t)b * 4 + h) * 2 + 0) * 16 + n) * (128 * 64); const bf16_t* sb = sf + (size_t)16 * 128 * 64;
#pragma unroll
        for (int ks = 0; ks < 4; ++ks) {
            const v4u qw = __builtin_bit_cast(v4u, qf[ks]); const bf16x8 qdf = __builtin_bit_cast(bf16x8, scale8(qw, decf)), qdb = __builtin_bit_cast(bf16x8, scale8(qw, decb));
#pragma unroll
            for (int dt = 0; dt < 2; ++dt) { const size_t so = (size_t)(64 * dvh + 32 * dt + r32) * 64 + 16 * ks + 8 * hi;
                ot[dt] = __builtin_amdgcn_mfma_f32_32x32x16_bf16(*(const bf16x8*)(sf + so), qdf, ot[dt], 0, 0, 0);
                ot[dt] = __builtin_amdgcn_mfma_f32_32x32x16_bf16(*(const bf16x8*)(sb + so), qdb, ot[dt], 0, 0, 0); }
        }
    }
#pragma unroll
    for (int i = 0; i < 4; ++i) { const int pc = tid + 512 * i; *(LAS v4u*)(lds + OFF_G + (pc >> 4) * (GP2 * 2) + (pc & 15) * 16) = gg[i]; }
    float s1 = 0.f;
#pragma unroll
    for (int dt = 0; dt < 2; ++dt)
#pragma unroll
        for (int r = 0; r < 16; ++r) s1 += ot[dt][r];
    s1 += __shfl_xor(s1, 32);
    if (hi == 0) red[wid * 32 + r32] = s1;
    __syncthreads();
    const float mu = (red[wid * 32 + r32] + red[(wid ^ 4) * 32 + r32]) * (1.0f / 128.0f);
    float s2 = 0.f;
#pragma unroll
    for (int dt = 0; dt < 2; ++dt)
#pragma unroll
        for (int r = 0; r < 16; ++r) { const float d = ot[dt][r] - mu; s2 = fmaf(d, d, s2); }
    s2 += __shfl_xor(s2, 32);
    __syncthreads();
    if (hi == 0) red[wid * 32 + r32] = s2;
    __syncthreads();
    const float rs = 1.0f / sqrtf((red[wid * 32 + r32] + red[(wid ^ 4) * 32 + r32]) * (1.0f / 128.0f) + LN_EPS);
    LAS unsigned char* grow = lds + OFF_G + (32 * rg + r32) * (GP2 * 2);
#pragma unroll
    for (int dt = 0; dt < 2; ++dt)
#pragma unroll
        for (int rq = 0; rq < 4; ++rq) {
            const int dv = 64 * dvh + 32 * dt + 8 * rq + 4 * hi;
            const f32x4 gg = *(const f32x4*)(gng + h * 128 + dv), gb = *(const f32x4*)(gnb + h * 128 + dv);
            const v2u gw = *(const LAS v2u*)(grow + dv * 2);
            const float g0 = bflo(gw.x), g1 = bfhi(gw.x), g2 = bflo(gw.y), g3 = bfhi(gw.y);
            const float y0 = ((ot[dt][4 * rq] - mu) * rs * gg[0] + gb[0]) * (g0 * __builtin_amdgcn_rcpf(1.0f + __builtin_amdgcn_exp2f(-1.4426950408889634f * g0)));
            const float y1 = ((ot[dt][4 * rq + 1] - mu) * rs * gg[1] + gb[1]) * (g1 * __builtin_amdgcn_rcpf(1.0f + __builtin_amdgcn_exp2f(-1.4426950408889634f * g1)));
            const float y2 = ((ot[dt][4 * rq + 2] - mu) * rs * gg[2] + gb[2]) * (g2 * __builtin_amdgcn_rcpf(1.0f + __builtin_amdgcn_exp2f(-1.4426950408889634f * g2)));
            const float y3 = ((ot[dt][4 * rq + 3] - mu) * rs * gg[3] + gb[3]) * (g3 * __builtin_amdgcn_rcpf(1.0f + __builtin_amdgcn_exp2f(-1.4426950408889634f * g3)));
            v2u w; w.x = pk2(y0, y1); w.y = pk2(y2, y3);
            *(LAS v2u*)(grow + dv * 2) = w;
        }
    __syncthreads();
#pragma unroll
    for (int i = 0; i < 4; ++i) { const int pc = tid + 512 * i; *(v4u*)(MIX + (m0 + (pc >> 4)) * DM + h * 128 + (pc & 15) * 8) = *(const LAS v4u*)(lds + OFF_G + (pc >> 4) * (GP2 * 2) + (pc & 15) * 16); }
}
}

struct Args {
    const float* in[26]; float* out; unsigned char* ws; int ph_lo, ph_hi, li, pad;
};
enum { I_X = 0, I_C, I_CTX, I_CCTX, I_LNING, I_LNINB, I_WADA, I_BADA, I_WIN, I_LDF, I_LDB, I_GNG, I_GNB, I_QNG, I_KNG, I_WO, I_LN1G, I_LN1B, I_RW, I_RB, I_WUP, I_BUP, I_WDN, I_BDN, I_LN2G, I_LN2B };

struct Frame {
    LAS unsigned char* lds;
    unsigned* ctl;
    int tid, lane, wave, G, gtid, nthreads, gw, ngw;
};

constexpr int LDS_BYTES = 147456, MISC_OFF = 147456 - 1024;

__device__ __forceinline__ int phys_in(int lc) { const int pn = lc >> 8, wc = (lc >> 6) & 3, d = lc & 63; const int blk = d >> 5, bj = (d >> 4) & 1, f1 = (d >> 3) & 1, n = (d >> 2) & 1, j = d & 3;
    return pn * 256 + 128 * bj + 32 * wc + 16 * n + 4 * (2 * blk + f1) + j; }
__device__ __forceinline__ int phys_up(int c) { return 256 * ((c & 1023) >> 7) + 128 * (c >> 10) + (c & 127); }

__device__ __forceinline__ void transpose_load(f32x4 (&v)[16], const float* W, int K, int N, int item, int lane) {
    const int nkb = K / 64, kb = item % nkb, nb = item / nkb, k0 = 64 * kb, n0 = 64 * nb;
    const float* src = W + (size_t)(k0 + (lane >> 4)) * N + n0 + (lane & 15) * 4;
#pragma unroll
    for (int i = 0; i < 16; ++i) v[i] = __builtin_nontemporal_load((const f32x4*)(src + (size_t)(4 * i) * N));
}
__device__ __forceinline__ void transpose_write(const f32x4 (&v)[16], LAS float* scr, int lane) {
#pragma unroll
    for (int i = 0; i < 16; ++i) { LAS float* d = scr + (4 * i + (lane >> 4)) * 65 + (lane & 15) * 4; d[0] = v[i][0]; d[1] = v[i][1]; d[2] = v[i][2]; d[3] = v[i][3]; }
    asm volatile("s_waitcnt lgkmcnt(0)" ::: "memory");
}
template <int MAP, bool F8> __device__ __forceinline__ void transpose_out(int K, void* WT, LAS float* scr, int item, int lane) {
    const int nkb = K / 64, kb = item % nkb, nb = item / nkb, k0 = 64 * kb, n0 = 64 * nb;
    const int c = lane & 7;
#pragma unroll
    for (int j = 0; j < 8; ++j) { const int n = (lane >> 3) + 8 * j; const LAS float* s = scr + (8 * c) * 65 + n;
        const int ln = n0 + n; const int pr = MAP == 1 ? phys_in(ln) : (MAP == 2 ? phys_up(ln) : ln);
        if constexpr (F8) { v2u q; q.x = 0u; q.y = 0u;
            q.x = __builtin_amdgcn_cvt_pk_fp8_f32(64.f * s[0 * 65], 64.f * s[1 * 65], q.x, false); q.x = __builtin_amdgcn_cvt_pk_fp8_f32(64.f * s[2 * 65], 64.f * s[3 * 65], q.x, true);
            q.y = __builtin_amdgcn_cvt_pk_fp8_f32(64.f * s[4 * 65], 64.f * s[5 * 65], q.y, false); q.y = __builtin_amdgcn_cvt_pk_fp8_f32(64.f * s[6 * 65], 64.f * s[7 * 65], q.y, true);
            *(v2u*)((unsigned char*)WT + (size_t)pr * K + k0 + 8 * c) = q; }
        else { v4u o; o.x = pk2(s[0 * 65], s[1 * 65]); o.y = pk2(s[2 * 65], s[3 * 65]); o.z = pk2(s[4 * 65], s[5 * 65]); o.w = pk2(s[6 * 65], s[7 * 65]);
            *(v4u*)((bf16_t*)WT + (size_t)pr * K + k0 + 8 * c) = o; } }
    asm volatile("s_waitcnt lgkmcnt(0)" ::: "memory");
}
__device__ __forceinline__ void transpose8_write(const f32x4 (&v)[16], LAS unsigned* T, int lane) {
#pragma unroll
    for (int i = 0; i < 16; ++i) { unsigned w = 0u; w = __builtin_amdgcn_cvt_pk_fp8_f32(64.f * v[i][0], 64.f * v[i][1], w, false); w = __builtin_amdgcn_cvt_pk_fp8_f32(64.f * v[i][2], 64.f * v[i][3], w, true);
        T[(4 * i + (lane >> 4)) * 17 + (lane & 15)] = w; }
    asm volatile("s_waitcnt lgkmcnt(0)" ::: "memory");
}
template <int MAP> __device__ __forceinline__ void transpose8_out(int K, unsigned char* WT, const LAS unsigned* T, int item, int lane) {
    const int nkb = K / 64, kb = item % nkb, nb = item / nkb, k0 = 64 * kb, n0 = 64 * nb;
    const int c = lane & 7, ng2 = lane >> 3;
#pragma unroll
    for (int j = 0; j < 2; ++j) { const int ng = ng2 + 8 * j; unsigned d[8];
#pragma unroll
        for (int i = 0; i < 8; ++i) d[i] = T[(8 * c + i) * 17 + ng];
        unsigned r[2][4];
#pragma unroll
        for (int h = 0; h < 2; ++h) { const unsigned d0 = d[4 * h], d1 = d[4 * h + 1], d2 = d[4 * h + 2], d3 = d[4 * h + 3];
            const unsigned t0 = __builtin_amdgcn_perm(d1, d0, 0x05010400u), t1 = __builtin_amdgcn_perm(d1, d0, 0x07030602u), t2 = __builtin_amdgcn_perm(d3, d2, 0x05010400u), t3 = __builtin_amdgcn_perm(d3, d2, 0x07030602u);
            r[h][0] = __builtin_amdgcn_perm(t2, t0, 0x05040100u); r[h][1] = __builtin_amdgcn_perm(t2, t0, 0x07060302u); r[h][2] = __builtin_amdgcn_perm(t3, t1, 0x05040100u); r[h][3] = __builtin_amdgcn_perm(t3, t1, 0x07060302u); }
#pragma unroll
        for (int q = 0; q < 4; ++q) { const int ln = n0 + 4 * ng + q; const int pr = MAP == 2 ? phys_up(ln) : ln; v2u o; o.x = r[0][q]; o.y = r[1][q];
            *(v2u*)(WT + (size_t)pr * K + k0 + 8 * c) = o; } }
    asm volatile("s_waitcnt lgkmcnt(0)" ::: "memory");
}
template <int MAP, bool F8> __device__ __forceinline__ void transpose_item(const float* W, int K, int N, void* WT, LAS float* scr, int item, int lane) {
    f32x4 v[16]; transpose_load(v, W, K, N, item, lane); transpose_write(v, scr, lane); transpose_out<MAP, F8>(K, WT, scr, item, lane);
}

__device__ __forceinline__ void p0_prologue(const Args& a, Frame& F) {
    unsigned char* ws = a.ws;
    float* ADA = (float*)(ws + WS_ADA); float* ROPE = (float*)(ws + WS_ROPE);
    for (int idx = F.gtid; idx < 64 * 16; idx += F.nthreads) {
        const int pos = idx >> 4, i = idx & 15;
        const float inv = exp2f(-(float)i * (13.287712379549449f / 16.0f));
        const float ang = (float)pos * inv;
        ROPE[idx * 2] = cosf(ang); ROPE[idx * 2 + 1] = sinf(ang);
    }
    { bf16_t* RWT = (bf16_t*)(ws + WS_RWT);
      for (int idx = F.gtid; idx < 32 * 1024; idx += F.nthreads) { const int e = idx >> 10, k = idx & 1023; const float w = a.in[I_RW][k * 32 + e]; const unsigned hi = f2bf(w); RWT[idx] = (bf16_t)hi; RWT[32768 + idx] = (bf16_t)f2bf(w - bf2f(hi)); } }
    for (int tile = blockIdx.x; tile < 192; tile += F.G) {
        LAS float* SL = (LAS float*)F.lds;
        LAS float* PT = (LAS float*)(F.lds + 17 * 4096);
        for (int i = F.tid; i < 17 * 1024; i += NTHR) { const int r = i >> 10, k = i & 1023; const float s = r < 16 ? a.in[I_C][r * 1024 + k] : a.in[I_CCTX][k]; SL[i] = s / (1.0f + __expf(-s)); }
        __syncthreads();
        const int col = F.lane & 31, kh = F.lane >> 5; const float* w = a.in[I_WADA] + tile * 32 + col; const int k0 = F.wave * 128 + 64 * kh;
        float acc[17];
#pragma unroll
        for (int r = 0; r < 17; ++r) acc[r] = 0.f;
#pragma unroll 1
        for (int kb = 0; kb < 64; kb += 32) {
            float wv[32];
#pragma unroll
            for (int q = 0; q < 32; ++q) wv[q] = __builtin_nontemporal_load(w + (size_t)(k0 + kb + q) * 6144);
#pragma unroll
            for (int k4 = 0; k4 < 32; k4 += 4)
#pragma unroll
                for (int r = 0; r < 17; ++r) { const f32x4 s4 = *(const LAS f32x4*)(SL + r * 1024 + k0 + kb + k4); acc[r] = fmaf(s4[0], wv[k4], acc[r]); acc[r] = fmaf(s4[1], wv[k4 + 1], acc[r]); acc[r] = fmaf(s4[2], wv[k4 + 2], acc[r]); acc[r] = fmaf(s4[3], wv[k4 + 3], acc[r]); }
        }
#pragma unroll
        for (int r = 0; r < 17; ++r) { acc[r] += __shfl_xor(acc[r], 32); if (kh == 0) PT[(F.wave * 17 + r) * 32 + col] = acc[r]; }
        __syncthreads();
        for (int i = F.tid; i < 17 * 32; i += NTHR) { const int r = i >> 5, c = i & 31; float s = a.in[I_BADA][tile * 32 + c];
#pragma unroll
            for (int wv = 0; wv < 8; ++wv) s += PT[(wv * 17 + r) * 32 + c];
            ADA[r * 6144 + tile * 32 + c] = s; }
        __syncthreads();
    }
    LAS float* scr = (LAS float*)(F.lds + F.wave * 16640);
    constexpr int I_IN = 16 * (NIN / 64), I_O = 16 * 16;
    for (int it = F.gw; it < I_IN + I_O; it += F.ngw) {
        if (it < I_IN) transpose_item<1, false>(a.in[I_WIN], 1024, NIN, ws + WS_WIN, scr, it, F.lane);
        else transpose_item<0, false>(a.in[I_WO], 1024, 1024, ws + WS_WO, scr, it - I_IN, F.lane);
    }
}
__device__ __forceinline__ void moe_weights_convert(const Args& a, Frame& F, int first, int last, int wi, int nw) {
    unsigned char* ws = a.ws;
    LAS float* scr = (LAS float*)(F.lds + F.wave * 16640);
    constexpr int I_UP = 16 * 32, I_DN = 16 * 16, NIT = NEXP * (I_UP + I_DN);
#define MW_LD(it_) do { const int _it = (it_); if (_it < NEXP * I_UP) { const int e = _it / I_UP; transpose_load(v, a.in[I_WUP] + (size_t)e * 1024 * 2048, 1024, 2048, _it % I_UP, F.lane); } \
        else { const int r = _it - NEXP * I_UP, e = r / I_DN; transpose_load(v, a.in[I_WDN] + (size_t)e * 1024 * 1024, 1024, 1024, r % I_DN, F.lane); } } while (0)
    { int _l = F.lane; asm volatile("" : "+v"(_l)); F.lane = _l; }
    f32x4 v[16];
    MW_LD(first + wi < last ? first + wi : last - 1);
    for (int it = first + wi; it < last; it += nw) {
        transpose8_write(v, (LAS unsigned*)scr, F.lane);
        MW_LD(it + nw < last ? it + nw : last - 1);
        if (it < NEXP * I_UP) { const int e = it / I_UP; transpose8_out<2>(1024, ws + WS_WUP + (size_t)e * 2048 * 1024, (const LAS unsigned*)scr, it % I_UP, F.lane); }
        else { const int r = it - NEXP * I_UP, e = r / I_DN; transpose8_out<0>(1024, ws + WS_WDN + (size_t)e * 1024 * 1024, (const LAS unsigned*)scr, r % I_DN, F.lane); }
    }
#undef MW_LD
}

__device__ __forceinline__ void p1_ln_mod(const Args& a, Frame& F) {
    unsigned char* ws = a.ws;
    const float* ADA = (const float*)(ws + WS_ADA); float* STATS = (float*)(ws + WS_STATS); bf16_t* H = (bf16_t*)(ws + WS_H);
    const f32x4* g4 = (const f32x4*)a.in[I_LNING] + F.lane; const f32x4* b4 = (const f32x4*)a.in[I_LNINB] + F.lane;
    auto rowsrc = [&](int u) { const int b = u / SU, p = u % SU; return (const f32x4*)(p < CTX ? a.in[I_CTX] + ((size_t)b * CTX + p) * DM : a.in[I_X] + ((size_t)b * SEQ + (p - CTX)) * DM) + F.lane; };
    f32x4 vn[4];
    if (F.gw < NROW) { const f32x4* xr = rowsrc(F.gw);
#pragma unroll
        for (int j = 0; j < 4; ++j) vn[j] = __builtin_nontemporal_load(xr + 64 * j); }
    for (int u = F.gw; u < NROW; u += F.ngw) {
        const int b = u / SU, p = u % SU;
        f32x4 v[4]; float s = 0.f;
#pragma unroll
        for (int j = 0; j < 4; ++j) v[j] = vn[j];
        { const int un = (u + F.ngw < NROW) ? u + F.ngw : u; const f32x4* xr = rowsrc(un);
#pragma unroll
            for (int j = 0; j < 4; ++j) vn[j] = __builtin_nontemporal_load(xr + 64 * j); }
#pragma unroll
        for (int j = 0; j < 4; ++j) s += (v[j].x + v[j].y) + (v[j].z + v[j].w);
        const float mean = wave_sum(s) * (1.f / DM); float s2 = 0.f;
#pragma unroll
        for (int j = 0; j < 4; ++j) { v[j] = v[j] - mean; s2 += (v[j].x * v[j].x + v[j].y * v[j].y) + (v[j].z * v[j].z + v[j].w * v[j].w); }
        const float rstd = 1.f / sqrtf(wave_sum(s2) * (1.f / DM) + LN_EPS);
        const float* ad = ADA + (p < CTX ? 16 : b) * 6144;
        const f32x4* sh4 = (const f32x4*)ad + F.lane; const f32x4* sc4 = (const f32x4*)(ad + 1024) + F.lane;
        v2u* o8 = (v2u*)(H + (size_t)u * DM) + F.lane;
#pragma unroll
        for (int j = 0; j < 4; ++j) {
            const f32x4 g = g4[64 * j], bb = b4[64 * j], sh = sh4[64 * j], sc = sc4[64 * j];
            const f32x4 xl = v[j] * rstd * g + bb; const f32x4 h = xl * (sc + 1.0f) + sh;
            v2u w; w.x = pk2(h.x, h.y); w.y = pk2(h.z, h.w); o8[64 * j] = w;
        }
        if (p >= CTX && F.lane == 0) { const int m = b * SEQ + (p - CTX); STATS[2 * m] = mean; STATS[2 * m + 1] = rstd; }
    }
}

__device__ __forceinline__ void store64(bf16_t* dst, const float (&v)[64]) {
#pragma unroll
    for (int q = 0; q < 8; ++q) { v4u w; w.x = pk2(v[8 * q], v[8 * q + 1]); w.y = pk2(v[8 * q + 2], v[8 * q + 3]); w.z = pk2(v[8 * q + 4], v[8 * q + 5]); w.w = pk2(v[8 * q + 6], v[8 * q + 7]); *(v4u*)(dst + 8 * q) = w; }
}
__device__ __forceinline__ void rope64(float (&v)[64], const float* ROPE, int t) {
    const float* rr = ROPE + (t >> 6) * 32; const float* rc = ROPE + (t & 63) * 32;
#pragma unroll
    for (int i = 0; i < 16; ++i) {
        const float cr = rr[2 * i], sr = rr[2 * i + 1], cc = rc[2 * i], sc = rc[2 * i + 1];
        const float x1 = v[i], x2 = v[16 + i], x3 = v[32 + i], x4 = v[48 + i];
        v[i] = x1 * cr - x2 * sr; v[16 + i] = x2 * cr + x1 * sr; v[32 + i] = x3 * cc - x4 * sc; v[48 + i] = x4 * cc + x3 * sc;
    }
}
__device__ __forceinline__ void rms64(float (&v)[64], const float* g) {
    float ss = 0.f;
#pragma unroll
    for (int d = 0; d < 64; ++d) ss = fmaf(v[d], v[d], ss);
    const float r = 1.0f / sqrtf(ss * (1.0f / 64.0f) + LN_EPS);
#pragma unroll
    for (int d = 0; d < 64; ++d) v[d] = v[d] * r * g[d];
}
__device__ __forceinline__ void p3_attn_scalar(const Args& a, Frame& F) {
    unsigned char* ws = a.ws;
    const bf16_t* AQ = (const bf16_t*)(ws + WS_AQ); const bf16_t* AK = (const bf16_t*)(ws + WS_AK); const bf16_t* AV = (const bf16_t*)(ws + WS_AV); bf16_t* MIX = (bf16_t*)(ws + WS_MIX);
    for (int it = F.gtid; it < BATCH * 8 * SEQ; it += F.nthreads) {
        const int t = it % SEQ, h = (it / SEQ) % 8, b = it / (SEQ * 8); const int m = b * SEQ + t, hk = h >> 2;
        v4u q[8];
#pragma unroll
        for (int i = 0; i < 8; ++i) q[i] = *(const v4u*)(AQ + (size_t)m * 512 + h * 64 + 8 * i);
        float o[64];
#pragma unroll
        for (int d = 0; d < 64; ++d) o[d] = 0.f;
        float mr = -1e30f, l = 0.f;
        const bf16_t* kb = AK + (size_t)b * SU * 128 + hk * 64; const bf16_t* vb = AV + (size_t)b * SU * 128 + hk * 64;
        for (int j = 0; j < SU; ++j) {
            float s = 0.f;
#pragma unroll
            for (int i = 0; i < 8; ++i) s = dot8(q[i], *(const v4u*)(kb + (size_t)j * 128 + 8 * i), s);
            const float mn = fmaxf(mr, s), corr = exp2f(mr - mn), pe = exp2f(s - mn);
            l = l * corr + pe; mr = mn;
#pragma unroll
            for (int i = 0; i < 8; ++i) { const v4u vv = *(const v4u*)(vb + (size_t)j * 128 + 8 * i);
                o[8 * i + 0] = fmaf(pe, bflo(vv.x), o[8 * i + 0] * corr); o[8 * i + 1] = fmaf(pe, bfhi(vv.x), o[8 * i + 1] * corr);
                o[8 * i + 2] = fmaf(pe, bflo(vv.y), o[8 * i + 2] * corr); o[8 * i + 3] = fmaf(pe, bfhi(vv.y), o[8 * i + 3] * corr);
                o[8 * i + 4] = fmaf(pe, bflo(vv.z), o[8 * i + 4] * corr); o[8 * i + 5] = fmaf(pe, bfhi(vv.z), o[8 * i + 5] * corr);
                o[8 * i + 6] = fmaf(pe, bflo(vv.w), o[8 * i + 6] * corr); o[8 * i + 7] = fmaf(pe, bfhi(vv.w), o[8 * i + 7] * corr); }
        }
        const float rl = 1.0f / l;
#pragma unroll
        for (int d = 0; d < 64; ++d) o[d] *= rl;
        store64(MIX + (size_t)m * DM + 512 + h * 64, o);
    }
}
__device__ __forceinline__ void p3_ret_scalar(const Args& a, Frame& F) {
    unsigned char* ws = a.ws;
    const bf16_t* RQ = (const bf16_t*)(ws + WS_RQ); const bf16_t* RK = (const bf16_t*)(ws + WS_RK); const bf16_t* RV = (const bf16_t*)(ws + WS_RV); const bf16_t* RG = (const bf16_t*)(ws + WS_RG);
    bf16_t* MIX = (bf16_t*)(ws + WS_MIX); float* YRET = (float*)(ws + WS_YRET);
    for (int it = F.gtid; it < BATCH * 4 * SEQ; it += F.nthreads) {
        const int t = it % SEQ, h = (it / SEQ) % 4, b = it / (SEQ * 4); const int m = b * SEQ + t;
        const float lgf = a.in[I_LDF][h] * 1.4426950408889634f, lgb = a.in[I_LDB][h] * 1.4426950408889634f;
        v4u q[8];
#pragma unroll
        for (int i = 0; i < 8; ++i) q[i] = *(const v4u*)(RQ + (size_t)m * 256 + h * 64 + 8 * i);
        const bf16_t* kb = RK + (size_t)b * SU * 256 + h * 64; const bf16_t* vb = RV + (size_t)b * SU * 512 + h * 128;
        float* yr = YRET + ((size_t)m * 4 + h) * 128;
        for (int dq = 0; dq < 4; ++dq) {
            float acc[32];
#pragma unroll
            for (int e = 0; e < 32; ++e) acc[e] = 0.f;
            for (int j = 0; j < SU; ++j) {
                float s = 0.f;
#pragma unroll
                for (int i = 0; i < 8; ++i) s = dot8(q[i], *(const v4u*)(kb + (size_t)j * 256 + 8 * i), s);
                float w;
                if (j < CTX) w = exp2f(lgf * (float)(t + CTX - j)) + exp2f(lgb * (float)(SEQ - t + j));
                else { const int tj = j - CTX; w = tj < t ? exp2f(lgf * (float)(t - tj)) : (tj > t ? exp2f(lgb * (float)(tj - t)) : 2.0f); }
                s *= w;
#pragma unroll
                for (int i = 0; i < 4; ++i) { const v4u vv = *(const v4u*)(vb + (size_t)j * 512 + dq * 32 + 8 * i);
                    acc[8 * i + 0] = fmaf(s, bflo(vv.x), acc[8 * i + 0]); acc[8 * i + 1] = fmaf(s, bfhi(vv.x), acc[8 * i + 1]);
                    acc[8 * i + 2] = fmaf(s, bflo(vv.y), acc[8 * i + 2]); acc[8 * i + 3] = fmaf(s, bfhi(vv.y), acc[8 * i + 3]);
                    acc[8 * i + 4] = fmaf(s, bflo(vv.z), acc[8 * i + 4]); acc[8 * i + 5] = fmaf(s, bfhi(vv.z), acc[8 * i + 5]);
                    acc[8 * i + 6] = fmaf(s, bflo(vv.w), acc[8 * i + 6]); acc[8 * i + 7] = fmaf(s, bfhi(vv.w), acc[8 * i + 7]); }
            }
#pragma unroll
            for (int e = 0; e < 32; ++e) yr[dq * 32 + e] = acc[e];
        }
        asm volatile("s_waitcnt vmcnt(0)" ::: "memory");
        float s1 = 0.f;
        for (int e = 0; e < 128; ++e) s1 += yr[e];
        const float mu = s1 * (1.0f / 128.0f); float s2 = 0.f;
        for (int e = 0; e < 128; ++e) { const float d = yr[e] - mu; s2 = fmaf(d, d, s2); }
        const float rs = 1.0f / sqrtf(s2 * (1.0f / 128.0f) + LN_EPS);
        const float* gg = a.in[I_GNG] + h * 128; const float* gb = a.in[I_GNB] + h * 128;
        for (int e = 0; e < 128; e += 2) {
            const unsigned gw = *(const unsigned*)(RG + (size_t)m * 512 + h * 128 + e);
            const float g0 = bflo(gw), g1 = bfhi(gw);
            const float y0 = ((yr[e] - mu) * rs * gg[e] + gb[e]) * (g0 / (1.0f + __expf(-g0)));
            const float y1 = ((yr[e + 1] - mu) * rs * gg[e + 1] + gb[e + 1]) * (g1 / (1.0f + __expf(-g1)));
            *(unsigned*)(MIX + (size_t)m * DM + h * 128 + e) = pk2(y0, y1);
        }
    }
}

__device__ __forceinline__ void p6_ln1_route(const Args& a, Frame& F) {
    typedef short bf16x8 __attribute__((ext_vector_type(8)));
    unsigned char* ws = a.ws;
    const float* ADA = (const float*)(ws + WS_ADA); const float* STATS = (const float*)(ws + WS_STATS); const bf16_t* Y1 = (const bf16_t*)(ws + WS_Y1); const bf16_t* RWT = (const bf16_t*)(ws + WS_RWT);
    float* X1 = (float*)(ws + WS_X1); bf16_t* H2 = (bf16_t*)(ws + WS_H2); unsigned* CNT = F.ctl + CW_CNT; v2u* LIST = (v2u*)(ws + WS_LIST);
    constexpr int HP = 1032;
    LAS bf16_t* HSH = (LAS bf16_t*)F.lds; LAS bf16_t* HSL = (LAS bf16_t*)(F.lds + 16 * HP * 2);
    LAS float* PP = (LAS float*)(F.lds + 2 * 16 * HP * 2);
    LAS float* PRM = PP + 8 * 16 * 32;
    LAS unsigned* SEL = (LAS unsigned*)(PRM + 7 * 1024);
    LAS unsigned* HIST = SEL + 512 * 4;
    const int fr = F.lane & 15, fq = F.lane >> 4;
    bf16x8 bh[2][4], bl[2][4];
#pragma unroll
    for (int eh = 0; eh < 2; ++eh)
#pragma unroll
        for (int ks = 0; ks < 4; ++ks) { const size_t o = (size_t)(16 * eh + fr) * 1024 + 128 * F.wave + 32 * ks + 8 * fq; bh[eh][ks] = *(const bf16x8*)(RWT + o); bl[eh][ks] = *(const bf16x8*)(RWT + 32768 + o); }
    for (int rb = blockIdx.x; rb < NTOK / 128; rb += F.G) {
        const int m0 = rb * 128, b = m0 / SEQ; const float* ad = ADA + b * 6144;
        __syncthreads();
        for (int i = F.tid; i < 1024; i += NTHR) {
            PRM[i] = a.in[I_LNING][i] * DN_ALPHA; PRM[1024 + i] = a.in[I_LNINB][i] * DN_ALPHA; PRM[2048 + i] = ad[2048 + i];
            PRM[3072 + i] = a.in[I_LN1G][i]; PRM[4096 + i] = a.in[I_LN1B][i]; PRM[5120 + i] = ad[4096 + i] + 1.0f; PRM[6144 + i] = ad[3072 + i]; }
        if (F.tid < 64) HIST[F.tid] = 0u;
        __syncthreads();
#define P6_FETCH(m_) do { const int _m = (m_); _Pragma("unroll") for (int j = 0; j < 4; ++j) { xn[j] = __builtin_nontemporal_load((const f32x4*)(a.in[I_X] + (size_t)_m * DM) + F.lane + 64 * j); \
            yn[j] = __builtin_nontemporal_load((const v2u*)(Y1 + (size_t)_m * DM) + F.lane + 64 * j); } mn = STATS[2 * _m]; rn = STATS[2 * _m + 1]; } while (0)
        f32x4 xn[4]; v2u yn[4]; float mn, rn;
        P6_FETCH(m0 + 2 * F.wave);
        for (int it = 0; it < 8; ++it) {
#pragma unroll 1
            for (int rr = 0; rr < 2; ++rr) {
                const int lr = 2 * F.wave + rr, m = m0 + 16 * it + lr; const float mean = mn, rstd = rn;
                f32x4 xc[4]; v2u yc[4];
#pragma unroll
                for (int j = 0; j < 4; ++j) { xc[j] = xn[j]; yc[j] = yn[j]; }
                { const int q = 2 * it + rr + 1; const int mnext = q < 16 ? m0 + 16 * (q >> 1) + 2 * F.wave + (q & 1) : m; P6_FETCH(mnext); }
                f32x4 z[4]; float s = 0.f;
#pragma unroll
                for (int j = 0; j < 4; ++j) {
                    const f32x4 xv = xc[j];
                    const v2u yw = yc[j];
                    const f32x4 y = {bflo(yw.x), bfhi(yw.x), bflo(yw.y), bfhi(yw.y)};
                    const f32x4 p0 = ((const LAS f32x4*)PRM + F.lane)[64 * j], p1 = ((const LAS f32x4*)(PRM + 1024) + F.lane)[64 * j], p2 = ((const LAS f32x4*)(PRM + 2048) + F.lane)[64 * j];
                    z[j] = (xv - mean) * rstd * p0 + p1 + p2 * y;
                    s += (z[j].x + z[j].y) + (z[j].z + z[j].w);
                }
                const float mz = wave_sum(s) * (1.f / DM); float s2 = 0.f;
#pragma unroll
                for (int j = 0; j < 4; ++j) { z[j] = z[j] - mz; s2 += (z[j].x * z[j].x + z[j].y * z[j].y) + (z[j].z * z[j].z + z[j].w * z[j].w); }
                const float rz = 1.f / sqrtf(wave_sum(s2) * (1.f / DM) + LN_EPS);
#pragma unroll
                for (int j = 0; j < 4; ++j) {
                    const f32x4 p3 = ((const LAS f32x4*)(PRM + 3072) + F.lane)[64 * j], p4 = ((const LAS f32x4*)(PRM + 4096) + F.lane)[64 * j], p5 = ((const LAS f32x4*)(PRM + 5120) + F.lane)[64 * j], p6 = ((const LAS f32x4*)(PRM + 6144) + F.lane)[64 * j];
                    const f32x4 x1 = z[j] * rz * p3 + p4; const f32x4 h2 = x1 * p5 + p6;
                    { v2u xw; xw.x = pk2(x1.x, x1.y); xw.y = pk2(x1.z, x1.w); ((v2u*)((bf16_t*)X1 + (size_t)m * DM) + F.lane)[64 * j] = xw; }
                    const unsigned h0 = f2bf(h2.x), h1 = f2bf(h2.y), h2b = f2bf(h2.z), h3 = f2bf(h2.w);
                    v2u w; w.x = h0 | (h1 << 16); w.y = h2b | (h3 << 16);
                    { unsigned q = 0u; q = __builtin_amdgcn_cvt_pk_fp8_f32(h2.x, h2.y, q, false); q = __builtin_amdgcn_cvt_pk_fp8_f32(h2.z, h2.w, q, true); ((unsigned*)((unsigned char*)H2 + (size_t)m * DM) + F.lane)[64 * j] = q; }
                    v2u lo; lo.x = pk2(h2.x - bf2f(h0), h2.y - bf2f(h1)); lo.y = pk2(h2.z - bf2f(h2b), h2.w - bf2f(h3));
                    *(LAS v2u*)(HSH + lr * HP + 4 * F.lane + 256 * j) = w; *(LAS v2u*)(HSL + lr * HP + 4 * F.lane + 256 * j) = lo;
                }
            }
            __syncthreads();
            f32x4 acc[2] = {(f32x4){0.f, 0.f, 0.f, 0.f}, (f32x4){0.f, 0.f, 0.f, 0.f}};
#pragma unroll
            for (int ks = 0; ks < 4; ++ks) {
                const bf16x8 ah = *(const LAS bf16x8*)(HSH + fr * HP + 128 * F.wave + 32 * ks + 8 * fq), al = *(const LAS bf16x8*)(HSL + fr * HP + 128 * F.wave + 32 * ks + 8 * fq);
#pragma unroll
                for (int eh = 0; eh < 2; ++eh) { acc[eh] = __builtin_amdgcn_mfma_f32_16x16x32_bf16(ah, bh[eh][ks], acc[eh], 0, 0, 0); acc[eh] = __builtin_amdgcn_mfma_f32_16x16x32_bf16(ah, bl[eh][ks], acc[eh], 0, 0, 0); acc[eh] = __builtin_amdgcn_mfma_f32_16x16x32_bf16(al, bh[eh][ks], acc[eh], 0, 0, 0); }
            }
#pragma unroll
            for (int eh = 0; eh < 2; ++eh)
#pragma unroll
                for (int r = 0; r < 4; ++r) PP[(F.wave * 16 + 4 * fq + r) * 32 + 16 * eh + fr] = acc[eh][r];
            __syncthreads();
            {
                const int lr = 2 * F.wave + (F.lane >> 5), ex = F.lane & 31;
                float mine = a.in[I_RB][ex];
#pragma unroll
                for (int wv = 0; wv < 8; ++wv) mine += PP[(wv * 16 + lr) * 32 + ex];
                float sv[4]; int si[4];
#pragma unroll
                for (int k = 0; k < 4; ++k) {
                    float v = mine; int ix = ex;
#pragma unroll
                    for (int o = 16; o >= 1; o >>= 1) { const float ov = __shfl_xor(v, o); const int oi = __shfl_xor(ix, o); if (ov > v || (ov == v && oi < ix)) { v = ov; ix = oi; } }
                    sv[k] = v; si[k] = ix; if (ex == ix) mine = -3.0e38f;
                }
                const float e1 = __expf(sv[1] - sv[0]), e2 = __expf(sv[2] - sv[0]), e3 = __expf(sv[3] - sv[0]);
                const float rs = 1.0f / (1.0f + e1 + e2 + e3);
                if (ex < 4) {
                    const int sel = ex == 0 ? si[0] : (ex == 1 ? si[1] : (ex == 2 ? si[2] : si[3]));
                    const float gt = (ex == 0 ? 1.0f : (ex == 1 ? e1 : (ex == 2 ? e2 : e3))) * rs;
                    const unsigned rank = atomicAdd((unsigned*)(HIST + sel), 1u);
                    const int slot = (16 * it + lr) * 4 + ex;
                    SEL[slot * 4] = (unsigned)sel; SEL[slot * 4 + 1] = rank; SEL[slot * 4 + 2] = (unsigned)((m0 + 16 * it + lr) * 4 + ex); SEL[slot * 4 + 3] = __float_as_uint(gt);
                }
            }
        }
        __syncthreads();
        if (F.tid < 32) HIST[32 + F.tid] = atomicAdd(CNT + F.tid, HIST[F.tid]);
        __syncthreads();
        { const unsigned ex = SEL[F.tid * 4], rank = SEL[F.tid * 4 + 1]; v2u ent; ent.x = SEL[F.tid * 4 + 2]; ent.y = SEL[F.tid * 4 + 3]; LIST[(size_t)ex * LISTCAP + HIST[32 + ex] + rank] = ent; }
    }
}

__device__ __forceinline__ void p9_final(const Args& a, Frame& F) {
    unsigned char* ws = a.ws;
    const float* ADA = (const float*)(ws + WS_ADA); const bf16_t* X1 = (const bf16_t*)(ws + WS_X1); const unsigned char* YE = (const unsigned char*)(ws + WS_YE);
    unsigned yn[4][4]; v2u xn[4];
    auto fetch = [&](int m) {
#pragma unroll
        for (int j = 0; j < 4; ++j) {
#pragma unroll
            for (int k = 0; k < 4; ++k) yn[j][k] = __builtin_nontemporal_load((const unsigned*)(YE + ((size_t)m * 4 + k) * DM) + F.lane + 64 * j);
            xn[j] = __builtin_nontemporal_load((const v2u*)(X1 + (size_t)m * DM) + F.lane + 64 * j); } };
    if (F.gw < NTOK) fetch(F.gw);
    for (int m = F.gw; m < NTOK; m += F.ngw) {
        const int b = m / SEQ; const float* ad = ADA + b * 6144;
        f32x4 z[4]; float s = 0.f;
#pragma unroll
        for (int j = 0; j < 4; ++j) {
            f32x4 f = {0.f, 0.f, 0.f, 0.f};
#pragma unroll
            for (int k = 0; k < 4; ++k) { const unsigned yw = yn[j][k];
                f += (f32x4){__builtin_amdgcn_cvt_f32_fp8(yw, 0), __builtin_amdgcn_cvt_f32_fp8(yw, 1), __builtin_amdgcn_cvt_f32_fp8(yw, 2), __builtin_amdgcn_cvt_f32_fp8(yw, 3)}; }
            f = f * (1.0f / 64.0f);
            const v2u xw = xn[j]; const f32x4 x1 = {bflo(xw.x), bfhi(xw.x), bflo(xw.y), bfhi(xw.y)};
            const f32x4 g2 = ((const f32x4*)(ad + 5120) + F.lane)[64 * j];
            z[j] = x1 * DN_ALPHA + g2 * f;
            s += (z[j].x + z[j].y) + (z[j].z + z[j].w);
        }
        fetch((m + F.ngw < NTOK) ? m + F.ngw : m);
        const float mz = wave_sum(s) * (1.f / DM); float s2 = 0.f;
#pragma unroll
        for (int j = 0; j < 4; ++j) { z[j] = z[j] - mz; s2 += (z[j].x * z[j].x + z[j].y * z[j].y) + (z[j].z * z[j].z + z[j].w * z[j].w); }
        const float rz = 1.f / sqrtf(wave_sum(s2) * (1.f / DM) + LN_EPS);
#pragma unroll
        for (int j = 0; j < 4; ++j) {
            const f32x4 g = ((const f32x4*)a.in[I_LN2G] + F.lane)[64 * j], bb = ((const f32x4*)a.in[I_LN2B] + F.lane)[64 * j];
            __builtin_nontemporal_store(z[j] * rz * g + bb, (f32x4*)(a.out + (size_t)m * DM) + F.lane + 64 * j);
        }
    }
}

constexpr int N_PHASES = 10;
constexpr int CONV_NIT = NEXP * (16 * 32 + 16 * 16), CONV_P2 = 64 * 8 * 4;
#ifndef MK_N_LAUNCHES
#define MK_N_LAUNCHES 1
#endif
__global__ void __launch_bounds__(NTHR, 2) fwd_kernel(Args a) {
    extern __shared__ __attribute__((aligned(16))) unsigned char lds[];
    Frame F;
    F.lds = (LAS unsigned char*)lds;
#define REFRESH() do { int _t = threadIdx.x; asm volatile("" : "+v"(_t)); F.tid = _t; F.lane = _t & 63; F.wave = __builtin_amdgcn_readfirstlane(_t >> 6); F.gtid = blockIdx.x * NTHR + _t; F.gw = blockIdx.x * NWAVES + F.wave; } while (0)
    F.G = gridDim.x; F.nthreads = F.G * NTHR; F.ngw = F.G * NWAVES; REFRESH();
    F.ctl = (unsigned*)(a.ws + WS_CTL);
    volatile LAS unsigned* MISC = (volatile LAS unsigned*)(F.lds + MISC_OFF);
    for (int u = F.tid; u < (LDS_BYTES - 131072) / 4; u += NTHR) ((LAS unsigned*)(F.lds + 131072))[u] = 0u;
    __syncthreads();
    XcdBarrier bar; bar.bar = F.ctl + CW_BAR + a.li * XCD_BAR_WORDS; bar.x = 0; bar.st = nullptr;
    if (MK_N_LAUNCHES == 1) bar = xcd_barrier_post(F.ctl + CW_BAR, MISC + 8);
    const int lo = a.ph_lo, hi = a.ph_hi;
#define IN(k) (lo <= (k) && (k) < hi)
#define SEAM(k) do { if (IN(k) && IN((k) + 1)) xcd_barrier(bar); } while (0)
    if (IN(0)) { REFRESH(); p0_prologue(a, F); } SEAM(0);
    if (IN(1)) { REFRESH(); p1_ln_mod(a, F); } SEAM(1);
    if (IN(2)) { REFRESH();
        pg8::SchedInProj S{F.G, (int)blockIdx.x}; pg8::EpiInProj E{a.ws, a.in[I_QNG], a.in[I_KNG], (const float*)(a.ws + WS_ROPE)};
        pg8::gemm_phase<pg8::EpiInProj, pg8::SchedInProj, false>(F.lds, (const bf16_t*)(a.ws + WS_H), (const bf16_t*)(a.ws + WS_WIN), S, E);
        if (F.G == 256) { if (blockIdx.x >= 192) { REFRESH(); __syncthreads(); moe_weights_convert(a, F, 0, CONV_P2, ((int)blockIdx.x - 192) * NWAVES + F.wave, 64 * NWAVES); } }
        else if (blockIdx.x == 0) {   }
    } SEAM(2);
    if (IN(3)) { REFRESH();
        const attn_body::AttnTensors AT{(const attn_body::bf16*)(a.ws + WS_AQ), (const attn_body::bf16*)(a.ws + WS_AK), (const attn_body::bf16*)(a.ws + WS_AV), (attn_body::bf16*)(a.ws + WS_MIX) + 512};
        const attn_body::StaticOrder S((int)F.G, (int)blockIdx.x);
        if ((F.G & 255) == 0) {
            float gqm = 0.f, gkm = 0.f;
            for (int i = 0; i < 64; ++i) { gqm = fmaxf(gqm, fabsf(a.in[I_QNG][i])); gkm = fmaxf(gkm, fabsf(a.in[I_KNG][i])); }
            const float refB = 1.02f * C2 * 64.0f * gqm * gkm;
            const int slot = (int)(blockIdx.x % 5u); attn_body::AttnUnit u;
            for (int i = 0; i < 5; ++i) {
                if (i == slot) { __syncthreads(); moe_weights_convert(a, F, CONV_P2, CONV_NIT, F.gw, F.ngw); __syncthreads(); }
                if (i < 4 && S.next(i, u)) attn_body::attn_unit<8>(u.b, u.h, u.qb, AT.Q, AT.K, AT.V, AT.O, (char*)lds, refB);
            }
        } else { p3_attn_scalar(a, F); __syncthreads(); moe_weights_convert(a, F, 0, CONV_NIT, F.gw, F.ngw); }
        __syncthreads();
        for (int u = blockIdx.x; u < 256; u += F.G) { const int dvh = u & 1, dir = (u >> 1) & 1, h = (u >> 2) & 3, b = u >> 4;
            ret::state_unit(b, h, dir, dvh, (const bf16_t*)(a.ws + WS_RK), (const bf16_t*)(a.ws + WS_RV), (bf16_t*)(a.ws + WS_ST), (dir ? a.in[I_LDB][h] : a.in[I_LDF][h]) * 1.4426950408889634f, F.lds); }
    } SEAM(3);
    if (IN(4)) { REFRESH();
        ret::OutRegs R; int u = blockIdx.x;
        if (u < 1024) ret::out_load(R, u, (const bf16_t*)(a.ws + WS_RQ), (const bf16_t*)(a.ws + WS_RK), (const bf16_t*)(a.ws + WS_RV), (const bf16_t*)(a.ws + WS_RG));
        for (; u < 1024; u += F.G) { const int un = (u + F.G < 1024) ? u + F.G : -1;
            ret::out_unit(R, u, un, (const bf16_t*)(a.ws + WS_RQ), (const bf16_t*)(a.ws + WS_RK), (const bf16_t*)(a.ws + WS_RV), (const bf16_t*)(a.ws + WS_RG), (const bf16_t*)(a.ws + WS_ST), a.in[I_GNG], a.in[I_GNB],
                          a.in[I_LDF], a.in[I_LDB], (bf16_t*)(a.ws + WS_MIX), F.lds); }
    } SEAM(4);
    if (IN(5)) { REFRESH();
        pg8::SchedDense S{NTOK / 256, DM / 256, F.G, (int)blockIdx.x}; pg8::EpiPlainBf16 E{(bf16_t*)(a.ws + WS_Y1), DM};
        pg8::gemm_phase<pg8::EpiPlainBf16, pg8::SchedDense, false>(F.lds, (const bf16_t*)(a.ws + WS_MIX), (const bf16_t*)(a.ws + WS_WO), S, E);
    } SEAM(5);
    if (IN(6)) { REFRESH(); p6_ln1_route(a, F); } SEAM(6);
    if (IN(7)) { REFRESH();
        LAS int* tab = (LAS int*)(F.lds + 131072 + 1024); pg8::moe_build_tab(tab, F.ctl + CW_CNT);
        pg8::SchedMoE S{8, 2048, F.G, (int)blockIdx.x, tab, (const v2u*)(a.ws + WS_LIST)}; pg8::EpiUp E{a.ws + WS_ACT, a.in[I_BUP]};
        pg8::gemm_phase<pg8::EpiUp, pg8::SchedMoE, true, true>(F.lds, (const bf16_t*)(a.ws + WS_H2), (const bf16_t*)(a.ws + WS_WUP), S, E);
    } SEAM(7);
    if (IN(8)) { REFRESH();
        LAS int* tab = (LAS int*)(F.lds + 131072 + 1024); pg8::moe_build_tab(tab, F.ctl + CW_CNT);
        pg8::SchedMoE S{4, 1024, F.G, (int)blockIdx.x, tab, (const v2u*)(a.ws + WS_LIST)}; pg8::EpiDown E{(bf16_t*)(a.ws + WS_YE), a.in[I_BDN], (const v2u*)(a.ws + WS_LIST)};
        pg8::gemm_phase<pg8::EpiDown, pg8::SchedMoE, false, true>(F.lds, (const bf16_t*)(a.ws + WS_ACT), (const bf16_t*)(a.ws + WS_WDN), S, E);
    } SEAM(8);
    if (IN(9)) { REFRESH(); p9_final(a, F); }
#undef IN
#undef SEAM
}

extern "C" void kernel_launch(void* const* d_in, const int* in_sizes, int n_in, void* d_out, int out_size, void* d_ws, size_t ws_size, hipStream_t stream) {
    static int grid = 0;
    if (grid == 0) {
        if (n_in != 26 || out_size != NTOK * DM || ws_size < WS_END) { fprintf(stderr, "kernel_launch: unexpected shapes (n_in %d, out %d, ws %zu); nothing launched\n", n_in, out_size, ws_size); grid = -1; return; }
        int dev = 0, cus = 0;
        if (hipGetDevice(&dev) != hipSuccess || hipDeviceGetAttribute(&cus, hipDeviceAttributeMultiprocessorCount, dev) != hipSuccess) { grid = -1; return; }
        if (hipFuncSetAttribute((const void*)fwd_kernel, hipFuncAttributeMaxDynamicSharedMemorySize, LDS_BYTES) != hipSuccess) { fprintf(stderr, "kernel_launch: hipFuncSetAttribute failed\n"); grid = -1; return; }
        (void)hipGetLastError();
        grid = cus;
    }
    if (grid < 0) return;
    if (hipMemsetAsync((char*)d_ws + WS_CTL, 0, CTL_ZERO_BYTES, stream) != hipSuccess) return;
    Args a{};
    for (int i = 0; i < 26; ++i) a.in[i] = (const float*)d_in[i];
    a.out = (float*)d_out; a.ws = (unsigned char*)d_ws;
    if (MK_N_LAUNCHES == 1) { a.ph_lo = 0; a.ph_hi = N_PHASES; a.li = 0; hipLaunchKernelGGL(fwd_kernel, dim3(grid), dim3(NTHR), LDS_BYTES, stream, a); }
    else for (int p = 0; p < N_PHASES; ++p) { a.ph_lo = p; a.ph_hi = p + 1; a.li = 0; hipLaunchKernelGGL(fwd_kernel, dim3(grid), dim3(NTHR), LDS_BYTES, stream, a); }
}
```

```cpp
#include <hip/hip_runtime.h>
#include <cstdio>
#include <cstdint>

constexpr int BATCH = 16, SEQ = 2048, DM = 1024, CTX = 256, SU = SEQ + CTX;
constexpr int NTOK = BATCH * SEQ, NROW = BATCH * SU;
constexpr int NIN = 2304, NEXP = 32, LISTCAP = 32768;
constexpr float LN_EPS = 1e-6f, DN_ALPHA = 1.189207115002721f;
constexpr float C2 = 0.125f * 1.4426950408889634f;
constexpr int NWAVES = 8, NTHR = 512;

constexpr size_t MiB = 1u << 20;
constexpr size_t WS_CTL = 0, CTL_ZERO_BYTES = 64 * 1024;
constexpr size_t WS_ADA = 1 * MiB, WS_ROPE = 1 * MiB + 512 * 1024, WS_STATS = 2 * MiB, WS_LIST = 4 * MiB;
constexpr size_t WS_RWT = 12 * MiB;
constexpr size_t WS_WIN = 16 * MiB, WS_WO = 22 * MiB, WS_WUP = 32 * MiB, WS_WDN = 160 * MiB;
constexpr size_t WS_X1 = 224 * MiB, WS_H2 = 352 * MiB, WS_ACT = 416 * MiB;
constexpr size_t WS_MIX = 416 * MiB, WS_Y1 = 480 * MiB, WS_YRET = 544 * MiB;
constexpr size_t WS_YE = 688 * MiB;
constexpr size_t WS_H = 688 * MiB, WS_RQ = 760 * MiB, WS_RK = 776 * MiB, WS_RV = 794 * MiB, WS_RG = 830 * MiB, WS_AQ = 862 * MiB, WS_AK = 894 * MiB, WS_AV = 903 * MiB;
constexpr size_t WS_ST = 912 * MiB;
constexpr size_t WS_END = 944 * MiB;
constexpr int CW_TMO = 0, CW_CNT = 256, CW_BAR = 4096;

#define GAS __attribute__((address_space(1)))
#define LAS __attribute__((address_space(3)))
typedef unsigned short bf16_t;
typedef unsigned v4u __attribute__((ext_vector_type(4)));
typedef unsigned v2u __attribute__((ext_vector_type(2)));
typedef float f32x4 __attribute__((ext_vector_type(4)));

__device__ __forceinline__ float bf2f(unsigned v) { return __uint_as_float(v << 16); }
__device__ __forceinline__ unsigned f2bf(float f) { unsigned u = __float_as_uint(f); return (u + 0x7fffu + ((u >> 16) & 1u)) >> 16; }
__device__ __forceinline__ unsigned pk2(float lo, float hi) { return f2bf(lo) | (f2bf(hi) << 16); }
__device__ __forceinline__ float bflo(unsigned w) { return __uint_as_float(w << 16); }
__device__ __forceinline__ float bfhi(unsigned w) { return __uint_as_float(w & 0xffff0000u); }
__device__ __forceinline__ float wave_sum(float v) {
#pragma unroll
    for (int o = 1; o < 64; o <<= 1) v += __shfl_xor(v, o);
    return v;
}
__device__ __forceinline__ float dot8(v4u a, v4u w, float acc) {
    acc = fmaf(bflo(a.x), bflo(w.x), acc); acc = fmaf(bfhi(a.x), bfhi(w.x), acc);
    acc = fmaf(bflo(a.y), bflo(w.y), acc); acc = fmaf(bfhi(a.y), bfhi(w.y), acc);
    acc = fmaf(bflo(a.z), bflo(w.z), acc); acc = fmaf(bfhi(a.z), bfhi(w.z), acc);
    acc = fmaf(bflo(a.w), bflo(w.w), acc); acc = fmaf(bfhi(a.w), bfhi(w.w), acc);
    return acc;
}

#define XB_TMO      128
#define XB_XCNT(j)  (256  + 64 * (j))
#define XB_XSUB(j)  (1280 + 64 * (j))
#define XB_XGEN(j)  (2304 + 64 * (j))
#define XB_TOP      3328
#define XB_TOPGEN   3392
#define XCD_BAR_WORDS 3456
#define XB_SPIN_CAP (1u << 24)
__device__ __forceinline__ unsigned xb_ld(unsigned* p)              { return __hip_atomic_load(p, __ATOMIC_RELAXED, __HIP_MEMORY_SCOPE_AGENT); }
__device__ __forceinline__ unsigned xb_add(unsigned* p, unsigned v) { return __hip_atomic_fetch_add(p, v, __ATOMIC_RELAXED, __HIP_MEMORY_SCOPE_AGENT); }
__device__ __forceinline__ unsigned xb_xcc_id() { return (unsigned)__builtin_amdgcn_s_getreg((3 << 11) | 20) & 0xFu; }
#define XB_SPIN(cond, bar) do { unsigned _sp = 0; while (cond) { __builtin_amdgcn_s_sleep(1); \
    if ((++_sp & 255u) == 0u) { if (xb_ld(&(bar)[XB_TMO])) break; if (_sp > XB_SPIN_CAP) { atomicAdd(&(bar)[XB_TMO], 1u); break; } } } } while (0)
struct XcdBarrier { unsigned* bar; unsigned x; volatile LAS unsigned* st; };
__device__ __forceinline__ XcdBarrier xcd_barrier_post(unsigned* bar, volatile LAS unsigned* st) {
    XcdBarrier b; b.bar = bar; b.x = xb_xcc_id(); b.st = st;
    if (threadIdx.x == 0) (void)xb_add(&bar[XB_XCNT(b.x)], 1u);
    return b;
}
__device__ __forceinline__ void xcd_barrier_complete(unsigned* bar, unsigned x, unsigned& nloc, unsigned& nx) {
    const unsigned G = gridDim.x * gridDim.y * gridDim.z;
    unsigned sum, cnt, mine, sp = 0u;
    for (;;) {
        sum = 0u; cnt = 0u; mine = 0u;
#pragma unroll
        for (unsigned j = 0; j < 16; ++j) { const unsigned c = xb_ld(&bar[XB_XCNT(j)]); sum += c; cnt += (c > 0u) ? 1u : 0u; mine = (j == x) ? c : mine; }
        if (sum == G) break;
        __builtin_amdgcn_s_sleep(1);
        if ((++sp & 255u) == 0u) { if (xb_ld(&bar[XB_TMO])) break; if (sp > XB_SPIN_CAP) { atomicAdd(&bar[XB_TMO], 1u); break; } }
    }
    nloc = mine > 0u ? mine : 1u; nx = cnt > 0u ? cnt : 1u;
}
__device__ __forceinline__ void xcd_barrier(const XcdBarrier& b) {
    asm volatile("s_waitcnt vmcnt(0)" ::: "memory");
    __syncthreads();
    if (threadIdx.x == 0) {
        unsigned* bar = b.bar;
        __builtin_amdgcn_s_waitcnt(0);
        unsigned nloc = b.st[0], nx = b.st[1];
        if (nloc == 0u) { xcd_barrier_complete(bar, b.x, nloc, nx); b.st[0] = nloc; b.st[1] = nx; }
        const unsigned old = xb_add(&bar[XB_XSUB(b.x)], 1u);
        const unsigned gen = old / nloc;
        if (old + 1u == (gen + 1u) * nloc) {
            __builtin_amdgcn_fence(__ATOMIC_RELEASE, "agent");
            asm volatile("s_waitcnt vmcnt(0)" ::: "memory");
            const unsigned og = xb_add(&bar[XB_TOP], 1u);
            const unsigned tg = og / nx;
            if (og + 1u == (tg + 1u) * nx) xb_add(&bar[XB_TOPGEN], 1u);
            else XB_SPIN(xb_ld(&bar[XB_TOPGEN]) == tg, bar);
            __builtin_amdgcn_fence(__ATOMIC_ACQUIRE, "agent");
            xb_add(&bar[XB_XGEN(b.x)], 1u);
            asm volatile("s_waitcnt vmcnt(0)" ::: "memory");
        } else {
            XB_SPIN(xb_ld(&bar[XB_XGEN(b.x)]) == gen, bar);
            __builtin_amdgcn_fence(__ATOMIC_ACQUIRE, "agent");
            asm volatile("s_waitcnt vmcnt(0)" ::: "memory");
        }
    }
    __syncthreads();
}

namespace pg8 {
typedef short bf16x8 __attribute__((ext_vector_type(8)));
typedef int v4i __attribute__((ext_vector_type(4)));
typedef int v8i __attribute__((ext_vector_type(8)));
constexpr int BM = 256, BK = 64, HALF = 128, HTB = HALF * BK * 2, NXCD = 8, WGM = 1, KD = 1024, NT = KD / BK;
__device__ __forceinline__ int lds_byte(int r, int c) { const int st = (r >> 4) * 2 + (c >> 5), rr = r & 15, cc = c & 31, ob = rr * 64 + cc * 2; return st * 1024 + (ob ^ (((ob >> 9) & 1) << 5)); }
__device__ __forceinline__ void stage_rc(int b, int& R, int& C) { const int st = b / 1024, sb = b % 1024, swz = sb ^ (((sb >> 9) & 1) << 5); R = (st >> 1) * 16 + swz / 64; C = (st & 1) * 32 + (swz % 64) / 2; }
__device__ __forceinline__ int perm32(int rho) { const int n = rho >> 4, i = rho & 15; return 8 * (i >> 2) + 4 * n + (i & 3); }
__device__ __forceinline__ unsigned cvt_pk_bf16(float lo, float hi) { unsigned r; asm volatile("v_cvt_pk_bf16_f32 %0, %1, %2" : "=v"(r) : "v"(lo), "v"(hi)); return r; }

struct Unit { int pm, pn, brow, e, r0, cnt; };

__device__ __forceinline__ void tile_order(int L, int nM, int nN, int& pm, int& pn) {
    const int nwg = nM * nN; int wgid = L; { const int q = nwg / NXCD, r = nwg % NXCD, xcd = wgid % NXCD, off = wgid / NXCD; wgid = (xcd < r ? xcd * (q + 1) : r * (q + 1) + (xcd - r) * q) + off; }
    const int nig = WGM * nN, gid = wgid / nig, fm = gid * WGM, gsz = (nM - fm) < WGM ? (nM - fm) : WGM;
    pm = fm + ((wgid % nig) % gsz); pn = (wgid % nig) / gsz;
}
struct SchedDense {
    int nM, nN, G, c;
    __device__ __forceinline__ bool next(int i, Unit& u) const { const long L = (long)i * G + c; if (L >= (long)nM * nN) return false; tile_order((int)L, nM, nN, u.pm, u.pn); u.brow = u.pn * BM; u.e = 0; u.r0 = 0; u.cnt = 0; return true; }
    __device__ __forceinline__ unsigned arow_tok(const Unit&, int) const { return 0u; }
};

template <class Epi, class Sched, bool GATHER, bool F8 = false>
__device__ __forceinline__ void gemm_phase(LAS unsigned char* lds, const bf16_t* A, const bf16_t* Bt, const Sched& S, const Epi& E) {
    const int tid = threadIdx.x, wid = __builtin_amdgcn_readfirstlane(tid >> 6), lane = tid & 63, wr = wid >> 2, wc = wid & 3, fr = lane & 15, fq = lane >> 4;
    constexpr int K = F8 ? KD / 2 : KD, nt = F8 ? NT / 2 : NT;
    unsigned voffA[2], voffB[2];
#pragma unroll
    for (int i = 0; i < 2; ++i) { int R, C; stage_rc(tid * 16 + i * 8192, R, C); const int Rb = Epi::PERM ? ((R & ~31) + perm32(R & 31)) : R;
        voffA[i] = GATHER ? (unsigned)(C * 2) : (unsigned)(R * K + C) * 2u; voffB[i] = (unsigned)(Rb * K + C) * 2u; }
    constexpr size_t kstep = (size_t)(BK * 2), hstep = (size_t)HALF * K * 2, tstep = 2 * hstep;
    const unsigned ldsw = (unsigned)wid * 1024u;
    const int aoff = lds_byte(wr * 64 + fr, fq * 8), boff = lds_byte(wc * 32 + fr, fq * 8);
#define PG8_SA(b, h) (((b) * 2 + (h)) * HTB)
#define PG8_SB(b, h) ((4 + (b) * 2 + (h)) * HTB)
#define PG8_STAGE_B(bufoff, gbase) do { _Pragma("unroll") for (int _i = 0; _i < 2; ++_i) \
        __builtin_amdgcn_global_load_lds((const unsigned*)((const char*)(gbase) + voffB[_i]), (LAS unsigned*)(lds + (bufoff) + ldsw + _i * 8192), 16, 0, 0); } while (0)
#define PG8_STAGE_A(bufoff, h, kb, nx) do { _Pragma("unroll") for (int _i = 0; _i < 2; ++_i) { \
        const char* _src = GATHER ? (const char*)A + (((((nx) ? ron[h] : roc[h]) >> (16 * _i)) & 0xffffu) << (F8 ? 10 : 11)) + voffA[0] + (kb) : ((nx) ? nA : cA) + (size_t)(h) * hstep + (kb) + voffA[_i]; \
        __builtin_amdgcn_global_load_lds((const unsigned*)_src, (LAS unsigned*)(lds + (bufoff) + ldsw + _i * 8192), 16, 0, 0); } } while (0)
#define PG8_LDA(dst, b, h) do { _Pragma("unroll") for (int m = 0; m < 4; ++m) { if constexpr (F8) { dst##8[m].lo = *(const LAS v4i*)(lds + PG8_SA(b, h) + aoff + m * 2048); dst##8[m].hi = *(const LAS v4i*)(lds + PG8_SA(b, h) + aoff + m * 2048 + 1024); } \
        else { _Pragma("unroll") for (int k = 0; k < 2; ++k) dst[m][k] = *(const LAS bf16x8*)(lds + PG8_SA(b, h) + aoff + m * 2048 + k * 1024); } } } while (0)
#define PG8_LDB(dst, b, h) do { _Pragma("unroll") for (int n = 0; n < 2; ++n) { if constexpr (F8) { dst##8[n].lo = *(const LAS v4i*)(lds + PG8_SB(b, h) + boff + n * 2048); dst##8[n].hi = *(const LAS v4i*)(lds + PG8_SB(b, h) + boff + n * 2048 + 1024); } \
        else { _Pragma("unroll") for (int k = 0; k < 2; ++k) dst[n][k] = *(const LAS bf16x8*)(lds + PG8_SB(b, h) + boff + n * 2048 + k * 1024); } } } while (0)
#define PG8_MMA(ai, bj, At, Bt_) do { __builtin_amdgcn_s_setprio(1); _Pragma("unroll") for (int m = 0; m < 4; ++m) _Pragma("unroll") for (int n = 0; n < 2; ++n) { \
        if constexpr (F8) { asm volatile("v_mfma_scale_f32_16x16x128_f8f6f4 %0, %1, %2, %0, %3, %3 op_sel_hi:[0,0,0]" : "+v"(acc[ai][bj][m][n]) : "v"(Bt_##8[n]), "v"(At##8[m]), "v"(sc8)); } \
        else { _Pragma("unroll") for (int k = 0; k < 2; ++k) acc[ai][bj][m][n] = __builtin_amdgcn_mfma_f32_16x16x32_bf16(Bt_[n][k], At[m][k], acc[ai][bj][m][n], 0, 0, 0); } } \
        __builtin_amdgcn_s_setprio(0); } while (0)
#define PG8_WAIT_V(n) asm volatile("s_waitcnt vmcnt(" #n ")" ::: "memory")
#define PG8_WAIT_L(n) asm volatile("s_waitcnt lgkmcnt(" #n ")" ::: "memory")
#define PG8_BAR __builtin_amdgcn_s_barrier()
#define PG8_SCHED __builtin_amdgcn_sched_barrier(0)
#define PG8_LOAD_RO(dst, unit) do { int _R, _C; stage_rc((int)threadIdx.x * 16, _R, _C); _Pragma("unroll") for (int _h = 0; _h < 2; ++_h) dst[_h] = S.arow_tok(unit, _h * HALF + _R) | (S.arow_tok(unit, _h * HALF + _R + 64) << 16); } while (0)
    Unit cur, nxt; int ui = 0;
    if (!S.next(0, cur)) return;
    f32x4 acc[2][2][4][2];
#pragma unroll
    for (int a = 0; a < 2; ++a)
#pragma unroll
        for (int b = 0; b < 2; ++b)
#pragma unroll
            for (int m = 0; m < 4; ++m)
#pragma unroll
                for (int n = 0; n < 2; ++n) acc[a][b][m][n] = (f32x4){0.f, 0.f, 0.f, 0.f};
    if (Epi::HAS_INIT) { const typename Epi::Init i0 = E.init(cur, wr, wc, fr, fq);
#pragma unroll
      for (int a = 0; a < 2; ++a)
#pragma unroll
        for (int b = 0; b < 2; ++b)
#pragma unroll
            for (int m = 0; m < 4; ++m)
#pragma unroll
                for (int n = 0; n < 2; ++n) acc[a][b][m][n] = i0.v[b][n]; }
    unsigned sc8 = 0x7c7c7c7cu; asm volatile("" : "+v"(sc8));
    bf16x8 At[4][2], B0[2][2], B1[2][2]; v8i At8[4], B08[2], B18[2];
    unsigned roc[2] = {0u, 0u}, ron[2] = {0u, 0u};
    bool has_next = S.next(1, nxt);
    if (GATHER) { PG8_LOAD_RO(roc, cur); if (has_next) { PG8_LOAD_RO(ron, nxt); } else { ron[0] = roc[0]; ron[1] = roc[1]; } }
    const char* cA = (const char*)A + (GATHER ? (size_t)0 : (size_t)cur.pm * tstep); const char* cB = (const char*)Bt + (size_t)cur.brow * K * 2;
    const char* nA = cA;
    PG8_STAGE_B(PG8_SB(0, 0), cB); PG8_STAGE_B(PG8_SB(0, 1), cB + hstep); PG8_STAGE_A(PG8_SA(0, 0), 0, 0, false); PG8_STAGE_A(PG8_SA(0, 1), 1, 0, false);
    if (wr == 1) PG8_BAR;
    PG8_WAIT_V(2); PG8_BAR;
    PG8_STAGE_B(PG8_SB(1, 0), cB + kstep); PG8_STAGE_A(PG8_SA(1, 0), 0, kstep, false); PG8_STAGE_B(PG8_SB(1, 1), cB + hstep + kstep);
    PG8_WAIT_V(6); PG8_BAR;
    for (;;) {
        nA = (has_next && !GATHER) ? (const char*)A + (size_t)nxt.pm * tstep : cA;
        const char* nB = has_next ? (const char*)Bt + (size_t)nxt.brow * K * 2 : cB;
#pragma unroll 1
        for (int t = 0; t < nt; t += 2) {
            const bool last = (t == nt - 2);
            const size_t k1 = (size_t)(t + 1) * kstep, k2 = last ? (size_t)0 : (size_t)(t + 2) * kstep, k3 = k2 + kstep;
            const char* b2 = last ? nB : cB + (size_t)(t + 2) * kstep; const char* b3 = b2 + kstep;
            PG8_LDB(B0, 0, 0); PG8_LDB(B1, 0, 1); PG8_SCHED; PG8_LDA(At, 0, 0); PG8_STAGE_A(PG8_SA(1, 1), 1, k1, false);
            PG8_WAIT_V(8); PG8_WAIT_L(0); PG8_BAR; PG8_MMA(0, 0, At, B0); PG8_MMA(0, 1, At, B1); PG8_BAR; PG8_SCHED;
            PG8_LDA(At, 0, 1); PG8_STAGE_B(PG8_SB(0, 0), b2); PG8_STAGE_B(PG8_SB(0, 1), b2 + hstep); PG8_STAGE_A(PG8_SA(0, 0), 0, k2, last);
            PG8_WAIT_V(8); PG8_WAIT_L(0); PG8_BAR; PG8_MMA(1, 0, At, B0); PG8_MMA(1, 1, At, B1); PG8_BAR; PG8_SCHED;
            PG8_LDB(B0, 1, 0); PG8_LDB(B1, 1, 1); PG8_SCHED; PG8_LDA(At, 1, 0); PG8_STAGE_A(PG8_SA(0, 1), 1, k2, last);
            PG8_WAIT_V(8); PG8_WAIT_L(0); PG8_BAR; PG8_MMA(0, 0, At, B0); PG8_MMA(0, 1, At, B1); PG8_BAR; PG8_SCHED;
            PG8_LDA(At, 1, 1); PG8_STAGE_B(PG8_SB(1, 0), b3); PG8_STAGE_B(PG8_SB(1, 1), b3 + hstep); PG8_STAGE_A(PG8_SA(1, 0), 0, k3, last);
            PG8_WAIT_V(8); PG8_WAIT_L(0); PG8_BAR; PG8_MMA(1, 0, At, B0); PG8_MMA(1, 1, At, B1); PG8_BAR; PG8_SCHED;
        }
        const typename Epi::Pre pre = E.pre(cur, wr, wc, fr, fq);
        typename Epi::Init inx = typename Epi::Init(); if (Epi::HAS_INIT && has_next) inx = E.init(nxt, wr, wc, fr, fq);
        Unit nn; bool has_nn = false; unsigned rnn[2] = {0u, 0u};
        if (has_next) { has_nn = S.next(ui + 2, nn); if (GATHER && has_nn) { PG8_LOAD_RO(rnn, nn); } }
        if (wr == 0) PG8_BAR;
        if constexpr (F8) asm volatile("s_nop 15\n\ts_nop 15" ::: "memory");
        E(acc, cur, wr, wc, fr, fq, pre);
        if (!has_next) break;
#pragma unroll
        for (int a = 0; a < 2; ++a)
#pragma unroll
            for (int b = 0; b < 2; ++b)
#pragma unroll
                for (int m = 0; m < 4; ++m)
#pragma unroll
                    for (int n = 0; n < 2; ++n) acc[a][b][m][n] = Epi::HAS_INIT ? inx.v[b][n] : (f32x4){0.f, 0.f, 0.f, 0.f};
        cur = nxt; cA = nA; cB = nB; ++ui;
        has_next = has_nn; nxt = nn;
        if (GATHER) { roc[0] = ron[0]; roc[1] = ron[1]; if (has_next) { ron[0] = rnn[0]; ron[1] = rnn[1]; } }
        if (wr == 1) PG8_BAR;
    }
    PG8_WAIT_V(0);
    PG8_BAR;
#undef PG8_SA
#undef PG8_SB
#undef PG8_STAGE_A
#undef PG8_STAGE_B
#undef PG8_LDA
#undef PG8_LDB
#undef PG8_MMA
#undef PG8_WAIT_V
#undef PG8_WAIT_L
#undef PG8_BAR
#undef PG8_SCHED
#undef PG8_LOAD_RO
}

struct EpiPlainBf16 {
    static constexpr bool PERM = true;
    bf16_t* O; int ldc;
    static constexpr bool HAS_INIT = false; struct Init { f32x4 v[2][2]; };
    __device__ __forceinline__ Init init(const Unit&, int, int, int, int) const { return Init(); }
    struct Pre {};
    __device__ __forceinline__ Pre pre(const Unit&, int, int, int, int) const { return Pre{}; }
    __device__ __forceinline__ void operator()(const f32x4 (&acc)[2][2][4][2], const Unit& u, int wr, int wc, int fr, int fq, const Pre&) const {
        const int row0 = u.pm * BM + wr * 64 + fr, col0 = u.pn * BM + wc * 32 + 8 * fq;
#pragma unroll
        for (int ai = 0; ai < 2; ++ai)
#pragma unroll
            for (int m = 0; m < 4; ++m) { bf16_t* rowp = O + (size_t)(row0 + ai * HALF + m * 16) * ldc + col0;
#pragma unroll
                for (int bj = 0; bj < 2; ++bj) { const f32x4 v0 = acc[ai][bj][m][0], v1 = acc[ai][bj][m][1];
                    v4u w; w.x = cvt_pk_bf16(v0[0], v0[1]); w.y = cvt_pk_bf16(v0[2], v0[3]); w.z = cvt_pk_bf16(v1[0], v1[1]); w.w = cvt_pk_bf16(v1[2], v1[3]);
                    *(v4u*)(rowp + bj * HALF) = w; } }
    }
};

struct SchedInProj {
    int G, c;
    __device__ __forceinline__ bool next(int i, Unit& u) const {
        const int L = i * G + c;
        if (L < 1152) { int lt, pn; tile_order(L, 128, 9, lt, pn); u.pm = (lt >> 3) * 9 + 1 + (lt & 7); u.pn = pn; }
        else if (L < 1216) { const int q = L - 1152, ct = q >> 2, j = q & 3; u.pm = ct * 9; u.pn = (j == 3) ? 8 : 1 + j; }
        else return false;
        u.brow = u.pn * BM; u.e = 0; u.r0 = 0; u.cnt = 0; return true;
    }
    __device__ __forceinline__ unsigned arow_tok(const Unit&, int) const { return 0u; }
};
struct EpiInProj {
    static constexpr bool PERM = false;
    unsigned char* ws; const float* qng; const float* kng; const float* rope;
    static constexpr bool HAS_INIT = false; struct Init { f32x4 v[2][2]; };
    __device__ __forceinline__ Init init(const Unit&, int, int, int, int) const { return Init(); }
    struct Pre {};
    __device__ __forceinline__ Pre pre(const Unit&, int, int, int, int) const { return Pre{}; }
    __device__ __forceinline__ void operator()(const f32x4 (&acc)[2][2][4][2], const Unit& u, int wr, int wc, int fr, int fq, const Pre&) const {
        const int g = u.pn * 4 + wc, bt = u.pm / 9, pt = u.pm % 9; const bool isctx = (pt == 0);
        const int blk = fq >> 1, f1 = fq & 1, dbase = 32 * blk + 8 * f1;
        const bool do_rms = (g >= 24 && g < 34), do_rope = !isctx && (g < 8 || (g >= 24 && g < 34)), latrows = (g < 4) || (g >= 16 && g < 32);
        const float scale = (g >= 4 && g < 8) ? 0.125f : ((g >= 24 && g < 32) ? C2 : 1.0f);
        bf16_t* dst; int pitch;
        if (g < 4) { dst = (bf16_t*)(ws + WS_RQ) + g * 64; pitch = 256; }
        else if (g < 8) { dst = (bf16_t*)(ws + WS_RK) + (g - 4) * 64; pitch = 256; }
        else if (g < 16) { dst = (bf16_t*)(ws + WS_RV) + (g - 8) * 64; pitch = 512; }
        else if (g < 24) { dst = (bf16_t*)(ws + WS_RG) + (g - 16) * 64; pitch = 512; }
        else if (g < 32) { dst = (bf16_t*)(ws + WS_AQ) + (g - 24) * 64; pitch = 512; }
        else if (g < 34) { dst = (bf16_t*)(ws + WS_AK) + (g - 32) * 64; pitch = 128; }
        else { dst = (bf16_t*)(ws + WS_AV) + (g - 34) * 64; pitch = 128; }
        const int rowbase = latrows ? bt * SEQ + (pt - 1) * 256 : u.pm * 256;
        dst += dbase;
        f32x4 gv[2][2];
#pragma unroll
        for (int bj = 0; bj < 2; ++bj)
#pragma unroll
            for (int n = 0; n < 2; ++n) gv[bj][n] = do_rms ? *(const f32x4*)((g < 32 ? qng : kng) + dbase + 16 * bj + 4 * n) : (f32x4){1.f, 1.f, 1.f, 1.f};
#pragma unroll
        for (int ai = 0; ai < 2; ++ai)
#pragma unroll
            for (int m = 0; m < 4; ++m) {
                const int r = ai * HALF + wr * 64 + m * 16 + fr;
                f32x4 v[2][2];
#pragma unroll
                for (int bj = 0; bj < 2; ++bj)
#pragma unroll
                    for (int n = 0; n < 2; ++n) v[bj][n] = acc[ai][bj][m][n];
                if (do_rms) {
                    float ss = 0.f;
#pragma unroll
                    for (int bj = 0; bj < 2; ++bj)
#pragma unroll
                        for (int n = 0; n < 2; ++n) ss += (v[bj][n][0] * v[bj][n][0] + v[bj][n][1] * v[bj][n][1]) + (v[bj][n][2] * v[bj][n][2] + v[bj][n][3] * v[bj][n][3]);
                    ss += __shfl_xor(ss, 16); ss += __shfl_xor(ss, 32);
                    const float rinv = 1.0f / sqrtf(ss * (1.0f / 64.0f) + LN_EPS);
#pragma unroll
                    for (int bj = 0; bj < 2; ++bj)
#pragma unroll
                        for (int n = 0; n < 2; ++n) v[bj][n] = v[bj][n] * rinv * gv[bj][n];
                }
                if (do_rope) {
                    const int t = (pt - 1) * 256 + r, pos = blk ? (t & 63) : (t >> 6);
                    const f32x4* rp = (const f32x4*)(rope + pos * 32 + 16 * f1);
#pragma unroll
                    for (int n = 0; n < 2; ++n) { const f32x4 p0 = rp[2 * n], p1 = rp[2 * n + 1];
                        const f32x4 lo = v[0][n], hi = v[1][n];
                        const f32x4 cs = {p0[0], p0[2], p1[0], p1[2]}, sn = {p0[1], p0[3], p1[1], p1[3]};
                        v[0][n] = lo * cs - hi * sn; v[1][n] = hi * cs + lo * sn; }
                }
                bf16_t* rowp = dst + (size_t)(rowbase + r) * pitch;
#pragma unroll
                for (int bj = 0; bj < 2; ++bj) { const f32x4 v0 = v[bj][0] * scale, v1 = v[bj][1] * scale;
                    v4u w; w.x = cvt_pk_bf16(v0[0], v0[1]); w.y = cvt_pk_bf16(v0[2], v0[3]); w.z = cvt_pk_bf16(v1[0], v1[1]); w.w = cvt_pk_bf16(v1[2], v1[3]);
                    *(v4u*)(rowp + 16 * bj) = w; }
            }
    }
};

struct SchedMoE {
    int nN, NB, G, c; const LAS int* tab; const v2u* LIST;
    __device__ __forceinline__ bool next(int i, Unit& u) const {
        const int ntiles = __builtin_amdgcn_readfirstlane(tab[32]); const long L = (long)i * G + c; if (L >= (long)ntiles * nN) return false;
        tile_order((int)L, ntiles, nN, u.pm, u.pn);
        const int ln = (int)(threadIdx.x & 63u); const int tq = (ln >= 1 && ln < 32) ? tab[ln] : 0x7fffffff;
        const int e = __builtin_popcountll(__ballot(u.pm >= tq));
        u.e = e; u.r0 = (u.pm - __builtin_amdgcn_readfirstlane(tab[e])) * 256; u.cnt = __builtin_amdgcn_readfirstlane(tab[33 + e]); u.brow = e * NB + u.pn * BM; return true;
    }
    __device__ __forceinline__ unsigned arow_tok(const Unit& u, int r) const { int rr = u.r0 + r; rr = rr < u.cnt ? rr : u.cnt - 1; return LIST[(size_t)u.e * LISTCAP + rr].x >> 2; }
};
__device__ __forceinline__ void moe_build_tab(LAS int* tab, const unsigned* CNT) {
    if (threadIdx.x == 0) { int st = 0; for (int e = 0; e < 32; ++e) { const int c = (int)CNT[e]; tab[e] = st; tab[33 + e] = c; st += (c + 255) >> 8; } tab[32] = st; }
    __syncthreads();
}
struct EpiUp {
    static constexpr bool PERM = true;
    unsigned char* ACT; const float* bup;
    static constexpr bool HAS_INIT = true; struct Init { f32x4 v[2][2]; };
    __device__ __forceinline__ Init init(const Unit& u, int wr, int wc, int fr, int fq) const {
        const float* bg = bup + (size_t)u.e * 2048 + u.pn * 128 + wc * 32 + 8 * fq; Init i; i.v[0][0] = *(const f32x4*)bg; i.v[0][1] = *(const f32x4*)(bg + 4); i.v[1][0] = *(const f32x4*)(bg + 1024) + 1.0f; i.v[1][1] = *(const f32x4*)(bg + 1028) + 1.0f; return i; }
    struct Pre {};
    __device__ __forceinline__ Pre pre(const Unit&, int, int, int, int) const { return Pre{}; }
    __device__ __forceinline__ void operator()(const f32x4 (&acc)[2][2][4][2], const Unit& u, int wr, int wc, int fr, int fq, const Pre&) const {
        const int colt = u.pn * 128 + wc * 32 + 8 * fq;
#pragma unroll
        for (int ai = 0; ai < 2; ++ai)
#pragma unroll
            for (int m = 0; m < 4; ++m) {
                const int row = u.pm * BM + ai * HALF + wr * 64 + m * 16 + fr;
                f32x4 ag[2] = {acc[ai][0][m][0], acc[ai][0][m][1]}, al[2] = {acc[ai][1][m][0], acc[ai][1][m][1]};
                asm volatile("" : "+v"(ag[0]), "+v"(ag[1]), "+v"(al[0]), "+v"(al[1]));
                float o[8];
#pragma unroll
                for (int n = 0; n < 2; ++n)
#pragma unroll
                    for (int j = 0; j < 4; ++j) { const float gl = __builtin_amdgcn_fmed3f(ag[n][j], -3.0e38f, 7.0f); const float l1 = __builtin_amdgcn_fmed3f(al[n][j], -6.0f, 8.0f);
                        o[4 * n + j] = (gl * l1) * __builtin_amdgcn_rcpf(1.0f + __builtin_amdgcn_exp2f(-1.702f * 1.4426950408889634f * gl)); }
                v2u w; w.x = 0u; w.y = 0u;
                w.x = __builtin_amdgcn_cvt_pk_fp8_f32(o[0], o[1], w.x, false); w.x = __builtin_amdgcn_cvt_pk_fp8_f32(o[2], o[3], w.x, true);
                w.y = __builtin_amdgcn_cvt_pk_fp8_f32(o[4], o[5], w.y, false); w.y = __builtin_amdgcn_cvt_pk_fp8_f32(o[6], o[7], w.y, true);
                *(v2u*)(ACT + (size_t)row * 1024 + colt) = w;
            }
    }
};
struct EpiDown {
    static constexpr bool PERM = true;
    bf16_t* YE; const float* bdn; const v2u* LIST;
    static constexpr bool HAS_INIT = true; struct Init { f32x4 v[2][2]; };
    __device__ __forceinline__ Init init(const Unit& u, int wr, int wc, int fr, int fq) const {
        Init i; const float* bb = bdn + (size_t)u.e * 1024 + u.pn * BM + wc * 32 + 8 * fq;
#pragma unroll
        for (int bj = 0; bj < 2; ++bj)
#pragma unroll
            for (int n = 0; n < 2; ++n) i.v[bj][n] = *(const f32x4*)(bb + bj * HALF + 4 * n);
        return i; }
    struct Pre { v2u ent[2][4]; };
    __device__ __forceinline__ Pre pre(const Unit& u, int wr, int wc, int fr, int fq) const {
        Pre p;
#pragma unroll
        for (int ai = 0; ai < 2; ++ai)
#pragma unroll
            for (int m = 0; m < 4; ++m) { const int rr = u.r0 + ai * HALF + wr * 64 + m * 16 + fr; p.ent[ai][m] = LIST[(size_t)u.e * LISTCAP + (rr < u.cnt ? rr : u.cnt - 1)]; }
        return p;
    }
    __device__ __forceinline__ void operator()(const f32x4 (&acc)[2][2][4][2], const Unit& u, int wr, int wc, int fr, int fq, const Pre& P) const {
        const int col0 = u.pn * BM + wc * 32 + 8 * fq;
#pragma unroll
        for (int ai = 0; ai < 2; ++ai)
#pragma unroll
            for (int m = 0; m < 4; ++m) {
                const int rr = u.r0 + ai * HALF + wr * 64 + m * 16 + fr; const bool valid = rr < u.cnt;
                const v2u ent = P.ent[ai][m]; const float gate = __uint_as_float(ent.y);
                unsigned char* rowp = (unsigned char*)YE + (size_t)ent.x * 1024 + col0;
                const float g64 = gate * 64.0f;
#pragma unroll
                for (int bj = 0; bj < 2; ++bj) { f32x4 a0 = acc[ai][bj][m][0], a1 = acc[ai][bj][m][1]; asm volatile("" : "+v"(a0), "+v"(a1));
                    const f32x4 v0 = a0 * g64, v1 = a1 * g64;
                    v2u w; w.x = 0u; w.y = 0u;
                    w.x = __builtin_amdgcn_cvt_pk_fp8_f32(v0[0], v0[1], w.x, false); w.x = __builtin_amdgcn_cvt_pk_fp8_f32(v0[2], v0[3], w.x, true);
                    w.y = __builtin_amdgcn_cvt_pk_fp8_f32(v1[0], v1[1], w.y, false); w.y = __builtin_amdgcn_cvt_pk_fp8_f32(v1[2], v1[3], w.y, true);
                    if (valid) *(v2u*)(rowp + bj * HALF) = w; }
            }
    }
};
}

#include <hip/hip_bf16.h>
#include <cmath>
namespace attn_body {
using bf16=__hip_bfloat16;
using bf16x8=__attribute__((ext_vector_type(8)))short;
using s16x4=__attribute__((ext_vector_type(4)))short;
using f32x16=__attribute__((ext_vector_type(16)))float;
using u32x4=__attribute__((ext_vector_type(4)))unsigned;
constexpr int D=64,QP=512,KP=128,OP=1024,SEQQ=2048,SEQK=2304;
constexpr int NW=8,QBLK=32,QB=QBLK*NW,KVBLK=64,NQB=SEQQ/QB;
constexpr int ATTN_UNIT_ROWS=QB;
__device__ __forceinline__ int crow(int r,int hi){return (r&3)+8*(r>>2)+4*hi;}
#define SBAR() __builtin_amdgcn_sched_barrier(0)
__device__ __forceinline__ void cmask(f32x16&p0,f32x16&p1,int jb,int qrel,int hi){
  const float NEG=-INFINITY; int kb=64*jb+4*hi;
  #pragma unroll
  for(int r=0;r<16;++r){int kv=kb+(r&3)+8*(r>>2); if(kv>qrel)p0[r]=NEG; if(kv+32>qrel)p1[r]=NEG;}
}

constexpr int NSLOT=3, SLOTB=8192;
constexpr int LDS_K=0, LDS_V=NSLOT*SLOTB, LDS_WS=2*NSLOT*SLOTB, LDS_OST=LDS_WS+NW*64*4, LDS_BYTES=LDS_OST+NW*4096;
constexpr float C2=0.125f*1.4426950408889634f;
__device__ __forceinline__ void glds16(const void*gsrc,unsigned lds_dst){unsigned keep;
  asm volatile("s_mov_b32 %0, m0\n\ts_mov_b32 m0, %2\n\ts_nop 0\n\tglobal_load_lds_dwordx4 %1, off\n\ts_mov_b32 m0, %0":"=&s"(keep):"v"(gsrc),"s"(lds_dst):"memory");}
__device__ __forceinline__ float max3f(float a,float b,float c){float r;asm("v_max3_f32 %0, %1, %2, %3":"=v"(r):"v"(a),"v"(b),"v"(c));return r;}
__device__ __forceinline__ float max2f(float a,float b){float r;asm("v_max_f32_e32 %0, %1, %2":"=v"(r):"v"(a),"v"(b));return r;}
__device__ __forceinline__ float fadd_s(float a,float b){float r;asm("v_add_f32_e32 %0, %1, %2":"=v"(r):"v"(a),"v"(b));return r;}
__device__ __forceinline__ float fsub_s(float a,float b){float r;asm("v_sub_f32_e32 %0, %1, %2":"=v"(r):"v"(a),"v"(b));return r;}
typedef float f32x2_t __attribute__((ext_vector_type(2))); typedef __bf16 bf16x2_t __attribute__((ext_vector_type(2)));
__device__ __forceinline__ unsigned cvtpk_s(float lo,float hi){f32x2_t v={lo,hi};bf16x2_t b=__builtin_convertvector(v,bf16x2_t);return __builtin_bit_cast(unsigned,b);}
#define WAIT_BAR(N) asm volatile("s_waitcnt vmcnt(" #N ") lgkmcnt(0)\n\ts_barrier":::"memory")

__device__ __forceinline__ void qkt(f32x16&p0,f32x16&p1,const char*Kslot,const bf16x8*qr,const f32x16&negm,int r32,int hi){
  const char*kb=Kslot+hi*1024+r32*16;
  #pragma unroll
  for(int d0=0;d0<4;++d0){
    const bf16x8 b0=*reinterpret_cast<const bf16x8*>(kb+d0*2048);
    const bf16x8 b1=*reinterpret_cast<const bf16x8*>(kb+d0*2048+512);
    if(d0==0){p0=__builtin_amdgcn_mfma_f32_32x32x16_bf16(b0,qr[0],negm,0,0,0);p1=__builtin_amdgcn_mfma_f32_32x32x16_bf16(b1,qr[0],negm,0,0,0);}
    else{p0=__builtin_amdgcn_mfma_f32_32x32x16_bf16(b0,qr[d0],p0,0,0,0);p1=__builtin_amdgcn_mfma_f32_32x32x16_bf16(b1,qr[d0],p1,0,0,0);}}
}
typedef __attribute__((address_space(3))) const char* lds_cptr;
typedef short v4i16_t __attribute__((ext_vector_type(4)));
__device__ __forceinline__ void kload8(bf16x8*kf,lds_cptr kp){
  kf[0]=*(const __attribute__((address_space(3))) bf16x8*)(kp);      kf[1]=*(const __attribute__((address_space(3))) bf16x8*)(kp+512);
  kf[2]=*(const __attribute__((address_space(3))) bf16x8*)(kp+2048); kf[3]=*(const __attribute__((address_space(3))) bf16x8*)(kp+2560);
  kf[4]=*(const __attribute__((address_space(3))) bf16x8*)(kp+4096); kf[5]=*(const __attribute__((address_space(3))) bf16x8*)(kp+4608);
  kf[6]=*(const __attribute__((address_space(3))) bf16x8*)(kp+6144); kf[7]=*(const __attribute__((address_space(3))) bf16x8*)(kp+6656);
}
__device__ __forceinline__ void kload2(bf16x8*kf,lds_cptr kp,int j){ kf[2*j]=*(const __attribute__((address_space(3))) bf16x8*)(kp+j*2048); kf[2*j+1]=*(const __attribute__((address_space(3))) bf16x8*)(kp+j*2048+512); }
__device__ __forceinline__ s16x4 vtr(lds_cptr p){ return __builtin_bit_cast(s16x4,__builtin_amdgcn_ds_read_tr16_b64_v4i16((__attribute__((address_space(3))) v4i16_t*)p)); }
__device__ __forceinline__ float rowmax(const f32x16&p0,const f32x16&p1){
  float a=max3f(p0[0],p0[1],p1[0]),b=max3f(p0[2],p0[3],p1[1]);a=max3f(a,p1[2],p1[3]);
  #pragma unroll
  for(int r=4;r<16;r+=4){a=max3f(a,p0[r],p0[r+1]);b=max3f(b,p0[r+2],p0[r+3]);a=max3f(a,p1[r],p1[r+1]);b=max3f(b,p1[r+2],p1[r+3]);}
  const float m=max2f(a,b);
  auto rr=__builtin_amdgcn_permlane32_swap(__float_as_uint(m),__float_as_uint(m),false,false);
  return max2f(__uint_as_float(rr[0]),__uint_as_float(rr[1]));
}
__device__ __forceinline__ void pv(f32x16*o,int vb,bf16x8 pa0,bf16x8 pa1,bf16x8 pa2,bf16x8 pa3){
  #pragma unroll
  for(int d0=0;d0<2;++d0){s16x4 lo[4],hi[4];
    #pragma unroll
    for(int ks=0;ks<4;++ks){
      asm volatile("ds_read_b64_tr_b16 %0,%1 offset:%c2":"=&v"(lo[ks]):"v"(vb),"i"(d0*4096+ks*1024):"memory");
      asm volatile("ds_read_b64_tr_b16 %0,%1 offset:%c2":"=&v"(hi[ks]):"v"(vb),"i"(d0*4096+ks*1024+512):"memory");}
    asm volatile("s_waitcnt lgkmcnt(0)":::"memory");SBAR();
    #define PK(k) (bf16x8){lo[k][0],lo[k][1],lo[k][2],lo[k][3],hi[k][0],hi[k][1],hi[k][2],hi[k][3]}
    o[d0]=__builtin_amdgcn_mfma_f32_32x32x16_bf16(pa0,PK(0),o[d0],0,0,0);
    o[d0]=__builtin_amdgcn_mfma_f32_32x32x16_bf16(pa1,PK(1),o[d0],0,0,0);
    o[d0]=__builtin_amdgcn_mfma_f32_32x32x16_bf16(pa2,PK(2),o[d0],0,0,0);
    o[d0]=__builtin_amdgcn_mfma_f32_32x32x16_bf16(pa3,PK(3),o[d0],0,0,0);
    #undef PK
  }
}

#ifndef ATTN_STORE16
#define ATTN_STORE16(p,v) (*(u32x4*)(p)=(v))
#endif
template<int THRL> __device__ __forceinline__ void attn_unit(int b,int h,int qb,const bf16*Q,const bf16*__restrict__ K,const bf16*__restrict__ V,bf16*O,char*shm,float refB){
  const int tid=threadIdx.x,lane=tid&63,r32=lane&31,hi=lane>>5; const int wid=__builtin_amdgcn_readfirstlane(tid>>6);
  const long rowq=(long)b*SEQQ,rowk=(long)b*SEQK; const int q0=qb*QB;
  const bf16*Qw=Q+(rowq+q0+wid*QBLK)*QP+h*D;
  const bf16*Kh=K+rowk*KP+(h>>2)*D,*Vh=V+rowk*KP+(h>>2)*D;
  const unsigned lds0=(unsigned)(uintptr_t)shm;
  float*wsf=(float*)(shm+LDS_WS)+wid*64;
  const bf16*ksrc=Kh+(long)lane*KP+wid*8;
  const bf16*vsrc=Vh+(long)(16*(wid&3)+(lane>>2))*KP+(wid>>2)*32+(lane&3)*8;
  const unsigned kdst=lds0+LDS_K+wid*1024, vdst=lds0+LDS_V+wid*1024;
  #define DMA_K(t,slot) glds16(ksrc+(long)(t)*KVBLK*KP,(unsigned)__builtin_amdgcn_readfirstlane(kdst+(slot)))
  #define DMA_V(t,slot) glds16(vsrc+(long)(t)*KVBLK*KP,(unsigned)__builtin_amdgcn_readfirstlane(vdst+(slot)))
  const int vb0=(int)(lds0+LDS_V)+((lane>>4)&1)*32+(lane&3)*8+(4*hi+((lane&15)>>2))*64;
  const char*Kbase=shm+LDS_K; bf16x8 kf[8];
  const lds_cptr shm3=(lds_cptr)shm; const lds_cptr kp0=shm3+LDS_K+hi*1024+r32*16; const lds_cptr vp0=shm3+LDS_V+((lane>>4)&1)*32+(lane&3)*8+(4*hi+((lane&15)>>2))*64;
  const int NT=SEQK/KVBLK;
  DMA_K(0,0);DMA_V(0,0);DMA_K(1,SLOTB);
  bf16x8 qr[4];
  #pragma unroll
  for(int d0=0;d0<4;++d0)qr[d0]=*reinterpret_cast<const bf16x8*>(&Qw[(long)r32*QP+d0*16+hi*8]);
  float mhat=refB,l_reg=0.f;f32x16 o[2];o[0]=f32x16{};o[1]=f32x16{};f32x16 negm; _Pragma("unroll") for(int r=0;r<16;++r)negm[r]=-refB; asm volatile("":"+v"(negm));

  #define CMASK(P0,P1,t) do{}while(0)
  bool resc=false;
  #define START(P0,P1) do{ resc=false; \
    _Pragma("unroll") for(int r=0;r<16;++r)P0[r]=__builtin_amdgcn_exp2f(P0[r]); }while(0)
  #define RESC() do{ if(resc){ asm volatile("s_waitcnt lgkmcnt(0)":::"memory"); \
      _Pragma("unroll") for(int d_=0;d_<2;++d_) _Pragma("unroll") for(int r=0;r<16;++r)o[d_][r]*=wsf[crow(r,hi)]; } }while(0)
  f32x16 pA0,pA1,pB0,pB1;
  int sl_prev=0,sl_cur=0,sl_next=SLOTB;
  #define ROT() do{sl_prev=sl_cur;sl_cur=sl_next;sl_next=(sl_next==(NSLOT-1)*SLOTB)?0:sl_next+SLOTB;}while(0)
  DMA_K(2,2*SLOTB);
  WAIT_BAR(3);
  qkt(pA0,pA1,Kbase,qr,negm,r32,hi);asm volatile("s_nop 15\n\ts_nop 7":"+v"(pA0),"+v"(pA1));CMASK(pA0,pA1,0);
  START(pA0,pA1);
  _Pragma("unroll") for(int r=0;r<16;++r)pA1[r]=__builtin_amdgcn_exp2f(pA1[r]);
  WAIT_BAR(0);
  DMA_K(3,0);DMA_V(1,SLOTB);
  ROT();
  kload8(kf,kp0+sl_cur);
  WAIT_BAR(2);
  s16x4 vlo[8],vhi[8]; u32x4 pw0,pw1,pw2,pw3;
  #define PKW(P,B) cvtpk_s(P[B],P[B+1])
  #define PAF(k) __builtin_bit_cast(bf16x8,pw##k)
  #define VFR(i) (bf16x8){vlo[i][0],vlo[i][1],vlo[i][2],vlo[i][3],vhi[i][0],vhi[i][1],vhi[i][2],vhi[i][3]}
  #define PIN(x) asm volatile("":"+v"(x))
  #define MX3(a,b,c) __builtin_fmaxf(__builtin_fmaxf((a),(b)),(c))
  #define GAPA(MF,A0,A1,A2,A3,W0,W1,PW) do{ MF; sacc+=A0; sacc+=A1; sacc+=A2; sacc+=A3; PIN(sacc); W0; W1; PIN(PW); SBAR(); }while(0)
  #define EX(v) __builtin_amdgcn_exp2f(v)
  #define GAPB(MF,X,B) do{ MF; X[B]=EX(X[B]); X[B+1]=EX(X[B+1]); X[B+2]=EX(X[B+2]); X[B+3]=EX(X[B+3]); PIN(X); SBAR(); }while(0)
  #define VRD(i) do{ vlo[i]=vtr(vp_+(((i)>>2)*4096+((i)&3)*1024)); vhi[i]=vtr(vp_+(((i)>>2)*4096+((i)&3)*1024+512)); }while(0)
  #define KRD(G,j) do{ if(G){ kload2(kf,kp0+sl_next,j); SBAR(); } }while(0)
  #define STEP(C0,C1,P0,P1,t,GK,GV,GL) do{ SBAR(); \
    const lds_cptr vp_=vp0+sl_prev; \
    VRD(0); SBAR(); float sacc=(P0[0]+P0[1]); \
    GAPA(C0=__builtin_amdgcn_mfma_f32_32x32x16_bf16(kf[0],qr[0],negm,0,0,0), P0[2],P0[3],P0[4],P0[5],     pw0[0]=PKW(P0,0), pw0[1]=PKW(P0,2), pw0); \
    VRD(4); SBAR(); GAPA(C1=__builtin_amdgcn_mfma_f32_32x32x16_bf16(kf[1],qr[0],negm,0,0,0), P0[6],P0[7],P0[8],P0[9],     pw0[2]=PKW(P0,4), pw0[3]=PKW(P0,6), pw0); \
    VRD(1); SBAR(); GAPA(C0=__builtin_amdgcn_mfma_f32_32x32x16_bf16(kf[2],qr[1],C0,0,0,0),   P0[10],P0[11],P0[12],P0[13], pw1[0]=PKW(P0,8), pw1[1]=PKW(P0,10), pw1); \
    VRD(5); SBAR(); GAPA(C1=__builtin_amdgcn_mfma_f32_32x32x16_bf16(kf[3],qr[1],C1,0,0,0),   P0[14],P0[15],P1[0],P1[1],   pw1[2]=PKW(P0,12),pw1[3]=PKW(P0,14), pw1); \
    VRD(2); SBAR(); GAPA(C0=__builtin_amdgcn_mfma_f32_32x32x16_bf16(kf[4],qr[2],C0,0,0,0),   P1[2],P1[3],P1[4],P1[5],     pw2[0]=PKW(P1,0), pw2[1]=PKW(P1,2), pw2); \
    VRD(6); SBAR(); GAPA(C1=__builtin_amdgcn_mfma_f32_32x32x16_bf16(kf[5],qr[2],C1,0,0,0),   P1[6],P1[7],P1[8],P1[9],     pw2[2]=PKW(P1,4), pw2[3]=PKW(P1,6), pw2); \
    VRD(3); SBAR(); GAPA(C0=__builtin_amdgcn_mfma_f32_32x32x16_bf16(kf[6],qr[3],C0,0,0,0),   P1[10],P1[11],P1[12],P1[13], pw3[0]=PKW(P1,8), pw3[1]=PKW(P1,10), pw3); \
    VRD(7); SBAR(); GAPA(C1=__builtin_amdgcn_mfma_f32_32x32x16_bf16(kf[7],qr[3],C1,0,0,0),   P1[14],P1[15],0.f,0.f,       pw3[2]=PKW(P1,12),pw3[3]=PKW(P1,14), pw3); \
    l_reg+=sacc; \
    if(GK){DMA_K((t)+3,sl_cur);} if(GV){DMA_V((t)+1,sl_next);} \
    CMASK(C0,C1,t); \
    resc=false; \
    SBAR(); \
    GAPB(o[0]=__builtin_amdgcn_mfma_f32_32x32x16_bf16(PAF(0),VFR(0),o[0],0,0,0), C0,0); \
    GAPB(o[1]=__builtin_amdgcn_mfma_f32_32x32x16_bf16(PAF(0),VFR(4),o[1],0,0,0), C0,4); \
    KRD(GL,0); GAPB(o[0]=__builtin_amdgcn_mfma_f32_32x32x16_bf16(PAF(1),VFR(1),o[0],0,0,0), C0,8); \
    KRD(GL,1); GAPB(o[1]=__builtin_amdgcn_mfma_f32_32x32x16_bf16(PAF(1),VFR(5),o[1],0,0,0), C0,12); \
    KRD(GL,2); GAPB(o[0]=__builtin_amdgcn_mfma_f32_32x32x16_bf16(PAF(2),VFR(2),o[0],0,0,0), C1,0); \
    KRD(GL,3); GAPB(o[1]=__builtin_amdgcn_mfma_f32_32x32x16_bf16(PAF(2),VFR(6),o[1],0,0,0), C1,4); \
    GAPB(o[0]=__builtin_amdgcn_mfma_f32_32x32x16_bf16(PAF(3),VFR(3),o[0],0,0,0), C1,8); \
    GAPB(o[1]=__builtin_amdgcn_mfma_f32_32x32x16_bf16(PAF(3),VFR(7),o[1],0,0,0), C1,12); \
    }while(0)
  int t=1;
  #undef CMASK
  #define CMASK(P0,P1,t) do{}while(0)
  for(;t+5<NT;t+=2){
    STEP(pB0,pB1,pA0,pA1,t,true,true,true);     WAIT_BAR(2); RESC(); ROT();
    STEP(pA0,pA1,pB0,pB1,t+1,true,true,true);   WAIT_BAR(2); RESC(); ROT();
  }
  #undef CMASK
  #define CMASK(P0,P1,t) do{}while(0)
  #define ENDW(tt) do{ if((tt)+3<NT){WAIT_BAR(2);} else if((tt)+2<NT){WAIT_BAR(1);} else {WAIT_BAR(0);} }while(0)
  for(;t+1<NT;t+=2){
    STEP(pB0,pB1,pA0,pA1,t,(t+3<NT),(t+1<NT),(t+1<NT));       ENDW(t);   RESC(); ROT();
    STEP(pA0,pA1,pB0,pB1,t+1,(t+4<NT),(t+2<NT),(t+2<NT));     ENDW(t+1); RESC(); ROT();
  }
  STEP(pB0,pB1,pA0,pA1,NT-1,false,false,false); RESC();
  { float sacc=pB0[0]+pB0[1]; _Pragma("unroll") for(int r=2;r<16;++r)sacc+=pB0[r]; _Pragma("unroll") for(int r=0;r<16;++r)sacc+=pB1[r]; l_reg+=sacc;
    pw0=(u32x4){PKW(pB0,0),PKW(pB0,2),PKW(pB0,4),PKW(pB0,6)};pw1=(u32x4){PKW(pB0,8),PKW(pB0,10),PKW(pB0,12),PKW(pB0,14)};pw2=(u32x4){PKW(pB1,0),PKW(pB1,2),PKW(pB1,4),PKW(pB1,6)};pw3=(u32x4){PKW(pB1,8),PKW(pB1,10),PKW(pB1,12),PKW(pB1,14)};
    SBAR(); pv(o,vb0+sl_cur,PAF(0),PAF(1),PAF(2),PAF(3)); }
  #undef PKW
  #undef PAF
  #undef VFR
  #undef PIN
  #undef MX3
  #undef GAPA
  #undef GAPB
  #undef EX
  #undef VRD
  #undef KRD
  #undef STEP
  #undef ENDW
  {auto rr=__builtin_amdgcn_permlane32_swap(__float_as_uint(l_reg),__float_as_uint(l_reg),false,false);l_reg=__uint_as_float(rr[0])+__uint_as_float(rr[1]);}
  if(hi==0)wsf[32+r32]=l_reg;asm volatile("s_waitcnt lgkmcnt(0)":::"memory");
  float rli[16];
  #pragma unroll
  for(int r=0;r<16;++r)rli[r]=__builtin_amdgcn_rcpf(wsf[32+crow(r,hi)]);
  bf16*Ow=O+(rowq+q0+wid*QBLK)*OP+h*D;
  { bf16*stg=(bf16*)(shm+LDS_OST)+wid*2048;
    #pragma unroll
    for(int r=0;r<16;++r){const int orow=crow(r,hi);
      #pragma unroll
      for(int d0=0;d0<2;++d0)stg[orow*64+d0*32+r32]=__float2bfloat16(o[d0][r]*rli[r]);}
    asm volatile("s_waitcnt lgkmcnt(0)":::"memory");
    #pragma unroll
    for(int i=0;i<4;++i){const int row=i*8+(lane>>3),ch=lane&7; const u32x4 v=*(const u32x4*)(stg+row*64+ch*8); ATTN_STORE16(Ow+(long)row*OP+ch*8,v);} }
  asm volatile("s_waitcnt lgkmcnt(0)\n\ts_barrier":::"memory");
  #undef DMA_K
  #undef DMA_V
  #undef CMASK
  #undef START
  #undef RESC
  #undef ROT
}
constexpr int ATTN_LDS_BYTES=LDS_BYTES;
struct AttnTensors { const bf16* Q; const bf16* K; const bf16* V; bf16* O; };
struct AttnUnit { int b, h, qb; };
struct StaticOrder {
  int vcu;
  __device__ __forceinline__ explicit StaticOrder(int grid,int block):vcu((block%8)*(grid/8)+block/8){}
  __device__ __forceinline__ bool next(int i,AttnUnit&u)const{ const int p=8*i+(vcu>>5); if(p>=32)return false; const int w=vcu&31; u.b=p>>1; u.h=(p&1)*4+(w>>3); u.qb=w&7; return true; }
};
template<class Sched,int THRL=8> __device__ __forceinline__ void attn_phase(char*lds,const AttnTensors&T,const Sched&S){
  AttnUnit u;
  for(int i=0;S.next(i,u);++i){ attn_unit<THRL>(u.b,u.h,u.qb,T.Q,T.K,T.V,T.O,lds,64.0f); }
}
#undef SBAR
#undef WAIT_BAR
}

namespace ret {
typedef short bf16x8 __attribute__((ext_vector_type(8)));
typedef short s16x4 __attribute__((ext_vector_type(4)));
typedef float f32x16 __attribute__((ext_vector_type(16)));
constexpr int VP = 160, KPT = 48;
constexpr int VB = 128 * VP * 2, KB = 128 * KPT * 2, BUF = VB + KB;
__device__ __forceinline__ int crow(int r, int hi) { return (r & 3) + 8 * (r >> 2) + 4 * hi; }
__device__ __forceinline__ s16x4 trd(const LAS unsigned char* p) { return __builtin_bit_cast(s16x4, __builtin_amdgcn_ds_read_tr16_b64_v4i16((LAS s16x4*)p)); }
__device__ __forceinline__ bf16x8 cat(s16x4 a, s16x4 b) { return (bf16x8){a[0], a[1], a[2], a[3], b[0], b[1], b[2], b[3]}; }
__device__ __forceinline__ v4u scale8(v4u w, float s) {
    v4u o; o.x = pk2(bflo(w.x) * s, bfhi(w.x) * s); o.y = pk2(bflo(w.y) * s, bfhi(w.y) * s); o.z = pk2(bflo(w.z) * s, bfhi(w.z) * s); o.w = pk2(bflo(w.w) * s, bfhi(w.w) * s); return o;
}
constexpr int RAP = 96, RAB = 128 * RAP * 2, RABUF = 2 * RAB;
__device__ __forceinline__ void state_unit(int b, int h, int dir, int dvh, const bf16_t* RK, const bf16_t* RV, bf16_t* ST, float lg2, LAS unsigned char* lds) {
    const int tid = threadIdx.x, lane = tid & 63, wid = __builtin_amdgcn_readfirstlane(tid >> 6), r32 = lane & 31, hi = lane >> 5, dvt = wid & 1, dkt = (wid >> 1) & 1;
    const float g128 = exp2f(lg2 * 128.0f);
    const int prow = tid >> 3, pc8 = tid & 7;
    const float kw0 = dir ? exp2f(lg2 * (float)prow) : exp2f(lg2 * (float)(127 - prow)), kw1 = dir ? exp2f(lg2 * (float)(prow + 64)) : exp2f(lg2 * (float)(63 - prow));
    v4u vreg[2], kreg[2];
    auto chunk_of = [&](int s) { return dir ? (s == 0 ? 1 : (s == 1 ? 0 : 19 - s)) : s; };
    auto load = [&](int s) {
        const size_t urow = (size_t)b * SU + (size_t)chunk_of(s) * 128;
#pragma unroll
        for (int i = 0; i < 2; ++i) { vreg[i] = *(const v4u*)(RV + (urow + prow + 64 * i) * 512 + h * 128 + dvh * 64 + pc8 * 8); kreg[i] = *(const v4u*)(RK + (urow + prow + 64 * i) * 256 + h * 64 + pc8 * 8); }
    };
    load(0);
    f32x16 acc = {};
    const int gq = lane >> 4, colblk = gq & 1, q4 = (lane >> 2) & 3, p4 = lane & 3;
    for (int s = 0; s < 18; ++s) {
        LAS unsigned char* buf = lds + (s & 1) * RABUF;
#pragma unroll
        for (int i = 0; i < 2; ++i) { *(LAS v4u*)(buf + (prow + 64 * i) * (RAP * 2) + pc8 * 16) = vreg[i]; *(LAS v4u*)(buf + RAB + (prow + 64 * i) * (RAP * 2) + pc8 * 16) = scale8(kreg[i], i ? kw1 : kw0); }
        __syncthreads();
        if (s + 1 < 18) load(s + 1);
        if (wid < 4) {
            if (s >= 2) {
                const int n = dir ? 17 - s : s - 2;
                bf16_t* st = ST + ((((size_t)b * 4 + h) * 2 + dir) * 16 + n) * (128 * 64) + dkt * 32 + r32;
#pragma unroll
                for (int r = 0; r < 16; ++r) st[(size_t)(64 * dvh + 32 * dvt + crow(r, hi)) * 64] = (bf16_t)f2bf(acc[r]);
            }
            if (s < 17) {
#pragma unroll
                for (int r = 0; r < 16; ++r) acc[r] *= g128;
                const LAS unsigned char* va = buf + (8 * hi + q4) * (RAP * 2) + (32 * dvt + 16 * colblk + 4 * p4) * 2;
                const LAS unsigned char* ka = buf + RAB + (8 * hi + q4) * (RAP * 2) + (32 * dkt + 16 * colblk + 4 * p4) * 2;
#pragma unroll
                for (int ks = 0; ks < 8; ++ks) {
                    const bf16x8 af = cat(trd(va + ks * 16 * RAP * 2), trd(va + (ks * 16 + 4) * RAP * 2));
                    const bf16x8 bfm = cat(trd(ka + ks * 16 * RAP * 2), trd(ka + (ks * 16 + 4) * RAP * 2));
                    acc = __builtin_amdgcn_mfma_f32_32x32x16_bf16(af, bfm, acc, 0, 0, 0);
                }
            }
        }
    }
    __syncthreads();
}
constexpr int QP2 = 72, GP2 = 136;
constexpr int OFF_Q = VB, OFF_K = OFF_Q + 128 * QP2 * 2, OFF_G = OFF_K + 128 * QP2 * 2, OFF_RED = OFF_G + 128 * GP2 * 2;
struct OutRegs { v4u vv[4], qq[2], kk[2]; };
__device__ __forceinline__ void out_load(OutRegs& R, int u, const bf16_t* RQ, const bf16_t* RK, const bf16_t* RV, const bf16_t* RG) {
    const int tid = threadIdx.x, n = u & 15, h = (u >> 4) & 3, b = u >> 6;
    const size_t m0 = (size_t)b * SEQ + 128 * n, u0 = (size_t)b * SU + CTX + 128 * n;
#pragma unroll
    for (int i = 0; i < 4; ++i) { const int pc = tid + 512 * i; R.vv[i] = *(const v4u*)(RV + (u0 + (pc >> 4)) * 512 + h * 128 + (pc & 15) * 8); }
#pragma unroll
    for (int i = 0; i < 2; ++i) { const int pc = tid + 512 * i; R.qq[i] = *(const v4u*)(RQ + (m0 + (pc >> 3)) * 256 + h * 64 + (pc & 7) * 8); R.kk[i] = *(const v4u*)(RK + (u0 + (pc >> 3)) * 256 + h * 64 + (pc & 7) * 8); }
}
__device__ __forceinline__ void out_unit(OutRegs& R, int u, int unext, const bf16_t* RQ, const bf16_t* RK, const bf16_t* RV, const bf16_t* RG, const bf16_t* ST, const float* gng, const float* gnb, const float* ldf, const float* ldb, bf16_t* MIX, LAS unsigned char* lds) {
    const int n = u & 15, h = (u >> 4) & 3, b = u >> 6; const float lgf = ldf[h] * 1.4426950408889634f, lgb = ldb[h] * 1.4426950408889634f;
    const int tid = threadIdx.x, lane = tid & 63, wid = __builtin_amdgcn_readfirstlane(tid >> 6), r32 = lane & 31, hi = lane >> 5, rg = wid & 3, dvh = wid >> 2;
    const size_t m0 = (size_t)b * SEQ + 128 * n, u0 = (size_t)b * SU + CTX + 128 * n;
    LAS float* red = (LAS float*)(lds + OFF_RED);
    {
        __syncthreads();
#pragma unroll
        for (int i = 0; i < 4; ++i) { const int pc = tid + 512 * i; *(LAS v4u*)(lds + (pc >> 4) * (VP * 2) + (pc & 15) * 16) = R.vv[i]; }
#pragma unroll
        for (int i = 0; i < 2; ++i) { const int pc = tid + 512 * i; *(LAS v4u*)(lds + OFF_Q + (pc >> 3) * (QP2 * 2) + (pc & 7) * 16) = R.qq[i]; *(LAS v4u*)(lds + OFF_K + (pc >> 3) * (QP2 * 2) + (pc & 7) * 16) = R.kk[i]; }
    }
    __syncthreads();
    out_load(R, unext >= 0 ? unext : u, RQ, RK, RV, RG);
    bf16x8 qf[4];
#pragma unroll
    for (int ks = 0; ks < 4; ++ks) qf[ks] = *(const LAS bf16x8*)(lds + OFF_Q + (32 * rg + r32) * (QP2 * 2) + (16 * ks + 8 * hi) * 2);
    f32x16 st[4];
#pragma unroll
    for (int kt = 0; kt < 4; ++kt) { st[kt] = (f32x16){};
#pragma unroll
        for (int ks = 0; ks < 4; ++ks) { const bf16x8 kf = *(const LAS bf16x8*)(lds + OFF_K + (32 * kt + r32) * (QP2 * 2) + (16 * ks + 8 * hi) * 2); st[kt] = __builtin_amdgcn_mfma_f32_32x32x16_bf16(kf, qf[ks], st[kt], 0, 0, 0); } }
    const int c = 32 * rg + r32;
    bf16x8 pa[4][2];
#pragma unroll
    for (int kt = 0; kt < 4; ++kt) {
#pragma unroll
        for (int r = 0; r < 16; ++r) { const int d = c - (32 * kt + crow(r, hi)); const float w = d > 0 ? __builtin_amdgcn_exp2f(lgf * (float)d) : (d < 0 ? __builtin_amdgcn_exp2f(lgb * (float)(-d)) : 2.0f); st[kt][r] *= w; }
#pragma unroll
        for (int s2 = 0; s2 < 2; ++s2) { v4u w; w.x = pk2(st[kt][8 * s2], st[kt][8 * s2 + 1]); w.y = pk2(st[kt][8 * s2 + 2], st[kt][8 * s2 + 3]); w.z = pk2(st[kt][8 * s2 + 4], st[kt][8 * s2 + 5]); w.w = pk2(st[kt][8 * s2 + 6], st[kt][8 * s2 + 7]); pa[kt][s2] = __builtin_bit_cast(bf16x8, w); }
    }
    asm volatile("" ::: "memory");
    v4u gg[4];
#pragma unroll
    for (int i = 0; i < 4; ++i) { const int pc = tid + 512 * i; gg[i] = *(const v4u*)(RG + (m0 + (pc >> 4)) * 512 + h * 128 + (pc & 15) * 8); }
    f32x16 ot[2] = {(f32x16){}, (f32x16){}};
    const int gq = lane >> 4, colblk = gq & 1, q4 = (lane >> 2) & 3, p4 = lane & 3;
#pragma unroll
    for (int dt = 0; dt < 2; ++dt) {
        const LAS unsigned char* va = lds + (4 * hi + q4) * (VP * 2) + (64 * dvh + 32 * dt + 16 * colblk + 4 * p4) * 2;
#pragma unroll
        for (int kt = 0; kt < 4; ++kt)
#pragma unroll
            for (int s2 = 0; s2 < 2; ++s2) { const int kb = 32 * kt + 16 * s2; const bf16x8 vf = cat(trd(va + kb * VP * 2), trd(va + (kb + 8) * VP * 2)); ot[dt] = __builtin_amdgcn_mfma_f32_32x32x16_bf16(vf, pa[kt][s2], ot[dt], 0, 0, 0); }
    }
    {
        const float decf = __builtin_amdgcn_exp2f(lgf * (float)(c + 1)), decb = __builtin_amdgcn_exp2f(lgb * (float)(128 - c));
        const bf16_t* sf = ST + ((((size_t)b * 4 + h) * 2 + 0) * 16 + n) * (128 * 64); const bf16_t* sb = sf + (size_t)16 * 128 * 64;
#pragma unroll
        for (int ks = 0; ks < 4; ++ks) {
            const v4u qw = __builtin_bit_cast(v4u, qf[ks]); const bf16x8 qdf = __builtin_bit_cast(bf16x8, scale8(qw, decf)), qdb = __builtin_bit_cast(bf16x8, scale8(qw, decb));
#pragma unroll
            for (int dt = 0; dt < 2; ++dt) { const size_t so = (size_t)(64 * dvh + 32 * dt + r32) * 64 + 16 * ks + 8 * hi;
                ot[dt] = __builtin_amdgcn_mfma_f32_32x32x16_bf16(*(const bf16x8*)(sf + so), qdf, ot[dt], 0, 0, 0);
                ot[dt] = __builtin_amdgcn_mfma_f32_32x32x16_bf16(*(const bf16x8*)(sb + so), qdb, ot[dt], 0, 0, 0); }
        }
    }
#pragma unroll
    for (int i = 0; i < 4; ++i) { const int pc = tid + 512 * i; *(LAS v4u*)(lds + OFF_G + (pc >> 4) * (GP2 * 2) + (pc & 15) * 16) = gg[i]; }
    float s1 = 0.f;
#pragma unroll
    for (int dt = 0; dt < 2; ++dt)
#pragma unroll
        for (int r = 0; r < 16; ++r) s1 += ot[dt][r];
    s1 += __shfl_xor(s1, 32);
    if (hi == 0) red[wid * 32 + r32] = s1;
    __syncthreads();
    const float mu = (red[wid * 32 + r32] + red[(wid ^ 4) * 32 + r32]) * (1.0f / 128.0f);
    float s2 = 0.f;
#pragma unroll
    for (int dt = 0; dt < 2; ++dt)
#pragma unroll
        for (int r = 0; r < 16; ++r) { const float d = ot[dt][r] - mu; s2 = fmaf(d, d, s2); }
    s2 += __shfl_xor(s2, 32);
    __syncthreads();
    if (hi == 0) red[wid * 32 + r32] = s2;
    __syncthreads();
    const float rs = 1.0f / sqrtf((red[wid * 32 + r32] + red[(wid ^ 4) * 32 + r32]) * (1.0f / 128.0f) + LN_EPS);
    LAS unsigned char* grow = lds + OFF_G + (32 * rg + r32) * (GP2 * 2);
#pragma unroll
    for (int dt = 0; dt < 2; ++dt)
#pragma unroll
        for (int rq = 0; rq < 4; ++rq) {
            const int dv = 64 * dvh + 32 * dt + 8 * rq + 4 * hi;
            const f32x4 gg = *(const f32x4*)(gng + h * 128 + dv), gb = *(const f32x4*)(gnb + h * 128 + dv);
            const v2u gw = *(const LAS v2u*)(grow + dv * 2);
            const float g0 = bflo(gw.x), g1 = bfhi(gw.x), g2 = bflo(gw.y), g3 = bfhi(gw.y);
            const float y0 = ((ot[dt][4 * rq] - mu) * rs * gg[0] + gb[0]) * (g0 * __builtin_amdgcn_rcpf(1.0f + __builtin_amdgcn_exp2f(-1.4426950408889634f * g0)));
            const float y1 = ((ot[dt][4 * rq + 1] - mu) * rs * gg[1] + gb[1]) * (g1 * __builtin_amdgcn_rcpf(1.0f + __builtin_amdgcn_exp2f(-1.4426950408889634f * g1)));
            const float y2 = ((ot[dt][4 * rq + 2] - mu) * rs * gg[2] + gb[2]) * (g2 * __builtin_amdgcn_rcpf(1.0f + __builtin_amdgcn_exp2f(-1.4426950408889634f * g2)));
            const float y3 = ((ot[dt][4 * rq + 3] - mu) * rs * gg[3] + gb[3]) * (g3 * __builtin_amdgcn_rcpf(1.0f + __builtin_amdgcn_exp2f(-1.4426950408889634f * g3)));
            v2u w; w.x = pk2(y0, y1); w.y = pk2(y2, y3);
            *(LAS v2u*)(grow + dv * 2) = w;
        }
    __syncthreads();
#pragma unroll
    for (int i = 0; i < 4; ++i) { const int pc = tid + 512 * i; *(v4u*)(MIX + (m0 + (pc >> 4)) * DM + h * 128 + (pc & 15) * 8) = *(const LAS v4u*)(lds + OFF_G + (pc >> 4) * (GP2 * 2) + (pc & 15) * 16); }
}
}

struct Args {
    const float* in[26]; float* out; unsigned char* ws; int ph_lo, ph_hi, li, pad;
};
enum { I_X = 0, I_C, I_CTX, I_CCTX, I_LNING, I_LNINB, I_WADA, I_BADA, I_WIN, I_LDF, I_LDB, I_GNG, I_GNB, I_QNG, I_KNG, I_WO, I_LN1G, I_LN1B, I_RW, I_RB, I_WUP, I_BUP, I_WDN, I_BDN, I_LN2G, I_LN2B };

struct Frame {
    LAS unsigned char* lds;
    unsigned* ctl;
    int tid, lane, wave, G, gtid, nthreads, gw, ngw;
};

constexpr int LDS_BYTES = 147456, MISC_OFF = 147456 - 1024;

__device__ __forceinline__ int phys_in(int lc) { const int pn = lc >> 8, wc = (lc >> 6) & 3, d = lc & 63; const int blk = d >> 5, bj = (d >> 4) & 1, f1 = (d >> 3) & 1, n = (d >> 2) & 1, j = d & 3;
    return pn * 256 + 128 * bj + 32 * wc + 16 * n + 4 * (2 * blk + f1) + j; }
__device__ __forceinline__ int phys_up(int c) { return 256 * ((c & 1023) >> 7) + 128 * (c >> 10) + (c & 127); }

__device__ __forceinline__ void transpose_load(f32x4 (&v)[16], const float* W, int K, int N, int item, int lane) {
    const int nkb = K / 64, kb = item % nkb, nb = item / nkb, k0 = 64 * kb, n0 = 64 * nb;
    const float* src = W + (size_t)(k0 + (lane >> 4)) * N + n0 + (lane & 15) * 4;
#pragma unroll
    for (int i = 0; i < 16; ++i) v[i] = __builtin_nontemporal_load((const f32x4*)(src + (size_t)(4 * i) * N));
}
__device__ __forceinline__ void transpose_write(const f32x4 (&v)[16], LAS float* scr, int lane) {
#pragma unroll
    for (int i = 0; i < 16; ++i) { LAS float* d = scr + (4 * i + (lane >> 4)) * 65 + (lane & 15) * 4; d[0] = v[i][0]; d[1] = v[i][1]; d[2] = v[i][2]; d[3] = v[i][3]; }
    asm volatile("s_waitcnt lgkmcnt(0)" ::: "memory");
}
template <int MAP, bool F8> __device__ __forceinline__ void transpose_out(int K, void* WT, LAS float* scr, int item, int lane) {
    const int nkb = K / 64, kb = item % nkb, nb = item / nkb, k0 = 64 * kb, n0 = 64 * nb;
    const int c = lane & 7;
#pragma unroll
    for (int j = 0; j < 8; ++j) { const int n = (lane >> 3) + 8 * j; const LAS float* s = scr + (8 * c) * 65 + n;
        const int ln = n0 + n; const int pr = MAP == 1 ? phys_in(ln) : (MAP == 2 ? phys_up(ln) : ln);
        if constexpr (F8) { v2u q; q.x = 0u; q.y = 0u;
            q.x = __builtin_amdgcn_cvt_pk_fp8_f32(64.f * s[0 * 65], 64.f * s[1 * 65], q.x, false); q.x = __builtin_amdgcn_cvt_pk_fp8_f32(64.f * s[2 * 65], 64.f * s[3 * 65], q.x, true);
            q.y = __builtin_amdgcn_cvt_pk_fp8_f32(64.f * s[4 * 65], 64.f * s[5 * 65], q.y, false); q.y = __builtin_amdgcn_cvt_pk_fp8_f32(64.f * s[6 * 65], 64.f * s[7 * 65], q.y, true);
            *(v2u*)((unsigned char*)WT + (size_t)pr * K + k0 + 8 * c) = q; }
        else { v4u o; o.x = pk2(s[0 * 65], s[1 * 65]); o.y = pk2(s[2 * 65], s[3 * 65]); o.z = pk2(s[4 * 65], s[5 * 65]); o.w = pk2(s[6 * 65], s[7 * 65]);
            *(v4u*)((bf16_t*)WT + (size_t)pr * K + k0 + 8 * c) = o; } }
    asm volatile("s_waitcnt lgkmcnt(0)" ::: "memory");
}
__device__ __forceinline__ void transpose8_write(const f32x4 (&v)[16], LAS unsigned* T, int lane) {
#pragma unroll
    for (int i = 0; i < 16; ++i) { unsigned w = 0u; w = __builtin_amdgcn_cvt_pk_fp8_f32(64.f * v[i][0], 64.f * v[i][1], w, false); w = __builtin_amdgcn_cvt_pk_fp8_f32(64.f * v[i][2], 64.f * v[i][3], w, true);
        T[(4 * i + (lane >> 4)) * 17 + (lane & 15)] = w; }
    asm volatile("s_waitcnt lgkmcnt(0)" ::: "memory");
}
template <int MAP> __device__ __forceinline__ void transpose8_out(int K, unsigned char* WT, const LAS unsigned* T, int item, int lane) {
    const int nkb = K / 64, kb = item % nkb, nb = item / nkb, k0 = 64 * kb, n0 = 64 * nb;
    const int c = lane & 7, ng2 = lane >> 3;
#pragma unroll
    for (int j = 0; j < 2; ++j) { const int ng = ng2 + 8 * j; unsigned d[8];
#pragma unroll
        for (int i = 0; i < 8; ++i) d[i] = T[(8 * c + i) * 17 + ng];
        unsigned r[2][4];
#pragma unroll
        for (int h = 0; h < 2; ++h) { const unsigned d0 = d[4 * h], d1 = d[4 * h + 1], d2 = d[4 * h + 2], d3 = d[4 * h + 3];
            const unsigned t0 = __builtin_amdgcn_perm(d1, d0, 0x05010400u), t1 = __builtin_amdgcn_perm(d1, d0, 0x07030602u), t2 = __builtin_amdgcn_perm(d3, d2, 0x05010400u), t3 = __builtin_amdgcn_perm(d3, d2, 0x07030602u);
            r[h][0] = __builtin_amdgcn_perm(t2, t0, 0x05040100u); r[h][1] = __builtin_amdgcn_perm(t2, t0, 0x07060302u); r[h][2] = __builtin_amdgcn_perm(t3, t1, 0x05040100u); r[h][3] = __builtin_amdgcn_perm(t3, t1, 0x07060302u); }
#pragma unroll
        for (int q = 0; q < 4; ++q) { const int ln = n0 + 4 * ng + q; const int pr = MAP == 2 ? phys_up(ln) : ln; v2u o; o.x = r[0][q]; o.y = r[1][q];
            *(v2u*)(WT + (size_t)pr * K + k0 + 8 * c) = o; } }
    asm volatile("s_waitcnt lgkmcnt(0)" ::: "memory");
}
template <int MAP, bool F8> __device__ __forceinline__ void transpose_item(const float* W, int K, int N, void* WT, LAS float* scr, int item, int lane) {
    f32x4 v[16]; transpose_load(v, W, K, N, item, lane); transpose_write(v, scr, lane); transpose_out<MAP, F8>(K, WT, scr, item, lane);
}

__device__ __forceinline__ void p0_prologue(const Args& a, Frame& F) {
    unsigned char* ws = a.ws;
    float* ADA = (float*)(ws + WS_ADA); float* ROPE = (float*)(ws + WS_ROPE);
    for (int idx = F.gtid; idx < 64 * 16; idx += F.nthreads) {
        const int pos = idx >> 4, i = idx & 15;
        const float inv = exp2f(-(float)i * (13.287712379549449f / 16.0f));
        const float ang = (float)pos * inv;
        ROPE[idx * 2] = cosf(ang); ROPE[idx * 2 + 1] = sinf(ang);
    }
    { bf16_t* RWT = (bf16_t*)(ws + WS_RWT);
      for (int idx = F.gtid; idx < 32 * 1024; idx += F.nthreads) { const int e = idx >> 10, k = idx & 1023; const float w = a.in[I_RW][k * 32 + e]; const unsigned hi = f2bf(w); RWT[idx] = (bf16_t)hi; RWT[32768 + idx] = (bf16_t)f2bf(w - bf2f(hi)); } }
    for (int tile = blockIdx.x; tile < 192; tile += F.G) {
        LAS float* SL = (LAS float*)F.lds;
        LAS float* PT = (LAS float*)(F.lds + 17 * 4096);
        for (int i = F.tid; i < 17 * 1024; i += NTHR) { const int r = i >> 10, k = i & 1023; const float s = r < 16 ? a.in[I_C][r * 1024 + k] : a.in[I_CCTX][k]; SL[i] = s / (1.0f + __expf(-s)); }
        __syncthreads();
        const int col = F.lane & 31, kh = F.lane >> 5; const float* w = a.in[I_WADA] + tile * 32 + col; const int k0 = F.wave * 128 + 64 * kh;
        float acc[17];
#pragma unroll
        for (int r = 0; r < 17; ++r) acc[r] = 0.f;
#pragma unroll 1
        for (int kb = 0; kb < 64; kb += 32) {
            float wv[32];
#pragma unroll
            for (int q = 0; q < 32; ++q) wv[q] = __builtin_nontemporal_load(w + (size_t)(k0 + kb + q) * 6144);
#pragma unroll
            for (int k4 = 0; k4 < 32; k4 += 4)
#pragma unroll
                for (int r = 0; r < 17; ++r) { const f32x4 s4 = *(const LAS f32x4*)(SL + r * 1024 + k0 + kb + k4); acc[r] = fmaf(s4[0], wv[k4], acc[r]); acc[r] = fmaf(s4[1], wv[k4 + 1], acc[r]); acc[r] = fmaf(s4[2], wv[k4 + 2], acc[r]); acc[r] = fmaf(s4[3], wv[k4 + 3], acc[r]); }
        }
#pragma unroll
        for (int r = 0; r < 17; ++r) { acc[r] += __shfl_xor(acc[r], 32); if (kh == 0) PT[(F.wave * 17 + r) * 32 + col] = acc[r]; }
        __syncthreads();
        for (int i = F.tid; i < 17 * 32; i += NTHR) { const int r = i >> 5, c = i & 31; float s = a.in[I_BADA][tile * 32 + c];
#pragma unroll
            for (int wv = 0; wv < 8; ++wv) s += PT[(wv * 17 + r) * 32 + c];
            ADA[r * 6144 + tile * 32 + c] = s; }
        __syncthreads();
    }
    LAS float* scr = (LAS float*)(F.lds + F.wave * 16640);
    constexpr int I_IN = 16 * (NIN / 64), I_O = 16 * 16;
    for (int it = F.gw; it < I_IN + I_O; it += F.ngw) {
        if (it < I_IN) transpose_item<1, false>(a.in[I_WIN], 1024, NIN, ws + WS_WIN, scr, it, F.lane);
        else transpose_item<0, false>(a.in[I_WO], 1024, 1024, ws + WS_WO, scr, it - I_IN, F.lane);
    }
}
__device__ __forceinline__ void moe_weights_convert(const Args& a, Frame& F, int first, int last, int wi, int nw) {
    unsigned char* ws = a.ws;
    LAS float* scr = (LAS float*)(F.lds + F.wave * 16640);
    constexpr int I_UP = 16 * 32, I_DN = 16 * 16, NIT = NEXP * (I_UP + I_DN);
#define MW_LD(it_) do { const int _it = (it_); if (_it < NEXP * I_UP) { const int e = _it / I_UP; transpose_load(v, a.in[I_WUP] + (size_t)e * 1024 * 2048, 1024, 2048, _it % I_UP, F.lane); } \
        else { const int r = _it - NEXP * I_UP, e = r / I_DN; transpose_load(v, a.in[I_WDN] + (size_t)e * 1024 * 1024, 1024, 1024, r % I_DN, F.lane); } } while (0)
    { int _l = F.lane; asm volatile("" : "+v"(_l)); F.lane = _l; }
    f32x4 v[16];
    MW_LD(first + wi < last ? first + wi : last - 1);
    for (int it = first + wi; it < last; it += nw) {
        transpose8_write(v, (LAS unsigned*)scr, F.lane);
        MW_LD(it + nw < last ? it + nw : last - 1);
        if (it < NEXP * I_UP) { const int e = it / I_UP; transpose8_out<2>(1024, ws + WS_WUP + (size_t)e * 2048 * 1024, (const LAS unsigned*)scr, it % I_UP, F.lane); }
        else { const int r = it - NEXP * I_UP, e = r / I_DN; transpose8_out<0>(1024, ws + WS_WDN + (size_t)e * 1024 * 1024, (const LAS unsigned*)scr, r % I_DN, F.lane); }
    }
#undef MW_LD
}

__device__ __forceinline__ void p1_ln_mod(const Args& a, Frame& F) {
    unsigned char* ws = a.ws;
    const float* ADA = (const float*)(ws + WS_ADA); float* STATS = (float*)(ws + WS_STATS); bf16_t* H = (bf16_t*)(ws + WS_H);
    const f32x4* g4 = (const f32x4*)a.in[I_LNING] + F.lane; const f32x4* b4 = (const f32x4*)a.in[I_LNINB] + F.lane;
    auto rowsrc = [&](int u) { const int b = u / SU, p = u % SU; return (const f32x4*)(p < CTX ? a.in[I_CTX] + ((size_t)b * CTX + p) * DM : a.in[I_X] + ((size_t)b * SEQ + (p - CTX)) * DM) + F.lane; };
    f32x4 vn[4];
    if (F.gw < NROW) { const f32x4* xr = rowsrc(F.gw);
#pragma unroll
        for (int j = 0; j < 4; ++j) vn[j] = __builtin_nontemporal_load(xr + 64 * j); }
    for (int u = F.gw; u < NROW; u += F.ngw) {
        const int b = u / SU, p = u % SU;
        f32x4 v[4]; float s = 0.f;
#pragma unroll
        for (int j = 0; j < 4; ++j) v[j] = vn[j];
        { const int un = (u + F.ngw < NROW) ? u + F.ngw : u; const f32x4* xr = rowsrc(un);
#pragma unroll
            for (int j = 0; j < 4; ++j) vn[j] = __builtin_nontemporal_load(xr + 64 * j); }
#pragma unroll
        for (int j = 0; j < 4; ++j) s += (v[j].x + v[j].y) + (v[j].z + v[j].w);
        const float mean = wave_sum(s) * (1.f / DM); float s2 = 0.f;
#pragma unroll
        for (int j = 0; j < 4; ++j) { v[j] = v[j] - mean; s2 += (v[j].x * v[j].x + v[j].y * v[j].y) + (v[j].z * v[j].z + v[j].w * v[j].w); }
        const float rstd = 1.f / sqrtf(wave_sum(s2) * (1.f / DM) + LN_EPS);
        const float* ad = ADA + (p < CTX ? 16 : b) * 6144;
        const f32x4* sh4 = (const f32x4*)ad + F.lane; const f32x4* sc4 = (const f32x4*)(ad + 1024) + F.lane;
        v2u* o8 = (v2u*)(H + (size_t)u * DM) + F.lane;
#pragma unroll
        for (int j = 0; j < 4; ++j) {
            const f32x4 g = g4[64 * j], bb = b4[64 * j], sh = sh4[64 * j], sc = sc4[64 * j];
            const f32x4 xl = v[j] * rstd * g + bb; const f32x4 h = xl * (sc + 1.0f) + sh;
            v2u w; w.x = pk2(h.x, h.y); w.y = pk2(h.z, h.w); o8[64 * j] = w;
        }
        if (p >= CTX && F.lane == 0) { const int m = b * SEQ + (p - CTX); STATS[2 * m] = mean; STATS[2 * m + 1] = rstd; }
    }
}

__device__ __forceinline__ void store64(bf16_t* dst, const float (&v)[64]) {
#pragma unroll
    for (int q = 0; q < 8; ++q) { v4u w; w.x = pk2(v[8 * q], v[8 * q + 1]); w.y = pk2(v[8 * q + 2], v[8 * q + 3]); w.z = pk2(v[8 * q + 4], v[8 * q + 5]); w.w = pk2(v[8 * q + 6], v[8 * q + 7]); *(v4u*)(dst + 8 * q) = w; }
}
__device__ __forceinline__ void rope64(float (&v)[64], const float* ROPE, int t) {
    const float* rr = ROPE + (t >> 6) * 32; const float* rc = ROPE + (t & 63) * 32;
#pragma unroll
    for (int i = 0; i < 16; ++i) {
        const float cr = rr[2 * i], sr = rr[2 * i + 1], cc = rc[2 * i], sc = rc[2 * i + 1];
        const float x1 = v[i], x2 = v[16 + i], x3 = v[32 + i], x4 = v[48 + i];
        v[i] = x1 * cr - x2 * sr; v[16 + i] = x2 * cr + x1 * sr; v[32 + i] = x3 * cc - x4 * sc; v[48 + i] = x4 * cc + x3 * sc;
    }
}
__device__ __forceinline__ void rms64(float (&v)[64], const float* g) {
    float ss = 0.f;
#pragma unroll
    for (int d = 0; d < 64; ++d) ss = fmaf(v[d], v[d], ss);
    const float r = 1.0f / sqrtf(ss * (1.0f / 64.0f) + LN_EPS);
#pragma unroll
    for (int d = 0; d < 64; ++d) v[d] = v[d] * r * g[d];
}
__device__ __forceinline__ void p3_attn_scalar(const Args& a, Frame& F) {
    unsigned char* ws = a.ws;
    const bf16_t* AQ = (const bf16_t*)(ws + WS_AQ); const bf16_t* AK = (const bf16_t*)(ws + WS_AK); const bf16_t* AV = (const bf16_t*)(ws + WS_AV); bf16_t* MIX = (bf16_t*)(ws + WS_MIX);
    for (int it = F.gtid; it < BATCH * 8 * SEQ; it += F.nthreads) {
        const int t = it % SEQ, h = (it / SEQ) % 8, b = it / (SEQ * 8); const int m = b * SEQ + t, hk = h >> 2;
        v4u q[8];
#pragma unroll
        for (int i = 0; i < 8; ++i) q[i] = *(const v4u*)(AQ + (size_t)m * 512 + h * 64 + 8 * i);
        float o[64];
#pragma unroll
        for (int d = 0; d < 64; ++d) o[d] = 0.f;
        float mr = -1e30f, l = 0.f;
        const bf16_t* kb = AK + (size_t)b * SU * 128 + hk * 64; const bf16_t* vb = AV + (size_t)b * SU * 128 + hk * 64;
        for (int j = 0; j < SU; ++j) {
            float s = 0.f;
#pragma unroll
            for (int i = 0; i < 8; ++i) s = dot8(q[i], *(const v4u*)(kb + (size_t)j * 128 + 8 * i), s);
            const float mn = fmaxf(mr, s), corr = exp2f(mr - mn), pe = exp2f(s - mn);
            l = l * corr + pe; mr = mn;
#pragma unroll
            for (int i = 0; i < 8; ++i) { const v4u vv = *(const v4u*)(vb + (size_t)j * 128 + 8 * i);
                o[8 * i + 0] = fmaf(pe, bflo(vv.x), o[8 * i + 0] * corr); o[8 * i + 1] = fmaf(pe, bfhi(vv.x), o[8 * i + 1] * corr);
                o[8 * i + 2] = fmaf(pe, bflo(vv.y), o[8 * i + 2] * corr); o[8 * i + 3] = fmaf(pe, bfhi(vv.y), o[8 * i + 3] * corr);
                o[8 * i + 4] = fmaf(pe, bflo(vv.z), o[8 * i + 4] * corr); o[8 * i + 5] = fmaf(pe, bfhi(vv.z), o[8 * i + 5] * corr);
                o[8 * i + 6] = fmaf(pe, bflo(vv.w), o[8 * i + 6] * corr); o[8 * i + 7] = fmaf(pe, bfhi(vv.w), o[8 * i + 7] * corr); }
        }
        const float rl = 1.0f / l;
#pragma unroll
        for (int d = 0; d < 64; ++d) o[d] *= rl;
        store64(MIX + (size_t)m * DM + 512 + h * 64, o);
    }
}
__device__ __forceinline__ void p3_ret_scalar(const Args& a, Frame& F) {
    unsigned char* ws = a.ws;
    const bf16_t* RQ = (const bf16_t*)(ws + WS_RQ); const bf16_t* RK = (const bf16_t*)(ws + WS_RK); const bf16_t* RV = (const bf16_t*)(ws + WS_RV); const bf16_t* RG = (const bf16_t*)(ws + WS_RG);
    bf16_t* MIX = (bf16_t*)(ws + WS_MIX); float* YRET = (float*)(ws + WS_YRET);
    for (int it = F.gtid; it < BATCH * 4 * SEQ; it += F.nthreads) {
        const int t = it % SEQ, h = (it / SEQ) % 4, b = it / (SEQ * 4); const int m = b * SEQ + t;
        const float lgf = a.in[I_LDF][h] * 1.4426950408889634f, lgb = a.in[I_LDB][h] * 1.4426950408889634f;
        v4u q[8];
#pragma unroll
        for (int i = 0; i < 8; ++i) q[i] = *(const v4u*)(RQ + (size_t)m * 256 + h * 64 + 8 * i);
        const bf16_t* kb = RK + (size_t)b * SU * 256 + h * 64; const bf16_t* vb = RV + (size_t)b * SU * 512 + h * 128;
        float* yr = YRET + ((size_t)m * 4 + h) * 128;
        for (int dq = 0; dq < 4; ++dq) {
            float acc[32];
#pragma unroll
            for (int e = 0; e < 32; ++e) acc[e] = 0.f;
            for (int j = 0; j < SU; ++j) {
                float s = 0.f;
#pragma unroll
                for (int i = 0; i < 8; ++i) s = dot8(q[i], *(const v4u*)(kb + (size_t)j * 256 + 8 * i), s);
                float w;
                if (j < CTX) w = exp2f(lgf * (float)(t + CTX - j)) + exp2f(lgb * (float)(SEQ - t + j));
                else { const int tj = j - CTX; w = tj < t ? exp2f(lgf * (float)(t - tj)) : (tj > t ? exp2f(lgb * (float)(tj - t)) : 2.0f); }
                s *= w;
#pragma unroll
                for (int i = 0; i < 4; ++i) { const v4u vv = *(const v4u*)(vb + (size_t)j * 512 + dq * 32 + 8 * i);
                    acc[8 * i + 0] = fmaf(s, bflo(vv.x), acc[8 * i + 0]); acc[8 * i + 1] = fmaf(s, bfhi(vv.x), acc[8 * i + 1]);
                    acc[8 * i + 2] = fmaf(s, bflo(vv.y), acc[8 * i + 2]); acc[8 * i + 3] = fmaf(s, bfhi(vv.y), acc[8 * i + 3]);
                    acc[8 * i + 4] = fmaf(s, bflo(vv.z), acc[8 * i + 4]); acc[8 * i + 5] = fmaf(s, bfhi(vv.z), acc[8 * i + 5]);
                    acc[8 * i + 6] = fmaf(s, bflo(vv.w), acc[8 * i + 6]); acc[8 * i + 7] = fmaf(s, bfhi(vv.w), acc[8 * i + 7]); }
            }
#pragma unroll
            for (int e = 0; e < 32; ++e) yr[dq * 32 + e] = acc[e];
        }
        asm volatile("s_waitcnt vmcnt(0)" ::: "memory");
        float s1 = 0.f;
        for (int e = 0; e < 128; ++e) s1 += yr[e];
        const float mu = s1 * (1.0f / 128.0f); float s2 = 0.f;
        for (int e = 0; e < 128; ++e) { const float d = yr[e] - mu; s2 = fmaf(d, d, s2); }
        const float rs = 1.0f / sqrtf(s2 * (1.0f / 128.0f) + LN_EPS);
        const float* gg = a.in[I_GNG] + h * 128; const float* gb = a.in[I_GNB] + h * 128;
        for (int e = 0; e < 128; e += 2) {
            const unsigned gw = *(const unsigned*)(RG + (size_t)m * 512 + h * 128 + e);
            const float g0 = bflo(gw), g1 = bfhi(gw);
            const float y0 = ((yr[e] - mu) * rs * gg[e] + gb[e]) * (g0 / (1.0f + __expf(-g0)));
            const float y1 = ((yr[e + 1] - mu) * rs * gg[e + 1] + gb[e + 1]) * (g1 / (1.0f + __expf(-g1)));
            *(unsigned*)(MIX + (size_t)m * DM + h * 128 + e) = pk2(y0, y1);
        }
    }
}

__device__ __forceinline__ void p6_ln1_route(const Args& a, Frame& F) {
    typedef short bf16x8 __attribute__((ext_vector_type(8)));
    unsigned char* ws = a.ws;
    const float* ADA = (const float*)(ws + WS_ADA); const float* STATS = (const float*)(ws + WS_STATS); const bf16_t* Y1 = (const bf16_t*)(ws + WS_Y1); const bf16_t* RWT = (const bf16_t*)(ws + WS_RWT);
    float* X1 = (float*)(ws + WS_X1); bf16_t* H2 = (bf16_t*)(ws + WS_H2); unsigned* CNT = F.ctl + CW_CNT; v2u* LIST = (v2u*)(ws + WS_LIST);
    constexpr int HP = 1032;
    LAS bf16_t* HSH = (LAS bf16_t*)F.lds; LAS bf16_t* HSL = (LAS bf16_t*)(F.lds + 16 * HP * 2);
    LAS float* PP = (LAS float*)(F.lds + 2 * 16 * HP * 2);
    LAS float* PRM = PP + 8 * 16 * 32;
    LAS unsigned* SEL = (LAS unsigned*)(PRM + 7 * 1024);
    LAS unsigned* HIST = SEL + 512 * 4;
    const int fr = F.lane & 15, fq = F.lane >> 4;
    bf16x8 bh[2][4], bl[2][4];
#pragma unroll
    for (int eh = 0; eh < 2; ++eh)
#pragma unroll
        for (int ks = 0; ks < 4; ++ks) { const size_t o = (size_t)(16 * eh + fr) * 1024 + 128 * F.wave + 32 * ks + 8 * fq; bh[eh][ks] = *(const bf16x8*)(RWT + o); bl[eh][ks] = *(const bf16x8*)(RWT + 32768 + o); }
    for (int rb = blockIdx.x; rb < NTOK / 128; rb += F.G) {
        const int m0 = rb * 128, b = m0 / SEQ; const float* ad = ADA + b * 6144;
        __syncthreads();
        for (int i = F.tid; i < 1024; i += NTHR) {
            PRM[i] = a.in[I_LNING][i] * DN_ALPHA; PRM[1024 + i] = a.in[I_LNINB][i] * DN_ALPHA; PRM[2048 + i] = ad[2048 + i];
            PRM[3072 + i] = a.in[I_LN1G][i]; PRM[4096 + i] = a.in[I_LN1B][i]; PRM[5120 + i] = ad[4096 + i] + 1.0f; PRM[6144 + i] = ad[3072 + i]; }
        if (F.tid < 64) HIST[F.tid] = 0u;
        __syncthreads();
#define P6_FETCH(m_) do { const int _m = (m_); _Pragma("unroll") for (int j = 0; j < 4; ++j) { xn[j] = __builtin_nontemporal_load((const f32x4*)(a.in[I_X] + (size_t)_m * DM) + F.lane + 64 * j); \
            yn[j] = __builtin_nontemporal_load((const v2u*)(Y1 + (size_t)_m * DM) + F.lane + 64 * j); } mn = STATS[2 * _m]; rn = STATS[2 * _m + 1]; } while (0)
        f32x4 xn[4]; v2u yn[4]; float mn, rn;
        P6_FETCH(m0 + 2 * F.wave);
        for (int it = 0; it < 8; ++it) {
#pragma unroll 1
            for (int rr = 0; rr < 2; ++rr) {
                const int lr = 2 * F.wave + rr, m = m0 + 16 * it + lr; const float mean = mn, rstd = rn;
                f32x4 xc[4]; v2u yc[4];
#pragma unroll
                for (int j = 0; j < 4; ++j) { xc[j] = xn[j]; yc[j] = yn[j]; }
                { const int q = 2 * it + rr + 1; const int mnext = q < 16 ? m0 + 16 * (q >> 1) + 2 * F.wave + (q & 1) : m; P6_FETCH(mnext); }
                f32x4 z[4]; float s = 0.f;
#pragma unroll
                for (int j = 0; j < 4; ++j) {
                    const f32x4 xv = xc[j];
                    const v2u yw = yc[j];
                    const f32x4 y = {bflo(yw.x), bfhi(yw.x), bflo(yw.y), bfhi(yw.y)};
                    const f32x4 p0 = ((const LAS f32x4*)PRM + F.lane)[64 * j], p1 = ((const LAS f32x4*)(PRM + 1024) + F.lane)[64 * j], p2 = ((const LAS f32x4*)(PRM + 2048) + F.lane)[64 * j];
                    z[j] = (xv - mean) * rstd * p0 + p1 + p2 * y;
                    s += (z[j].x + z[j].y) + (z[j].z + z[j].w);
                }
                const float mz = wave_sum(s) * (1.f / DM); float s2 = 0.f;
#pragma unroll
                for (int j = 0; j < 4; ++j) { z[j] = z[j] - mz; s2 += (z[j].x * z[j].x + z[j].y * z[j].y) + (z[j].z * z[j].z + z[j].w * z[j].w); }
                const float rz = 1.f / sqrtf(wave_sum(s2) * (1.f / DM) + LN_EPS);
#pragma unroll
                for (int j = 0; j < 4; ++j) {
                    const f32x4 p3 = ((const LAS f32x4*)(PRM + 3072) + F.lane)[64 * j], p4 = ((const LAS f32x4*)(PRM + 4096) + F.lane)[64 * j], p5 = ((const LAS f32x4*)(PRM + 5120) + F.lane)[64 * j], p6 = ((const LAS f32x4*)(PRM + 6144) + F.lane)[64 * j];
                    const f32x4 x1 = z[j] * rz * p3 + p4; const f32x4 h2 = x1 * p5 + p6;
                    { v2u xw; xw.x = pk2(x1.x, x1.y); xw.y = pk2(x1.z, x1.w); ((v2u*)((bf16_t*)X1 + (size_t)m * DM) + F.lane)[64 * j] = xw; }
                    const unsigned h0 = f2bf(h2.x), h1 = f2bf(h2.y), h2b = f2bf(h2.z), h3 = f2bf(h2.w);
                    v2u w; w.x = h0 | (h1 << 16); w.y = h2b | (h3 << 16);
                    { unsigned q = 0u; q = __builtin_amdgcn_cvt_pk_fp8_f32(h2.x, h2.y, q, false); q = __builtin_amdgcn_cvt_pk_fp8_f32(h2.z, h2.w, q, true); ((unsigned*)((unsigned char*)H2 + (size_t)m * DM) + F.lane)[64 * j] = q; }
                    v2u lo; lo.x = pk2(h2.x - bf2f(h0), h2.y - bf2f(h1)); lo.y = pk2(h2.z - bf2f(h2b), h2.w - bf2f(h3));
                    *(LAS v2u*)(HSH + lr * HP + 4 * F.lane + 256 * j) = w; *(LAS v2u*)(HSL + lr * HP + 4 * F.lane + 256 * j) = lo;
                }
            }
            __syncthreads();
            f32x4 acc[2] = {(f32x4){0.f, 0.f, 0.f, 0.f}, (f32x4){0.f, 0.f, 0.f, 0.f}};
#pragma unroll
            for (int ks = 0; ks < 4; ++ks) {
                const bf16x8 ah = *(const LAS bf16x8*)(HSH + fr * HP + 128 * F.wave + 32 * ks + 8 * fq), al = *(const LAS bf16x8*)(HSL + fr * HP + 128 * F.wave + 32 * ks + 8 * fq);
#pragma unroll
                for (int eh = 0; eh < 2; ++eh) { acc[eh] = __builtin_amdgcn_mfma_f32_16x16x32_bf16(ah, bh[eh][ks], acc[eh], 0, 0, 0); acc[eh] = __builtin_amdgcn_mfma_f32_16x16x32_bf16(ah, bl[eh][ks], acc[eh], 0, 0, 0); acc[eh] = __builtin_amdgcn_mfma_f32_16x16x32_bf16(al, bh[eh][ks], acc[eh], 0, 0, 0); }
            }
#pragma unroll
            for (int eh = 0; eh < 2; ++eh)
#pragma unroll
                for (int r = 0; r < 4; ++r) PP[(F.wave * 16 + 4 * fq + r) * 32 + 16 * eh + fr] = acc[eh][r];
            __syncthreads();
            {
                const int lr = 2 * F.wave + (F.lane >> 5), ex = F.lane & 31;
                float mine = a.in[I_RB][ex];
#pragma unroll
                for (int wv = 0; wv < 8; ++wv) mine += PP[(wv * 16 + lr) * 32 + ex];
                float sv[4]; int si[4];
#pragma unroll
                for (int k = 0; k < 4; ++k) {
                    float v = mine; int ix = ex;
#pragma unroll
                    for (int o = 16; o >= 1; o >>= 1) { const float ov = __shfl_xor(v, o); const int oi = __shfl_xor(ix, o); if (ov > v || (ov == v && oi < ix)) { v = ov; ix = oi; } }
                    sv[k] = v; si[k] = ix; if (ex == ix) mine = -3.0e38f;
                }
                const float e1 = __expf(sv[1] - sv[0]), e2 = __expf(sv[2] - sv[0]), e3 = __expf(sv[3] - sv[0]);
                const float rs = 1.0f / (1.0f + e1 + e2 + e3);
                if (ex < 4) {
                    const int sel = ex == 0 ? si[0] : (ex == 1 ? si[1] : (ex == 2 ? si[2] : si[3]));
                    const float gt = (ex == 0 ? 1.0f : (ex == 1 ? e1 : (ex == 2 ? e2 : e3))) * rs;
                    const unsigned rank = atomicAdd((unsigned*)(HIST + sel), 1u);
                    const int slot = (16 * it + lr) * 4 + ex;
                    SEL[slot * 4] = (unsigned)sel; SEL[slot * 4 + 1] = rank; SEL[slot * 4 + 2] = (unsigned)((m0 + 16 * it + lr) * 4 + ex); SEL[slot * 4 + 3] = __float_as_uint(gt);
                }
            }
        }
        __syncthreads();
        if (F.tid < 32) HIST[32 + F.tid] = atomicAdd(CNT + F.tid, HIST[F.tid]);
        __syncthreads();
        { const unsigned ex = SEL[F.tid * 4], rank = SEL[F.tid * 4 + 1]; v2u ent; ent.x = SEL[F.tid * 4 + 2]; ent.y = SEL[F.tid * 4 + 3]; LIST[(size_t)ex * LISTCAP + HIST[32 + ex] + rank] = ent; }
    }
}

__device__ __forceinline__ void p9_final(const Args& a, Frame& F) {
    unsigned char* ws = a.ws;
    const float* ADA = (const float*)(ws + WS_ADA); const bf16_t* X1 = (const bf16_t*)(ws + WS_X1); const unsigned char* YE = (const unsigned char*)(ws + WS_YE);
    unsigned yn[4][4]; v2u xn[4];
    auto fetch = [&](int m) {
#pragma unroll
        for (int j = 0; j < 4; ++j) {
#pragma unroll
            for (int k = 0; k < 4; ++k) yn[j][k] = __builtin_nontemporal_load((const unsigned*)(YE + ((size_t)m * 4 + k) * DM) + F.lane + 64 * j);
            xn[j] = __builtin_nontemporal_load((const v2u*)(X1 + (size_t)m * DM) + F.lane + 64 * j); } };
    if (F.gw < NTOK) fetch(F.gw);
    for (int m = F.gw; m < NTOK; m += F.ngw) {
        const int b = m / SEQ; const float* ad = ADA + b * 6144;
        f32x4 z[4]; float s = 0.f;
#pragma unroll
        for (int j = 0; j < 4; ++j) {
            f32x4 f = {0.f, 0.f, 0.f, 0.f};
#pragma unroll
            for (int k = 0; k < 4; ++k) { const unsigned yw = yn[j][k];
                f += (f32x4){__builtin_amdgcn_cvt_f32_fp8(yw, 0), __builtin_amdgcn_cvt_f32_fp8(yw, 1), __builtin_amdgcn_cvt_f32_fp8(yw, 2), __builtin_amdgcn_cvt_f32_fp8(yw, 3)}; }
            f = f * (1.0f / 64.0f);
            const v2u xw = xn[j]; const f32x4 x1 = {bflo(xw.x), bfhi(xw.x), bflo(xw.y), bfhi(xw.y)};
            const f32x4 g2 = ((const f32x4*)(ad + 5120) + F.lane)[64 * j];
            z[j] = x1 * DN_ALPHA + g2 * f;
            s += (z[j].x + z[j].y) + (z[j].z + z[j].w);
        }
        fetch((m + F.ngw < NTOK) ? m + F.ngw : m);
        const float mz = wave_sum(s) * (1.f / DM); float s2 = 0.f;
#pragma unroll
        for (int j = 0; j < 4; ++j) { z[j] = z[j] - mz; s2 += (z[j].x * z[j].x + z[j].y * z[j].y) + (z[j].z * z[j].z + z[j].w * z[j].w); }
        const float rz = 1.f / sqrtf(wave_sum(s2) * (1.f / DM) + LN_EPS);
#pragma unroll
        for (int j = 0; j < 4; ++j) {
            const f32x4 g = ((const f32x4*)a.in[I_LN2G] + F.lane)[64 * j], bb = ((const f32x4*)a.in[I_LN2B] + F.lane)[64 * j];
            __builtin_nontemporal_store(z[j] * rz * g + bb, (f32x4*)(a.out + (size_t)m * DM) + F.lane + 64 * j);
        }
    }
}

constexpr int N_PHASES = 10;
constexpr int CONV_NIT = NEXP * (16 * 32 + 16 * 16), CONV_P2 = 64 * 8 * 4;
#ifndef MK_N_LAUNCHES
#define MK_N_LAUNCHES 1
#endif
__global__ void __launch_bounds__(NTHR, 2) fwd_kernel(Args a) {
    extern __shared__ __attribute__((aligned(16))) unsigned char lds[];
    Frame F;
    F.lds = (LAS unsigned char*)lds;
#define REFRESH() do { int _t = threadIdx.x; asm volatile("" : "+v"(_t)); F.tid = _t; F.lane = _t & 63; F.wave = __builtin_amdgcn_readfirstlane(_t >> 6); F.gtid = blockIdx.x * NTHR + _t; F.gw = blockIdx.x * NWAVES + F.wave; } while (0)
    F.G = gridDim.x; F.nthreads = F.G * NTHR; F.ngw = F.G * NWAVES; REFRESH();
    F.ctl = (unsigned*)(a.ws + WS_CTL);
    volatile LAS unsigned* MISC = (volatile LAS unsigned*)(F.lds + MISC_OFF);
    for (int u = F.tid; u < (LDS_BYTES - 131072) / 4; u += NTHR) ((LAS unsigned*)(F.lds + 131072))[u] = 0u;
    __syncthreads();
    XcdBarrier bar; bar.bar = F.ctl + CW_BAR + a.li * XCD_BAR_WORDS; bar.x = 0; bar.st = nullptr;
    if (MK_N_LAUNCHES == 1) bar = xcd_barrier_post(F.ctl + CW_BAR, MISC + 8);
    const int lo = a.ph_lo, hi = a.ph_hi;
#define IN(k) (lo <= (k) && (k) < hi)
#define SEAM(k) do { if (IN(k) && IN((k) + 1)) xcd_barrier(bar); } while (0)
    if (IN(0)) { REFRESH(); p0_prologue(a, F); } SEAM(0);
    if (IN(1)) { REFRESH(); p1_ln_mod(a, F); } SEAM(1);
    if (IN(2)) { REFRESH();
        pg8::SchedInProj S{F.G, (int)blockIdx.x}; pg8::EpiInProj E{a.ws, a.in[I_QNG], a.in[I_KNG], (const float*)(a.ws + WS_ROPE)};
        pg8::gemm_phase<pg8::EpiInProj, pg8::SchedInProj, false>(F.lds, (const bf16_t*)(a.ws + WS_H), (const bf16_t*)(a.ws + WS_WIN), S, E);
        if (F.G == 256) { if (blockIdx.x >= 192) { REFRESH(); __syncthreads(); moe_weights_convert(a, F, 0, CONV_P2, ((int)blockIdx.x - 192) * NWAVES + F.wave, 64 * NWAVES); } }
        else if (blockIdx.x == 0) {   }
    } SEAM(2);
    if (IN(3)) { REFRESH();
        const attn_body::AttnTensors AT{(const attn_body::bf16*)(a.ws + WS_AQ), (const attn_body::bf16*)(a.ws + WS_AK), (const attn_body::bf16*)(a.ws + WS_AV), (attn_body::bf16*)(a.ws + WS_MIX) + 512};
        const attn_body::StaticOrder S((int)F.G, (int)blockIdx.x);
        if ((F.G & 255) == 0) {
            float gqm = 0.f, gkm = 0.f;
            for (int i = 0; i < 64; ++i) { gqm = fmaxf(gqm, fabsf(a.in[I_QNG][i])); gkm = fmaxf(gkm, fabsf(a.in[I_KNG][i])); }
            const float refB = 1.02f * C2 * 64.0f * gqm * gkm;
            const int slot = (int)(blockIdx.x % 5u); attn_body::AttnUnit u;
            for (int i = 0; i < 5; ++i) {
                if (i == slot) { __syncthreads(); moe_weights_convert(a, F, CONV_P2, CONV_NIT, F.gw, F.ngw); __syncthreads(); }
                if (i < 4 && S.next(i, u)) attn_body::attn_unit<8>(u.b, u.h, u.qb, AT.Q, AT.K, AT.V, AT.O, (char*)lds, refB);
            }
        } else { p3_attn_scalar(a, F); __syncthreads(); moe_weights_convert(a, F, 0, CONV_NIT, F.gw, F.ngw); }
        __syncthreads();
        for (int u = blockIdx.x; u < 256; u += F.G) { const int dvh = u & 1, dir = (u >> 1) & 1, h = (u >> 2) & 3, b = u >> 4;
            ret::state_unit(b, h, dir, dvh, (const bf16_t*)(a.ws + WS_RK), (const bf16_t*)(a.ws + WS_RV), (bf16_t*)(a.ws + WS_ST), (dir ? a.in[I_LDB][h] : a.in[I_LDF][h]) * 1.4426950408889634f, F.lds); }
    } SEAM(3);
    if (IN(4)) { REFRESH();
        ret::OutRegs R; int u = blockIdx.x;
        if (u < 1024) ret::out_load(R, u, (const bf16_t*)(a.ws + WS_RQ), (const bf16_t*)(a.ws + WS_RK), (const bf16_t*)(a.ws + WS_RV), (const bf16_t*)(a.ws + WS_RG));
        for (; u < 1024; u += F.G) { const int un = (u + F.G < 1024) ? u + F.G : -1;
            ret::out_unit(R, u, un, (const bf16_t*)(a.ws + WS_RQ), (const bf16_t*)(a.ws + WS_RK), (const bf16_t*)(a.ws + WS_RV), (const bf16_t*)(a.ws + WS_RG), (const bf16_t*)(a.ws + WS_ST), a.in[I_GNG], a.in[I_GNB],
                          a.in[I_LDF], a.in[I_LDB], (bf16_t*)(a.ws + WS_MIX), F.lds); }
    } SEAM(4);
    if (IN(5)) { REFRESH();
        pg8::SchedDense S{NTOK / 256, DM / 256, F.G, (int)blockIdx.x}; pg8::EpiPlainBf16 E{(bf16_t*)(a.ws + WS_Y1), DM};
        pg8::gemm_phase<pg8::EpiPlainBf16, pg8::SchedDense, false>(F.lds, (const bf16_t*)(a.ws + WS_MIX), (const bf16_t*)(a.ws + WS_WO), S, E);
    } SEAM(5);
    if (IN(6)) { REFRESH(); p6_ln1_route(a, F); } SEAM(6);
    if (IN(7)) { REFRESH();
        LAS int* tab = (LAS int*)(F.lds + 131072 + 1024); pg8::moe_build_tab(tab, F.ctl + CW_CNT);
        pg8::SchedMoE S{8, 2048, F.G, (int)blockIdx.x, tab, (const v2u*)(a.ws + WS_LIST)}; pg8::EpiUp E{a.ws + WS_ACT, a.in[I_BUP]};
        pg8::gemm_phase<pg8::EpiUp, pg8::SchedMoE, true, true>(F.lds, (const bf16_t*)(a.ws + WS_H2), (const bf16_t*)(a.ws + WS_WUP), S, E);
    } SEAM(7);
    if (IN(8)) { REFRESH();
        LAS int* tab = (LAS int*)(F.lds + 131072 + 1024); pg8::moe_build_tab(tab, F.ctl + CW_CNT);
        pg8::SchedMoE S{4, 1024, F.G, (int)blockIdx.x, tab, (const v2u*)(a.ws + WS_LIST)}; pg8::EpiDown E{(bf16_t*)(a.ws + WS_YE), a.in[I_BDN], (const v2u*)(a.ws + WS_LIST)};
        pg8::gemm_phase<pg8::EpiDown, pg8::SchedMoE, false, true>(F.lds, (const bf16_t*)(a.ws + WS_ACT), (const bf16_t*)(a.ws + WS_WDN), S, E);
    } SEAM(8);
    if (IN(9)) { REFRESH(); p9_final(a, F); }
#undef IN
#undef SEAM
}

extern "C" void kernel_launch(void* const* d_in, const int* in_sizes, int n_in, void* d_out, int out_size, void* d_ws, size_t ws_size, hipStream_t stream) {
    static int grid = 0;
    if (grid == 0) {
        if (n_in != 26 || out_size != NTOK * DM || ws_size < WS_END) { fprintf(stderr, "kernel_launch: unexpected shapes (n_in %d, out %d, ws %zu); nothing launched\n", n_in, out_size, ws_size); grid = -1; return; }
        int dev = 0, cus = 0;
        if (hipGetDevice(&dev) != hipSuccess || hipDeviceGetAttribute(&cus, hipDeviceAttributeMultiprocessorCount, dev) != hipSuccess) { grid = -1; return; }
        if (hipFuncSetAttribute((const void*)fwd_kernel, hipFuncAttributeMaxDynamicSharedMemorySize, LDS_BYTES) != hipSuccess) { fprintf(stderr, "kernel_launch: hipFuncSetAttribute failed\n"); grid = -1; return; }
        (void)hipGetLastError();
        grid = cus;
    }
    if (grid < 0) return;
    if (hipMemsetAsync((char*)d_ws + WS_CTL, 0, CTL_ZERO_BYTES, stream) != hipSuccess) return;
    Args a{};
    for (int i = 0; i < 26; ++i) a.in[i] = (const float*)d_in[i];
    a.out = (float*)d_out; a.ws = (unsigned char*)d_ws;
    if (MK_N_LAUNCHES == 1) { a.ph_lo = 0; a.ph_hi = N_PHASES; a.li = 0; hipLaunchKernelGGL(fwd_kernel, dim3(grid), dim3(NTHR), LDS_BYTES, stream, a); }
    else for (int p = 0; p < N_PHASES; ++p) { a.ph_lo = p; a.ph_hi = p + 1; a.li = 0; hipLaunchKernelGGL(fwd_kernel, dim3(grid), dim3(NTHR), LDS_BYTES, stream, a); }
}
```

```cpp
#include <hip/hip_runtime.h>
#include <cstdio>
#include <cstdint>

constexpr int BATCH = 16, SEQ = 2048, DM = 1024, CTX = 256, SU = SEQ + CTX;
constexpr int NTOK = BATCH * SEQ, NROW = BATCH * SU;
constexpr int NIN = 2304, NEXP = 32, LISTCAP = 32768;
constexpr float LN_EPS = 1e-6f, DN_ALPHA = 1.189207115002721f;
constexpr float C2 = 0.125f * 1.4426950408889634f;
constexpr int NWAVES = 8, NTHR = 512;

constexpr size_t MiB = 1u << 20;
constexpr size_t WS_CTL = 0, CTL_ZERO_BYTES = 64 * 1024;
constexpr size_t WS_ADA = 1 * MiB, WS_ROPE = 1 * MiB + 512 * 1024, WS_STATS = 2 * MiB, WS_LIST = 4 * MiB;
constexpr size_t WS_RWT = 12 * MiB;
constexpr size_t WS_WIN = 16 * MiB, WS_WO = 22 * MiB, WS_WUP = 32 * MiB, WS_WDN = 160 * MiB;
constexpr size_t WS_X1 = 224 * MiB, WS_H2 = 352 * MiB, WS_ACT = 416 * MiB;
constexpr size_t WS_MIX = 416 * MiB, WS_Y1 = 480 * MiB, WS_YRET = 544 * MiB;
constexpr size_t WS_YE = 688 * MiB;
constexpr size_t WS_H = 688 * MiB, WS_RQ = 760 * MiB, WS_RK = 776 * MiB, WS_RV = 794 * MiB, WS_RG = 830 * MiB, WS_AQ = 862 * MiB, WS_AK = 894 * MiB, WS_AV = 903 * MiB;
constexpr size_t WS_ST = 912 * MiB;
constexpr size_t WS_END = 944 * MiB;
constexpr int CW_TMO = 0, CW_CNT = 256, CW_BAR = 4096;

#define GAS __attribute__((address_space(1)))
#define LAS __attribute__((address_space(3)))
typedef unsigned short bf16_t;
typedef unsigned v4u __attribute__((ext_vector_type(4)));
typedef unsigned v2u __attribute__((ext_vector_type(2)));
typedef float f32x4 __attribute__((ext_vector_type(4)));

__device__ __forceinline__ float bf2f(unsigned v) { return __uint_as_float(v << 16); }
__device__ __forceinline__ unsigned f2bf(float f) { unsigned u = __float_as_uint(f); return (u + 0x7fffu + ((u >> 16) & 1u)) >> 16; }
__device__ __forceinline__ unsigned pk2(float lo, float hi) { return f2bf(lo) | (f2bf(hi) << 16); }
__device__ __forceinline__ float bflo(unsigned w) { return __uint_as_float(w << 16); }
__device__ __forceinline__ float bfhi(unsigned w) { return __uint_as_float(w & 0xffff0000u); }
__device__ __forceinline__ float wave_sum(float v) {
#pragma unroll
    for (int o = 1; o < 64; o <<= 1) v += __shfl_xor(v, o);
    return v;
}
__device__ __forceinline__ float dot8(v4u a, v4u w, float acc) {
    acc = fmaf(bflo(a.x), bflo(w.x), acc); acc = fmaf(bfhi(a.x), bfhi(w.x), acc);
    acc = fmaf(bflo(a.y), bflo(w.y), acc); acc = fmaf(bfhi(a.y), bfhi(w.y), acc);
    acc = fmaf(bflo(a.z), bflo(w.z), acc); acc = fmaf(bfhi(a.z), bfhi(w.z), acc);
    acc = fmaf(bflo(a.w), bflo(w.w), acc); acc = fmaf(bfhi(a.w), bfhi(w.w), acc);
    return acc;
}

#define XB_TMO      128
#define XB_XCNT(j)  (256  + 64 * (j))
#define XB_XSUB(j)  (1280 + 64 * (j))
#define XB_XGEN(j)  (2304 + 64 * (j))
#define XB_TOP      3328
#define XB_TOPGEN   3392
#define XCD_BAR_WORDS 3456
#define XB_SPIN_CAP (1u << 24)
__device__ __forceinline__ unsigned xb_ld(unsigned* p)              { return __hip_atomic_load(p, __ATOMIC_RELAXED, __HIP_MEMORY_SCOPE_AGENT); }
__device__ __forceinline__ unsigned xb_add(unsigned* p, unsigned v) { return __hip_atomic_fetch_add(p, v, __ATOMIC_RELAXED, __HIP_MEMORY_SCOPE_AGENT); }
__device__ __forceinline__ unsigned xb_xcc_id() { return (unsigned)__builtin_amdgcn_s_getreg((3 << 11) | 20) & 0xFu; }
#define XB_SPIN(cond, bar) do { unsigned _sp = 0; while (cond) { __builtin_amdgcn_s_sleep(1); \
    if ((++_sp & 255u) == 0u) { if (xb_ld(&(bar)[XB_TMO])) break; if (_sp > XB_SPIN_CAP) { atomicAdd(&(bar)[XB_TMO], 1u); break; } } } } while (0)
struct XcdBarrier { unsigned* bar; unsigned x; volatile LAS unsigned* st; };
__device__ __forceinline__ XcdBarrier xcd_barrier_post(unsigned* bar, volatile LAS unsigned* st) {
    XcdBarrier b; b.bar = bar; b.x = xb_xcc_id(); b.st = st;
    if (threadIdx.x == 0) (void)xb_add(&bar[XB_XCNT(b.x)], 1u);
    return b;
}
__device__ __forceinline__ void xcd_barrier_complete(unsigned* bar, unsigned x, unsigned& nloc, unsigned& nx) {
    const unsigned G = gridDim.x * gridDim.y * gridDim.z;
    unsigned sum, cnt, mine, sp = 0u;
    for (;;) {
        sum = 0u; cnt = 0u; mine = 0u;
#pragma unroll
        for (unsigned j = 0; j < 16; ++j) { const unsigned c = xb_ld(&bar[XB_XCNT(j)]); sum += c; cnt += (c > 0u) ? 1u : 0u; mine = (j == x) ? c : mine; }
        if (sum == G) break;
        __builtin_amdgcn_s_sleep(1);
        if ((++sp & 255u) == 0u) { if (xb_ld(&bar[XB_TMO])) break; if (sp > XB_SPIN_CAP) { atomicAdd(&bar[XB_TMO], 1u); break; } }
    }
    nloc = mine > 0u ? mine : 1u; nx = cnt > 0u ? cnt : 1u;
}
__device__ __forceinline__ void xcd_barrier(const XcdBarrier& b) {
    asm volatile("s_waitcnt vmcnt(0)" ::: "memory");
    __syncthreads();
    if (threadIdx.x == 0) {
        unsigned* bar = b.bar;
        __builtin_amdgcn_s_waitcnt(0);
        unsigned nloc = b.st[0], nx = b.st[1];
        if (nloc == 0u) { xcd_barrier_complete(bar, b.x, nloc, nx); b.st[0] = nloc; b.st[1] = nx; }
        const unsigned old = xb_add(&bar[XB_XSUB(b.x)], 1u);
        const unsigned gen = old / nloc;
        if (old + 1u == (gen + 1u) * nloc) {
            __builtin_amdgcn_fence(__ATOMIC_RELEASE, "agent");
            asm volatile("s_waitcnt vmcnt(0)" ::: "memory");
            const unsigned og = xb_add(&bar[XB_TOP], 1u);
            const unsigned tg = og / nx;
            if (og + 1u == (tg + 1u) * nx) xb_add(&bar[XB_TOPGEN], 1u);
            else XB_SPIN(xb_ld(&bar[XB_TOPGEN]) == tg, bar);
            __builtin_amdgcn_fence(__ATOMIC_ACQUIRE, "agent");
            xb_add(&bar[XB_XGEN(b.x)], 1u);
            asm volatile("s_waitcnt vmcnt(0)" ::: "memory");
        } else {
            XB_SPIN(xb_ld(&bar[XB_XGEN(b.x)]) == gen, bar);
            __builtin_amdgcn_fence(__ATOMIC_ACQUIRE, "agent");
            asm volatile("s_waitcnt vmcnt(0)" ::: "memory");
        }
    }
    __syncthreads();
}

namespace pg8 {
typedef short bf16x8 __attribute__((ext_vector_type(8)));
typedef int v4i __attribute__((ext_vector_type(4)));
typedef int v8i __attribute__((ext_vector_type(8)));
constexpr int BM = 256, BK = 64, HALF = 128, HTB = HALF * BK * 2, NXCD = 8, WGM = 1, KD = 1024, NT = KD / BK;
__device__ __forceinline__ int lds_byte(int r, int c) { const int st = (r >> 4) * 2 + (c >> 5), rr = r & 15, cc = c & 31, ob = rr * 64 + cc * 2; return st * 1024 + (ob ^ (((ob >> 9) & 1) << 5)); }
__device__ __forceinline__ void stage_rc(int b, int& R, int& C) { const int st = b / 1024, sb = b % 1024, swz = sb ^ (((sb >> 9) & 1) << 5); R = (st >> 1) * 16 + swz / 64; C = (st & 1) * 32 + (swz % 64) / 2; }
__device__ __forceinline__ int perm32(int rho) { const int n = rho >> 4, i = rho & 15; return 8 * (i >> 2) + 4 * n + (i & 3); }
__device__ __forceinline__ unsigned cvt_pk_bf16(float lo, float hi) { unsigned r; asm volatile("v_cvt_pk_bf16_f32 %0, %1, %2" : "=v"(r) : "v"(lo), "v"(hi)); return r; }

struct Unit { int pm, pn, brow, e, r0, cnt; };

__device__ __forceinline__ void tile_order(int L, int nM, int nN, int& pm, int& pn) {
    const int nwg = nM * nN; int wgid = L; { const int q = nwg / NXCD, r = nwg % NXCD, xcd = wgid % NXCD, off = wgid / NXCD; wgid = (xcd < r ? xcd * (q + 1) : r * (q + 1) + (xcd - r) * q) + off; }
    const int nig = WGM * nN, gid = wgid / nig, fm = gid * WGM, gsz = (nM - fm) < WGM ? (nM - fm) : WGM;
    pm = fm + ((wgid % nig) % gsz); pn = (wgid % nig) / gsz;
}
struct SchedDense {
    int nM, nN, G, c;
    __device__ __forceinline__ bool next(int i, Unit& u) const { const long L = (long)i * G + c; if (L >= (long)nM * nN) return false; tile_order((int)L, nM, nN, u.pm, u.pn); u.brow = u.pn * BM; u.e = 0; u.r0 = 0; u.cnt = 0; return true; }
    __device__ __forceinline__ unsigned arow_tok(const Unit&, int) const { return 0u; }
};

template <class Epi, class Sched, bool GATHER, bool F8 = false>
__device__ __forceinline__ void gemm_phase(LAS unsigned char* lds, const bf16_t* A, const bf16_t* Bt, const Sched& S, const Epi& E) {
    const int tid = threadIdx.x, wid = __builtin_amdgcn_readfirstlane(tid >> 6), lane = tid & 63, wr = wid >> 2, wc = wid & 3, fr = lane & 15, fq = lane >> 4;
    constexpr int K = F8 ? KD / 2 : KD, nt = F8 ? NT / 2 : NT;
    unsigned voffA[2], voffB[2];
#pragma unroll
    for (int i = 0; i < 2; ++i) { int R, C; stage_rc(tid * 16 + i * 8192, R, C); const int Rb = Epi::PERM ? ((R & ~31) + perm32(R & 31)) : R;
        voffA[i] = GATHER ? (unsigned)(C * 2) : (unsigned)(R * K + C) * 2u; voffB[i] = (unsigned)(Rb * K + C) * 2u; }
    constexpr size_t kstep = (size_t)(BK * 2), hstep = (size_t)HALF * K * 2, tstep = 2 * hstep;
    const unsigned ldsw = (unsigned)wid * 1024u;
    const int aoff = lds_byte(wr * 64 + fr, fq * 8), boff = lds_byte(wc * 32 + fr, fq * 8);
#define PG8_SA(b, h) (((b) * 2 + (h)) * HTB)
#define PG8_SB(b, h) ((4 + (b) * 2 + (h)) * HTB)
#define PG8_STAGE_B(bufoff, gbase) do { _Pragma("unroll") for (int _i = 0; _i < 2; ++_i) \
        __builtin_amdgcn_global_load_lds((const unsigned*)((const char*)(gbase) + voffB[_i]), (LAS unsigned*)(lds + (bufoff) + ldsw + _i * 8192), 16, 0, 0); } while (0)
#define PG8_STAGE_A(bufoff, h, kb, nx) do { _Pragma("unroll") for (int _i = 0; _i < 2; ++_i) { \
        const char* _src = GATHER ? (const char*)A + (((((nx) ? ron[h] : roc[h]) >> (16 * _i)) & 0xffffu) << (F8 ? 10 : 11)) + voffA[0] + (kb) : ((nx) ? nA : cA) + (size_t)(h) * hstep + (kb) + voffA[_i]; \
        __builtin_amdgcn_global_load_lds((const unsigned*)_src, (LAS unsigned*)(lds + (bufoff) + ldsw + _i * 8192), 16, 0, 0); } } while (0)
#define PG8_LDA(dst, b, h) do { _Pragma("unroll") for (int m = 0; m < 4; ++m) { if constexpr (F8) { dst##8[m].lo = *(const LAS v4i*)(lds + PG8_SA(b, h) + aoff + m * 2048); dst##8[m].hi = *(const LAS v4i*)(lds + PG8_SA(b, h) + aoff + m * 2048 + 1024); } \
        else { _Pragma("unroll") for (int k = 0; k < 2; ++k) dst[m][k] = *(const LAS bf16x8*)(lds + PG8_SA(b, h) + aoff + m * 2048 + k * 1024); } } } while (0)
#define PG8_LDB(dst, b, h) do { _Pragma("unroll") for (int n = 0; n < 2; ++n) { if constexpr (F8) { dst##8[n].lo = *(const LAS v4i*)(lds + PG8_SB(b, h) + boff + n * 2048); dst##8[n].hi = *(const LAS v4i*)(lds + PG8_SB(b, h) + boff + n * 2048 + 1024); } \
        else { _Pragma("unroll") for (int k = 0; k < 2; ++k) dst[n][k] = *(const LAS bf16x8*)(lds + PG8_SB(b, h) + boff + n * 2048 + k * 1024); } } } while (0)
#define PG8_MMA(ai, bj, At, Bt_) do { __builtin_amdgcn_s_setprio(1); _Pragma("unroll") for (int m = 0; m < 4; ++m) _Pragma("unroll") for (int n = 0; n < 2; ++n) { \
        if constexpr (F8) { asm volatile("v_mfma_scale_f32_16x16x128_f8f6f4 %0, %1, %2, %0, %3, %3 op_sel_hi:[0,0,0]" : "+v"(acc[ai][bj][m][n]) : "v"(Bt_##8[n]), "v"(At##8[m]), "v"(sc8)); } \
        else { _Pragma("unroll") for (int k = 0; k < 2; ++k) acc[ai][bj][m][n] = __builtin_amdgcn_mfma_f32_16x16x32_bf16(Bt_[n][k], At[m][k], acc[ai][bj][m][n], 0, 0, 0); } } \
        __builtin_amdgcn_s_setprio(0); } while (0)
#define PG8_WAIT_V(n) asm volatile("s_waitcnt vmcnt(" #n ")" ::: "memory")
#define PG8_WAIT_L(n) asm volatile("s_waitcnt lgkmcnt(" #n ")" ::: "memory")
#define PG8_BAR __builtin_amdgcn_s_barrier()
#define PG8_SCHED __builtin_amdgcn_sched_barrier(0)
#define PG8_LOAD_RO(dst, unit) do { int _R, _C; stage_rc((int)threadIdx.x * 16, _R, _C); _Pragma("unroll") for (int _h = 0; _h < 2; ++_h) dst[_h] = S.arow_tok(unit, _h * HALF + _R) | (S.arow_tok(unit, _h * HALF + _R + 64) << 16); } while (0)
    Unit cur, nxt; int ui = 0;
    if (!S.next(0, cur)) return;
    f32x4 acc[2][2][4][2];
#pragma unroll
    for (int a = 0; a < 2; ++a)
#pragma unroll
        for (int b = 0; b < 2; ++b)
#pragma unroll
            for (int m = 0; m < 4; ++m)
#pragma unroll
                for (int n = 0; n < 2; ++n) acc[a][b][m][n] = (f32x4){0.f, 0.f, 0.f, 0.f};
    if (Epi::HAS_INIT) { const typename Epi::Init i0 = E.init(cur, wr, wc, fr, fq);
#pragma unroll
      for (int a = 0; a < 2; ++a)
#pragma unroll
        for (int b = 0; b < 2; ++b)
#pragma unroll
            for (int m = 0; m < 4; ++m)
#pragma unroll
                for (int n = 0; n < 2; ++n) acc[a][b][m][n] = i0.v[b][n]; }
    unsigned sc8 = 0x7c7c7c7cu; asm volatile("" : "+v"(sc8));
    bf16x8 At[4][2], B0[2][2], B1[2][2]; v8i At8[4], B08[2], B18[2];
    unsigned roc[2] = {0u, 0u}, ron[2] = {0u, 0u};
    bool has_next = S.next(1, nxt);
    if (GATHER) { PG8_LOAD_RO(roc, cur); if (has_next) { PG8_LOAD_RO(ron, nxt); } else { ron[0] = roc[0]; ron[1] = roc[1]; } }
    const char* cA = (const char*)A + (GATHER ? (size_t)0 : (size_t)cur.pm * tstep); const char* cB = (const char*)Bt + (size_t)cur.brow * K * 2;
    const char* nA = cA;
    PG8_STAGE_B(PG8_SB(0, 0), cB); PG8_STAGE_B(PG8_SB(0, 1), cB + hstep); PG8_STAGE_A(PG8_SA(0, 0), 0, 0, false); PG8_STAGE_A(PG8_SA(0, 1), 1, 0, false);
    if (wr == 1) PG8_BAR;
    PG8_WAIT_V(2); PG8_BAR;
    PG8_STAGE_B(PG8_SB(1, 0), cB + kstep); PG8_STAGE_A(PG8_SA(1, 0), 0, kstep, false); PG8_STAGE_B(PG8_SB(1, 1), cB + hstep + kstep);
    PG8_WAIT_V(6); PG8_BAR;
    for (;;) {
        nA = (has_next && !GATHER) ? (const char*)A + (size_t)nxt.pm * tstep : cA;
        const char* nB = has_next ? (const char*)Bt + (size_t)nxt.brow * K * 2 : cB;
#pragma unroll 1
        for (int t = 0; t < nt; t += 2) {
            const bool last = (t == nt - 2);
            const size_t k1 = (size_t)(t + 1) * kstep, k2 = last ? (size_t)0 : (size_t)(t + 2) * kstep, k3 = k2 + kstep;
            const char* b2 = last ? nB : cB + (size_t)(t + 2) * kstep; const char* b3 = b2 + kstep;
            PG8_LDB(B0, 0, 0); PG8_LDB(B1, 0, 1); PG8_SCHED; PG8_LDA(At, 0, 0); PG8_STAGE_A(PG8_SA(1, 1), 1, k1, false);
            PG8_WAIT_V(8); PG8_WAIT_L(0); PG8_BAR; PG8_MMA(0, 0, At, B0); PG8_MMA(0, 1, At, B1); PG8_BAR; PG8_SCHED;
            PG8_LDA(At, 0, 1); PG8_STAGE_B(PG8_SB(0, 0), b2); PG8_STAGE_B(PG8_SB(0, 1), b2 + hstep); PG8_STAGE_A(PG8_SA(0, 0), 0, k2, last);
            PG8_WAIT_V(8); PG8_WAIT_L(0); PG8_BAR; PG8_MMA(1, 0, At, B0); PG8_MMA(1, 1, At, B1); PG8_BAR; PG8_SCHED;
            PG8_LDB(B0, 1, 0); PG8_LDB(B1, 1, 1); PG8_SCHED; PG8_LDA(At, 1, 0); PG8_STAGE_A(PG8_SA(0, 1), 1, k2, last);
            PG8_WAIT_V(8); PG8_WAIT_L(0); PG8_BAR; PG8_MMA(0, 0, At, B0); PG8_MMA(0, 1, At, B1); PG8_BAR; PG8_SCHED;
            PG8_LDA(At, 1, 1); PG8_STAGE_B(PG8_SB(1, 0), b3); PG8_STAGE_B(PG8_SB(1, 1), b3 + hstep); PG8_STAGE_A(PG8_SA(1, 0), 0, k3, last);
            PG8_WAIT_V(8); PG8_WAIT_L(0); PG8_BAR; PG8_MMA(1, 0, At, B0); PG8_MMA(1, 1, At, B1); PG8_BAR; PG8_SCHED;
        }
        const typename Epi::Pre pre = E.pre(cur, wr, wc, fr, fq);
        typename Epi::Init inx = typename Epi::Init(); if (Epi::HAS_INIT && has_next) inx = E.init(nxt, wr, wc, fr, fq);
        Unit nn; bool has_nn = false; unsigned rnn[2] = {0u, 0u};
        if (has_next) { has_nn = S.next(ui + 2, nn); if (GATHER && has_nn) { PG8_LOAD_RO(rnn, nn); } }
        if (wr == 0) PG8_BAR;
        if constexpr (F8) asm volatile("s_nop 15\n\ts_nop 15" ::: "memory");
        E(acc, cur, wr, wc, fr, fq, pre);
        if (!has_next) break;
#pragma unroll
        for (int a = 0; a < 2; ++a)
#pragma unroll
            for (int b = 0; b < 2; ++b)
#pragma unroll
                for (int m = 0; m < 4; ++m)
#pragma unroll
                    for (int n = 0; n < 2; ++n) acc[a][b][m][n] = Epi::HAS_INIT ? inx.v[b][n] : (f32x4){0.f, 0.f, 0.f, 0.f};
        cur = nxt; cA = nA; cB = nB; ++ui;
        has_next = has_nn; nxt = nn;
        if (GATHER) { roc[0] = ron[0]; roc[1] = ron[1]; if (has_next) { ron[0] = rnn[0]; ron[1] = rnn[1]; } }
        if (wr == 1) PG8_BAR;
    }
    PG8_WAIT_V(0);
    PG8_BAR;
#undef PG8_SA
#undef PG8_SB
#undef PG8_STAGE_A
#undef PG8_STAGE_B
#undef PG8_LDA
#undef PG8_LDB
#undef PG8_MMA
#undef PG8_WAIT_V
#undef PG8_WAIT_L
#undef PG8_BAR
#undef PG8_SCHED
#undef PG8_LOAD_RO
}

struct EpiPlainBf16 {
    static constexpr bool PERM = true;
    bf16_t* O; int ldc;
    static constexpr bool HAS_INIT = false; struct Init { f32x4 v[2][2]; };
    __device__ __forceinline__ Init init(const Unit&, int, int, int, int) const { return Init(); }
    struct Pre {};
    __device__ __forceinline__ Pre pre(const Unit&, int, int, int, int) const { return Pre{}; }
    __device__ __forceinline__ void operator()(const f32x4 (&acc)[2][2][4][2], const Unit& u, int wr, int wc, int fr, int fq, const Pre&) const {
        const int row0 = u.pm * BM + wr * 64 + fr, col0 = u.pn * BM + wc * 32 + 8 * fq;
#pragma unroll
        for (int ai = 0; ai < 2; ++ai)
#pragma unroll
            for (int m = 0; m < 4; ++m) { bf16_t* rowp = O + (size_t)(row0 + ai * HALF + m * 16) * ldc + col0;
#pragma unroll
                for (int bj = 0; bj < 2; ++bj) { const f32x4 v0 = acc[ai][bj][m][0], v1 = acc[ai][bj][m][1];
                    v4u w; w.x = cvt_pk_bf16(v0[0], v0[1]); w.y = cvt_pk_bf16(v0[2], v0[3]); w.z = cvt_pk_bf16(v1[0], v1[1]); w.w = cvt_pk_bf16(v1[2], v1[3]);
                    *(v4u*)(rowp + bj * HALF) = w; } }
    }
};

struct SchedInProj {
    int G, c;
    __device__ __forceinline__ bool next(int i, Unit& u) const {
        const int L = i * G + c;
        if (L < 1152) { int lt, pn; tile_order(L, 128, 9, lt, pn); u.pm = (lt >> 3) * 9 + 1 + (lt & 7); u.pn = pn; }
        else if (L < 1216) { const int q = L - 1152, ct = q >> 2, j = q & 3; u.pm = ct * 9; u.pn = (j == 3) ? 8 : 1 + j; }
        else return false;
        u.brow = u.pn * BM; u.e = 0; u.r0 = 0; u.cnt = 0; return true;
    }
    __device__ __forceinline__ unsigned arow_tok(const Unit&, int) const { return 0u; }
};
struct EpiInProj {
    static constexpr bool PERM = false;
    unsigned char* ws; const float* qng; const float* kng; const float* rope;
    static constexpr bool HAS_INIT = false; struct Init { f32x4 v[2][2]; };
    __device__ __forceinline__ Init init(const Unit&, int, int, int, int) const { return Init(); }
    struct Pre {};
    __device__ __forceinline__ Pre pre(const Unit&, int, int, int, int) const { return Pre{}; }
    __device__ __forceinline__ void operator()(const f32x4 (&acc)[2][2][4][2], const Unit& u, int wr, int wc, int fr, int fq, const Pre&) const {
        const int g = u.pn * 4 + wc, bt = u.pm / 9, pt = u.pm % 9; const bool isctx = (pt == 0);
        const int blk = fq >> 1, f1 = fq & 1, dbase = 32 * blk + 8 * f1;
        const bool do_rms = (g >= 24 && g < 34), do_rope = !isctx && (g < 8 || (g >= 24 && g < 34)), latrows = (g < 4) || (g >= 16 && g < 32);
        const float scale = (g >= 4 && g < 8) ? 0.125f : ((g >= 24 && g < 32) ? C2 : 1.0f);
        bf16_t* dst; int pitch;
        if (g < 4) { dst = (bf16_t*)(ws + WS_RQ) + g * 64; pitch = 256; }
        else if (g < 8) { dst = (bf16_t*)(ws + WS_RK) + (g - 4) * 64; pitch = 256; }
        else if (g < 16) { dst = (bf16_t*)(ws + WS_RV) + (g - 8) * 64; pitch = 512; }
        else if (g < 24) { dst = (bf16_t*)(ws + WS_RG) + (g - 16) * 64; pitch = 512; }
        else if (g < 32) { dst = (bf16_t*)(ws + WS_AQ) + (g - 24) * 64; pitch = 512; }
        else if (g < 34) { dst = (bf16_t*)(ws + WS_AK) + (g - 32) * 64; pitch = 128; }
        else { dst = (bf16_t*)(ws + WS_AV) + (g - 34) * 64; pitch = 128; }
        const int rowbase = latrows ? bt * SEQ + (pt - 1) * 256 : u.pm * 256;
        dst += dbase;
        f32x4 gv[2][2];
#pragma unroll
        for (int bj = 0; bj < 2; ++bj)
#pragma unroll
            for (int n = 0; n < 2; ++n) gv[bj][n] = do_rms ? *(const f32x4*)((g < 32 ? qng : kng) + dbase + 16 * bj + 4 * n) : (f32x4){1.f, 1.f, 1.f, 1.f};
#pragma unroll
        for (int ai = 0; ai < 2; ++ai)
#pragma unroll
            for (int m = 0; m < 4; ++m) {
                const int r = ai * HALF + wr * 64 + m * 16 + fr;
                f32x4 v[2][2];
#pragma unroll
                for (int bj = 0; bj < 2; ++bj)
#pragma unroll
                    for (int n = 0; n < 2; ++n) v[bj][n] = acc[ai][bj][m][n];
                if (do_rms) {
                    float ss = 0.f;
#pragma unroll
                    for (int bj = 0; bj < 2; ++bj)
#pragma unroll
                        for (int n = 0; n < 2; ++n) ss += (v[bj][n][0] * v[bj][n][0] + v[bj][n][1] * v[bj][n][1]) + (v[bj][n][2] * v[bj][n][2] + v[bj][n][3] * v[bj][n][3]);
                    ss += __shfl_xor(ss, 16); ss += __shfl_xor(ss, 32);
                    const float rinv = 1.0f / sqrtf(ss * (1.0f / 64.0f) + LN_EPS);
#pragma unroll
                    for (int bj = 0; bj < 2; ++bj)
#pragma unroll
                        for (int n = 0; n < 2; ++n) v[bj][n] = v[bj][n] * rinv * gv[bj][n];
                }
                if (do_rope) {
                    const int t = (pt - 1) * 256 + r, pos = blk ? (t & 63) : (t >> 6);
                    const f32x4* rp = (const f32x4*)(rope + pos * 32 + 16 * f1);
#pragma unroll
                    for (int n = 0; n < 2; ++n) { const f32x4 p0 = rp[2 * n], p1 = rp[2 * n + 1];
                        const f32x4 lo = v[0][n], hi = v[1][n];
                        const f32x4 cs = {p0[0], p0[2], p1[0], p1[2]}, sn = {p0[1], p0[3], p1[1], p1[3]};
                        v[0][n] = lo * cs - hi * sn; v[1][n] = hi * cs + lo * sn; }
                }
                bf16_t* rowp = dst + (size_t)(rowbase + r) * pitch;
#pragma unroll
                for (int bj = 0; bj < 2; ++bj) { const f32x4 v0 = v[bj][0] * scale, v1 = v[bj][1] * scale;
                    v4u w; w.x = cvt_pk_bf16(v0[0], v0[1]); w.y = cvt_pk_bf16(v0[2], v0[3]); w.z = cvt_pk_bf16(v1[0], v1[1]); w.w = cvt_pk_bf16(v1[2], v1[3]);
                    *(v4u*)(rowp + 16 * bj) = w; }
            }
    }
};

struct SchedMoE {
    int nN, NB, G, c; const LAS int* tab; const v2u* LIST;
    __device__ __forceinline__ bool next(int i, Unit& u) const {
        const int ntiles = __builtin_amdgcn_readfirstlane(tab[32]); const long L = (long)i * G + c; if (L >= (long)ntiles * nN) return false;
        tile_order((int)L, ntiles, nN, u.pm, u.pn);
        const int ln = (int)(threadIdx.x & 63u); const int tq = (ln >= 1 && ln < 32) ? tab[ln] : 0x7fffffff;
        const int e = __builtin_popcountll(__ballot(u.pm >= tq));
        u.e = e; u.r0 = (u.pm - __builtin_amdgcn_readfirstlane(tab[e])) * 256; u.cnt = __builtin_amdgcn_readfirstlane(tab[33 + e]); u.brow = e * NB + u.pn * BM; return true;
    }
    __device__ __forceinline__ unsigned arow_tok(const Unit& u, int r) const { int rr = u.r0 + r; rr = rr < u.cnt ? rr : u.cnt - 1; return LIST[(size_t)u.e * LISTCAP + rr].x >> 2; }
};
__device__ __forceinline__ void moe_build_tab(LAS int* tab, const unsigned* CNT) {
    if (threadIdx.x == 0) { int st = 0; for (int e = 0; e < 32; ++e) { const int c = (int)CNT[e]; tab[e] = st; tab[33 + e] = c; st += (c + 255) >> 8; } tab[32] = st; }
    __syncthreads();
}
struct EpiUp {
    static constexpr bool PERM = true;
    unsigned char* ACT; const float* bup;
    static constexpr bool HAS_INIT = true; struct Init { f32x4 v[2][2]; };
    __device__ __forceinline__ Init init(const Unit& u, int wr, int wc, int fr, int fq) const {
        const float* bg = bup + (size_t)u.e * 2048 + u.pn * 128 + wc * 32 + 8 * fq; Init i; i.v[0][0] = *(const f32x4*)bg; i.v[0][1] = *(const f32x4*)(bg + 4); i.v[1][0] = *(const f32x4*)(bg + 1024) + 1.0f; i.v[1][1] = *(const f32x4*)(bg + 1028) + 1.0f; return i; }
    struct Pre {};
    __device__ __forceinline__ Pre pre(const Unit&, int, int, int, int) const { return Pre{}; }
    __device__ __forceinline__ void operator()(const f32x4 (&acc)[2][2][4][2], const Unit& u, int wr, int wc, int fr, int fq, const Pre&) const {
        const int colt = u.pn * 128 + wc * 32 + 8 * fq;
#pragma unroll
        for (int ai = 0; ai < 2; ++ai)
#pragma unroll
            for (int m = 0; m < 4; ++m) {
                const int row = u.pm * BM + ai * HALF + wr * 64 + m * 16 + fr;
                f32x4 ag[2] = {acc[ai][0][m][0], acc[ai][0][m][1]}, al[2] = {acc[ai][1][m][0], acc[ai][1][m][1]};
                asm volatile("" : "+v"(ag[0]), "+v"(ag[1]), "+v"(al[0]), "+v"(al[1]));
                float o[8];
#pragma unroll
                for (int n = 0; n < 2; ++n)
#pragma unroll
                    for (int j = 0; j < 4; ++j) { const float gl = __builtin_amdgcn_fmed3f(ag[n][j], -3.0e38f, 7.0f); const float l1 = __builtin_amdgcn_fmed3f(al[n][j], -6.0f, 8.0f);
                        o[4 * n + j] = (gl * l1) * __builtin_amdgcn_rcpf(1.0f + __builtin_amdgcn_exp2f(-1.702f * 1.4426950408889634f * gl)); }
                v2u w; w.x = 0u; w.y = 0u;
                w.x = __builtin_amdgcn_cvt_pk_fp8_f32(o[0], o[1], w.x, false); w.x = __builtin_amdgcn_cvt_pk_fp8_f32(o[2], o[3], w.x, true);
                w.y = __builtin_amdgcn_cvt_pk_fp8_f32(o[4], o[5], w.y, false); w.y = __builtin_amdgcn_cvt_pk_fp8_f32(o[6], o[7], w.y, true);
                *(v2u*)(ACT + (size_t)row * 1024 + colt) = w;
            }
    }
};
struct EpiDown {
    static constexpr bool PERM = true;
    bf16_t* YE; const float* bdn; const v2u* LIST;
    static constexpr bool HAS_INIT = true; struct Init { f32x4 v[2][2]; };
    __device__ __forceinline__ Init init(const Unit& u, int wr, int wc, int fr, int fq) const {
        Init i; const float* bb = bdn + (size_t)u.e * 1024 + u.pn * BM + wc * 32 + 8 * fq;
#pragma unroll
        for (int bj = 0; bj < 2; ++bj)
#pragma unroll
            for (int n = 0; n < 2; ++n) i.v[bj][n] = *(const f32x4*)(bb + bj * HALF + 4 * n);
        return i; }
    struct Pre { v2u ent[2][4]; };
    __device__ __forceinline__ Pre pre(const Unit& u, int wr, int wc, int fr, int fq) const {
        Pre p;
#pragma unroll
        for (int ai = 0; ai < 2; ++ai)
#pragma unroll
            for (int m = 0; m < 4; ++m) { const int rr = u.r0 + ai * HALF + wr * 64 + m * 16 + fr; p.ent[ai][m] = LIST[(size_t)u.e * LISTCAP + (rr < u.cnt ? rr : u.cnt - 1)]; }
        return p;
    }
    __device__ __forceinline__ void operator()(const f32x4 (&acc)[2][2][4][2], const Unit& u, int wr, int wc, int fr, int fq, const Pre& P) const {
        const int col0 = u.pn * BM + wc * 32 + 8 * fq;
#pragma unroll
        for (int ai = 0; ai < 2; ++ai)
#pragma unroll
            for (int m = 0; m < 4; ++m) {
                const int rr = u.r0 + ai * HALF + wr * 64 + m * 16 + fr; const bool valid = rr < u.cnt;
                const v2u ent = P.ent[ai][m]; const float gate = __uint_as_float(ent.y);
                unsigned char* rowp = (unsigned char*)YE + (size_t)ent.x * 1024 + col0;
                const float g64 = gate * 64.0f;
#pragma unroll
                for (int bj = 0; bj < 2; ++bj) { f32x4 a0 = acc[ai][bj][m][0], a1 = acc[ai][bj][m][1]; asm volatile("" : "+v"(a0), "+v"(a1));
                    const f32x4 v0 = a0 * g64, v1 = a1 * g64;
                    v2u w; w.x = 0u; w.y = 0u;
                    w.x = __builtin_amdgcn_cvt_pk_fp8_f32(v0[0], v0[1], w.x, false); w.x = __builtin_amdgcn_cvt_pk_fp8_f32(v0[2], v0[3], w.x, true);
                    w.y = __builtin_amdgcn_cvt_pk_fp8_f32(v1[0], v1[1], w.y, false); w.y = __builtin_amdgcn_cvt_pk_fp8_f32(v1[2], v1[3], w.y, true);
                    if (valid) *(v2u*)(rowp + bj * HALF) = w; }
            }
    }
};
}

#include <hip/hip_bf16.h>
#include <cmath>
namespace attn_body {
using bf16=__hip_bfloat16;
using bf16x8=__attribute__((ext_vector_type(8)))short;
using s16x4=__attribute__((ext_vector_type(4)))short;
using f32x16=__attribute__((ext_vector_type(16)))float;
using u32x4=__attribute__((ext_vector_type(4)))unsigned;
constexpr int D=64,QP=512,KP=128,OP=1024,SEQQ=2048,SEQK=2304;
constexpr int NW=8,QBLK=32,QB=QBLK*NW,KVBLK=64,NQB=SEQQ/QB;
constexpr int ATTN_UNIT_ROWS=QB;
__device__ __forceinline__ int crow(int r,int hi){return (r&3)+8*(r>>2)+4*hi;}
#define SBAR() __builtin_amdgcn_sched_barrier(0)
__device__ __forceinline__ void cmask(f32x16&p0,f32x16&p1,int jb,int qrel,int hi){
  const float NEG=-INFINITY; int kb=64*jb+4*hi;
  #pragma unroll
  for(int r=0;r<16;++r){int kv=kb+(r&3)+8*(r>>2); if(kv>qrel)p0[r]=NEG; if(kv+32>qrel)p1[r]=NEG;}
}

constexpr int NSLOT=3, SLOTB=8192;
constexpr int LDS_K=0, LDS_V=NSLOT*SLOTB, LDS_WS=2*NSLOT*SLOTB, LDS_OST=LDS_WS+NW*64*4, LDS_BYTES=LDS_OST+NW*4096;
constexpr float C2=0.125f*1.4426950408889634f;
__device__ __forceinline__ void glds16(const void*gsrc,unsigned lds_dst){unsigned keep;
  asm volatile("s_mov_b32 %0, m0\n\ts_mov_b32 m0, %2\n\ts_nop 0\n\tglobal_load_lds_dwordx4 %1, off\n\ts_mov_b32 m0, %0":"=&s"(keep):"v"(gsrc),"s"(lds_dst):"memory");}
__device__ __forceinline__ float max3f(float a,float b,float c){float r;asm("v_max3_f32 %0, %1, %2, %3":"=v"(r):"v"(a),"v"(b),"v"(c));return r;}
__device__ __forceinline__ float max2f(float a,float b){float r;asm("v_max_f32_e32 %0, %1, %2":"=v"(r):"v"(a),"v"(b));return r;}
__device__ __forceinline__ float fadd_s(float a,float b){float r;asm("v_add_f32_e32 %0, %1, %2":"=v"(r):"v"(a),"v"(b));return r;}
__device__ __forceinline__ float fsub_s(float a,float b){float r;asm("v_sub_f32_e32 %0, %1, %2":"=v"(r):"v"(a),"v"(b));return r;}
typedef float f32x2_t __attribute__((ext_vector_type(2))); typedef __bf16 bf16x2_t __attribute__((ext_vector_type(2)));
__device__ __forceinline__ unsigned cvtpk_s(float lo,float hi){f32x2_t v={lo,hi};bf16x2_t b=__builtin_convertvector(v,bf16x2_t);return __builtin_bit_cast(unsigned,b);}
#define WAIT_BAR(N) asm volatile("s_waitcnt vmcnt(" #N ") lgkmcnt(0)\n\ts_barrier":::"memory")

__device__ __forceinline__ void qkt(f32x16&p0,f32x16&p1,const char*Kslot,const bf16x8*qr,const f32x16&negm,int r32,int hi){
  const char*kb=Kslot+hi*1024+r32*16;
  #pragma unroll
  for(int d0=0;d0<4;++d0){
    const bf16x8 b0=*reinterpret_cast<const bf16x8*>(kb+d0*2048);
    const bf16x8 b1=*reinterpret_cast<const bf16x8*>(kb+d0*2048+512);
    if(d0==0){p0=__builtin_amdgcn_mfma_f32_32x32x16_bf16(b0,qr[0],negm,0,0,0);p1=__builtin_amdgcn_mfma_f32_32x32x16_bf16(b1,qr[0],negm,0,0,0);}
    else{p0=__builtin_amdgcn_mfma_f32_32x32x16_bf16(b0,qr[d0],p0,0,0,0);p1=__builtin_amdgcn_mfma_f32_32x32x16_bf16(b1,qr[d0],p1,0,0,0);}}
}
typedef __attribute__((address_space(3))) const char* lds_cptr;
typedef short v4i16_t __attribute__((ext_vector_type(4)));
__device__ __forceinline__ void kload8(bf16x8*kf,lds_cptr kp){
  kf[0]=*(const __attribute__((address_space(3))) bf16x8*)(kp);      kf[1]=*(const __attribute__((address_space(3))) bf16x8*)(kp+512);
  kf[2]=*(const __attribute__((address_space(3))) bf16x8*)(kp+2048); kf[3]=*(const __attribute__((address_space(3))) bf16x8*)(kp+2560);
  kf[4]=*(const __attribute__((address_space(3))) bf16x8*)(kp+4096); kf[5]=*(const __attribute__((address_space(3))) bf16x8*)(kp+4608);
  kf[6]=*(const __attribute__((address_space(3))) bf16x8*)(kp+6144); kf[7]=*(const __attribute__((address_space(3))) bf16x8*)(kp+6656);
}
__device__ __forceinline__ void kload2(bf16x8*kf,lds_cptr kp,int j){ kf[2*j]=*(const __attribute__((address_space(3))) bf16x8*)(kp+j*2048); kf[2*j+1]=*(const __attribute__((address_space(3))) bf16x8*)(kp+j*2048+512); }
__device__ __forceinline__ s16x4 vtr(lds_cptr p){ return __builtin_bit_cast(s16x4,__builtin_amdgcn_ds_read_tr16_b64_v4i16((__attribute__((address_space(3))) v4i16_t*)p)); }
__device__ __forceinline__ float rowmax(const f32x16&p0,const f32x16&p1){
  float a=max3f(p0[0],p0[1],p1[0]),b=max3f(p0[2],p0[3],p1[1]);a=max3f(a,p1[2],p1[3]);
  #pragma unroll
  for(int r=4;r<16;r+=4){a=max3f(a,p0[r],p0[r+1]);b=max3f(b,p0[r+2],p0[r+3]);a=max3f(a,p1[r],p1[r+1]);b=max3f(b,p1[r+2],p1[r+3]);}
  const float m=max2f(a,b);
  auto rr=__builtin_amdgcn_permlane32_swap(__float_as_uint(m),__float_as_uint(m),false,false);
  return max2f(__uint_as_float(rr[0]),__uint_as_float(rr[1]));
}
__device__ __forceinline__ void pv(f32x16*o,int vb,bf16x8 pa0,bf16x8 pa1,bf16x8 pa2,bf16x8 pa3){
  #pragma unroll
  for(int d0=0;d0<2;++d0){s16x4 lo[4],hi[4];
    #pragma unroll
    for(int ks=0;ks<4;++ks){
      asm volatile("ds_read_b64_tr_b16 %0,%1 offset:%c2":"=&v"(lo[ks]):"v"(vb),"i"(d0*4096+ks*1024):"memory");
      asm volatile("ds_read_b64_tr_b16 %0,%1 offset:%c2":"=&v"(hi[ks]):"v"(vb),"i"(d0*4096+ks*1024+512):"memory");}
    asm volatile("s_waitcnt lgkmcnt(0)":::"memory");SBAR();
    #define PK(k) (bf16x8){lo[k][0],lo[k][1],lo[k][2],lo[k][3],hi[k][0],hi[k][1],hi[k][2],hi[k][3]}
    o[d0]=__builtin_amdgcn_mfma_f32_32x32x16_bf16(pa0,PK(0),o[d0],0,0,0);
    o[d0]=__builtin_amdgcn_mfma_f32_32x32x16_bf16(pa1,PK(1),o[d0],0,0,0);
    o[d0]=__builtin_amdgcn_mfma_f32_32x32x16_bf16(pa2,PK(2),o[d0],0,0,0);
    o[d0]=__builtin_amdgcn_mfma_f32_32x32x16_bf16(pa3,PK(3),o[d0],0,0,0);
    #undef PK
  }
}

#ifndef ATTN_STORE16
#define ATTN_STORE16(p,v) (*(u32x4*)(p)=(v))
#endif
template<int THRL> __device__ __forceinline__ void attn_unit(int b,int h,int qb,const bf16*Q,const bf16*__restrict__ K,const bf16*__restrict__ V,bf16*O,char*shm,float refB){
  const int tid=threadIdx.x,lane=tid&63,r32=lane&31,hi=lane>>5; const int wid=__builtin_amdgcn_readfirstlane(tid>>6);
  const long rowq=(long)b*SEQQ,rowk=(long)b*SEQK; const int q0=qb*QB;
  const bf16*Qw=Q+(rowq+q0+wid*QBLK)*QP+h*D;
  const bf16*Kh=K+rowk*KP+(h>>2)*D,*Vh=V+rowk*KP+(h>>2)*D;
  const unsigned lds0=(unsigned)(uintptr_t)shm;
  float*wsf=(float*)(shm+LDS_WS)+wid*64;
  const bf16*ksrc=Kh+(long)lane*KP+wid*8;
  const bf16*vsrc=Vh+(long)(16*(wid&3)+(lane>>2))*KP+(wid>>2)*32+(lane&3)*8;
  const unsigned kdst=lds0+LDS_K+wid*1024, vdst=lds0+LDS_V+wid*1024;
  #define DMA_K(t,slot) glds16(ksrc+(long)(t)*KVBLK*KP,(unsigned)__builtin_amdgcn_readfirstlane(kdst+(slot)))
  #define DMA_V(t,slot) glds16(vsrc+(long)(t)*KVBLK*KP,(unsigned)__builtin_amdgcn_readfirstlane(vdst+(slot)))
  const int vb0=(int)(lds0+LDS_V)+((lane>>4)&1)*32+(lane&3)*8+(4*hi+((lane&15)>>2))*64;
  const char*Kbase=shm+LDS_K; bf16x8 kf[8];
  const lds_cptr shm3=(lds_cptr)shm; const lds_cptr kp0=shm3+LDS_K+hi*1024+r32*16; const lds_cptr vp0=shm3+LDS_V+((lane>>4)&1)*32+(lane&3)*8+(4*hi+((lane&15)>>2))*64;
  const int NT=SEQK/KVBLK;
  DMA_K(0,0);DMA_V(0,0);DMA_K(1,SLOTB);
  bf16x8 qr[4];
  #pragma unroll
  for(int d0=0;d0<4;++d0)qr[d0]=*reinterpret_cast<const bf16x8*>(&Qw[(long)r32*QP+d0*16+hi*8]);
  float mhat=refB,l_reg=0.f;f32x16 o[2];o[0]=f32x16{};o[1]=f32x16{};f32x16 negm; _Pragma("unroll") for(int r=0;r<16;++r)negm[r]=-refB; asm volatile("":"+v"(negm));

  #define CMASK(P0,P1,t) do{}while(0)
  bool resc=false;
  #define START(P0,P1) do{ resc=false; \
    _Pragma("unroll") for(int r=0;r<16;++r)P0[r]=__builtin_amdgcn_exp2f(P0[r]); }while(0)
  #define RESC() do{ if(resc){ asm volatile("s_waitcnt lgkmcnt(0)":::"memory"); \
      _Pragma("unroll") for(int d_=0;d_<2;++d_) _Pragma("unroll") for(int r=0;r<16;++r)o[d_][r]*=wsf[crow(r,hi)]; } }while(0)
  f32x16 pA0,pA1,pB0,pB1;
  int sl_prev=0,sl_cur=0,sl_next=SLOTB;
  #define ROT() do{sl_prev=sl_cur;sl_cur=sl_next;sl_next=(sl_next==(NSLOT-1)*SLOTB)?0:sl_next+SLOTB;}while(0)
  DMA_K(2,2*SLOTB);
  WAIT_BAR(3);
  qkt(pA0,pA1,Kbase,qr,negm,r32,hi);asm volatile("s_nop 15\n\ts_nop 7":"+v"(pA0),"+v"(pA1));CMASK(pA0,pA1,0);
  START(pA0,pA1);
  _Pragma("unroll") for(int r=0;r<16;++r)pA1[r]=__builtin_amdgcn_exp2f(pA1[r]);
  WAIT_BAR(0);
  DMA_K(3,0);DMA_V(1,SLOTB);
  ROT();
  kload8(kf,kp0+sl_cur);
  WAIT_BAR(2);
  s16x4 vlo[8],vhi[8]; u32x4 pw0,pw1,pw2,pw3;
  #define PKW(P,B) cvtpk_s(P[B],P[B+1])
  #define PAF(k) __builtin_bit_cast(bf16x8,pw##k)
  #define VFR(i) (bf16x8){vlo[i][0],vlo[i][1],vlo[i][2],vlo[i][3],vhi[i][0],vhi[i][1],vhi[i][2],vhi[i][3]}
  #define PIN(x) asm volatile("":"+v"(x))
  #define MX3(a,b,c) __builtin_fmaxf(__builtin_fmaxf((a),(b)),(c))
  #define GAPA(MF,A0,A1,A2,A3,W0,W1,PW) do{ MF; sacc+=A0; sacc+=A1; sacc+=A2; sacc+=A3; PIN(sacc); W0; W1; PIN(PW); SBAR(); }while(0)
  #define EX(v) __builtin_amdgcn_exp2f(v)
  #define GAPB(MF,X,B) do{ MF; X[B]=EX(X[B]); X[B+1]=EX(X[B+1]); X[B+2]=EX(X[B+2]); X[B+3]=EX(X[B+3]); PIN(X); SBAR(); }while(0)
  #define VRD(i) do{ vlo[i]=vtr(vp_+(((i)>>2)*4096+((i)&3)*1024)); vhi[i]=vtr(vp_+(((i)>>2)*4096+((i)&3)*1024+512)); }while(0)
  #define KRD(G,j) do{ if(G){ kload2(kf,kp0+sl_next,j); SBAR(); } }while(0)
  #define STEP(C0,C1,P0,P1,t,GK,GV,GL) do{ SBAR(); \
    const lds_cptr vp_=vp0+sl_prev; \
    VRD(0); SBAR(); float sacc=(P0[0]+P0[1]); \
    GAPA(C0=__builtin_amdgcn_mfma_f32_32x32x16_bf16(kf[0],qr[0],negm,0,0,0), P0[2],P0[3],P0[4],P0[5],     pw0[0]=PKW(P0,0), pw0[1]=PKW(P0,2), pw0); \
    VRD(4); SBAR(); GAPA(C1=__builtin_amdgcn_mfma_f32_32x32x16_bf16(kf[1],qr[0],negm,0,0,0), P0[6],P0[7],P0[8],P0[9],     pw0[2]=PKW(P0,4), pw0[3]=PKW(P0,6), pw0); \
    VRD(1); SBAR(); GAPA(C0=__builtin_amdgcn_mfma_f32_32x32x16_bf16(kf[2],qr[1],C0,0,0,0),   P0[10],P0[11],P0[12],P0[13], pw1[0]=PKW(P0,8), pw1[1]=PKW(P0,10), pw1); \
    VRD(5); SBAR(); GAPA(C1=__builtin_amdgcn_mfma_f32_32x32x16_bf16(kf[3],qr[1],C1,0,0,0),   P0[14],P0[15],P1[0],P1[1],   pw1[2]=PKW(P0,12),pw1[3]=PKW(P0,14), pw1); \
    VRD(2); SBAR(); GAPA(C0=__builtin_amdgcn_mfma_f32_32x32x16_bf16(kf[4],qr[2],C0,0,0,0),   P1[2],P1[3],P1[4],P1[5],     pw2[0]=PKW(P1,0), pw2[1]=PKW(P1,2), pw2); \
    VRD(6); SBAR(); GAPA(C1=__builtin_amdgcn_mfma_f32_32x32x16_bf16(kf[5],qr[2],C1,0,0,0),   P1[6],P1[7],P1[8],P1[9],     pw2[2]=PKW(P1,4), pw2[3]=PKW(P1,6), pw2); \
    VRD(3); SBAR(); GAPA(C0=__builtin_amdgcn_mfma_f32_32x32x16_bf16(kf[6],qr[3],C0,0,0,0),   P1[10],P1[11],P1[12],P1[13], pw3[0]=PKW(P1,8), pw3[1]=PKW(P1,10), pw3); \
    VRD(7); SBAR(); GAPA(C1=__builtin_amdgcn_mfma_f32_32x32x16_bf16(kf[7],qr[3],C1,0,0,0),   P1[14],P1[15],0.f,0.f,       pw3[2]=PKW(P1,12),pw3[3]=PKW(P1,14), pw3); \
    l_reg+=sacc; \
    if(GK){DMA_K((t)+3,sl_cur);} if(GV){DMA_V((t)+1,sl_next);} \
    CMASK(C0,C1,t); \
    resc=false; \
    SBAR(); \
    GAPB(o[0]=__builtin_amdgcn_mfma_f32_32x32x16_bf16(PAF(0),VFR(0),o[0],0,0,0), C0,0); \
    GAPB(o[1]=__builtin_amdgcn_mfma_f32_32x32x16_bf16(PAF(0),VFR(4),o[1],0,0,0), C0,4); \
    KRD(GL,0); GAPB(o[0]=__builtin_amdgcn_mfma_f32_32x32x16_bf16(PAF(1),VFR(1),o[0],0,0,0), C0,8); \
    KRD(GL,1); GAPB(o[1]=__builtin_amdgcn_mfma_f32_32x32x16_bf16(PAF(1),VFR(5),o[1],0,0,0), C0,12); \
    KRD(GL,2); GAPB(o[0]=__builtin_amdgcn_mfma_f32_32x32x16_bf16(PAF(2),VFR(2),o[0],0,0,0), C1,0); \
    KRD(GL,3); GAPB(o[1]=__builtin_amdgcn_mfma_f32_32x32x16_bf16(PAF(2),VFR(6),o[1],0,0,0), C1,4); \
    GAPB(o[0]=__builtin_amdgcn_mfma_f32_32x32x16_bf16(PAF(3),VFR(3),o[0],0,0,0), C1,8); \
    GAPB(o[1]=__builtin_amdgcn_mfma_f32_32x32x16_bf16(PAF(3),VFR(7),o[1],0,0,0), C1,12); \
    }while(0)
  int t=1;
  #undef CMASK
  #define CMASK(P0,P1,t) do{}while(0)
  for(;t+5<NT;t+=2){
    STEP(pB0,pB1,pA0,pA1,t,true,true,true);     WAIT_BAR(2); RESC(); ROT();
    STEP(pA0,pA1,pB0,pB1,t+1,true,true,true);   WAIT_BAR(2); RESC(); ROT();
  }
  #undef CMASK
  #define CMASK(P0,P1,t) do{}while(0)
  #define ENDW(tt) do{ if((tt)+3<NT){WAIT_BAR(2);} else if((tt)+2<NT){WAIT_BAR(1);} else {WAIT_BAR(0);} }while(0)
  for(;t+1<NT;t+=2){
    STEP(pB0,pB1,pA0,pA1,t,(t+3<NT),(t+1<NT),(t+1<NT));       ENDW(t);   RESC(); ROT();
    STEP(pA0,pA1,pB0,pB1,t+1,(t+4<NT),(t+2<NT),(t+2<NT));     ENDW(t+1); RESC(); ROT();
  }
  STEP(pB0,pB1,pA0,pA1,NT-1,false,false,false); RESC();
  { float sacc=pB0[0]+pB0[1]; _Pragma("unroll") for(int r=2;r<16;++r)sacc+=pB0[r]; _Pragma("unroll") for(int r=0;r<16;++r)sacc+=pB1[r]; l_reg+=sacc;
    pw0=(u32x4){PKW(pB0,0),PKW(pB0,2),PKW(pB0,4),PKW(pB0,6)};pw1=(u32x4){PKW(pB0,8),PKW(pB0,10),PKW(pB0,12),PKW(pB0,14)};pw2=(u32x4){PKW(pB1,0),PKW(pB1,2),PKW(pB1,4),PKW(pB1,6)};pw3=(u32x4){PKW(pB1,8),PKW(pB1,10),PKW(pB1,12),PKW(pB1,14)};
    SBAR(); pv(o,vb0+sl_cur,PAF(0),PAF(1),PAF(2),PAF(3)); }
  #undef PKW
  #undef PAF
  #undef VFR
  #undef PIN
  #undef MX3
  #undef GAPA
  #undef GAPB
  #undef EX
  #undef VRD
  #undef KRD
  #undef STEP
  #undef ENDW
  {auto rr=__builtin_amdgcn_permlane32_swap(__float_as_uint(l_reg),__float_as_uint(l_reg),false,false);l_reg=__uint_as_float(rr[0])+__uint_as_float(rr[1]);}
  if(hi==0)wsf[32+r32]=l_reg;asm volatile("s_waitcnt lgkmcnt(0)":::"memory");
  float rli[16];
  #pragma unroll
  for(int r=0;r<16;++r)rli[r]=__builtin_amdgcn_rcpf(wsf[32+crow(r,hi)]);
  bf16*Ow=O+(rowq+q0+wid*QBLK)*OP+h*D;
  { bf16*stg=(bf16*)(shm+LDS_OST)+wid*2048;
    #pragma unroll
    for(int r=0;r<16;++r){const int orow=crow(r,hi);
      #pragma unroll
      for(int d0=0;d0<2;++d0)stg[orow*64+d0*32+r32]=__float2bfloat16(o[d0][r]*rli[r]);}
    asm volatile("s_waitcnt lgkmcnt(0)":::"memory");
    #pragma unroll
    for(int i=0;i<4;++i){const int row=i*8+(lane>>3),ch=lane&7; const u32x4 v=*(const u32x4*)(stg+row*64+ch*8); ATTN_STORE16(Ow+(long)row*OP+ch*8,v);} }
  asm volatile("s_waitcnt lgkmcnt(0)\n\ts_barrier":::"memory");
  #undef DMA_K
  #undef DMA_V
  #undef CMASK
  #undef START
  #undef RESC
  #undef ROT
}
constexpr int ATTN_LDS_BYTES=LDS_BYTES;
struct AttnTensors { const bf16* Q; const bf16* K; const bf16* V; bf16* O; };
struct AttnUnit { int b, h, qb; };
struct StaticOrder {
  int vcu;
  __device__ __forceinline__ explicit StaticOrder(int grid,int block):vcu((block%8)*(grid/8)+block/8){}
  __device__ __forceinline__ bool next(int i,AttnUnit&u)const{ const int p=8*i+(vcu>>5); if(p>=32)return false; const int w=vcu&31; u.b=p>>1; u.h=(p&1)*4+(w>>3); u.qb=w&7; return true; }
};
template<class Sched,int THRL=8> __device__ __forceinline__ void attn_phase(char*lds,const AttnTensors&T,const Sched&S){
  AttnUnit u;
  for(int i=0;S.next(i,u);++i){ attn_unit<THRL>(u.b,u.h,u.qb,T.Q,T.K,T.V,T.O,lds,64.0f); }
}
#undef SBAR
#undef WAIT_BAR
}

namespace ret {
typedef short bf16x8 __attribute__((ext_vector_type(8)));
typedef short s16x4 __attribute__((ext_vector_type(4)));
typedef float f32x16 __attribute__((ext_vector_type(16)));
constexpr int VP = 160, KPT = 48;
constexpr int VB = 128 * VP * 2, KB = 128 * KPT * 2, BUF = VB + KB;
__device__ __forceinline__ int crow(int r, int hi) { return (r & 3) + 8 * (r >> 2) + 4 * hi; }
__device__ __forceinline__ s16x4 trd(const LAS unsigned char* p) { return __builtin_bit_cast(s16x4, __builtin_amdgcn_ds_read_tr16_b64_v4i16((LAS s16x4*)p)); }
__device__ __forceinline__ bf16x8 cat(s16x4 a, s16x4 b) { return (bf16x8){a[0], a[1], a[2], a[3], b[0], b[1], b[2], b[3]}; }
__device__ __forceinline__ v4u scale8(v4u w, float s) {
    v4u o; o.x = pk2(bflo(w.x) * s, bfhi(w.x) * s); o.y = pk2(bflo(w.y) * s, bfhi(w.y) * s); o.z = pk2(bflo(w.z) * s, bfhi(w.z) * s); o.w = pk2(bflo(w.w) * s, bfhi(w.w) * s); return o;
}
constexpr int RAP = 96, RAB = 128 * RAP * 2, RABUF = 2 * RAB;
__device__ __forceinline__ void state_unit(int b, int h, int dir, int dvh, const bf16_t* RK, const bf16_t* RV, bf16_t* ST, float lg2, LAS unsigned char* lds) {
    const int tid = threadIdx.x, lane = tid & 63, wid = __builtin_amdgcn_readfirstlane(tid >> 6), r32 = lane & 31, hi = lane >> 5, dvt = wid & 1, dkt = (wid >> 1) & 1;
    const float g128 = exp2f(lg2 * 128.0f);
    const int prow = tid >> 3, pc8 = tid & 7;
    const float kw0 = dir ? exp2f(lg2 * (float)prow) : exp2f(lg2 * (float)(127 - prow)), kw1 = dir ? exp2f(lg2 * (float)(prow + 64)) : exp2f(lg2 * (float)(63 - prow));
    v4u vreg[2], kreg[2];
    auto chunk_of = [&](int s) { return dir ? (s == 0 ? 1 : (s == 1 ? 0 : 19 - s)) : s; };
    auto load = [&](int s) {
        const size_t urow = (size_t)b * SU + (size_t)chunk_of(s) * 128;
#pragma unroll
        for (int i = 0; i < 2; ++i) { vreg[i] = *(const v4u*)(RV + (urow + prow + 64 * i) * 512 + h * 128 + dvh * 64 + pc8 * 8); kreg[i] = *(const v4u*)(RK + (urow + prow + 64 * i) * 256 + h * 64 + pc8 * 8); }
    };
    load(0);
    f32x16 acc = {};
    const int gq = lane >> 4, colblk = gq & 1, q4 = (lane >> 2) & 3, p4 = lane & 3;
    for (int s = 0; s < 18; ++s) {
        LAS unsigned char* buf = lds + (s & 1) * RABUF;
#pragma unroll
        for (int i = 0; i < 2; ++i) { *(LAS v4u*)(buf + (prow + 64 * i) * (RAP * 2) + pc8 * 16) = vreg[i]; *(LAS v4u*)(buf + RAB + (prow + 64 * i) * (RAP * 2) + pc8 * 16) = scale8(kreg[i], i ? kw1 : kw0); }
        __syncthreads();
        if (s + 1 < 18) load(s + 1);
        if (wid < 4) {
            if (s >= 2) {
                const int n = dir ? 17 - s : s - 2;
                bf16_t* st = ST + ((((size_t)b * 4 + h) * 2 + dir) * 16 + n) * (128 * 64) + dkt * 32 + r32;
#pragma unroll
                for (int r = 0; r < 16; ++r) st[(size_t)(64 * dvh + 32 * dvt + crow(r, hi)) * 64] = (bf16_t)f2bf(acc[r]);
            }
            if (s < 17) {
#pragma unroll
                for (int r = 0; r < 16; ++r) acc[r] *= g128;
                const LAS unsigned char* va = buf + (8 * hi + q4) * (RAP * 2) + (32 * dvt + 16 * colblk + 4 * p4) * 2;
                const LAS unsigned char* ka = buf + RAB + (8 * hi + q4) * (RAP * 2) + (32 * dkt + 16 * colblk + 4 * p4) * 2;
#pragma unroll
                for (int ks = 0; ks < 8; ++ks) {
                    const bf16x8 af = cat(trd(va + ks * 16 * RAP * 2), trd(va + (ks * 16 + 4) * RAP * 2));
                    const bf16x8 bfm = cat(trd(ka + ks * 16 * RAP * 2), trd(ka + (ks * 16 + 4) * RAP * 2));
                    acc = __builtin_amdgcn_mfma_f32_32x32x16_bf16(af, bfm, acc, 0, 0, 0);
                }
            }
        }
    }
    __syncthreads();
}
constexpr int QP2 = 72, GP2 = 136;
constexpr int OFF_Q = VB, OFF_K = OFF_Q + 128 * QP2 * 2, OFF_G = OFF_K + 128 * QP2 * 2, OFF_RED = OFF_G + 128 * GP2 * 2;
struct OutRegs { v4u vv[4], qq[2], kk[2]; };
__device__ __forceinline__ void out_load(OutRegs& R, int u, const bf16_t* RQ, const bf16_t* RK, const bf16_t* RV, const bf16_t* RG) {
    const int tid = threadIdx.x, n = u & 15, h = (u >> 4) & 3, b = u >> 6;
    const size_t m0 = (size_t)b * SEQ + 128 * n, u0 = (size_t)b * SU + CTX + 128 * n;
#pragma unroll
    for (int i = 0; i < 4; ++i) { const int pc = tid + 512 * i; R.vv[i] = *(const v4u*)(RV + (u0 + (pc >> 4)) * 512 + h * 128 + (pc & 15) * 8); }
#pragma unroll
    for (int i = 0; i < 2; ++i) { const int pc = tid + 512 * i; R.qq[i] = *(const v4u*)(RQ + (m0 + (pc >> 3)) * 256 + h * 64 + (pc & 7) * 8); R.kk[i] = *(const v4u*)(RK + (u0 + (pc >> 3)) * 256 + h * 64 + (pc & 7) * 8); }
}
__device__ __forceinline__ void out_unit(OutRegs& R, int u, int unext, const bf16_t* RQ, const bf16_t* RK, const bf16_t* RV, const bf16_t* RG, const bf16_t* ST, const float* gng, const float* gnb, const float* ldf, const float* ldb, bf16_t* MIX, LAS unsigned char* lds) {
    const int n = u & 15, h = (u >> 4) & 3, b = u >> 6; const float lgf = ldf[h] * 1.4426950408889634f, lgb = ldb[h] * 1.4426950408889634f;
    const int tid = threadIdx.x, lane = tid & 63, wid = __builtin_amdgcn_readfirstlane(tid >> 6), r32 = lane & 31, hi = lane >> 5, rg = wid & 3, dvh = wid >> 2;
    const size_t m0 = (size_t)b * SEQ + 128 * n, u0 = (size_t)b * SU + CTX + 128 * n;
    LAS float* red = (LAS float*)(lds + OFF_RED);
    {
        __syncthreads();
#pragma unroll
        for (int i = 0; i < 4; ++i) { const int pc = tid + 512 * i; *(LAS v4u*)(lds + (pc >> 4) * (VP * 2) + (pc & 15) * 16) = R.vv[i]; }
#pragma unroll
        for (int i = 0; i < 2; ++i) { const int pc = tid + 512 * i; *(LAS v4u*)(lds + OFF_Q + (pc >> 3) * (QP2 * 2) + (pc & 7) * 16) = R.qq[i]; *(LAS v4u*)(lds + OFF_K + (pc >> 3) * (QP2 * 2) + (pc & 7) * 16) = R.kk[i]; }
    }
    __syncthreads();
    out_load(R, unext >= 0 ? unext : u, RQ, RK, RV, RG);
    bf16x8 qf[4];
#pragma unroll
    for (int ks = 0; ks < 4; ++ks) qf[ks] = *(const LAS bf16x8*)(lds + OFF_Q + (32 * rg + r32) * (QP2 * 2) + (16 * ks + 8 * hi) * 2);
    f32x16 st[4];
#pragma unroll
    for (int kt = 0; kt < 4; ++kt) { st[kt] = (f32x16){};
#pragma unroll
        for (int ks = 0; ks < 4; ++ks) { const bf16x8 kf = *(const LAS bf16x8*)(lds + OFF_K + (32 * kt + r32) * (QP2 * 2) + (16 * ks + 8 * hi) * 2); st[kt] = __builtin_amdgcn_mfma_f32_32x32x16_bf16(kf, qf[ks], st[kt], 0, 0, 0); } }
    const int c = 32 * rg + r32;
    bf16x8 pa[4][2];
#pragma unroll
    for (int kt = 0; kt < 4; ++kt) {
#pragma unroll
        for (int r = 0; r < 16; ++r) { const int d = c - (32 * kt + crow(r, hi)); const float w = d > 0 ? __builtin_amdgcn_exp2f(lgf * (float)d) : (d < 0 ? __builtin_amdgcn_exp2f(lgb * (float)(-d)) : 2.0f); st[kt][r] *= w; }
#pragma unroll
        for (int s2 = 0; s2 < 2; ++s2) { v4u w; w.x = pk2(st[kt][8 * s2], st[kt][8 * s2 + 1]); w.y = pk2(st[kt][8 * s2 + 2], st[kt][8 * s2 + 3]); w.z = pk2(st[kt][8 * s2 + 4], st[kt][8 * s2 + 5]); w.w = pk2(st[kt][8 * s2 + 6], st[kt][8 * s2 + 7]); pa[kt][s2] = __builtin_bit_cast(bf16x8, w); }
    }
    asm volatile("" ::: "memory");
    v4u gg[4];
#pragma unroll
    for (int i = 0; i < 4; ++i) { const int pc = tid + 512 * i; gg[i] = *(const v4u*)(RG + (m0 + (pc >> 4)) * 512 + h * 128 + (pc & 15) * 8); }
    f32x16 ot[2] = {(f32x16){}, (f32x16){}};
    const int gq = lane >> 4, colblk = gq & 1, q4 = (lane >> 2) & 3, p4 = lane & 3;
#pragma unroll
    for (int dt = 0; dt < 2; ++dt) {
        const LAS unsigned char* va = lds + (4 * hi + q4) * (VP * 2) + (64 * dvh + 32 * dt + 16 * colblk + 4 * p4) * 2;
#pragma unroll
        for (int kt = 0; kt < 4; ++kt)
#pragma unroll
            for (int s2 = 0; s2 < 2; ++s2) { const int kb = 32 * kt + 16 * s2; const bf16x8 vf = cat(trd(va + kb * VP * 2), trd(va + (kb + 8) * VP * 2)); ot[dt] = __builtin_amdgcn_mfma_f32_32x32x16_bf16(vf, pa[kt][s2], ot[dt], 0, 0, 0); }
    }
    {
        const float decf = __builtin_amdgcn_exp2f(lgf * (float)(c + 1)), decb = __builtin_amdgcn_exp2f(lgb * (float)(128 - c));
        const bf16_t* sf = ST + ((((size_t)b * 4 + h) * 2 + 0) * 16 + n) * (128 * 64); const bf16_t* sb = sf + (size_t)16 * 128 * 64;
#pragma unroll
        for (int ks = 0; ks < 4; ++ks) {
            const v4u qw = __builtin_bit_cast(v4u, qf[ks]); const bf16x8 qdf = __builtin_bit_cast(bf16x8, scale8(qw, decf)), qdb = __builtin_bit_cast(bf16x8, scale8(qw, decb));
#pragma unroll
            for (int dt = 0; dt < 2; ++dt) { const size_t so = (size_t)(64 * dvh + 32 * dt + r32) * 64 + 16 * ks + 8 * hi;
                ot[dt] = __builtin_amdgcn_mfma_f32_32x32x16_bf16(*(const bf16x8*)(sf + so), qdf, ot[dt], 0, 0, 0);
                ot[dt] = __builtin_amdgcn_mfma_f32_32x32x16_bf16(*(const bf16x8*)(sb + so), qdb, ot[dt], 0, 0, 0); }
        }
    }
#pragma unroll
    for (int i = 0; i < 4; ++i) { const int pc = tid + 512 * i; *(LAS v4u*)(lds + OFF_G + (pc >> 4) * (GP2 * 2) + (pc & 15) * 16) = gg[i]; }
    float s1 = 0.f;
#pragma unroll
    for (int dt = 0; dt < 2; ++dt)
#pragma unroll
        for (int r = 0; r < 16; ++r) s1 += ot[dt][r];
    s1 += __shfl_xor(s1, 32);
    if (hi == 0) red[wid * 32 + r32] = s1;
    __syncthreads();
    const float mu = (red[wid * 32 + r32] + red[(wid ^ 4) * 32 + r32]) * (1.0f / 128.0f);
    float s2 = 0.f;
#pragma unroll
    for (int dt = 0; dt < 2; ++dt)
#pragma unroll
        for (int r = 0; r < 16; ++r) { const float d = ot[dt][r] - mu; s2 = fmaf(d, d, s2); }
    s2 += __shfl_xor(s2, 32);
    __syncthreads();
    if (hi == 0) red[wid * 32 + r32] = s2;
    __syncthreads();
    const float rs = 1.0f / sqrtf((red[wid * 32 + r32] + red[(wid ^ 4) * 32 + r32]) * (1.0f / 128.0f) + LN_EPS);
    LAS unsigned char* grow = lds + OFF_G + (32 * rg + r32) * (GP2 * 2);
#pragma unroll
    for (int dt = 0; dt < 2; ++dt)
#pragma unroll
        for (int rq = 0; rq < 4; ++rq) {
            const int dv = 64 * dvh + 32 * dt + 8 * rq + 4 * hi;
            const f32x4 gg = *(const f32x4*)(gng + h * 128 + dv), gb = *(const f32x4*)(gnb + h * 128 + dv);
            const v2u gw = *(const LAS v2u*)(grow + dv * 2);
            const float g0 = bflo(gw.x), g1 = bfhi(gw.x), g2 = bflo(gw.y), g3 = bfhi(gw.y);
            const float y0 = ((ot[dt][4 * rq] - mu) * rs * gg[0] + gb[0]) * (g0 * __builtin_amdgcn_rcpf(1.0f + __builtin_amdgcn_exp2f(-1.4426950408889634f * g0)));
            const float y1 = ((ot[dt][4 * rq + 1] - mu) * rs * gg[1] + gb[1]) * (g1 * __builtin_amdgcn_rcpf(1.0f + __builtin_amdgcn_exp2f(-1.4426950408889634f * g1)));
            const float y2 = ((ot[dt][4 * rq + 2] - mu) * rs * gg[2] + gb[2]) * (g2 * __builtin_amdgcn_rcpf(1.0f + __builtin_amdgcn_exp2f(-1.4426950408889634f * g2)));
            const float y3 = ((ot[dt][4 * rq + 3] - mu) * rs * gg[3] + gb[3]) * (g3 * __builtin_amdgcn_rcpf(1.0f + __builtin_amdgcn_exp2f(-1.4426950408889634f * g3)));
            v2u w; w.x = pk2(y0, y1); w.y = pk2(y2, y3);
            *(LAS v2u*)(grow + dv * 2) = w;
        }
    __syncthreads();
#pragma unroll
    for (int i = 0; i < 4; ++i) { const int pc = tid + 512 * i; *(v4u*)(MIX + (m0 + (pc >> 4)) * DM + h * 128 + (pc & 15) * 8) = *(const LAS v4u*)(lds + OFF_G + (pc >> 4) * (GP2 * 2) + (pc & 15) * 16); }
}
}

struct Args {
    const float* in[26]; float* out; unsigned char* ws; int ph_lo, ph_hi, li, pad;
};
enum { I_X = 0, I_C, I_CTX, I_CCTX, I_LNING, I_LNINB, I_WADA, I_BADA, I_WIN, I_LDF, I_LDB, I_GNG, I_GNB, I_QNG, I_KNG, I_WO, I_LN1G, I_LN1B, I_RW, I_RB, I_WUP, I_BUP, I_WDN, I_BDN, I_LN2G, I_LN2B };

struct Frame {
    LAS unsigned char* lds;
    unsigned* ctl;
    int tid, lane, wave, G, gtid, nthreads, gw, ngw;
};

constexpr int LDS_BYTES = 147456, MISC_OFF = 147456 - 1024;

__device__ __forceinline__ int phys_in(int lc) { const int pn = lc >> 8, wc = (lc >> 6) & 3, d = lc & 63; const int blk = d >> 5, bj = (d >> 4) & 1, f1 = (d >> 3) & 1, n = (d >> 2) & 1, j = d & 3;
    return pn * 256 + 128 * bj + 32 * wc + 16 * n + 4 * (2 * blk + f1) + j; }
__device__ __forceinline__ int phys_up(int c) { return 256 * ((c & 1023) >> 7) + 128 * (c >> 10) + (c & 127); }

__device__ __forceinline__ void transpose_load(f32x4 (&v)[16], const float* W, int K, int N, int item, int lane) {
    const int nkb = K / 64, kb = item % nkb, nb = item / nkb, k0 = 64 * kb, n0 = 64 * nb;
    const float* src = W + (size_t)(k0 + (lane >> 4)) * N + n0 + (lane & 15) * 4;
#pragma unroll
    for (int i = 0; i < 16; ++i) v[i] = __builtin_nontemporal_load((const f32x4*)(src + (size_t)(4 * i) * N));
}
__device__ __forceinline__ void transpose_write(const f32x4 (&v)[16], LAS float* scr, int lane) {
#pragma unroll
    for (int i = 0; i < 16; ++i) { LAS float* d = scr + (4 * i + (lane >> 4)) * 65 + (lane & 15) * 4; d[0] = v[i][0]; d[1] = v[i][1]; d[2] = v[i][2]; d[3] = v[i][3]; }
    asm volatile("s_waitcnt lgkmcnt(0)" ::: "memory");
}
template <int MAP, bool F8> __device__ __forceinline__ void transpose_out(int K, void* WT, LAS float* scr, int item, int lane) {
    const int nkb = K / 64, kb = item % nkb, nb = item / nkb, k0 = 64 * kb, n0 = 64 * nb;
    const int c = lane & 7;
#pragma unroll
    for (int j = 0; j < 8; ++j) { const int n = (lane >> 3) + 8 * j; const LAS float* s = scr + (8 * c) * 65 + n;
        const int ln = n0 + n; const int pr = MAP == 1 ? phys_in(ln) : (MAP == 2 ? phys_up(ln) : ln);
        if constexpr (F8) { v2u q; q.x = 0u; q.y = 0u;
            q.x = __builtin_amdgcn_cvt_pk_fp8_f32(64.f * s[0 * 65], 64.f * s[1 * 65], q.x, false); q.x = __builtin_amdgcn_cvt_pk_fp8_f32(64.f * s[2 * 65], 64.f * s[3 * 65], q.x, true);
            q.y = __builtin_amdgcn_cvt_pk_fp8_f32(64.f * s[4 * 65], 64.f * s[5 * 65], q.y, false); q.y = __builtin_amdgcn_cvt_pk_fp8_f32(64.f * s[6 * 65], 64.f * s[7 * 65], q.y, true);
            *(v2u*)((unsigned char*)WT + (size_t)pr * K + k0 + 8 * c) = q; }
        else { v4u o; o.x = pk2(s[0 * 65], s[1 * 65]); o.y = pk2(s[2 * 65], s[3 * 65]); o.z = pk2(s[4 * 65], s[5 * 65]); o.w = pk2(s[6 * 65], s[7 * 65]);
            *(v4u*)((bf16_t*)WT + (size_t)pr * K + k0 + 8 * c) = o; } }
    asm volatile("s_waitcnt lgkmcnt(0)" ::: "memory");
}
__device__ __forceinline__ void transpose8_write(const f32x4 (&v)[16], LAS unsigned* T, int lane) {
#pragma unroll
    for (int i = 0; i < 16; ++i) { unsigned w = 0u; w = __builtin_amdgcn_cvt_pk_fp8_f32(64.f * v[i][0], 64.f * v[i][1], w, false); w = __builtin_amdgcn_cvt_pk_fp8_f32(64.f * v[i][2], 64.f * v[i][3], w, true);
        T[(4 * i + (lane >> 4)) * 17 + (lane & 15)] = w; }
    asm volatile("s_waitcnt lgkmcnt(0)" ::: "memory");
}
template <int MAP> __device__ __forceinline__ void transpose8_out(int K, unsigned char* WT, const LAS unsigned* T, int item, int lane) {
    const int nkb = K / 64, kb = item % nkb, nb = item / nkb, k0 = 64 * kb, n0 = 64 * nb;
    const int c = lane & 7, ng2 = lane >> 3;
#pragma unroll
    for (int j = 0; j < 2; ++j) { const int ng = ng2 + 8 * j; unsigned d[8];
#pragma unroll
        for (int i = 0; i < 8; ++i) d[i] = T[(8 * c + i) * 17 + ng];
        unsigned r[2][4];
#pragma unroll
        for (int h = 0; h < 2; ++h) { const unsigned d0 = d[4 * h], d1 = d[4 * h + 1], d2 = d[4 * h + 2], d3 = d[4 * h + 3];
            const unsigned t0 = __builtin_amdgcn_perm(d1, d0, 0x05010400u), t1 = __builtin_amdgcn_perm(d1, d0, 0x07030602u), t2 = __builtin_amdgcn_perm(d3, d2, 0x05010400u), t3 = __builtin_amdgcn_perm(d3, d2, 0x07030602u);
            r[h][0] = __builtin_amdgcn_perm(t2, t0, 0x05040100u); r[h][1] = __builtin_amdgcn_perm(t2, t0, 0x07060302u); r[h][2] = __builtin_amdgcn_perm(t3, t1, 0x05040100u); r[h][3] = __builtin_amdgcn_perm(t3, t1, 0x07060302u); }
#pragma unroll
        for (int q = 0; q < 4; ++q) { const int ln = n0 + 4 * ng + q; const int pr = MAP == 2 ? phys_up(ln) : ln; v2u o; o.x = r[0][q]; o.y = r[1][q];
            *(v2u*)(WT + (size_t)pr * K + k0 + 8 * c) = o; } }
    asm volatile("s_waitcnt lgkmcnt(0)" ::: "memory");
}
template <int MAP, bool F8> __device__ __forceinline__ void transpose_item(const float* W, int K, int N, void* WT, LAS float* scr, int item, int lane) {
    f32x4 v[16]; transpose_load(v, W, K, N, item, lane); transpose_write(v, scr, lane); transpose_out<MAP, F8>(K, WT, scr, item, lane);
}

__device__ __forceinline__ void p0_prologue(const Args& a, Frame& F) {
    unsigned char* ws = a.ws;
    float* ADA = (float*)(ws + WS_ADA); float* ROPE = (float*)(ws + WS_ROPE);
    for (int idx = F.gtid; idx < 64 * 16; idx += F.nthreads) {
        const int pos = idx >> 4, i = idx & 15;
        const float inv = exp2f(-(float)i * (13.287712379549449f / 16.0f));
        const float ang = (float)pos * inv;
        ROPE[idx * 2] = cosf(ang); ROPE[idx * 2 + 1] = sinf(ang);
    }
    { bf16_t* RWT = (bf16_t*)(ws + WS_RWT);
      for (int idx = F.gtid; idx < 32 * 1024; idx += F.nthreads) { const int e = idx >> 10, k = idx & 1023; const float w = a.in[I_RW][k * 32 + e]; const unsigned hi = f2bf(w); RWT[idx] = (bf16_t)hi; RWT[32768 + idx] = (bf16_t)f2bf(w - bf2f(hi)); } }
    for (int tile = blockIdx.x; tile < 192; tile += F.G) {
        LAS float* SL = (LAS float*)F.lds;
        LAS float* PT = (LAS float*)(F.lds + 17 * 4096);
        for (int i = F.tid; i < 17 * 1024; i += NTHR) { const int r = i >> 10, k = i & 1023; const float s = r < 16 ? a.in[I_C][r * 1024 + k] : a.in[I_CCTX][k]; SL[i] = s / (1.0f + __expf(-s)); }
        __syncthreads();
        const int col = F.lane & 31, kh = F.lane >> 5; const float* w = a.in[I_WADA] + tile * 32 + col; const int k0 = F.wave * 128 + 64 * kh;
        float acc[17];
#pragma unroll
        for (int r = 0; r < 17; ++r) acc[r] = 0.f;
#pragma unroll 1
        for (int kb = 0; kb < 64; kb += 32) {
            float wv[32];
#pragma unroll
            for (int q = 0; q < 32; ++q) wv[q] = __builtin_nontemporal_load(w + (size_t)(k0 + kb + q) * 6144);
#pragma unroll
            for (int k4 = 0; k4 < 32; k4 += 4)
#pragma unroll
                for (int r = 0; r < 17; ++r) { const f32x4 s4 = *(const LAS f32x4*)(SL + r * 1024 + k0 + kb + k4); acc[r] = fmaf(s4[0], wv[k4], acc[r]); acc[r] = fmaf(s4[1], wv[k4 + 1], acc[r]); acc[r] = fmaf(s4[2], wv[k4 + 2], acc[r]); acc[r] = fmaf(s4[3], wv[k4 + 3], acc[r]); }
        }
#pragma unroll
        for (int r = 0; r < 17; ++r) { acc[r] += __shfl_xor(acc[r], 32); if (kh == 0) PT[(F.wave * 17 + r) * 32 + col] = acc[r]; }
        __syncthreads();
        for (int i = F.tid; i < 17 * 32; i += NTHR) { const int r = i >> 5, c = i & 31; float s = a.in[I_BADA][tile * 32 + c];
#pragma unroll
            for (int wv = 0; wv < 8; ++wv) s += PT[(wv * 17 + r) * 32 + c];
            ADA[r * 6144 + tile * 32 + c] = s; }
        __syncthreads();
    }
    LAS float* scr = (LAS float*)(F.lds + F.wave * 16640);
    constexpr int I_IN = 16 * (NIN / 64), I_O = 16 * 16;
    for (int it = F.gw; it < I_IN + I_O; it += F.ngw) {
        if (it < I_IN) transpose_item<1, false>(a.in[I_WIN], 1024, NIN, ws + WS_WIN, scr, it, F.lane);
        else transpose_item<0, false>(a.in[I_WO], 1024, 1024, ws + WS_WO, scr, it - I_IN, F.lane);
    }
}
__device__ __forceinline__ void moe_weights_convert(const Args& a, Frame& F, int first, int last, int wi, int nw) {
    unsigned char* ws = a.ws;
    LAS float* scr = (LAS float*)(F.lds + F.wave * 16640);
    constexpr int I_UP = 16 * 32, I_DN = 16 * 16, NIT = NEXP * (I_UP + I_DN);
#define MW_LD(it_) do { const int _it = (it_); if (_it < NEXP * I_UP) { const int e = _it / I_UP; transpose_load(v, a.in[I_WUP] + (size_t)e * 1024 * 2048, 1024, 2048, _it % I_UP, F.lane); } \
        else { const int r = _it - NEXP * I_UP, e = r / I_DN; transpose_load(v, a.in[I_WDN] + (size_t)e * 1024 * 1024, 1024, 1024, r % I_DN, F.lane); } } while (0)
    { int _l = F.lane; asm volatile("" : "+v"(_l)); F.lane = _l; }
    f32x4 v[16];
    MW_LD(first + wi < last ? first + wi : last - 1);
    for (int it = first + wi; it < last; it += nw) {
        transpose8_write(v, (LAS unsigned*)scr, F.lane);
        MW_LD(it + nw < last ? it + nw : last - 1);
        if (it < NEXP * I_UP) { const int e = it / I_UP; transpose8_out<2>(1024, ws + WS_WUP + (size_t)e * 2048 * 1024, (const LAS unsigned*)scr, it % I_UP, F.lane); }
        else { const int r = it - NEXP * I_UP, e = r / I_DN; transpose8_out<0>(1024, ws + WS_WDN + (size_t)e * 1024 * 1024, (const LAS unsigned*)scr, r % I_DN, F.lane); }
    }
#undef MW_LD
}

__device__ __forceinline__ void p1_ln_mod(const Args& a, Frame& F) {
    unsigned char* ws = a.ws;
    const float* ADA = (const float*)(ws + WS_ADA); float* STATS = (float*)(ws + WS_STATS); bf16_t* H = (bf16_t*)(ws + WS_H);
    const int rpw = (NROW + F.ngw - 1) / F.ngw, u0 = F.gw * rpw, u1 = (u0 + rpw < NROW) ? u0 + rpw : NROW;
    auto rowsrc = [&](int u) { const int b = u / SU, p = u % SU; return (const f32x4*)(p < CTX ? a.in[I_CTX] + ((size_t)b * CTX + p) * DM : a.in[I_X] + ((size_t)b * SEQ + (p - CTX)) * DM) + F.lane; };
    f32x4 vn[4], G[4], Bv[4]; int kind = -1;
    if (u0 < u1) { const f32x4* xr = rowsrc(u0);
#pragma unroll
        for (int j = 0; j < 4; ++j) vn[j] = __builtin_nontemporal_load(xr + 64 * j); }
    for (int u = u0; u < u1; ++u) {
        const int b = u / SU, p = u % SU, kd = p < CTX ? 16 : b;
        if (kd != kind) { kind = kd; const float* ad = ADA + kd * 6144;
#pragma unroll
            for (int j = 0; j < 4; ++j) { const f32x4 g = ((const f32x4*)a.in[I_LNING] + F.lane)[64 * j], bb = ((const f32x4*)a.in[I_LNINB] + F.lane)[64 * j], sh = ((const f32x4*)ad + F.lane)[64 * j], sc = ((const f32x4*)(ad + 1024) + F.lane)[64 * j] + 1.0f;
                G[j] = g * sc; Bv[j] = bb * sc + sh; } }
        f32x4 v[4]; float s = 0.f;
#pragma unroll
        for (int j = 0; j < 4; ++j) v[j] = vn[j];
        { const int un = (u + 1 < u1) ? u + 1 : u; const f32x4* xr = rowsrc(un);
#pragma unroll
            for (int j = 0; j < 4; ++j) vn[j] = __builtin_nontemporal_load(xr + 64 * j); }
#pragma unroll
        for (int j = 0; j < 4; ++j) s += (v[j].x + v[j].y) + (v[j].z + v[j].w);
        const float mean = wave_sum(s) * (1.f / DM); float s2 = 0.f;
#pragma unroll
        for (int j = 0; j < 4; ++j) { v[j] = v[j] - mean; s2 += (v[j].x * v[j].x + v[j].y * v[j].y) + (v[j].z * v[j].z + v[j].w * v[j].w); }
        const float rstd = 1.f / sqrtf(wave_sum(s2) * (1.f / DM) + LN_EPS);
        v2u* o8 = (v2u*)(H + (size_t)u * DM) + F.lane;
#pragma unroll
        for (int j = 0; j < 4; ++j) { const f32x4 h = v[j] * rstd * G[j] + Bv[j]; v2u w; w.x = pk2(h.x, h.y); w.y = pk2(h.z, h.w); o8[64 * j] = w; }
        if (p >= CTX && F.lane == 0) { const int m = b * SEQ + (p - CTX); STATS[2 * m] = mean; STATS[2 * m + 1] = rstd; }
    }
}

__device__ __forceinline__ void store64(bf16_t* dst, const float (&v)[64]) {
#pragma unroll
    for (int q = 0; q < 8; ++q) { v4u w; w.x = pk2(v[8 * q], v[8 * q + 1]); w.y = pk2(v[8 * q + 2], v[8 * q + 3]); w.z = pk2(v[8 * q + 4], v[8 * q + 5]); w.w = pk2(v[8 * q + 6], v[8 * q + 7]); *(v4u*)(dst + 8 * q) = w; }
}
__device__ __forceinline__ void rope64(float (&v)[64], const float* ROPE, int t) {
    const float* rr = ROPE + (t >> 6) * 32; const float* rc = ROPE + (t & 63) * 32;
#pragma unroll
    for (int i = 0; i < 16; ++i) {
        const float cr = rr[2 * i], sr = rr[2 * i + 1], cc = rc[2 * i], sc = rc[2 * i + 1];
        const float x1 = v[i], x2 = v[16 + i], x3 = v[32 + i], x4 = v[48 + i];
        v[i] = x1 * cr - x2 * sr; v[16 + i] = x2 * cr + x1 * sr; v[32 + i] = x3 * cc - x4 * sc; v[48 + i] = x4 * cc + x3 * sc;
    }
}
__device__ __forceinline__ void rms64(float (&v)[64], const float* g) {
    float ss = 0.f;
#pragma unroll
    for (int d = 0; d < 64; ++d) ss = fmaf(v[d], v[d], ss);
    const float r = 1.0f / sqrtf(ss * (1.0f / 64.0f) + LN_EPS);
#pragma unroll
    for (int d = 0; d < 64; ++d) v[d] = v[d] * r * g[d];
}
__device__ __forceinline__ void p3_attn_scalar(const Args& a, Frame& F) {
    unsigned char* ws = a.ws;
    const bf16_t* AQ = (const bf16_t*)(ws + WS_AQ); const bf16_t* AK = (const bf16_t*)(ws + WS_AK); const bf16_t* AV = (const bf16_t*)(ws + WS_AV); bf16_t* MIX = (bf16_t*)(ws + WS_MIX);
    for (int it = F.gtid; it < BATCH * 8 * SEQ; it += F.nthreads) {
        const int t = it % SEQ, h = (it / SEQ) % 8, b = it / (SEQ * 8); const int m = b * SEQ + t, hk = h >> 2;
        v4u q[8];
#pragma unroll
        for (int i = 0; i < 8; ++i) q[i] = *(const v4u*)(AQ + (size_t)m * 512 + h * 64 + 8 * i);
        float o[64];
#pragma unroll
        for (int d = 0; d < 64; ++d) o[d] = 0.f;
        float mr = -1e30f, l = 0.f;
        const bf16_t* kb = AK + (size_t)b * SU * 128 + hk * 64; const bf16_t* vb = AV + (size_t)b * SU * 128 + hk * 64;
        for (int j = 0; j < SU; ++j) {
            float s = 0.f;
#pragma unroll
            for (int i = 0; i < 8; ++i) s = dot8(q[i], *(const v4u*)(kb + (size_t)j * 128 + 8 * i), s);
            const float mn = fmaxf(mr, s), corr = exp2f(mr - mn), pe = exp2f(s - mn);
            l = l * corr + pe; mr = mn;
#pragma unroll
            for (int i = 0; i < 8; ++i) { const v4u vv = *(const v4u*)(vb + (size_t)j * 128 + 8 * i);
                o[8 * i + 0] = fmaf(pe, bflo(vv.x), o[8 * i + 0] * corr); o[8 * i + 1] = fmaf(pe, bfhi(vv.x), o[8 * i + 1] * corr);
                o[8 * i + 2] = fmaf(pe, bflo(vv.y), o[8 * i + 2] * corr); o[8 * i + 3] = fmaf(pe, bfhi(vv.y), o[8 * i + 3] * corr);
                o[8 * i + 4] = fmaf(pe, bflo(vv.z), o[8 * i + 4] * corr); o[8 * i + 5] = fmaf(pe, bfhi(vv.z), o[8 * i + 5] * corr);
                o[8 * i + 6] = fmaf(pe, bflo(vv.w), o[8 * i + 6] * corr); o[8 * i + 7] = fmaf(pe, bfhi(vv.w), o[8 * i + 7] * corr); }
        }
        const float rl = 1.0f / l;
#pragma unroll
        for (int d = 0; d < 64; ++d) o[d] *= rl;
        store64(MIX + (size_t)m * DM + 512 + h * 64, o);
    }
}
__device__ __forceinline__ void p3_ret_scalar(const Args& a, Frame& F) {
    unsigned char* ws = a.ws;
    const bf16_t* RQ = (const bf16_t*)(ws + WS_RQ); const bf16_t* RK = (const bf16_t*)(ws + WS_RK); const bf16_t* RV = (const bf16_t*)(ws + WS_RV); const bf16_t* RG = (const bf16_t*)(ws + WS_RG);
    bf16_t* MIX = (bf16_t*)(ws + WS_MIX); float* YRET = (float*)(ws + WS_YRET);
    for (int it = F.gtid; it < BATCH * 4 * SEQ; it += F.nthreads) {
        const int t = it % SEQ, h = (it / SEQ) % 4, b = it / (SEQ * 4); const int m = b * SEQ + t;
        const float lgf = a.in[I_LDF][h] * 1.4426950408889634f, lgb = a.in[I_LDB][h] * 1.4426950408889634f;
        v4u q[8];
#pragma unroll
        for (int i = 0; i < 8; ++i) q[i] = *(const v4u*)(RQ + (size_t)m * 256 + h * 64 + 8 * i);
        const bf16_t* kb = RK + (size_t)b * SU * 256 + h * 64; const bf16_t* vb = RV + (size_t)b * SU * 512 + h * 128;
        float* yr = YRET + ((size_t)m * 4 + h) * 128;
        for (int dq = 0; dq < 4; ++dq) {
            float acc[32];
#pragma unroll
            for (int e = 0; e < 32; ++e) acc[e] = 0.f;
            for (int j = 0; j < SU; ++j) {
                float s = 0.f;
#pragma unroll
                for (int i = 0; i < 8; ++i) s = dot8(q[i], *(const v4u*)(kb + (size_t)j * 256 + 8 * i), s);
                float w;
                if (j < CTX) w = exp2f(lgf * (float)(t + CTX - j)) + exp2f(lgb * (float)(SEQ - t + j));
                else { const int tj = j - CTX; w = tj < t ? exp2f(lgf * (float)(t - tj)) : (tj > t ? exp2f(lgb * (float)(tj - t)) : 2.0f); }
                s *= w;
#pragma unroll
                for (int i = 0; i < 4; ++i) { const v4u vv = *(const v4u*)(vb + (size_t)j * 512 + dq * 32 + 8 * i);
                    acc[8 * i + 0] = fmaf(s, bflo(vv.x), acc[8 * i + 0]); acc[8 * i + 1] = fmaf(s, bfhi(vv.x), acc[8 * i + 1]);
                    acc[8 * i + 2] = fmaf(s, bflo(vv.y), acc[8 * i + 2]); acc[8 * i + 3] = fmaf(s, bfhi(vv.y), acc[8 * i + 3]);
                    acc[8 * i + 4] = fmaf(s, bflo(vv.z), acc[8 * i + 4]); acc[8 * i + 5] = fmaf(s, bfhi(vv.z), acc[8 * i + 5]);
                    acc[8 * i + 6] = fmaf(s, bflo(vv.w), acc[8 * i + 6]); acc[8 * i + 7] = fmaf(s, bfhi(vv.w), acc[8 * i + 7]); }
            }
#pragma unroll
            for (int e = 0; e < 32; ++e) yr[dq * 32 + e] = acc[e];
        }
        asm volatile("s_waitcnt vmcnt(0)" ::: "memory");
        float s1 = 0.f;
        for (int e = 0; e < 128; ++e) s1 += yr[e];
        const float mu = s1 * (1.0f / 128.0f); float s2 = 0.f;
        for (int e = 0; e < 128; ++e) { const float d = yr[e] - mu; s2 = fmaf(d, d, s2); }
        const float rs = 1.0f / sqrtf(s2 * (1.0f / 128.0f) + LN_EPS);
        const float* gg = a.in[I_GNG] + h * 128; const float* gb = a.in[I_GNB] + h * 128;
        for (int e = 0; e < 128; e += 2) {
            const unsigned gw = *(const unsigned*)(RG + (size_t)m * 512 + h * 128 + e);
            const float g0 = bflo(gw), g1 = bfhi(gw);
            const float y0 = ((yr[e] - mu) * rs * gg[e] + gb[e]) * (g0 / (1.0f + __expf(-g0)));
            const float y1 = ((yr[e + 1] - mu) * rs * gg[e + 1] + gb[e + 1]) * (g1 / (1.0f + __expf(-g1)));
            *(unsigned*)(MIX + (size_t)m * DM + h * 128 + e) = pk2(y0, y1);
        }
    }
}

__device__ __forceinline__ void p6_ln1_route(const Args& a, Frame& F) {
    typedef short bf16x8 __attribute__((ext_vector_type(8)));
    unsigned char* ws = a.ws;
    const float* ADA = (const float*)(ws + WS_ADA); const float* STATS = (const float*)(ws + WS_STATS); const bf16_t* Y1 = (const bf16_t*)(ws + WS_Y1); const bf16_t* RWT = (const bf16_t*)(ws + WS_RWT);
    float* X1 = (float*)(ws + WS_X1); bf16_t* H2 = (bf16_t*)(ws + WS_H2); unsigned* CNT = F.ctl + CW_CNT; v2u* LIST = (v2u*)(ws + WS_LIST);
    constexpr int HP = 1032;
    LAS bf16_t* HSH = (LAS bf16_t*)F.lds; LAS bf16_t* HSL = (LAS bf16_t*)(F.lds + 16 * HP * 2);
    LAS float* PP = (LAS float*)(F.lds + 2 * 16 * HP * 2);
    LAS float* PRM = PP + 8 * 16 * 32;
    LAS unsigned* SEL = (LAS unsigned*)(PRM + 7 * 1024);
    LAS unsigned* HIST = SEL + 512 * 4;
    const int fr = F.lane & 15, fq = F.lane >> 4;
    bf16x8 bh[2][4], bl[2][4];
#pragma unroll
    for (int eh = 0; eh < 2; ++eh)
#pragma unroll
        for (int ks = 0; ks < 4; ++ks) { const size_t o = (size_t)(16 * eh + fr) * 1024 + 128 * F.wave + 32 * ks + 8 * fq; bh[eh][ks] = *(const bf16x8*)(RWT + o); bl[eh][ks] = *(const bf16x8*)(RWT + 32768 + o); }
    for (int rb = blockIdx.x; rb < NTOK / 128; rb += F.G) {
        const int m0 = rb * 128, b = m0 / SEQ; const float* ad = ADA + b * 6144;
        __syncthreads();
        for (int i = F.tid; i < 1024; i += NTHR) {
            PRM[i] = a.in[I_LNING][i] * DN_ALPHA; PRM[1024 + i] = a.in[I_LNINB][i] * DN_ALPHA; PRM[2048 + i] = ad[2048 + i];
            PRM[3072 + i] = a.in[I_LN1G][i]; PRM[4096 + i] = a.in[I_LN1B][i]; PRM[5120 + i] = ad[4096 + i] + 1.0f; PRM[6144 + i] = ad[3072 + i]; }
        if (F.tid < 64) HIST[F.tid] = 0u;
        __syncthreads();
#define P6_FETCH(m_) do { const int _m = (m_); _Pragma("unroll") for (int j = 0; j < 4; ++j) { xn[j] = __builtin_nontemporal_load((const f32x4*)(a.in[I_X] + (size_t)_m * DM) + F.lane + 64 * j); \
            yn[j] = __builtin_nontemporal_load((const v2u*)(Y1 + (size_t)_m * DM) + F.lane + 64 * j); } mn = STATS[2 * _m]; rn = STATS[2 * _m + 1]; } while (0)
        f32x4 xn[4]; v2u yn[4]; float mn, rn;
        P6_FETCH(m0 + 2 * F.wave);
        for (int it = 0; it < 8; ++it) {
#pragma unroll 1
            for (int rr = 0; rr < 2; ++rr) {
                const int lr = 2 * F.wave + rr, m = m0 + 16 * it + lr; const float mean = mn, rstd = rn;
                f32x4 xc[4]; v2u yc[4];
#pragma unroll
                for (int j = 0; j < 4; ++j) { xc[j] = xn[j]; yc[j] = yn[j]; }
                { const int q = 2 * it + rr + 1; const int mnext = q < 16 ? m0 + 16 * (q >> 1) + 2 * F.wave + (q & 1) : m; P6_FETCH(mnext); }
                f32x4 z[4]; float s = 0.f;
#pragma unroll
                for (int j = 0; j < 4; ++j) {
                    const f32x4 xv = xc[j];
                    const v2u yw = yc[j];
                    const f32x4 y = {bflo(yw.x), bfhi(yw.x), bflo(yw.y), bfhi(yw.y)};
                    const f32x4 p0 = ((const LAS f32x4*)PRM + F.lane)[64 * j], p1 = ((const LAS f32x4*)(PRM + 1024) + F.lane)[64 * j], p2 = ((const LAS f32x4*)(PRM + 2048) + F.lane)[64 * j];
                    z[j] = (xv - mean) * rstd * p0 + p1 + p2 * y;
                    s += (z[j].x + z[j].y) + (z[j].z + z[j].w);
                }
                const float mz = wave_sum(s) * (1.f / DM); float s2 = 0.f;
#pragma unroll
                for (int j = 0; j < 4; ++j) { z[j] = z[j] - mz; s2 += (z[j].x * z[j].x + z[j].y * z[j].y) + (z[j].z * z[j].z + z[j].w * z[j].w); }
                const float rz = 1.f / sqrtf(wave_sum(s2) * (1.f / DM) + LN_EPS);
#pragma unroll
                for (int j = 0; j < 4; ++j) {
                    const f32x4 p3 = ((const LAS f32x4*)(PRM + 3072) + F.lane)[64 * j], p4 = ((const LAS f32x4*)(PRM + 4096) + F.lane)[64 * j], p5 = ((const LAS f32x4*)(PRM + 5120) + F.lane)[64 * j], p6 = ((const LAS f32x4*)(PRM + 6144) + F.lane)[64 * j];
                    const f32x4 x1 = z[j] * rz * p3 + p4; const f32x4 h2 = x1 * p5 + p6;
                    { v2u xw; xw.x = pk2(x1.x, x1.y); xw.y = pk2(x1.z, x1.w); ((v2u*)((bf16_t*)X1 + (size_t)m * DM) + F.lane)[64 * j] = xw; }
                    const unsigned h0 = f2bf(h2.x), h1 = f2bf(h2.y), h2b = f2bf(h2.z), h3 = f2bf(h2.w);
                    v2u w; w.x = h0 | (h1 << 16); w.y = h2b | (h3 << 16);
                    { unsigned q = 0u; q = __builtin_amdgcn_cvt_pk_fp8_f32(h2.x, h2.y, q, false); q = __builtin_amdgcn_cvt_pk_fp8_f32(h2.z, h2.w, q, true); ((unsigned*)((unsigned char*)H2 + (size_t)m * DM) + F.lane)[64 * j] = q; }
                    v2u lo; lo.x = pk2(h2.x - bf2f(h0), h2.y - bf2f(h1)); lo.y = pk2(h2.z - bf2f(h2b), h2.w - bf2f(h3));
                    *(LAS v2u*)(HSH + lr * HP + 4 * F.lane + 256 * j) = w; *(LAS v2u*)(HSL + lr * HP + 4 * F.lane + 256 * j) = lo;
                }
            }
            __syncthreads();
            f32x4 acc[2] = {(f32x4){0.f, 0.f, 0.f, 0.f}, (f32x4){0.f, 0.f, 0.f, 0.f}};
#pragma unroll
            for (int ks = 0; ks < 4; ++ks) {
                const bf16x8 ah = *(const LAS bf16x8*)(HSH + fr * HP + 128 * F.wave + 32 * ks + 8 * fq), al = *(const LAS bf16x8*)(HSL + fr * HP + 128 * F.wave + 32 * ks + 8 * fq);
#pragma unroll
                for (int eh = 0; eh < 2; ++eh) { acc[eh] = __builtin_amdgcn_mfma_f32_16x16x32_bf16(ah, bh[eh][ks], acc[eh], 0, 0, 0); acc[eh] = __builtin_amdgcn_mfma_f32_16x16x32_bf16(ah, bl[eh][ks], acc[eh], 0, 0, 0); acc[eh] = __builtin_amdgcn_mfma_f32_16x16x32_bf16(al, bh[eh][ks], acc[eh], 0, 0, 0); }
            }
#pragma unroll
            for (int eh = 0; eh < 2; ++eh)
#pragma unroll
                for (int r = 0; r < 4; ++r) PP[(F.wave * 16 + 4 * fq + r) * 32 + 16 * eh + fr] = acc[eh][r];
            __syncthreads();
            {
                const int lr = 2 * F.wave + (F.lane >> 5), ex = F.lane & 31;
                float mine = a.in[I_RB][ex];
#pragma unroll
                for (int wv = 0; wv < 8; ++wv) mine += PP[(wv * 16 + lr) * 32 + ex];
                float sv[4]; int si[4];
#pragma unroll
                for (int k = 0; k < 4; ++k) {
                    float v = mine; int ix = ex;
#pragma unroll
                    for (int o = 16; o >= 1; o >>= 1) { const float ov = __shfl_xor(v, o); const int oi = __shfl_xor(ix, o); if (ov > v || (ov == v && oi < ix)) { v = ov; ix = oi; } }
                    sv[k] = v; si[k] = ix; if (ex == ix) mine = -3.0e38f;
                }
                const float e1 = __expf(sv[1] - sv[0]), e2 = __expf(sv[2] - sv[0]), e3 = __expf(sv[3] - sv[0]);
                const float rs = 1.0f / (1.0f + e1 + e2 + e3);
                if (ex < 4) {
                    const int sel = ex == 0 ? si[0] : (ex == 1 ? si[1] : (ex == 2 ? si[2] : si[3]));
                    const float gt = (ex == 0 ? 1.0f : (ex == 1 ? e1 : (ex == 2 ? e2 : e3))) * rs;
                    const unsigned rank = atomicAdd((unsigned*)(HIST + sel), 1u);
                    const int slot = (16 * it + lr) * 4 + ex;
                    SEL[slot * 4] = (unsigned)sel; SEL[slot * 4 + 1] = rank; SEL[slot * 4 + 2] = (unsigned)((m0 + 16 * it + lr) * 4 + ex); SEL[slot * 4 + 3] = __float_as_uint(gt);
                }
            }
        }
        __syncthreads();
        if (F.tid < 32) HIST[32 + F.tid] = atomicAdd(CNT + F.tid, HIST[F.tid]);
        __syncthreads();
        { const unsigned ex = SEL[F.tid * 4], rank = SEL[F.tid * 4 + 1]; v2u ent; ent.x = SEL[F.tid * 4 + 2]; ent.y = SEL[F.tid * 4 + 3]; LIST[(size_t)ex * LISTCAP + HIST[32 + ex] + rank] = ent; }
    }
}

__device__ __forceinline__ void p9_final(const Args& a, Frame& F) {
    unsigned char* ws = a.ws;
    const float* ADA = (const float*)(ws + WS_ADA); const bf16_t* X1 = (const bf16_t*)(ws + WS_X1); const unsigned char* YE = (const unsigned char*)(ws + WS_YE);
    const int rpw = (NTOK + F.ngw - 1) / F.ngw, m0 = F.gw * rpw, m1 = (m0 + rpw < NTOK) ? m0 + rpw : NTOK;
    unsigned yn[4][4]; v2u xn[4];
    auto fetch = [&](int m) {
#pragma unroll
        for (int j = 0; j < 4; ++j) {
#pragma unroll
            for (int k = 0; k < 4; ++k) yn[j][k] = __builtin_nontemporal_load((const unsigned*)(YE + ((size_t)m * 4 + k) * DM) + F.lane + 64 * j);
            xn[j] = __builtin_nontemporal_load((const v2u*)(X1 + (size_t)m * DM) + F.lane + 64 * j); } };
    if (m0 < m1) fetch(m0);
    f32x4 G2[4], LG[4], LB[4]; int kind = -1;
    for (int m = m0; m < m1; ++m) {
        const int b = m / SEQ;
        if (b != kind) { kind = b; const float* ad = ADA + b * 6144;
#pragma unroll
            for (int j = 0; j < 4; ++j) { G2[j] = ((const f32x4*)(ad + 5120) + F.lane)[64 * j] * (1.0f / 64.0f); LG[j] = ((const f32x4*)a.in[I_LN2G] + F.lane)[64 * j]; LB[j] = ((const f32x4*)a.in[I_LN2B] + F.lane)[64 * j]; } }
        f32x4 z[4]; float s = 0.f;
#pragma unroll
        for (int j = 0; j < 4; ++j) {
            f32x4 f = {0.f, 0.f, 0.f, 0.f};
#pragma unroll
            for (int k = 0; k < 4; ++k) { const unsigned yw = yn[j][k];
                f += (f32x4){__builtin_amdgcn_cvt_f32_fp8(yw, 0), __builtin_amdgcn_cvt_f32_fp8(yw, 1), __builtin_amdgcn_cvt_f32_fp8(yw, 2), __builtin_amdgcn_cvt_f32_fp8(yw, 3)}; }
            const v2u xw = xn[j]; const f32x4 x1 = {bflo(xw.x), bfhi(xw.x), bflo(xw.y), bfhi(xw.y)};
            z[j] = x1 * DN_ALPHA + G2[j] * f;
            s += (z[j].x + z[j].y) + (z[j].z + z[j].w);
        }
        fetch((m + 1 < m1) ? m + 1 : m);
        const float mz = wave_sum(s) * (1.f / DM); float s2 = 0.f;
#pragma unroll
        for (int j = 0; j < 4; ++j) { z[j] = z[j] - mz; s2 += (z[j].x * z[j].x + z[j].y * z[j].y) + (z[j].z * z[j].z + z[j].w * z[j].w); }
        const float rz = 1.f / sqrtf(wave_sum(s2) * (1.f / DM) + LN_EPS);
#pragma unroll
        for (int j = 0; j < 4; ++j) __builtin_nontemporal_store(z[j] * rz * LG[j] + LB[j], (f32x4*)(a.out + (size_t)m * DM) + F.lane + 64 * j);
    }
}

constexpr int N_PHASES = 10;
constexpr int CONV_NIT = NEXP * (16 * 32 + 16 * 16), CONV_P2 = 64 * 8 * 4;
#ifndef MK_N_LAUNCHES
#define MK_N_LAUNCHES 1
#endif
__global__ void __launch_bounds__(NTHR, 2) fwd_kernel(Args a) {
    extern __shared__ __attribute__((aligned(16))) unsigned char lds[];
    Frame F;
    F.lds = (LAS unsigned char*)lds;
#define REFRESH() do { int _t = threadIdx.x; asm volatile("" : "+v"(_t)); F.tid = _t; F.lane = _t & 63; F.wave = __builtin_amdgcn_readfirstlane(_t >> 6); F.gtid = blockIdx.x * NTHR + _t; F.gw = blockIdx.x * NWAVES + F.wave; } while (0)
    F.G = gridDim.x; F.nthreads = F.G * NTHR; F.ngw = F.G * NWAVES; REFRESH();
    F.ctl = (unsigned*)(a.ws + WS_CTL);
    volatile LAS unsigned* MISC = (volatile LAS unsigned*)(F.lds + MISC_OFF);
    for (int u = F.tid; u < (LDS_BYTES - 131072) / 4; u += NTHR) ((LAS unsigned*)(F.lds + 131072))[u] = 0u;
    __syncthreads();
    XcdBarrier bar; bar.bar = F.ctl + CW_BAR + a.li * XCD_BAR_WORDS; bar.x = 0; bar.st = nullptr;
    if (MK_N_LAUNCHES == 1) bar = xcd_barrier_post(F.ctl + CW_BAR, MISC + 8);
    const int lo = a.ph_lo, hi = a.ph_hi;
#define IN(k) (lo <= (k) && (k) < hi)
#define SEAM(k) do { if (IN(k) && IN((k) + 1)) xcd_barrier(bar); } while (0)
    if (IN(0)) { REFRESH(); p0_prologue(a, F); } SEAM(0);
    if (IN(1)) { REFRESH(); p1_ln_mod(a, F); } SEAM(1);
    if (IN(2)) { REFRESH();
        pg8::SchedInProj S{F.G, (int)blockIdx.x}; pg8::EpiInProj E{a.ws, a.in[I_QNG], a.in[I_KNG], (const float*)(a.ws + WS_ROPE)};
        pg8::gemm_phase<pg8::EpiInProj, pg8::SchedInProj, false>(F.lds, (const bf16_t*)(a.ws + WS_H), (const bf16_t*)(a.ws + WS_WIN), S, E);
        if (F.G == 256) { if (blockIdx.x >= 192) { REFRESH(); __syncthreads(); moe_weights_convert(a, F, 0, CONV_P2, ((int)blockIdx.x - 192) * NWAVES + F.wave, 64 * NWAVES); } }
        else if (blockIdx.x == 0) {   }
    } SEAM(2);
    if (IN(3)) { REFRESH();
        const attn_body::AttnTensors AT{(const attn_body::bf16*)(a.ws + WS_AQ), (const attn_body::bf16*)(a.ws + WS_AK), (const attn_body::bf16*)(a.ws + WS_AV), (attn_body::bf16*)(a.ws + WS_MIX) + 512};
        const attn_body::StaticOrder S((int)F.G, (int)blockIdx.x);
        if ((F.G & 255) == 0) {
            float gqm = 0.f, gkm = 0.f;
            for (int i = 0; i < 64; ++i) { gqm = fmaxf(gqm, fabsf(a.in[I_QNG][i])); gkm = fmaxf(gkm, fabsf(a.in[I_KNG][i])); }
            const float refB = 1.02f * C2 * 64.0f * gqm * gkm;
            const int slot = (int)(blockIdx.x % 5u); attn_body::AttnUnit u;
            for (int i = 0; i < 5; ++i) {
                if (i == slot) { __syncthreads(); moe_weights_convert(a, F, CONV_P2, CONV_NIT, F.gw, F.ngw); __syncthreads(); }
                if (i < 4 && S.next(i, u)) attn_body::attn_unit<8>(u.b, u.h, u.qb, AT.Q, AT.K, AT.V, AT.O, (char*)lds, refB);
            }
        } else { p3_attn_scalar(a, F); __syncthreads(); moe_weights_convert(a, F, 0, CONV_NIT, F.gw, F.ngw); }
        __syncthreads();
        for (int u = blockIdx.x; u < 256; u += F.G) { const int dvh = u & 1, dir = (u >> 1) & 1, h = (u >> 2) & 3, b = u >> 4;
            ret::state_unit(b, h, dir, dvh, (const bf16_t*)(a.ws + WS_RK), (const bf16_t*)(a.ws + WS_RV), (bf16_t*)(a.ws + WS_ST), (dir ? a.in[I_LDB][h] : a.in[I_LDF][h]) * 1.4426950408889634f, F.lds); }
    } SEAM(3);
    if (IN(4)) { REFRESH();
        ret::OutRegs R; int u = blockIdx.x;
        if (u < 1024) ret::out_load(R, u, (const bf16_t*)(a.ws + WS_RQ), (const bf16_t*)(a.ws + WS_RK), (const bf16_t*)(a.ws + WS_RV), (const bf16_t*)(a.ws + WS_RG));
        for (; u < 1024; u += F.G) { const int un = (u + F.G < 1024) ? u + F.G : -1;
            ret::out_unit(R, u, un, (const bf16_t*)(a.ws + WS_RQ), (const bf16_t*)(a.ws + WS_RK), (const bf16_t*)(a.ws + WS_RV), (const bf16_t*)(a.ws + WS_RG), (const bf16_t*)(a.ws + WS_ST), a.in[I_GNG], a.in[I_GNB],
                          a.in[I_LDF], a.in[I_LDB], (bf16_t*)(a.ws + WS_MIX), F.lds); }
    } SEAM(4);
    if (IN(5)) { REFRESH();
        pg8::SchedDense S{NTOK / 256, DM / 256, F.G, (int)blockIdx.x}; pg8::EpiPlainBf16 E{(bf16_t*)(a.ws + WS_Y1), DM};
        pg8::gemm_phase<pg8::EpiPlainBf16, pg8::SchedDense, false>(F.lds, (const bf16_t*)(a.ws + WS_MIX), (const bf16_t*)(a.ws + WS_WO), S, E);
    } SEAM(5);
    if (IN(6)) { REFRESH(); p6_ln1_route(a, F); } SEAM(6);
    if (IN(7)) { REFRESH();
        LAS int* tab = (LAS int*)(F.lds + 131072 + 1024); pg8::moe_build_tab(tab, F.ctl + CW_CNT);
        pg8::SchedMoE S{8, 2048, F.G, (int)blockIdx.x, tab, (const v2u*)(a.ws + WS_LIST)}; pg8::EpiUp E{a.ws + WS_ACT, a.in[I_BUP]};
        pg8::gemm_phase<pg8::EpiUp, pg8::SchedMoE, true, true>(F.lds, (const bf16_t*)(a.ws + WS_H2), (const bf16_t*)(a.ws + WS_WUP), S, E);
    } SEAM(7);
    if (IN(8)) { REFRESH();
        LAS int* tab = (LAS int*)(F.lds + 131072 + 1024); pg8::moe_build_tab(tab, F.ctl + CW_CNT);
        pg8::SchedMoE S{4, 1024, F.G, (int)blockIdx.x, tab, (const v2u*)(a.ws + WS_LIST)}; pg8::EpiDown E{(bf16_t*)(a.ws + WS_YE), a.in[I_BDN], (const v2u*)(a.ws + WS_LIST)};
        pg8::gemm_phase<pg8::EpiDown, pg8::SchedMoE, false, true>(F.lds, (const bf16_t*)(a.ws + WS_ACT), (const bf16_t*)(a.ws + WS_WDN), S, E);
    } SEAM(8);
    if (IN(9)) { REFRESH(); p9_final(a, F); }
#undef IN
#undef SEAM
}

extern "C" void kernel_launch(void* const* d_in, const int* in_sizes, int n_in, void* d_out, int out_size, void* d_ws, size_t ws_size, hipStream_t stream) {
    static int grid = 0;
    if (grid == 0) {
        if (n_in != 26 || out_size != NTOK * DM || ws_size < WS_END) { fprintf(stderr, "kernel_launch: unexpected shapes (n_in %d, out %d, ws %zu); nothing launched\n", n_in, out_size, ws_size); grid = -1; return; }
        int dev = 0, cus = 0;
        if (hipGetDevice(&dev) != hipSuccess || hipDeviceGetAttribute(&cus, hipDeviceAttributeMultiprocessorCount, dev) != hipSuccess) { grid = -1; return; }
        if (hipFuncSetAttribute((const void*)fwd_kernel, hipFuncAttributeMaxDynamicSharedMemorySize, LDS_BYTES) != hipSuccess) { fprintf(stderr, "kernel_launch: hipFuncSetAttribute failed\n"); grid = -1; return; }
        (void)hipGetLastError();
        grid = cus;
    }
    if (grid < 0) return;
    if (hipMemsetAsync((char*)d_ws + WS_CTL, 0, CTL_ZERO_BYTES, stream) != hipSuccess) return;
    Args a{};
    for (int i = 0; i < 26; ++i) a.in[i] = (const float*)d_in[i];
    a.out = (float*)d_out; a.ws = (unsigned char*)d_ws;
    if (MK_N_LAUNCHES == 1) { a.ph_lo = 0; a.ph_hi = N_PHASES; a.li = 0; hipLaunchKernelGGL(fwd_kernel, dim3(grid), dim3(NTHR), LDS_BYTES, stream, a); }
    else for (int p = 0; p < N_PHASES; ++p) { a.ph_lo = p; a.ph_hi = p + 1; a.li = 0; hipLaunchKernelGGL(fwd_kernel, dim3(grid), dim3(NTHR), LDS_BYTES, stream, a); }
}
```

```cpp
#include <hip/hip_runtime.h>
#include <cstdio>
#include <cstdint>

constexpr int BATCH = 16, SEQ = 2048, DM = 1024, CTX = 256, SU = SEQ + CTX;
constexpr int NTOK = BATCH * SEQ, NROW = BATCH * SU;
constexpr int NIN = 2304, NEXP = 32, LISTCAP = 32768;
constexpr float LN_EPS = 1e-6f, DN_ALPHA = 1.189207115002721f;
constexpr float C2 = 0.125f * 1.4426950408889634f;
constexpr int NWAVES = 8, NTHR = 512;

constexpr size_t MiB = 1u << 20;
constexpr size_t WS_CTL = 0, CTL_ZERO_BYTES = 64 * 1024;
constexpr size_t WS_ADA = 1 * MiB, WS_ROPE = 1 * MiB + 512 * 1024, WS_STATS = 2 * MiB, WS_LIST = 4 * MiB;
constexpr size_t WS_RWT = 12 * MiB;
constexpr size_t WS_WIN = 16 * MiB, WS_WO = 22 * MiB, WS_WUP = 32 * MiB, WS_WDN = 160 * MiB;
constexpr size_t WS_X1 = 224 * MiB, WS_H2 = 352 * MiB, WS_ACT = 416 * MiB;
constexpr size_t WS_MIX = 416 * MiB, WS_Y1 = 480 * MiB, WS_YRET = 544 * MiB;
constexpr size_t WS_YE = 688 * MiB;
constexpr size_t WS_H = 688 * MiB, WS_RQ = 760 * MiB, WS_RK = 776 * MiB, WS_RV = 794 * MiB, WS_RG = 830 * MiB, WS_AQ = 862 * MiB, WS_AK = 894 * MiB, WS_AV = 903 * MiB;
constexpr size_t WS_ST = 912 * MiB;
constexpr size_t WS_END = 944 * MiB;
constexpr int CW_TMO = 0, CW_CNT = 256, CW_BAR = 4096;

#define GAS __attribute__((address_space(1)))
#define LAS __attribute__((address_space(3)))
typedef unsigned short bf16_t;
typedef unsigned v4u __attribute__((ext_vector_type(4)));
typedef unsigned v2u __attribute__((ext_vector_type(2)));
typedef float f32x4 __attribute__((ext_vector_type(4)));

__device__ __forceinline__ float bf2f(unsigned v) { return __uint_as_float(v << 16); }
__device__ __forceinline__ unsigned f2bf(float f) { unsigned u = __float_as_uint(f); return (u + 0x7fffu + ((u >> 16) & 1u)) >> 16; }
__device__ __forceinline__ unsigned pk2(float lo, float hi) { return f2bf(lo) | (f2bf(hi) << 16); }
__device__ __forceinline__ float bflo(unsigned w) { return __uint_as_float(w << 16); }
__device__ __forceinline__ float bfhi(unsigned w) { return __uint_as_float(w & 0xffff0000u); }
__device__ __forceinline__ float wave_sum(float v) {
#pragma unroll
    for (int o = 1; o < 64; o <<= 1) v += __shfl_xor(v, o);
    return v;
}
__device__ __forceinline__ float dot8(v4u a, v4u w, float acc) {
    acc = fmaf(bflo(a.x), bflo(w.x), acc); acc = fmaf(bfhi(a.x), bfhi(w.x), acc);
    acc = fmaf(bflo(a.y), bflo(w.y), acc); acc = fmaf(bfhi(a.y), bfhi(w.y), acc);
    acc = fmaf(bflo(a.z), bflo(w.z), acc); acc = fmaf(bfhi(a.z), bfhi(w.z), acc);
    acc = fmaf(bflo(a.w), bflo(w.w), acc); acc = fmaf(bfhi(a.w), bfhi(w.w), acc);
    return acc;
}

#define XB_TMO      128
#define XB_XCNT(j)  (256  + 64 * (j))
#define XB_XSUB(j)  (1280 + 64 * (j))
#define XB_XGEN(j)  (2304 + 64 * (j))
#define XB_TOP      3328
#define XB_TOPGEN   3392
#define XCD_BAR_WORDS 3456
#define XB_SPIN_CAP (1u << 24)
__device__ __forceinline__ unsigned xb_ld(unsigned* p)              { return __hip_atomic_load(p, __ATOMIC_RELAXED, __HIP_MEMORY_SCOPE_AGENT); }
__device__ __forceinline__ unsigned xb_add(unsigned* p, unsigned v) { return __hip_atomic_fetch_add(p, v, __ATOMIC_RELAXED, __HIP_MEMORY_SCOPE_AGENT); }
__device__ __forceinline__ unsigned xb_xcc_id() { return (unsigned)__builtin_amdgcn_s_getreg((3 << 11) | 20) & 0xFu; }
#define XB_SPIN(cond, bar) do { unsigned _sp = 0; while (cond) { __builtin_amdgcn_s_sleep(1); \
    if ((++_sp & 255u) == 0u) { if (xb_ld(&(bar)[XB_TMO])) break; if (_sp > XB_SPIN_CAP) { atomicAdd(&(bar)[XB_TMO], 1u); break; } } } } while (0)
struct XcdBarrier { unsigned* bar; unsigned x; volatile LAS unsigned* st; };
__device__ __forceinline__ XcdBarrier xcd_barrier_post(unsigned* bar, volatile LAS unsigned* st) {
    XcdBarrier b; b.bar = bar; b.x = xb_xcc_id(); b.st = st;
    if (threadIdx.x == 0) (void)xb_add(&bar[XB_XCNT(b.x)], 1u);
    return b;
}
__device__ __forceinline__ void xcd_barrier_complete(unsigned* bar, unsigned x, unsigned& nloc, unsigned& nx) {
    const unsigned G = gridDim.x * gridDim.y * gridDim.z;
    unsigned sum, cnt, mine, sp = 0u;
    for (;;) {
        sum = 0u; cnt = 0u; mine = 0u;
#pragma unroll
        for (unsigned j = 0; j < 16; ++j) { const unsigned c = xb_ld(&bar[XB_XCNT(j)]); sum += c; cnt += (c > 0u) ? 1u : 0u; mine = (j == x) ? c : mine; }
        if (sum == G) break;
        __builtin_amdgcn_s_sleep(1);
        if ((++sp & 255u) == 0u) { if (xb_ld(&bar[XB_TMO])) break; if (sp > XB_SPIN_CAP) { atomicAdd(&bar[XB_TMO], 1u); break; } }
    }
    nloc = mine > 0u ? mine : 1u; nx = cnt > 0u ? cnt : 1u;
}
__device__ __forceinline__ void xcd_barrier(const XcdBarrier& b) {
    asm volatile("s_waitcnt vmcnt(0)" ::: "memory");
    __syncthreads();
    if (threadIdx.x == 0) {
        unsigned* bar = b.bar;
        __builtin_amdgcn_s_waitcnt(0);
        unsigned nloc = b.st[0], nx = b.st[1];
        if (nloc == 0u) { xcd_barrier_complete(bar, b.x, nloc, nx); b.st[0] = nloc; b.st[1] = nx; }
        const unsigned old = xb_add(&bar[XB_XSUB(b.x)], 1u);
        const unsigned gen = old / nloc;
        if (old + 1u == (gen + 1u) * nloc) {
            __builtin_amdgcn_fence(__ATOMIC_RELEASE, "agent");
            asm volatile("s_waitcnt vmcnt(0)" ::: "memory");
            const unsigned og = xb_add(&bar[XB_TOP], 1u);
            const unsigned tg = og / nx;
            if (og + 1u == (tg + 1u) * nx) xb_add(&bar[XB_TOPGEN], 1u);
            else XB_SPIN(xb_ld(&bar[XB_TOPGEN]) == tg, bar);
            __builtin_amdgcn_fence(__ATOMIC_ACQUIRE, "agent");
            xb_add(&bar[XB_XGEN(b.x)], 1u);
            asm volatile("s_waitcnt vmcnt(0)" ::: "memory");
        } else {
            XB_SPIN(xb_ld(&bar[XB_XGEN(b.x)]) == gen, bar);
            __builtin_amdgcn_fence(__ATOMIC_ACQUIRE, "agent");
            asm volatile("s_waitcnt vmcnt(0)" ::: "memory");
        }
    }
    __syncthreads();
}

namespace pg8 {
typedef short bf16x8 __attribute__((ext_vector_type(8)));
typedef int v4i __attribute__((ext_vector_type(4)));
typedef int v8i __attribute__((ext_vector_type(8)));
constexpr int BM = 256, BK = 64, HALF = 128, HTB = HALF * BK * 2, NXCD = 8, WGM = 1, KD = 1024, NT = KD / BK;
__device__ __forceinline__ int lds_byte(int r, int c) { const int st = (r >> 4) * 2 + (c >> 5), rr = r & 15, cc = c & 31, ob = rr * 64 + cc * 2; return st * 1024 + (ob ^ (((ob >> 9) & 1) << 5)); }
__device__ __forceinline__ void stage_rc(int b, int& R, int& C) { const int st = b / 1024, sb = b % 1024, swz = sb ^ (((sb >> 9) & 1) << 5); R = (st >> 1) * 16 + swz / 64; C = (st & 1) * 32 + (swz % 64) / 2; }
__device__ __forceinline__ int perm32(int rho) { const int n = rho >> 4, i = rho & 15; return 8 * (i >> 2) + 4 * n + (i & 3); }
__device__ __forceinline__ unsigned cvt_pk_bf16(float lo, float hi) { unsigned r; asm volatile("v_cvt_pk_bf16_f32 %0, %1, %2" : "=v"(r) : "v"(lo), "v"(hi)); return r; }

struct Unit { int pm, pn, brow, e, r0, cnt; };

__device__ __forceinline__ void tile_order(int L, int nM, int nN, int& pm, int& pn) {
    const int nwg = nM * nN; int wgid = L; { const int q = nwg / NXCD, r = nwg % NXCD, xcd = wgid % NXCD, off = wgid / NXCD; wgid = (xcd < r ? xcd * (q + 1) : r * (q + 1) + (xcd - r) * q) + off; }
    const int nig = WGM * nN, gid = wgid / nig, fm = gid * WGM, gsz = (nM - fm) < WGM ? (nM - fm) : WGM;
    pm = fm + ((wgid % nig) % gsz); pn = (wgid % nig) / gsz;
}
struct SchedDense {
    int nM, nN, G, c;
    __device__ __forceinline__ bool next(int i, Unit& u) const { const long L = (long)i * G + c; if (L >= (long)nM * nN) return false; tile_order((int)L, nM, nN, u.pm, u.pn); u.brow = u.pn * BM; u.e = 0; u.r0 = 0; u.cnt = 0; return true; }
    __device__ __forceinline__ unsigned arow_tok(const Unit&, int) const { return 0u; }
};

template <class Epi, class Sched, bool GATHER, bool F8 = false>
__device__ __forceinline__ void gemm_phase(LAS unsigned char* lds, const bf16_t* A, const bf16_t* Bt, const Sched& S, const Epi& E) {
    const int tid = threadIdx.x, wid = __builtin_amdgcn_readfirstlane(tid >> 6), lane = tid & 63, wr = wid >> 2, wc = wid & 3, fr = lane & 15, fq = lane >> 4;
    constexpr int K = F8 ? KD / 2 : KD, nt = F8 ? NT / 2 : NT;
    unsigned voffA[2], voffB[2];
#pragma unroll
    for (int i = 0; i < 2; ++i) { int R, C; stage_rc(tid * 16 + i * 8192, R, C); const int Rb = Epi::PERM ? ((R & ~31) + perm32(R & 31)) : R;
        voffA[i] = GATHER ? (unsigned)(C * 2) : (unsigned)(R * K + C) * 2u; voffB[i] = (unsigned)(Rb * K + C) * 2u; }
    constexpr size_t kstep = (size_t)(BK * 2), hstep = (size_t)HALF * K * 2, tstep = 2 * hstep;
    const unsigned ldsw = (unsigned)wid * 1024u;
    const int aoff = lds_byte(wr * 64 + fr, fq * 8), boff = lds_byte(wc * 32 + fr, fq * 8);
#define PG8_SA(b, h) (((b) * 2 + (h)) * HTB)
#define PG8_SB(b, h) ((4 + (b) * 2 + (h)) * HTB)
#define PG8_STAGE_B(bufoff, gbase) do { _Pragma("unroll") for (int _i = 0; _i < 2; ++_i) \
        __builtin_amdgcn_global_load_lds((const unsigned*)((const char*)(gbase) + voffB[_i]), (LAS unsigned*)(lds + (bufoff) + ldsw + _i * 8192), 16, 0, 0); } while (0)
#define PG8_STAGE_A(bufoff, h, kb, nx) do { _Pragma("unroll") for (int _i = 0; _i < 2; ++_i) { \
        const char* _src = GATHER ? (const char*)A + (((((nx) ? ron[h] : roc[h]) >> (16 * _i)) & 0xffffu) << (F8 ? 10 : 11)) + voffA[0] + (kb) : ((nx) ? nA : cA) + (size_t)(h) * hstep + (kb) + voffA[_i]; \
        __builtin_amdgcn_global_load_lds((const unsigned*)_src, (LAS unsigned*)(lds + (bufoff) + ldsw + _i * 8192), 16, 0, 0); } } while (0)
#define PG8_LDA(dst, b, h) do { _Pragma("unroll") for (int m = 0; m < 4; ++m) { if constexpr (F8) { dst##8[m].lo = *(const LAS v4i*)(lds + PG8_SA(b, h) + aoff + m * 2048); dst##8[m].hi = *(const LAS v4i*)(lds + PG8_SA(b, h) + aoff + m * 2048 + 1024); } \
        else { _Pragma("unroll") for (int k = 0; k < 2; ++k) dst[m][k] = *(const LAS bf16x8*)(lds + PG8_SA(b, h) + aoff + m * 2048 + k * 1024); } } } while (0)
#define PG8_LDB(dst, b, h) do { _Pragma("unroll") for (int n = 0; n < 2; ++n) { if constexpr (F8) { dst##8[n].lo = *(const LAS v4i*)(lds + PG8_SB(b, h) + boff + n * 2048); dst##8[n].hi = *(const LAS v4i*)(lds + PG8_SB(b, h) + boff + n * 2048 + 1024); } \
        else { _Pragma("unroll") for (int k = 0; k < 2; ++k) dst[n][k] = *(const LAS bf16x8*)(lds + PG8_SB(b, h) + boff + n * 2048 + k * 1024); } } } while (0)
#define PG8_MMA(ai, bj, At, Bt_) do { __builtin_amdgcn_s_setprio(1); _Pragma("unroll") for (int m = 0; m < 4; ++m) _Pragma("unroll") for (int n = 0; n < 2; ++n) { \
        if constexpr (F8) { asm volatile("v_mfma_scale_f32_16x16x128_f8f6f4 %0, %1, %2, %0, %3, %3 op_sel_hi:[0,0,0]" : "+v"(acc[ai][bj][m][n]) : "v"(Bt_##8[n]), "v"(At##8[m]), "v"(sc8)); } \
        else { _Pragma("unroll") for (int k = 0; k < 2; ++k) acc[ai][bj][m][n] = __builtin_amdgcn_mfma_f32_16x16x32_bf16(Bt_[n][k], At[m][k], acc[ai][bj][m][n], 0, 0, 0); } } \
        __builtin_amdgcn_s_setprio(0); } while (0)
#define PG8_WAIT_V(n) asm volatile("s_waitcnt vmcnt(" #n ")" ::: "memory")
#define PG8_WAIT_L(n) asm volatile("s_waitcnt lgkmcnt(" #n ")" ::: "memory")
#define PG8_BAR __builtin_amdgcn_s_barrier()
#define PG8_SCHED __builtin_amdgcn_sched_barrier(0)
#define PG8_LOAD_RO(dst, unit) do { int _R, _C; stage_rc((int)threadIdx.x * 16, _R, _C); _Pragma("unroll") for (int _h = 0; _h < 2; ++_h) dst[_h] = S.arow_tok(unit, _h * HALF + _R) | (S.arow_tok(unit, _h * HALF + _R + 64) << 16); } while (0)
    Unit cur, nxt; int ui = 0;
    if (!S.next(0, cur)) return;
    f32x4 acc[2][2][4][2];
#pragma unroll
    for (int a = 0; a < 2; ++a)
#pragma unroll
        for (int b = 0; b < 2; ++b)
#pragma unroll
            for (int m = 0; m < 4; ++m)
#pragma unroll
                for (int n = 0; n < 2; ++n) acc[a][b][m][n] = (f32x4){0.f, 0.f, 0.f, 0.f};
    if (Epi::HAS_INIT) { const typename Epi::Init i0 = E.init(cur, wr, wc, fr, fq);
#pragma unroll
      for (int a = 0; a < 2; ++a)
#pragma unroll
        for (int b = 0; b < 2; ++b)
#pragma unroll
            for (int m = 0; m < 4; ++m)
#pragma unroll
                for (int n = 0; n < 2; ++n) acc[a][b][m][n] = i0.v[b][n]; }
    unsigned sc8 = 0x7c7c7c7cu; asm volatile("" : "+v"(sc8));
    bf16x8 At[4][2], B0[2][2], B1[2][2]; v8i At8[4], B08[2], B18[2];
    unsigned roc[2] = {0u, 0u}, ron[2] = {0u, 0u};
    bool has_next = S.next(1, nxt);
    if (GATHER) { PG8_LOAD_RO(roc, cur); if (has_next) { PG8_LOAD_RO(ron, nxt); } else { ron[0] = roc[0]; ron[1] = roc[1]; } }
    const char* cA = (const char*)A + (GATHER ? (size_t)0 : (size_t)cur.pm * tstep); const char* cB = (const char*)Bt + (size_t)cur.brow * K * 2;
    const char* nA = cA;
    PG8_STAGE_B(PG8_SB(0, 0), cB); PG8_STAGE_B(PG8_SB(0, 1), cB + hstep); PG8_STAGE_A(PG8_SA(0, 0), 0, 0, false); PG8_STAGE_A(PG8_SA(0, 1), 1, 0, false);
    if (wr == 1) PG8_BAR;
    PG8_WAIT_V(2); PG8_BAR;
    PG8_STAGE_B(PG8_SB(1, 0), cB + kstep); PG8_STAGE_A(PG8_SA(1, 0), 0, kstep, false); PG8_STAGE_B(PG8_SB(1, 1), cB + hstep + kstep);
    PG8_WAIT_V(6); PG8_BAR;
    for (;;) {
        nA = (has_next && !GATHER) ? (const char*)A + (size_t)nxt.pm * tstep : cA;
        const char* nB = has_next ? (const char*)Bt + (size_t)nxt.brow * K * 2 : cB;
        const typename Epi::Pre pre = E.pre(cur, wr, wc, fr, fq);
#pragma unroll 1
        for (int t = 0; t < nt; t += 2) {
            const bool last = (t == nt - 2);
            const size_t k1 = (size_t)(t + 1) * kstep, k2 = last ? (size_t)0 : (size_t)(t + 2) * kstep, k3 = k2 + kstep;
            const char* b2 = last ? nB : cB + (size_t)(t + 2) * kstep; const char* b3 = b2 + kstep;
            PG8_LDB(B0, 0, 0); PG8_LDB(B1, 0, 1); PG8_SCHED; PG8_LDA(At, 0, 0); PG8_STAGE_A(PG8_SA(1, 1), 1, k1, false);
            PG8_WAIT_V(8); PG8_WAIT_L(0); PG8_BAR; PG8_MMA(0, 0, At, B0); PG8_MMA(0, 1, At, B1); PG8_BAR; PG8_SCHED;
            PG8_LDA(At, 0, 1); PG8_STAGE_B(PG8_SB(0, 0), b2); PG8_STAGE_B(PG8_SB(0, 1), b2 + hstep); PG8_STAGE_A(PG8_SA(0, 0), 0, k2, last);
            PG8_WAIT_V(8); PG8_WAIT_L(0); PG8_BAR; PG8_MMA(1, 0, At, B0); PG8_MMA(1, 1, At, B1); PG8_BAR; PG8_SCHED;
            PG8_LDB(B0, 1, 0); PG8_LDB(B1, 1, 1); PG8_SCHED; PG8_LDA(At, 1, 0); PG8_STAGE_A(PG8_SA(0, 1), 1, k2, last);
            PG8_WAIT_V(8); PG8_WAIT_L(0); PG8_BAR; PG8_MMA(0, 0, At, B0); PG8_MMA(0, 1, At, B1); PG8_BAR; PG8_SCHED;
            PG8_LDA(At, 1, 1); PG8_STAGE_B(PG8_SB(1, 0), b3); PG8_STAGE_B(PG8_SB(1, 1), b3 + hstep); PG8_STAGE_A(PG8_SA(1, 0), 0, k3, last);
            PG8_WAIT_V(8); PG8_WAIT_L(0); PG8_BAR; PG8_MMA(1, 0, At, B0); PG8_MMA(1, 1, At, B1); PG8_BAR; PG8_SCHED;
        }
        typename Epi::Init inx = typename Epi::Init(); if (Epi::HAS_INIT && has_next) inx = E.init(nxt, wr, wc, fr, fq);
        Unit nn; bool has_nn = false; unsigned rnn[2] = {0u, 0u};
        if (has_next) { has_nn = S.next(ui + 2, nn); if (GATHER && has_nn) { PG8_LOAD_RO(rnn, nn); } }
        if (wr == 0) PG8_BAR;
        if constexpr (F8) asm volatile("s_nop 15\n\ts_nop 15" ::: "memory");
        E(acc, cur, wr, wc, fr, fq, pre);
        if (!has_next) break;
#pragma unroll
        for (int a = 0; a < 2; ++a)
#pragma unroll
            for (int b = 0; b < 2; ++b)
#pragma unroll
                for (int m = 0; m < 4; ++m)
#pragma unroll
                    for (int n = 0; n < 2; ++n) acc[a][b][m][n] = Epi::HAS_INIT ? inx.v[b][n] : (f32x4){0.f, 0.f, 0.f, 0.f};
        cur = nxt; cA = nA; cB = nB; ++ui;
        has_next = has_nn; nxt = nn;
        if (GATHER) { roc[0] = ron[0]; roc[1] = ron[1]; if (has_next) { ron[0] = rnn[0]; ron[1] = rnn[1]; } }
        if (wr == 1) PG8_BAR;
    }
    PG8_WAIT_V(0);
    PG8_BAR;
#undef PG8_SA
#undef PG8_SB
#undef PG8_STAGE_A
#undef PG8_STAGE_B
#undef PG8_LDA
#undef PG8_LDB
#undef PG8_MMA
#undef PG8_WAIT_V
#undef PG8_WAIT_L
#undef PG8_BAR
#undef PG8_SCHED
#undef PG8_LOAD_RO
}

struct EpiPlainBf16 {
    static constexpr bool PERM = true;
    bf16_t* O; int ldc;
    static constexpr bool HAS_INIT = false; struct Init { f32x4 v[2][2]; };
    __device__ __forceinline__ Init init(const Unit&, int, int, int, int) const { return Init(); }
    struct Pre {};
    __device__ __forceinline__ Pre pre(const Unit&, int, int, int, int) const { return Pre{}; }
    __device__ __forceinline__ void operator()(const f32x4 (&acc)[2][2][4][2], const Unit& u, int wr, int wc, int fr, int fq, const Pre&) const {
        const int row0 = u.pm * BM + wr * 64 + fr, col0 = u.pn * BM + wc * 32 + 8 * fq;
#pragma unroll
        for (int ai = 0; ai < 2; ++ai)
#pragma unroll
            for (int m = 0; m < 4; ++m) { bf16_t* rowp = O + (size_t)(row0 + ai * HALF + m * 16) * ldc + col0;
#pragma unroll
                for (int bj = 0; bj < 2; ++bj) { const f32x4 v0 = acc[ai][bj][m][0], v1 = acc[ai][bj][m][1];
                    v4u w; w.x = cvt_pk_bf16(v0[0], v0[1]); w.y = cvt_pk_bf16(v0[2], v0[3]); w.z = cvt_pk_bf16(v1[0], v1[1]); w.w = cvt_pk_bf16(v1[2], v1[3]);
                    *(v4u*)(rowp + bj * HALF) = w; } }
    }
};

struct SchedInProj {
    int G, c;
    __device__ __forceinline__ bool next(int i, Unit& u) const {
        const int L = i * G + c;
        if (L < 1152) { int lt, pn; tile_order(L, 128, 9, lt, pn); u.pm = (lt >> 3) * 9 + 1 + (lt & 7); u.pn = pn; }
        else if (L < 1216) { const int q = L - 1152, ct = q >> 2, j = q & 3; u.pm = ct * 9; u.pn = (j == 3) ? 8 : 1 + j; }
        else return false;
        u.brow = u.pn * BM; u.e = 0; u.r0 = 0; u.cnt = 0; return true;
    }
    __device__ __forceinline__ unsigned arow_tok(const Unit&, int) const { return 0u; }
};
struct EpiInProj {
    static constexpr bool PERM = false;
    unsigned char* ws; const float* qng; const float* kng; const float* rope;
    static constexpr bool HAS_INIT = false; struct Init { f32x4 v[2][2]; };
    __device__ __forceinline__ Init init(const Unit&, int, int, int, int) const { return Init(); }
    struct Pre {};
    __device__ __forceinline__ Pre pre(const Unit&, int, int, int, int) const { return Pre{}; }
    __device__ __forceinline__ void operator()(const f32x4 (&acc)[2][2][4][2], const Unit& u, int wr, int wc, int fr, int fq, const Pre&) const {
        const int g = u.pn * 4 + wc, bt = u.pm / 9, pt = u.pm % 9; const bool isctx = (pt == 0);
        const int blk = fq >> 1, f1 = fq & 1, dbase = 32 * blk + 8 * f1;
        const bool do_rms = (g >= 24 && g < 34), do_rope = !isctx && (g < 8 || (g >= 24 && g < 34)), latrows = (g < 4) || (g >= 16 && g < 32);
        const float scale = (g >= 4 && g < 8) ? 0.125f : ((g >= 24 && g < 32) ? C2 : 1.0f);
        bf16_t* dst; int pitch;
        if (g < 4) { dst = (bf16_t*)(ws + WS_RQ) + g * 64; pitch = 256; }
        else if (g < 8) { dst = (bf16_t*)(ws + WS_RK) + (g - 4) * 64; pitch = 256; }
        else if (g < 16) { dst = (bf16_t*)(ws + WS_RV) + (g - 8) * 64; pitch = 512; }
        else if (g < 24) { dst = (bf16_t*)(ws + WS_RG) + (g - 16) * 64; pitch = 512; }
        else if (g < 32) { dst = (bf16_t*)(ws + WS_AQ) + (g - 24) * 64; pitch = 512; }
        else if (g < 34) { dst = (bf16_t*)(ws + WS_AK) + (g - 32) * 64; pitch = 128; }
        else { dst = (bf16_t*)(ws + WS_AV) + (g - 34) * 64; pitch = 128; }
        const int rowbase = latrows ? bt * SEQ + (pt - 1) * 256 : u.pm * 256;
        dst += dbase;
        f32x4 gv[2][2];
#pragma unroll
        for (int bj = 0; bj < 2; ++bj)
#pragma unroll
            for (int n = 0; n < 2; ++n) gv[bj][n] = do_rms ? *(const f32x4*)((g < 32 ? qng : kng) + dbase + 16 * bj + 4 * n) : (f32x4){1.f, 1.f, 1.f, 1.f};
#pragma unroll
        for (int ai = 0; ai < 2; ++ai)
#pragma unroll
            for (int m = 0; m < 4; ++m) {
                const int r = ai * HALF + wr * 64 + m * 16 + fr;
                f32x4 v[2][2];
#pragma unroll
                for (int bj = 0; bj < 2; ++bj)
#pragma unroll
                    for (int n = 0; n < 2; ++n) v[bj][n] = acc[ai][bj][m][n];
                if (do_rms) {
                    float ss = 0.f;
#pragma unroll
                    for (int bj = 0; bj < 2; ++bj)
#pragma unroll
                        for (int n = 0; n < 2; ++n) ss += (v[bj][n][0] * v[bj][n][0] + v[bj][n][1] * v[bj][n][1]) + (v[bj][n][2] * v[bj][n][2] + v[bj][n][3] * v[bj][n][3]);
                    ss += __shfl_xor(ss, 16); ss += __shfl_xor(ss, 32);
                    const float rinv = 1.0f / sqrtf(ss * (1.0f / 64.0f) + LN_EPS);
#pragma unroll
                    for (int bj = 0; bj < 2; ++bj)
#pragma unroll
                        for (int n = 0; n < 2; ++n) v[bj][n] = v[bj][n] * rinv * gv[bj][n];
                }
                if (do_rope) {
                    const int t = (pt - 1) * 256 + r, pos = blk ? (t & 63) : (t >> 6);
                    const f32x4* rp = (const f32x4*)(rope + pos * 32 + 16 * f1);
#pragma unroll
                    for (int n = 0; n < 2; ++n) { const f32x4 p0 = rp[2 * n], p1 = rp[2 * n + 1];
                        const f32x4 lo = v[0][n], hi = v[1][n];
                        const f32x4 cs = {p0[0], p0[2], p1[0], p1[2]}, sn = {p0[1], p0[3], p1[1], p1[3]};
                        v[0][n] = lo * cs - hi * sn; v[1][n] = hi * cs + lo * sn; }
                }
                bf16_t* rowp = dst + (size_t)(rowbase + r) * pitch;
#pragma unroll
                for (int bj = 0; bj < 2; ++bj) { const f32x4 v0 = v[bj][0] * scale, v1 = v[bj][1] * scale;
                    v4u w; w.x = cvt_pk_bf16(v0[0], v0[1]); w.y = cvt_pk_bf16(v0[2], v0[3]); w.z = cvt_pk_bf16(v1[0], v1[1]); w.w = cvt_pk_bf16(v1[2], v1[3]);
                    *(v4u*)(rowp + 16 * bj) = w; }
            }
    }
};

struct SchedMoE {
    int nN, NB, G, c; const LAS int* tab; const v2u* LIST;
    __device__ __forceinline__ bool next(int i, Unit& u) const {
        const int ntiles = __builtin_amdgcn_readfirstlane(tab[32]); const long L = (long)i * G + c; if (L >= (long)ntiles * nN) return false;
        tile_order((int)L, ntiles, nN, u.pm, u.pn);
        const int ln = (int)(threadIdx.x & 63u); const int tq = (ln >= 1 && ln < 32) ? tab[ln] : 0x7fffffff;
        const int e = __builtin_popcountll(__ballot(u.pm >= tq));
        u.e = e; u.r0 = (u.pm - __builtin_amdgcn_readfirstlane(tab[e])) * 256; u.cnt = __builtin_amdgcn_readfirstlane(tab[33 + e]); u.brow = e * NB + u.pn * BM; return true;
    }
    __device__ __forceinline__ unsigned arow_tok(const Unit& u, int r) const { int rr = u.r0 + r; rr = rr < u.cnt ? rr : u.cnt - 1; return LIST[(size_t)u.e * LISTCAP + rr].x >> 2; }
};
__device__ __forceinline__ void moe_build_tab(LAS int* tab, const unsigned* CNT) {
    if (threadIdx.x == 0) { int st = 0; for (int e = 0; e < 32; ++e) { const int c = (int)CNT[e]; tab[e] = st; tab[33 + e] = c; st += (c + 255) >> 8; } tab[32] = st; }
    __syncthreads();
}
struct EpiUp {
    static constexpr bool PERM = true;
    unsigned char* ACT; const float* bup;
    static constexpr bool HAS_INIT = true; struct Init { f32x4 v[2][2]; };
    __device__ __forceinline__ Init init(const Unit& u, int wr, int wc, int fr, int fq) const {
        const float* bg = bup + (size_t)u.e * 2048 + u.pn * 128 + wc * 32 + 8 * fq; Init i; i.v[0][0] = *(const f32x4*)bg; i.v[0][1] = *(const f32x4*)(bg + 4); i.v[1][0] = *(const f32x4*)(bg + 1024) + 1.0f; i.v[1][1] = *(const f32x4*)(bg + 1028) + 1.0f; return i; }
    struct Pre {};
    __device__ __forceinline__ Pre pre(const Unit&, int, int, int, int) const { return Pre{}; }
    __device__ __forceinline__ void operator()(const f32x4 (&acc)[2][2][4][2], const Unit& u, int wr, int wc, int fr, int fq, const Pre&) const {
        const int colt = u.pn * 128 + wc * 32 + 8 * fq;
#pragma unroll
        for (int ai = 0; ai < 2; ++ai)
#pragma unroll
            for (int m = 0; m < 4; ++m) {
                const int row = u.pm * BM + ai * HALF + wr * 64 + m * 16 + fr;
                f32x4 ag[2] = {acc[ai][0][m][0], acc[ai][0][m][1]}, al[2] = {acc[ai][1][m][0], acc[ai][1][m][1]};
                asm volatile("" : "+v"(ag[0]), "+v"(ag[1]), "+v"(al[0]), "+v"(al[1]));
                float o[8];
#pragma unroll
                for (int n = 0; n < 2; ++n)
#pragma unroll
                    for (int j = 0; j < 4; ++j) { const float gl = __builtin_amdgcn_fmed3f(ag[n][j], -3.0e38f, 7.0f); const float l1 = __builtin_amdgcn_fmed3f(al[n][j], -6.0f, 8.0f);
                        o[4 * n + j] = (gl * l1) * __builtin_amdgcn_rcpf(1.0f + __builtin_amdgcn_exp2f(-1.702f * 1.4426950408889634f * gl)); }
                v2u w; w.x = 0u; w.y = 0u;
                w.x = __builtin_amdgcn_cvt_pk_fp8_f32(o[0], o[1], w.x, false); w.x = __builtin_amdgcn_cvt_pk_fp8_f32(o[2], o[3], w.x, true);
                w.y = __builtin_amdgcn_cvt_pk_fp8_f32(o[4], o[5], w.y, false); w.y = __builtin_amdgcn_cvt_pk_fp8_f32(o[6], o[7], w.y, true);
                *(v2u*)(ACT + (size_t)row * 1024 + colt) = w;
            }
    }
};
struct EpiDown {
    static constexpr bool PERM = true;
    bf16_t* YE; const float* bdn; const v2u* LIST;
    static constexpr bool HAS_INIT = true; struct Init { f32x4 v[2][2]; };
    __device__ __forceinline__ Init init(const Unit& u, int wr, int wc, int fr, int fq) const {
        Init i; const float* bb = bdn + (size_t)u.e * 1024 + u.pn * BM + wc * 64 + 16 * fq;
#pragma unroll
        for (int bj = 0; bj < 2; ++bj)
#pragma unroll
            for (int n = 0; n < 2; ++n) i.v[bj][n] = *(const f32x4*)(bb + 8 * bj + 4 * n);
        return i; }
    struct Pre { v2u ent[2][4]; };
    __device__ __forceinline__ Pre pre(const Unit& u, int wr, int wc, int fr, int fq) const {
        Pre p;
#pragma unroll
        for (int ai = 0; ai < 2; ++ai)
#pragma unroll
            for (int m = 0; m < 4; ++m) { const int rr = u.r0 + ai * HALF + wr * 64 + m * 16 + fr; p.ent[ai][m] = LIST[(size_t)u.e * LISTCAP + (rr < u.cnt ? rr : u.cnt - 1)]; }
        return p;
    }
    __device__ __forceinline__ void operator()(const f32x4 (&acc)[2][2][4][2], const Unit& u, int wr, int wc, int fr, int fq, const Pre& P) const {
        const int col0 = u.pn * BM + wc * 64 + 16 * fq;
#pragma unroll
        for (int ai = 0; ai < 2; ++ai)
#pragma unroll
            for (int m = 0; m < 4; ++m) {
                const int rr = u.r0 + ai * HALF + wr * 64 + m * 16 + fr; const bool valid = rr < u.cnt;
                const v2u ent = P.ent[ai][m]; const float gate = __uint_as_float(ent.y);
                unsigned char* rowp = (unsigned char*)YE + (size_t)ent.x * 1024 + col0;
                const float g64 = gate * 64.0f;
                f32x4 a0 = acc[ai][0][m][0], a1 = acc[ai][0][m][1], a2 = acc[ai][1][m][0], a3 = acc[ai][1][m][1]; asm volatile("" : "+v"(a0), "+v"(a1), "+v"(a2), "+v"(a3));
                const f32x4 v0 = a0 * g64, v1 = a1 * g64, v2 = a2 * g64, v3 = a3 * g64;
                v4u w; w.x = 0u; w.y = 0u; w.z = 0u; w.w = 0u;
                w.x = __builtin_amdgcn_cvt_pk_fp8_f32(v0[0], v0[1], w.x, false); w.x = __builtin_amdgcn_cvt_pk_fp8_f32(v0[2], v0[3], w.x, true);
                w.y = __builtin_amdgcn_cvt_pk_fp8_f32(v1[0], v1[1], w.y, false); w.y = __builtin_amdgcn_cvt_pk_fp8_f32(v1[2], v1[3], w.y, true);
                w.z = __builtin_amdgcn_cvt_pk_fp8_f32(v2[0], v2[1], w.z, false); w.z = __builtin_amdgcn_cvt_pk_fp8_f32(v2[2], v2[3], w.z, true);
                w.w = __builtin_amdgcn_cvt_pk_fp8_f32(v3[0], v3[1], w.w, false); w.w = __builtin_amdgcn_cvt_pk_fp8_f32(v3[2], v3[3], w.w, true);
                if (valid) *(v4u*)rowp = w;
            }
    }
};
}

#include <hip/hip_bf16.h>
#include <cmath>
namespace attn_body {
using bf16=__hip_bfloat16;
using bf16x8=__attribute__((ext_vector_type(8)))short;
using s16x4=__attribute__((ext_vector_type(4)))short;
using f32x16=__attribute__((ext_vector_type(16)))float;
using u32x4=__attribute__((ext_vector_type(4)))unsigned;
constexpr int D=64,QP=512,KP=128,OP=1024,SEQQ=2048,SEQK=2304;
constexpr int NW=8,QBLK=32,QB=QBLK*NW,KVBLK=64,NQB=SEQQ/QB;
constexpr int ATTN_UNIT_ROWS=QB;
__device__ __forceinline__ int crow(int r,int hi){return (r&3)+8*(r>>2)+4*hi;}
#define SBAR() __builtin_amdgcn_sched_barrier(0)
__device__ __forceinline__ void cmask(f32x16&p0,f32x16&p1,int jb,int qrel,int hi){
  const float NEG=-INFINITY; int kb=64*jb+4*hi;
  #pragma unroll
  for(int r=0;r<16;++r){int kv=kb+(r&3)+8*(r>>2); if(kv>qrel)p0[r]=NEG; if(kv+32>qrel)p1[r]=NEG;}
}

constexpr int NSLOT=3, SLOTB=8192;
constexpr int LDS_K=0, LDS_V=NSLOT*SLOTB, LDS_WS=2*NSLOT*SLOTB, LDS_OST=LDS_WS+NW*64*4, LDS_BYTES=LDS_OST+NW*4096;
constexpr float C2=0.125f*1.4426950408889634f;
__device__ __forceinline__ void glds16(const void*gsrc,unsigned lds_dst){unsigned keep;
  asm volatile("s_mov_b32 %0, m0\n\ts_mov_b32 m0, %2\n\ts_nop 0\n\tglobal_load_lds_dwordx4 %1, off\n\ts_mov_b32 m0, %0":"=&s"(keep):"v"(gsrc),"s"(lds_dst):"memory");}
__device__ __forceinline__ float max3f(float a,float b,float c){float r;asm("v_max3_f32 %0, %1, %2, %3":"=v"(r):"v"(a),"v"(b),"v"(c));return r;}
__device__ __forceinline__ float max2f(float a,float b){float r;asm("v_max_f32_e32 %0, %1, %2":"=v"(r):"v"(a),"v"(b));return r;}
__device__ __forceinline__ float fadd_s(float a,float b){float r;asm("v_add_f32_e32 %0, %1, %2":"=v"(r):"v"(a),"v"(b));return r;}
__device__ __forceinline__ float fsub_s(float a,float b){float r;asm("v_sub_f32_e32 %0, %1, %2":"=v"(r):"v"(a),"v"(b));return r;}
typedef float f32x2_t __attribute__((ext_vector_type(2))); typedef __bf16 bf16x2_t __attribute__((ext_vector_type(2)));
__device__ __forceinline__ unsigned cvtpk_s(float lo,float hi){f32x2_t v={lo,hi};bf16x2_t b=__builtin_convertvector(v,bf16x2_t);return __builtin_bit_cast(unsigned,b);}
#define WAIT_BAR(N) asm volatile("s_waitcnt vmcnt(" #N ") lgkmcnt(0)\n\ts_barrier":::"memory")

__device__ __forceinline__ void qkt(f32x16&p0,f32x16&p1,const char*Kslot,const bf16x8*qr,const f32x16&negm,int r32,int hi){
  const char*kb=Kslot+hi*1024+r32*16;
  #pragma unroll
  for(int d0=0;d0<4;++d0){
    const bf16x8 b0=*reinterpret_cast<const bf16x8*>(kb+d0*2048);
    const bf16x8 b1=*reinterpret_cast<const bf16x8*>(kb+d0*2048+512);
    if(d0==0){p0=__builtin_amdgcn_mfma_f32_32x32x16_bf16(b0,qr[0],negm,0,0,0);p1=__builtin_amdgcn_mfma_f32_32x32x16_bf16(b1,qr[0],negm,0,0,0);}
    else{p0=__builtin_amdgcn_mfma_f32_32x32x16_bf16(b0,qr[d0],p0,0,0,0);p1=__builtin_amdgcn_mfma_f32_32x32x16_bf16(b1,qr[d0],p1,0,0,0);}}
}
typedef __attribute__((address_space(3))) const char* lds_cptr;
typedef short v4i16_t __attribute__((ext_vector_type(4)));
__device__ __forceinline__ void kload8(bf16x8*kf,lds_cptr kp){
  kf[0]=*(const __attribute__((address_space(3))) bf16x8*)(kp);      kf[1]=*(const __attribute__((address_space(3))) bf16x8*)(kp+512);
  kf[2]=*(const __attribute__((address_space(3))) bf16x8*)(kp+2048); kf[3]=*(const __attribute__((address_space(3))) bf16x8*)(kp+2560);
  kf[4]=*(const __attribute__((address_space(3))) bf16x8*)(kp+4096); kf[5]=*(const __attribute__((address_space(3))) bf16x8*)(kp+4608);
  kf[6]=*(const __attribute__((address_space(3))) bf16x8*)(kp+6144); kf[7]=*(const __attribute__((address_space(3))) bf16x8*)(kp+6656);
}
__device__ __forceinline__ void kload2(bf16x8*kf,lds_cptr kp,int j){ kf[2*j]=*(const __attribute__((address_space(3))) bf16x8*)(kp+j*2048); kf[2*j+1]=*(const __attribute__((address_space(3))) bf16x8*)(kp+j*2048+512); }
__device__ __forceinline__ s16x4 vtr(lds_cptr p){ return __builtin_bit_cast(s16x4,__builtin_amdgcn_ds_read_tr16_b64_v4i16((__attribute__((address_space(3))) v4i16_t*)p)); }
__device__ __forceinline__ float rowmax(const f32x16&p0,const f32x16&p1){
  float a=max3f(p0[0],p0[1],p1[0]),b=max3f(p0[2],p0[3],p1[1]);a=max3f(a,p1[2],p1[3]);
  #pragma unroll
  for(int r=4;r<16;r+=4){a=max3f(a,p0[r],p0[r+1]);b=max3f(b,p0[r+2],p0[r+3]);a=max3f(a,p1[r],p1[r+1]);b=max3f(b,p1[r+2],p1[r+3]);}
  const float m=max2f(a,b);
  auto rr=__builtin_amdgcn_permlane32_swap(__float_as_uint(m),__float_as_uint(m),false,false);
  return max2f(__uint_as_float(rr[0]),__uint_as_float(rr[1]));
}
__device__ __forceinline__ void pv(f32x16*o,int vb,bf16x8 pa0,bf16x8 pa1,bf16x8 pa2,bf16x8 pa3){
  #pragma unroll
  for(int d0=0;d0<2;++d0){s16x4 lo[4],hi[4];
    #pragma unroll
    for(int ks=0;ks<4;++ks){
      asm volatile("ds_read_b64_tr_b16 %0,%1 offset:%c2":"=&v"(lo[ks]):"v"(vb),"i"(d0*4096+ks*1024):"memory");
      asm volatile("ds_read_b64_tr_b16 %0,%1 offset:%c2":"=&v"(hi[ks]):"v"(vb),"i"(d0*4096+ks*1024+512):"memory");}
    asm volatile("s_waitcnt lgkmcnt(0)":::"memory");SBAR();
    #define PK(k) (bf16x8){lo[k][0],lo[k][1],lo[k][2],lo[k][3],hi[k][0],hi[k][1],hi[k][2],hi[k][3]}
    o[d0]=__builtin_amdgcn_mfma_f32_32x32x16_bf16(pa0,PK(0),o[d0],0,0,0);
    o[d0]=__builtin_amdgcn_mfma_f32_32x32x16_bf16(pa1,PK(1),o[d0],0,0,0);
    o[d0]=__builtin_amdgcn_mfma_f32_32x32x16_bf16(pa2,PK(2),o[d0],0,0,0);
    o[d0]=__builtin_amdgcn_mfma_f32_32x32x16_bf16(pa3,PK(3),o[d0],0,0,0);
    #undef PK
  }
}

#ifndef ATTN_STORE16
#define ATTN_STORE16(p,v) (*(u32x4*)(p)=(v))
#endif
template<int THRL> __device__ __forceinline__ void attn_unit(int b,int h,int qb,const bf16*Q,const bf16*__restrict__ K,const bf16*__restrict__ V,bf16*O,char*shm,float refB){
  const int tid=threadIdx.x,lane=tid&63,r32=lane&31,hi=lane>>5; const int wid=__builtin_amdgcn_readfirstlane(tid>>6);
  const long rowq=(long)b*SEQQ,rowk=(long)b*SEQK; const int q0=qb*QB;
  const bf16*Qw=Q+(rowq+q0+wid*QBLK)*QP+h*D;
  const bf16*Kh=K+rowk*KP+(h>>2)*D,*Vh=V+rowk*KP+(h>>2)*D;
  const unsigned lds0=(unsigned)(uintptr_t)shm;
  float*wsf=(float*)(shm+LDS_WS)+wid*64;
  const bf16*ksrc=Kh+(long)lane*KP+wid*8;
  const bf16*vsrc=Vh+(long)(16*(wid&3)+(lane>>2))*KP+(wid>>2)*32+(lane&3)*8;
  const unsigned kdst=lds0+LDS_K+wid*1024, vdst=lds0+LDS_V+wid*1024;
  #define DMA_K(t,slot) glds16(ksrc+(long)(t)*KVBLK*KP,(unsigned)__builtin_amdgcn_readfirstlane(kdst+(slot)))
  #define DMA_V(t,slot) glds16(vsrc+(long)(t)*KVBLK*KP,(unsigned)__builtin_amdgcn_readfirstlane(vdst+(slot)))
  const int vb0=(int)(lds0+LDS_V)+((lane>>4)&1)*32+(lane&3)*8+(4*hi+((lane&15)>>2))*64;
  const char*Kbase=shm+LDS_K; bf16x8 kf[8];
  const lds_cptr shm3=(lds_cptr)shm; const lds_cptr kp0=shm3+LDS_K+hi*1024+r32*16; const lds_cptr vp0=shm3+LDS_V+((lane>>4)&1)*32+(lane&3)*8+(4*hi+((lane&15)>>2))*64;
  const int NT=SEQK/KVBLK;
  DMA_K(0,0);DMA_V(0,0);DMA_K(1,SLOTB);
  bf16x8 qr[4];
  #pragma unroll
  for(int d0=0;d0<4;++d0)qr[d0]=*reinterpret_cast<const bf16x8*>(&Qw[(long)r32*QP+d0*16+hi*8]);
  float mhat=refB,l_reg=0.f;f32x16 o[2];o[0]=f32x16{};o[1]=f32x16{};f32x16 negm; _Pragma("unroll") for(int r=0;r<16;++r)negm[r]=-refB; asm volatile("":"+v"(negm));

  #define CMASK(P0,P1,t) do{}while(0)
  bool resc=false;
  #define START(P0,P1) do{ resc=false; \
    _Pragma("unroll") for(int r=0;r<16;++r)P0[r]=__builtin_amdgcn_exp2f(P0[r]); }while(0)
  #define RESC() do{ if(resc){ asm volatile("s_waitcnt lgkmcnt(0)":::"memory"); \
      _Pragma("unroll") for(int d_=0;d_<2;++d_) _Pragma("unroll") for(int r=0;r<16;++r)o[d_][r]*=wsf[crow(r,hi)]; } }while(0)
  f32x16 pA0,pA1,pB0,pB1;
  int sl_prev=0,sl_cur=0,sl_next=SLOTB;
  #define ROT() do{sl_prev=sl_cur;sl_cur=sl_next;sl_next=(sl_next==(NSLOT-1)*SLOTB)?0:sl_next+SLOTB;}while(0)
  DMA_K(2,2*SLOTB);
  WAIT_BAR(3);
  qkt(pA0,pA1,Kbase,qr,negm,r32,hi);asm volatile("s_nop 15\n\ts_nop 7":"+v"(pA0),"+v"(pA1));CMASK(pA0,pA1,0);
  START(pA0,pA1);
  _Pragma("unroll") for(int r=0;r<16;++r)pA1[r]=__builtin_amdgcn_exp2f(pA1[r]);
  WAIT_BAR(0);
  DMA_K(3,0);DMA_V(1,SLOTB);
  ROT();
  kload8(kf,kp0+sl_cur);
  WAIT_BAR(2);
  s16x4 vlo[8],vhi[8]; u32x4 pw0,pw1,pw2,pw3;
  #define PKW(P,B) cvtpk_s(P[B],P[B+1])
  #define PAF(k) __builtin_bit_cast(bf16x8,pw##k)
  #define VFR(i) (bf16x8){vlo[i][0],vlo[i][1],vlo[i][2],vlo[i][3],vhi[i][0],vhi[i][1],vhi[i][2],vhi[i][3]}
  #define PIN(x) asm volatile("":"+v"(x))
  #define MX3(a,b,c) __builtin_fmaxf(__builtin_fmaxf((a),(b)),(c))
  #define GAPA(MF,A0,A1,A2,A3,W0,W1,PW) do{ MF; sacc+=A0; sacc+=A1; sacc+=A2; sacc+=A3; PIN(sacc); W0; W1; PIN(PW); SBAR(); }while(0)
  #define EX(v) __builtin_amdgcn_exp2f(v)
  #define GAPB(MF,X,B) do{ MF; X[B]=EX(X[B]); X[B+1]=EX(X[B+1]); X[B+2]=EX(X[B+2]); X[B+3]=EX(X[B+3]); PIN(X); SBAR(); }while(0)
  #define VRD(i) do{ vlo[i]=vtr(vp_+(((i)>>2)*4096+((i)&3)*1024)); vhi[i]=vtr(vp_+(((i)>>2)*4096+((i)&3)*1024+512)); }while(0)
  #define KRD(G,j) do{ if(G){ kload2(kf,kp0+sl_next,j); SBAR(); } }while(0)
  #define STEP(C0,C1,P0,P1,t,GK,GV,GL) do{ SBAR(); \
    const lds_cptr vp_=vp0+sl_prev; \
    VRD(0); SBAR(); float sacc=(P0[0]+P0[1]); \
    GAPA(C0=__builtin_amdgcn_mfma_f32_32x32x16_bf16(kf[0],qr[0],negm,0,0,0), P0[2],P0[3],P0[4],P0[5],     pw0[0]=PKW(P0,0), pw0[1]=PKW(P0,2), pw0); \
    VRD(4); SBAR(); GAPA(C1=__builtin_amdgcn_mfma_f32_32x32x16_bf16(kf[1],qr[0],negm,0,0,0), P0[6],P0[7],P0[8],P0[9],     pw0[2]=PKW(P0,4), pw0[3]=PKW(P0,6), pw0); \
    VRD(1); SBAR(); GAPA(C0=__builtin_amdgcn_mfma_f32_32x32x16_bf16(kf[2],qr[1],C0,0,0,0),   P0[10],P0[11],P0[12],P0[13], pw1[0]=PKW(P0,8), pw1[1]=PKW(P0,10), pw1); \
    VRD(5); SBAR(); GAPA(C1=__builtin_amdgcn_mfma_f32_32x32x16_bf16(kf[3],qr[1],C1,0,0,0),   P0[14],P0[15],P1[0],P1[1],   pw1[2]=PKW(P0,12),pw1[3]=PKW(P0,14), pw1); \
    VRD(2); SBAR(); GAPA(C0=__builtin_amdgcn_mfma_f32_32x32x16_bf16(kf[4],qr[2],C0,0,0,0),   P1[2],P1[3],P1[4],P1[5],     pw2[0]=PKW(P1,0), pw2[1]=PKW(P1,2), pw2); \
    VRD(6); SBAR(); GAPA(C1=__builtin_amdgcn_mfma_f32_32x32x16_bf16(kf[5],qr[2],C1,0,0,0),   P1[6],P1[7],P1[8],P1[9],     pw2[2]=PKW(P1,4), pw2[3]=PKW(P1,6), pw2); \
    VRD(3); SBAR(); GAPA(C0=__builtin_amdgcn_mfma_f32_32x32x16_bf16(kf[6],qr[3],C0,0,0,0),   P1[10],P1[11],P1[12],P1[13], pw3[0]=PKW(P1,8), pw3[1]=PKW(P1,10), pw3); \
    VRD(7); SBAR(); GAPA(C1=__builtin_amdgcn_mfma_f32_32x32x16_bf16(kf[7],qr[3],C1,0,0,0),   P1[14],P1[15],0.f,0.f,       pw3[2]=PKW(P1,12),pw3[3]=PKW(P1,14), pw3); \
    l_reg+=sacc; \
    if(GK){DMA_K((t)+3,sl_cur);} if(GV){DMA_V((t)+1,sl_next);} \
    CMASK(C0,C1,t); \
    resc=false; \
    SBAR(); \
    GAPB(o[0]=__builtin_amdgcn_mfma_f32_32x32x16_bf16(PAF(0),VFR(0),o[0],0,0,0), C0,0); \
    GAPB(o[1]=__builtin_amdgcn_mfma_f32_32x32x16_bf16(PAF(0),VFR(4),o[1],0,0,0), C0,4); \
    KRD(GL,0); GAPB(o[0]=__builtin_amdgcn_mfma_f32_32x32x16_bf16(PAF(1),VFR(1),o[0],0,0,0), C0,8); \
    KRD(GL,1); GAPB(o[1]=__builtin_amdgcn_mfma_f32_32x32x16_bf16(PAF(1),VFR(5),o[1],0,0,0), C0,12); \
    KRD(GL,2); GAPB(o[0]=__builtin_amdgcn_mfma_f32_32x32x16_bf16(PAF(2),VFR(2),o[0],0,0,0), C1,0); \
    KRD(GL,3); GAPB(o[1]=__builtin_amdgcn_mfma_f32_32x32x16_bf16(PAF(2),VFR(6),o[1],0,0,0), C1,4); \
    GAPB(o[0]=__builtin_amdgcn_mfma_f32_32x32x16_bf16(PAF(3),VFR(3),o[0],0,0,0), C1,8); \
    GAPB(o[1]=__builtin_amdgcn_mfma_f32_32x32x16_bf16(PAF(3),VFR(7),o[1],0,0,0), C1,12); \
    }while(0)
  int t=1;
  #undef CMASK
  #define CMASK(P0,P1,t) do{}while(0)
  for(;t+5<NT;t+=2){
    STEP(pB0,pB1,pA0,pA1,t,true,true,true);     WAIT_BAR(2); RESC(); ROT();
    STEP(pA0,pA1,pB0,pB1,t+1,true,true,true);   WAIT_BAR(2); RESC(); ROT();
  }
  #undef CMASK
  #define CMASK(P0,P1,t) do{}while(0)
  #define ENDW(tt) do{ if((tt)+3<NT){WAIT_BAR(2);} else if((tt)+2<NT){WAIT_BAR(1);} else {WAIT_BAR(0);} }while(0)
  for(;t+1<NT;t+=2){
    STEP(pB0,pB1,pA0,pA1,t,(t+3<NT),(t+1<NT),(t+1<NT));       ENDW(t);   RESC(); ROT();
    STEP(pA0,pA1,pB0,pB1,t+1,(t+4<NT),(t+2<NT),(t+2<NT));     ENDW(t+1); RESC(); ROT();
  }
  STEP(pB0,pB1,pA0,pA1,NT-1,false,false,false); RESC();
  { float sacc=pB0[0]+pB0[1]; _Pragma("unroll") for(int r=2;r<16;++r)sacc+=pB0[r]; _Pragma("unroll") for(int r=0;r<16;++r)sacc+=pB1[r]; l_reg+=sacc;
    pw0=(u32x4){PKW(pB0,0),PKW(pB0,2),PKW(pB0,4),PKW(pB0,6)};pw1=(u32x4){PKW(pB0,8),PKW(pB0,10),PKW(pB0,12),PKW(pB0,14)};pw2=(u32x4){PKW(pB1,0),PKW(pB1,2),PKW(pB1,4),PKW(pB1,6)};pw3=(u32x4){PKW(pB1,8),PKW(pB1,10),PKW(pB1,12),PKW(pB1,14)};
    SBAR(); pv(o,vb0+sl_cur,PAF(0),PAF(1),PAF(2),PAF(3)); }
  #undef PKW
  #undef PAF
  #undef VFR
  #undef PIN
  #undef MX3
  #undef GAPA
  #undef GAPB
  #undef EX
  #undef VRD
  #undef KRD
  #undef STEP
  #undef ENDW
  {auto rr=__builtin_amdgcn_permlane32_swap(__float_as_uint(l_reg),__float_as_uint(l_reg),false,false);l_reg=__uint_as_float(rr[0])+__uint_as_float(rr[1]);}
  if(hi==0)wsf[32+r32]=l_reg;asm volatile("s_waitcnt lgkmcnt(0)":::"memory");
  float rli[16];
  #pragma unroll
  for(int r=0;r<16;++r)rli[r]=__builtin_amdgcn_rcpf(wsf[32+crow(r,hi)]);
  bf16*Ow=O+(rowq+q0+wid*QBLK)*OP+h*D;
  { bf16*stg=(bf16*)(shm+LDS_OST)+wid*2048;
    #pragma unroll
    for(int r=0;r<16;++r){const int orow=crow(r,hi);
      #pragma unroll
      for(int d0=0;d0<2;++d0)stg[orow*64+d0*32+r32]=__float2bfloat16(o[d0][r]*rli[r]);}
    asm volatile("s_waitcnt lgkmcnt(0)":::"memory");
    #pragma unroll
    for(int i=0;i<4;++i){const int row=i*8+(lane>>3),ch=lane&7; const u32x4 v=*(const u32x4*)(stg+row*64+ch*8); ATTN_STORE16(Ow+(long)row*OP+ch*8,v);} }
  asm volatile("s_waitcnt lgkmcnt(0)\n\ts_barrier":::"memory");
  #undef DMA_K
  #undef DMA_V
  #undef CMASK
  #undef START
  #undef RESC
  #undef ROT
}
constexpr int ATTN_LDS_BYTES=LDS_BYTES;
struct AttnTensors { const bf16* Q; const bf16* K; const bf16* V; bf16* O; };
struct AttnUnit { int b, h, qb; };
struct StaticOrder {
  int vcu;
  __device__ __forceinline__ explicit StaticOrder(int grid,int block):vcu((block%8)*(grid/8)+block/8){}
  __device__ __forceinline__ bool next(int i,AttnUnit&u)const{ const int p=8*i+(vcu>>5); if(p>=32)return false; const int w=vcu&31; u.b=p>>1; u.h=(p&1)*4+(w>>3); u.qb=w&7; return true; }
};
template<class Sched,int THRL=8> __device__ __forceinline__ void attn_phase(char*lds,const AttnTensors&T,const Sched&S){
  AttnUnit u;
  for(int i=0;S.next(i,u);++i){ attn_unit<THRL>(u.b,u.h,u.qb,T.Q,T.K,T.V,T.O,lds,64.0f); }
}
#undef SBAR
#undef WAIT_BAR
}

namespace ret {
typedef short bf16x8 __attribute__((ext_vector_type(8)));
typedef short s16x4 __attribute__((ext_vector_type(4)));
typedef float f32x16 __attribute__((ext_vector_type(16)));
constexpr int VP = 160, KPT = 48;
constexpr int VB = 128 * VP * 2, KB = 128 * KPT * 2, BUF = VB + KB;
__device__ __forceinline__ int crow(int r, int hi) { return (r & 3) + 8 * (r >> 2) + 4 * hi; }
__device__ __forceinline__ s16x4 trd(const LAS unsigned char* p) { return __builtin_bit_cast(s16x4, __builtin_amdgcn_ds_read_tr16_b64_v4i16((LAS s16x4*)p)); }
__device__ __forceinline__ bf16x8 cat(s16x4 a, s16x4 b) { return (bf16x8){a[0], a[1], a[2], a[3], b[0], b[1], b[2], b[3]}; }
__device__ __forceinline__ v4u scale8(v4u w, float s) {
    v4u o; o.x = pk2(bflo(w.x) * s, bfhi(w.x) * s); o.y = pk2(bflo(w.y) * s, bfhi(w.y) * s); o.z = pk2(bflo(w.z) * s, bfhi(w.z) * s); o.w = pk2(bflo(w.w) * s, bfhi(w.w) * s); return o;
}
constexpr int RAP = 96, RAB = 128 * RAP * 2, RABUF = 2 * RAB;
__device__ __forceinline__ void state_unit(int b, int h, int dir, int dvh, const bf16_t* RK, const bf16_t* RV, bf16_t* ST, float lg2, LAS unsigned char* lds) {
    const int tid = threadIdx.x, lane = tid & 63, wid = __builtin_amdgcn_readfirstlane(tid >> 6), r32 = lane & 31, hi = lane >> 5, dvt = wid & 1, dkt = (wid >> 1) & 1;
    const float g128 = exp2f(lg2 * 128.0f);
    const int prow = tid >> 3, pc8 = tid & 7;
    const float kw0 = dir ? exp2f(lg2 * (float)prow) : exp2f(lg2 * (float)(127 - prow)), kw1 = dir ? exp2f(lg2 * (float)(prow + 64)) : exp2f(lg2 * (float)(63 - prow));
    v4u vreg[2], kreg[2];
    auto chunk_of = [&](int s) { return dir ? (s == 0 ? 1 : (s == 1 ? 0 : 19 - s)) : s; };
    auto load = [&](int s) {
        const size_t urow = (size_t)b * SU + (size_t)chunk_of(s) * 128;
#pragma unroll
        for (int i = 0; i < 2; ++i) { vreg[i] = *(const v4u*)(RV + (urow + prow + 64 * i) * 512 + h * 128 + dvh * 64 + pc8 * 8); kreg[i] = *(const v4u*)(RK + (urow + prow + 64 * i) * 256 + h * 64 + pc8 * 8); }
    };
    load(0);
    f32x16 acc = {};
    const int gq = lane >> 4, colblk = gq & 1, q4 = (lane >> 2) & 3, p4 = lane & 3;
    for (int s = 0; s < 18; ++s) {
        LAS unsigned char* buf = lds + (s & 1) * RABUF;
#pragma unroll
        for (int i = 0; i < 2; ++i) { *(LAS v4u*)(buf + (prow + 64 * i) * (RAP * 2) + pc8 * 16) = vreg[i]; *(LAS v4u*)(buf + RAB + (prow + 64 * i) * (RAP * 2) + pc8 * 16) = scale8(kreg[i], i ? kw1 : kw0); }
        __syncthreads();
        if (s + 1 < 18) load(s + 1);
        if (wid < 4) {
            if (s >= 2) {
                const int n = dir ? 17 - s : s - 2;
                bf16_t* st = ST + ((((size_t)b * 4 + h) * 2 + dir) * 16 + n) * (128 * 64) + dkt * 32 + r32;
#pragma unroll
                for (int r = 0; r < 16; ++r) st[(size_t)(64 * dvh + 32 * dvt + crow(r, hi)) * 64] = (bf16_t)f2bf(acc[r]);
            }
            if (s < 17) {
#pragma unroll
                for (int r = 0; r < 16; ++r) acc[r] *= g128;
                const LAS unsigned char* va = buf + (8 * hi + q4) * (RAP * 2) + (32 * dvt + 16 * colblk + 4 * p4) * 2;
                const LAS unsigned char* ka = buf + RAB + (8 * hi + q4) * (RAP * 2) + (32 * dkt + 16 * colblk + 4 * p4) * 2;
#pragma unroll
                for (int ks = 0; ks < 8; ++ks) {
                    const bf16x8 af = cat(trd(va + ks * 16 * RAP * 2), trd(va + (ks * 16 + 4) * RAP * 2));
                    const bf16x8 bfm = cat(trd(ka + ks * 16 * RAP * 2), trd(ka + (ks * 16 + 4) * RAP * 2));
                    acc = __builtin_amdgcn_mfma_f32_32x32x16_bf16(af, bfm, acc, 0, 0, 0);
                }
            }
        }
    }
    __syncthreads();
}
constexpr int QP2 = 72, GP2 = 136;
constexpr int OFF_Q = VB, OFF_K = OFF_Q + 128 * QP2 * 2, OFF_G = OFF_K + 128 * QP2 * 2, OFF_RED = OFF_G + 128 * GP2 * 2;
struct OutRegs { v4u vv[4], qq[2], kk[2]; };
__device__ __forceinline__ void out_load(OutRegs& R, int u, const bf16_t* RQ, const bf16_t* RK, const bf16_t* RV, const bf16_t* RG) {
    const int tid = threadIdx.x, n = u & 15, h = (u >> 4) & 3, b = u >> 6;
    const size_t m0 = (size_t)b * SEQ + 128 * n, u0 = (size_t)b * SU + CTX + 128 * n;
#pragma unroll
    for (int i = 0; i < 4; ++i) { const int pc = tid + 512 * i; R.vv[i] = *(const v4u*)(RV + (u0 + (pc >> 4)) * 512 + h * 128 + (pc & 15) * 8); }
#pragma unroll
    for (int i = 0; i < 2; ++i) { const int pc = tid + 512 * i; R.qq[i] = *(const v4u*)(RQ + (m0 + (pc >> 3)) * 256 + h * 64 + (pc & 7) * 8); R.kk[i] = *(const v4u*)(RK + (u0 + (pc >> 3)) * 256 + h * 64 + (pc & 7) * 8); }
}
__device__ __forceinline__ void out_unit(OutRegs& R, int u, int unext, const bf16_t* RQ, const bf16_t* RK, const bf16_t* RV, const bf16_t* RG, const bf16_t* ST, const float* gng, const float* gnb, const float* ldf, const float* ldb, bf16_t* MIX, LAS unsigned char* lds) {
    const int n = u & 15, h = (u >> 4) & 3, b = u >> 6; const float lgf = ldf[h] * 1.4426950408889634f, lgb = ldb[h] * 1.4426950408889634f;
    const int tid = threadIdx.x, lane = tid & 63, wid = __builtin_amdgcn_readfirstlane(tid >> 6), r32 = lane & 31, hi = lane >> 5, rg = wid & 3, dvh = wid >> 2;
    const size_t m0 = (size_t)b * SEQ + 128 * n, u0 = (size_t)b * SU + CTX + 128 * n;
    LAS float* red = (LAS float*)(lds + OFF_RED);
    {
        __syncthreads();
#pragma unroll
        for (int i = 0; i < 4; ++i) { const int pc = tid + 512 * i; *(LAS v4u*)(lds + (pc >> 4) * (VP * 2) + (pc & 15) * 16) = R.vv[i]; }
#pragma unroll
        for (int i = 0; i < 2; ++i) { const int pc = tid + 512 * i; *(LAS v4u*)(lds + OFF_Q + (pc >> 3) * (QP2 * 2) + (pc & 7) * 16) = R.qq[i]; *(LAS v4u*)(lds + OFF_K + (pc >> 3) * (QP2 * 2) + (pc & 7) * 16) = R.kk[i]; }
    }
    __syncthreads();
    out_load(R, unext >= 0 ? unext : u, RQ, RK, RV, RG);
    bf16x8 qf[4];
#pragma unroll
    for (int ks = 0; ks < 4; ++ks) qf[ks] = *(const LAS bf16x8*)(lds + OFF_Q + (32 * rg + r32) * (QP2 * 2) + (16 * ks + 8 * hi) * 2);
    f32x16 st[4];
#pragma unroll
    for (int kt = 0; kt < 4; ++kt) { st[kt] = (f32x16){};
#pragma unroll
        for (int ks = 0; ks < 4; ++ks) { const bf16x8 kf = *(const LAS bf16x8*)(lds + OFF_K + (32 * kt + r32) * (QP2 * 2) + (16 * ks + 8 * hi) * 2); st[kt] = __builtin_amdgcn_mfma_f32_32x32x16_bf16(kf, qf[ks], st[kt], 0, 0, 0); } }
    const int c = 32 * rg + r32;
    bf16x8 pa[4][2];
#pragma unroll
    for (int kt = 0; kt < 4; ++kt) {
#pragma unroll
        for (int r = 0; r < 16; ++r) { const int d = c - (32 * kt + crow(r, hi)); const float w = d > 0 ? __builtin_amdgcn_exp2f(lgf * (float)d) : (d < 0 ? __builtin_amdgcn_exp2f(lgb * (float)(-d)) : 2.0f); st[kt][r] *= w; }
#pragma unroll
        for (int s2 = 0; s2 < 2; ++s2) { v4u w; w.x = pk2(st[kt][8 * s2], st[kt][8 * s2 + 1]); w.y = pk2(st[kt][8 * s2 + 2], st[kt][8 * s2 + 3]); w.z = pk2(st[kt][8 * s2 + 4], st[kt][8 * s2 + 5]); w.w = pk2(st[kt][8 * s2 + 6], st[kt][8 * s2 + 7]); pa[kt][s2] = __builtin_bit_cast(bf16x8, w); }
    }
    asm volatile("" ::: "memory");
    v4u gg[4];
#pragma unroll
    for (int i = 0; i < 4; ++i) { const int pc = tid + 512 * i; gg[i] = *(const v4u*)(RG + (m0 + (pc >> 4)) * 512 + h * 128 + (pc & 15) * 8); }
    f32x16 ot[2] = {(f32x16){}, (f32x16){}};
    const int gq = lane >> 4, colblk = gq & 1, q4 = (lane >> 2) & 3, p4 = lane & 3;
#pragma unroll
    for (int dt = 0; dt < 2; ++dt) {
        const LAS unsigned char* va = lds + (4 * hi + q4) * (VP * 2) + (64 * dvh + 32 * dt + 16 * colblk + 4 * p4) * 2;
#pragma unroll
        for (int kt = 0; kt < 4; ++kt)
#pragma unroll
            for (int s2 = 0; s2 < 2; ++s2) { const int kb = 32 * kt + 16 * s2; const bf16x8 vf = cat(trd(va + kb * VP * 2), trd(va + (kb + 8) * VP * 2)); ot[dt] = __builtin_amdgcn_mfma_f32_32x32x16_bf16(vf, pa[kt][s2], ot[dt], 0, 0, 0); }
    }
    {
        const float decf = __builtin_amdgcn_exp2f(lgf * (float)(c + 1)), decb = __builtin_amdgcn_exp2f(lgb * (float)(128 - c));
        const bf16_t* sf = ST + ((((size_t)b * 4 + h) * 2 + 0) * 16 + n) * (128 * 64); const bf16_t* sb = sf + (size_t)16 * 128 * 64;
#pragma unroll
        for (int ks = 0; ks < 4; ++ks) {
            const v4u qw = __builtin_bit_cast(v4u, qf[ks]); const bf16x8 qdf = __builtin_bit_cast(bf16x8, scale8(qw, decf)), qdb = __builtin_bit_cast(bf16x8, scale8(qw, decb));
#pragma unroll
            for (int dt = 0; dt < 2; ++dt) { const size_t so = (size_t)(64 * dvh + 32 * dt + r32) * 64 + 16 * ks + 8 * hi;
                ot[dt] = __builtin_amdgcn_mfma_f32_32x32x16_bf16(*(const bf16x8*)(sf + so), qdf, ot[dt], 0, 0, 0);
                ot[dt] = __builtin_amdgcn_mfma_f32_32x32x16_bf16(*(const bf16x8*)(sb + so), qdb, ot[dt], 0, 0, 0); }
        }
    }
#pragma unroll
    for (int i = 0; i < 4; ++i) { const int pc = tid + 512 * i; *(LAS v4u*)(lds + OFF_G + (pc >> 4) * (GP2 * 2) + (pc & 15) * 16) = gg[i]; }
    float s1 = 0.f;
#pragma unroll
    for (int dt = 0; dt < 2; ++dt)
#pragma unroll
        for (int r = 0; r < 16; ++r) s1 += ot[dt][r];
    s1 += __shfl_xor(s1, 32);
    if (hi == 0) red[wid * 32 + r32] = s1;
    __syncthreads();
    const float mu = (red[wid * 32 + r32] + red[(wid ^ 4) * 32 + r32]) * (1.0f / 128.0f);
    float s2 = 0.f;
#pragma unroll
    for (int dt = 0; dt < 2; ++dt)
#pragma unroll
        for (int r = 0; r < 16; ++r) { const float d = ot[dt][r] - mu; s2 = fmaf(d, d, s2); }
    s2 += __shfl_xor(s2, 32);
    __syncthreads();
    if (hi == 0) red[wid * 32 + r32] = s2;
    __syncthreads();
    const float rs = 1.0f / sqrtf((red[wid * 32 + r32] + red[(wid ^ 4) * 32 + r32]) * (1.0f / 128.0f) + LN_EPS);
    LAS unsigned char* grow = lds + OFF_G + (32 * rg + r32) * (GP2 * 2);
#pragma unroll
    for (int dt = 0; dt < 2; ++dt)
#pragma unroll
        for (int rq = 0; rq < 4; ++rq) {
            const int dv = 64 * dvh + 32 * dt + 8 * rq + 4 * hi;
            const f32x4 gg = *(const f32x4*)(gng + h * 128 + dv), gb = *(const f32x4*)(gnb + h * 128 + dv);
            const v2u gw = *(const LAS v2u*)(grow + dv * 2);
            const float g0 = bflo(gw.x), g1 = bfhi(gw.x), g2 = bflo(gw.y), g3 = bfhi(gw.y);
            const float y0 = ((ot[dt][4 * rq] - mu) * rs * gg[0] + gb[0]) * (g0 * __builtin_amdgcn_rcpf(1.0f + __builtin_amdgcn_exp2f(-1.4426950408889634f * g0)));
            const float y1 = ((ot[dt][4 * rq + 1] - mu) * rs * gg[1] + gb[1]) * (g1 * __builtin_amdgcn_rcpf(1.0f + __builtin_amdgcn_exp2f(-1.4426950408889634f * g1)));
            const float y2 = ((ot[dt][4 * rq + 2] - mu) * rs * gg[2] + gb[2]) * (g2 * __builtin_amdgcn_rcpf(1.0f + __builtin_amdgcn_exp2f(-1.4426950408889634f * g2)));
            const float y3 = ((ot[dt][4 * rq + 3] - mu) * rs * gg[3] + gb[3]) * (g3 * __builtin_amdgcn_rcpf(1.0f + __builtin_amdgcn_exp2f(-1.4426950408889634f * g3)));
            v2u w; w.x = pk2(y0, y1); w.y = pk2(y2, y3);
            *(LAS v2u*)(grow + dv * 2) = w;
        }
    __syncthreads();
#pragma unroll
    for (int i = 0; i < 4; ++i) { const int pc = tid + 512 * i; *(v4u*)(MIX + (m0 + (pc >> 4)) * DM + h * 128 + (pc & 15) * 8) = *(const LAS v4u*)(lds + OFF_G + (pc >> 4) * (GP2 * 2) + (pc & 15) * 16); }
}
}

struct Args {
    const float* in[26]; float* out; unsigned char* ws; int ph_lo, ph_hi, li, pad;
};
enum { I_X = 0, I_C, I_CTX, I_CCTX, I_LNING, I_LNINB, I_WADA, I_BADA, I_WIN, I_LDF, I_LDB, I_GNG, I_GNB, I_QNG, I_KNG, I_WO, I_LN1G, I_LN1B, I_RW, I_RB, I_WUP, I_BUP, I_WDN, I_BDN, I_LN2G, I_LN2B };

struct Frame {
    LAS unsigned char* lds;
    unsigned* ctl;
    int tid, lane, wave, G, gtid, nthreads, gw, ngw;
};

constexpr int LDS_BYTES = 147456, MISC_OFF = 147456 - 1024;

__device__ __forceinline__ int phys_in(int lc) { const int pn = lc >> 8, wc = (lc >> 6) & 3, d = lc & 63; const int blk = d >> 5, bj = (d >> 4) & 1, f1 = (d >> 3) & 1, n = (d >> 2) & 1, j = d & 3;
    return pn * 256 + 128 * bj + 32 * wc + 16 * n + 4 * (2 * blk + f1) + j; }
__device__ __forceinline__ int phys_up(int c) { return 256 * ((c & 1023) >> 7) + 128 * (c >> 10) + (c & 127); }
__device__ __forceinline__ int phys_dn(int c) { const int cc = c & 255; return (c & ~255) + 128 * ((cc >> 3) & 1) + 32 * (cc >> 6) + 8 * ((cc >> 4) & 3) + (cc & 7); }

__device__ __forceinline__ void transpose_load(f32x4 (&v)[16], const float* W, int K, int N, int item, int lane) {
    const int nkb = K / 64, kb = item % nkb, nb = item / nkb, k0 = 64 * kb, n0 = 64 * nb;
    const float* src = W + (size_t)(k0 + (lane >> 4)) * N + n0 + (lane & 15) * 4;
#pragma unroll
    for (int i = 0; i < 16; ++i) v[i] = __builtin_nontemporal_load((const f32x4*)(src + (size_t)(4 * i) * N));
}
__device__ __forceinline__ void transpose_write(const f32x4 (&v)[16], LAS float* scr, int lane) {
#pragma unroll
    for (int i = 0; i < 16; ++i) { LAS float* d = scr + (4 * i + (lane >> 4)) * 65 + (lane & 15) * 4; d[0] = v[i][0]; d[1] = v[i][1]; d[2] = v[i][2]; d[3] = v[i][3]; }
    asm volatile("s_waitcnt lgkmcnt(0)" ::: "memory");
}
template <int MAP, bool F8> __device__ __forceinline__ void transpose_out(int K, void* WT, LAS float* scr, int item, int lane) {
    const int nkb = K / 64, kb = item % nkb, nb = item / nkb, k0 = 64 * kb, n0 = 64 * nb;
    const int c = lane & 7;
#pragma unroll
    for (int j = 0; j < 8; ++j) { const int n = (lane >> 3) + 8 * j; const LAS float* s = scr + (8 * c) * 65 + n;
        const int ln = n0 + n; const int pr = MAP == 1 ? phys_in(ln) : (MAP == 2 ? phys_up(ln) : ln);
        if constexpr (F8) { v2u q; q.x = 0u; q.y = 0u;
            q.x = __builtin_amdgcn_cvt_pk_fp8_f32(64.f * s[0 * 65], 64.f * s[1 * 65], q.x, false); q.x = __builtin_amdgcn_cvt_pk_fp8_f32(64.f * s[2 * 65], 64.f * s[3 * 65], q.x, true);
            q.y = __builtin_amdgcn_cvt_pk_fp8_f32(64.f * s[4 * 65], 64.f * s[5 * 65], q.y, false); q.y = __builtin_amdgcn_cvt_pk_fp8_f32(64.f * s[6 * 65], 64.f * s[7 * 65], q.y, true);
            *(v2u*)((unsigned char*)WT + (size_t)pr * K + k0 + 8 * c) = q; }
        else { v4u o; o.x = pk2(s[0 * 65], s[1 * 65]); o.y = pk2(s[2 * 65], s[3 * 65]); o.z = pk2(s[4 * 65], s[5 * 65]); o.w = pk2(s[6 * 65], s[7 * 65]);
            *(v4u*)((bf16_t*)WT + (size_t)pr * K + k0 + 8 * c) = o; } }
    asm volatile("s_waitcnt lgkmcnt(0)" ::: "memory");
}
__device__ __forceinline__ void transpose8_write(const f32x4 (&v)[16], LAS unsigned* T, int lane) {
#pragma unroll
    for (int i = 0; i < 16; ++i) { unsigned w = 0u; w = __builtin_amdgcn_cvt_pk_fp8_f32(64.f * v[i][0], 64.f * v[i][1], w, false); w = __builtin_amdgcn_cvt_pk_fp8_f32(64.f * v[i][2], 64.f * v[i][3], w, true);
        T[(4 * i + (lane >> 4)) * 17 + (lane & 15)] = w; }
    asm volatile("s_waitcnt lgkmcnt(0)" ::: "memory");
}
template <int MAP> __device__ __forceinline__ void transpose8_out(int K, unsigned char* WT, const LAS unsigned* T, int item, int lane) {
    const int nkb = K / 64, kb = item % nkb, nb = item / nkb, k0 = 64 * kb, n0 = 64 * nb;
    const int c = lane & 7, ng2 = lane >> 3;
#pragma unroll
    for (int j = 0; j < 2; ++j) { const int ng = ng2 + 8 * j; unsigned d[8];
#pragma unroll
        for (int i = 0; i < 8; ++i) d[i] = T[(8 * c + i) * 17 + ng];
        unsigned r[2][4];
#pragma unroll
        for (int h = 0; h < 2; ++h) { const unsigned d0 = d[4 * h], d1 = d[4 * h + 1], d2 = d[4 * h + 2], d3 = d[4 * h + 3];
            const unsigned t0 = __builtin_amdgcn_perm(d1, d0, 0x05010400u), t1 = __builtin_amdgcn_perm(d1, d0, 0x07030602u), t2 = __builtin_amdgcn_perm(d3, d2, 0x05010400u), t3 = __builtin_amdgcn_perm(d3, d2, 0x07030602u);
            r[h][0] = __builtin_amdgcn_perm(t2, t0, 0x05040100u); r[h][1] = __builtin_amdgcn_perm(t2, t0, 0x07060302u); r[h][2] = __builtin_amdgcn_perm(t3, t1, 0x05040100u); r[h][3] = __builtin_amdgcn_perm(t3, t1, 0x07060302u); }
#pragma unroll
        for (int q = 0; q < 4; ++q) { const int ln = n0 + 4 * ng + q; const int pr = MAP == 2 ? phys_up(ln) : (MAP == 3 ? phys_dn(ln) : ln); v2u o; o.x = r[0][q]; o.y = r[1][q];
            *(v2u*)(WT + (size_t)pr * K + k0 + 8 * c) = o; } }
    asm volatile("s_waitcnt lgkmcnt(0)" ::: "memory");
}
template <int MAP, bool F8> __device__ __forceinline__ void transpose_item(const float* W, int K, int N, void* WT, LAS float* scr, int item, int lane) {
    f32x4 v[16]; transpose_load(v, W, K, N, item, lane); transpose_write(v, scr, lane); transpose_out<MAP, F8>(K, WT, scr, item, lane);
}

__device__ __forceinline__ void p0_prologue(const Args& a, Frame& F) {
    unsigned char* ws = a.ws;
    float* ADA = (float*)(ws + WS_ADA); float* ROPE = (float*)(ws + WS_ROPE);
    for (int idx = F.gtid; idx < 64 * 16; idx += F.nthreads) {
        const int pos = idx >> 4, i = idx & 15;
        const float inv = exp2f(-(float)i * (13.287712379549449f / 16.0f));
        const float ang = (float)pos * inv;
        ROPE[idx * 2] = cosf(ang); ROPE[idx * 2 + 1] = sinf(ang);
    }
    { bf16_t* RWT = (bf16_t*)(ws + WS_RWT);
      for (int idx = F.gtid; idx < 32 * 1024; idx += F.nthreads) { const int e = idx >> 10, k = idx & 1023; const float w = a.in[I_RW][k * 32 + e]; const unsigned hi = f2bf(w); RWT[idx] = (bf16_t)hi; RWT[32768 + idx] = (bf16_t)f2bf(w - bf2f(hi)); } }
    for (int tile = blockIdx.x; tile < 192; tile += F.G) {
        LAS float* SL = (LAS float*)F.lds;
        LAS float* PT = (LAS float*)(F.lds + 17 * 4096);
        for (int i = F.tid; i < 17 * 1024; i += NTHR) { const int r = i >> 10, k = i & 1023; const float s = r < 16 ? a.in[I_C][r * 1024 + k] : a.in[I_CCTX][k]; SL[i] = s / (1.0f + __expf(-s)); }
        __syncthreads();
        const int col = F.lane & 31, kh = F.lane >> 5; const float* w = a.in[I_WADA] + tile * 32 + col; const int k0 = F.wave * 128 + 64 * kh;
        float acc[17];
#pragma unroll
        for (int r = 0; r < 17; ++r) acc[r] = 0.f;
#pragma unroll 1
        for (int kb = 0; kb < 64; kb += 32) {
            float wv[32];
#pragma unroll
            for (int q = 0; q < 32; ++q) wv[q] = __builtin_nontemporal_load(w + (size_t)(k0 + kb + q) * 6144);
#pragma unroll
            for (int k4 = 0; k4 < 32; k4 += 4)
#pragma unroll
                for (int r = 0; r < 17; ++r) { const f32x4 s4 = *(const LAS f32x4*)(SL + r * 1024 + k0 + kb + k4); acc[r] = fmaf(s4[0], wv[k4], acc[r]); acc[r] = fmaf(s4[1], wv[k4 + 1], acc[r]); acc[r] = fmaf(s4[2], wv[k4 + 2], acc[r]); acc[r] = fmaf(s4[3], wv[k4 + 3], acc[r]); }
        }
#pragma unroll
        for (int r = 0; r < 17; ++r) { acc[r] += __shfl_xor(acc[r], 32); if (kh == 0) PT[(F.wave * 17 + r) * 32 + col] = acc[r]; }
        __syncthreads();
        for (int i = F.tid; i < 17 * 32; i += NTHR) { const int r = i >> 5, c = i & 31; float s = a.in[I_BADA][tile * 32 + c];
#pragma unroll
            for (int wv = 0; wv < 8; ++wv) s += PT[(wv * 17 + r) * 32 + c];
            ADA[r * 6144 + tile * 32 + c] = s; }
        __syncthreads();
    }
    LAS float* scr = (LAS float*)(F.lds + F.wave * 16640);
    constexpr int I_IN = 16 * (NIN / 64), I_O = 16 * 16;
    for (int it = F.gw; it < I_IN + I_O; it += F.ngw) {
        if (it < I_IN) transpose_item<1, false>(a.in[I_WIN], 1024, NIN, ws + WS_WIN, scr, it, F.lane);
        else transpose_item<0, false>(a.in[I_WO], 1024, 1024, ws + WS_WO, scr, it - I_IN, F.lane);
    }
}
__device__ __forceinline__ void xd_issue(const float* W, int N, int item, int lane, LAS unsigned char* buf) {
    const int kb = item & 15, nb = item >> 4, r = lane >> 4, p = lane & 15;
    const float* base = W + (size_t)(64 * kb + r) * N + 64 * nb;
#pragma unroll
    for (int g = 0; g < 16; ++g)
        __builtin_amdgcn_global_load_lds((const unsigned*)(base + (size_t)(4 * g) * N + 4 * (p ^ (g >> 1))), (LAS unsigned*)(buf + g * 1024), 16, 0, 2);
}
__device__ __forceinline__ void xd_read(float (&v)[8][8], const LAS unsigned char* buf, int lane) {
    const int c = lane & 7, ns = lane >> 3;
#pragma unroll
    for (int j = 0; j < 8; ++j) { const int n = ns + 8 * j; const LAS float* s = (const LAS float*)(buf + c * 2048 + ((((n >> 2) ^ c) & 15) << 4) + 4 * (n & 3));
#pragma unroll
        for (int i = 0; i < 8; ++i) v[j][i] = s[i * 64]; }
    asm volatile("s_waitcnt lgkmcnt(0)" ::: "memory");
}
template <int MAP> __device__ __forceinline__ void xd_store(const float (&v)[8][8], unsigned char* WT, int item, int lane) {
    const int kb = item & 15, nb = item >> 4, c = lane & 7, ns = lane >> 3;
#pragma unroll
    for (int j = 0; j < 8; ++j) { const int n = ns + 8 * j;
        v2u o; o.x = 0u; o.y = 0u;
        o.x = __builtin_amdgcn_cvt_pk_fp8_f32(64.f * v[j][0], 64.f * v[j][1], o.x, false); o.x = __builtin_amdgcn_cvt_pk_fp8_f32(64.f * v[j][2], 64.f * v[j][3], o.x, true);
        o.y = __builtin_amdgcn_cvt_pk_fp8_f32(64.f * v[j][4], 64.f * v[j][5], o.y, false); o.y = __builtin_amdgcn_cvt_pk_fp8_f32(64.f * v[j][6], 64.f * v[j][7], o.y, true);
        const int ln = 64 * nb + n; const int pr = MAP == 2 ? phys_up(ln) : phys_dn(ln);
        *(v2u*)(WT + (size_t)pr * 1024 + 64 * kb + 8 * c) = o; }
}
__device__ __forceinline__ void moe_weights_convert(const Args& a, Frame& F, int first, int last, int wi, int nw) {
    unsigned char* ws = a.ws;
    LAS unsigned char* buf = F.lds + F.wave * 16384;
    constexpr int I_UP = 16 * 32, I_DN = 16 * 16, NIT = NEXP * (I_UP + I_DN);
    { int _l = F.lane; asm volatile("" : "+v"(_l)); F.lane = _l; }
#define XD_ISSUE(it_) do { const int _it = (it_); if (_it < NEXP * I_UP) { const int e = _it / I_UP; xd_issue(a.in[I_WUP] + (size_t)e * 1024 * 2048, 2048, _it % I_UP, F.lane, buf); } \
        else { const int r = _it - NEXP * I_UP, e = r / I_DN; xd_issue(a.in[I_WDN] + (size_t)e * 1024 * 1024, 1024, r % I_DN, F.lane, buf); } } while (0)
    if (first + wi >= last) return;
    XD_ISSUE(first + wi);
#pragma unroll 1
    for (int it = first + wi; it < last; it += nw) {
        float v[8][8];
        asm volatile("s_waitcnt vmcnt(0)" ::: "memory");
        xd_read(v, buf, F.lane);
        if (it + nw < last) XD_ISSUE(it + nw);
        if (it < NEXP * I_UP) { const int e = it / I_UP; xd_store<2>(v, ws + WS_WUP + (size_t)e * 2048 * 1024, it % I_UP, F.lane); }
        else { const int r = it - NEXP * I_UP, e = r / I_DN; xd_store<3>(v, ws + WS_WDN + (size_t)e * 1024 * 1024, r % I_DN, F.lane); }
    }
#undef XD_ISSUE
}

__device__ __forceinline__ void p1_ln_mod(const Args& a, Frame& F) {
    unsigned char* ws = a.ws;
    const float* ADA = (const float*)(ws + WS_ADA); float* STATS = (float*)(ws + WS_STATS); bf16_t* H = (bf16_t*)(ws + WS_H);
    const int rpw = (NROW + F.ngw - 1) / F.ngw, u0 = F.gw * rpw, u1 = (u0 + rpw < NROW) ? u0 + rpw : NROW;
    auto rowsrc = [&](int u) { const int b = u / SU, p = u % SU; return (const f32x4*)(p < CTX ? a.in[I_CTX] + ((size_t)b * CTX + p) * DM : a.in[I_X] + ((size_t)b * SEQ + (p - CTX)) * DM) + F.lane; };
    f32x4 vn[4], G[4], Bv[4]; int kind = -1;
    if (u0 < u1) { const f32x4* xr = rowsrc(u0);
#pragma unroll
        for (int j = 0; j < 4; ++j) vn[j] = __builtin_nontemporal_load(xr + 64 * j); }
    for (int u = u0; u < u1; ++u) {
        const int b = u / SU, p = u % SU, kd = p < CTX ? 16 : b;
        if (kd != kind) { kind = kd; const float* ad = ADA + kd * 6144;
#pragma unroll
            for (int j = 0; j < 4; ++j) { const f32x4 g = ((const f32x4*)a.in[I_LNING] + F.lane)[64 * j], bb = ((const f32x4*)a.in[I_LNINB] + F.lane)[64 * j], sh = ((const f32x4*)ad + F.lane)[64 * j], sc = ((const f32x4*)(ad + 1024) + F.lane)[64 * j] + 1.0f;
                G[j] = g * sc; Bv[j] = bb * sc + sh; } }
        f32x4 v[4]; float s = 0.f;
#pragma unroll
        for (int j = 0; j < 4; ++j) v[j] = vn[j];
        { const int un = (u + 1 < u1) ? u + 1 : u; const f32x4* xr = rowsrc(un);
#pragma unroll
            for (int j = 0; j < 4; ++j) vn[j] = __builtin_nontemporal_load(xr + 64 * j); }
#pragma unroll
        for (int j = 0; j < 4; ++j) s += (v[j].x + v[j].y) + (v[j].z + v[j].w);
        const float mean = wave_sum(s) * (1.f / DM); float s2 = 0.f;
#pragma unroll
        for (int j = 0; j < 4; ++j) { v[j] = v[j] - mean; s2 += (v[j].x * v[j].x + v[j].y * v[j].y) + (v[j].z * v[j].z + v[j].w * v[j].w); }
        const float rstd = 1.f / sqrtf(wave_sum(s2) * (1.f / DM) + LN_EPS);
        v2u* o8 = (v2u*)(H + (size_t)u * DM) + F.lane;
#pragma unroll
        for (int j = 0; j < 4; ++j) { const f32x4 h = v[j] * rstd * G[j] + Bv[j]; v2u w; w.x = pk2(h.x, h.y); w.y = pk2(h.z, h.w); o8[64 * j] = w; }
        if (p >= CTX && F.lane == 0) { const int m = b * SEQ + (p - CTX); STATS[2 * m] = mean; STATS[2 * m + 1] = rstd; }
    }
}

__device__ __forceinline__ void store64(bf16_t* dst, const float (&v)[64]) {
#pragma unroll
    for (int q = 0; q < 8; ++q) { v4u w; w.x = pk2(v[8 * q], v[8 * q + 1]); w.y = pk2(v[8 * q + 2], v[8 * q + 3]); w.z = pk2(v[8 * q + 4], v[8 * q + 5]); w.w = pk2(v[8 * q + 6], v[8 * q + 7]); *(v4u*)(dst + 8 * q) = w; }
}
__device__ __forceinline__ void rope64(float (&v)[64], const float* ROPE, int t) {
    const float* rr = ROPE + (t >> 6) * 32; const float* rc = ROPE + (t & 63) * 32;
#pragma unroll
    for (int i = 0; i < 16; ++i) {
        const float cr = rr[2 * i], sr = rr[2 * i + 1], cc = rc[2 * i], sc = rc[2 * i + 1];
        const float x1 = v[i], x2 = v[16 + i], x3 = v[32 + i], x4 = v[48 + i];
        v[i] = x1 * cr - x2 * sr; v[16 + i] = x2 * cr + x1 * sr; v[32 + i] = x3 * cc - x4 * sc; v[48 + i] = x4 * cc + x3 * sc;
    }
}
__device__ __forceinline__ void rms64(float (&v)[64], const float* g) {
    float ss = 0.f;
#pragma unroll
    for (int d = 0; d < 64; ++d) ss = fmaf(v[d], v[d], ss);
    const float r = 1.0f / sqrtf(ss * (1.0f / 64.0f) + LN_EPS);
#pragma unroll
    for (int d = 0; d < 64; ++d) v[d] = v[d] * r * g[d];
}
__device__ __forceinline__ void p3_attn_scalar(const Args& a, Frame& F) {
    unsigned char* ws = a.ws;
    const bf16_t* AQ = (const bf16_t*)(ws + WS_AQ); const bf16_t* AK = (const bf16_t*)(ws + WS_AK); const bf16_t* AV = (const bf16_t*)(ws + WS_AV); bf16_t* MIX = (bf16_t*)(ws + WS_MIX);
    for (int it = F.gtid; it < BATCH * 8 * SEQ; it += F.nthreads) {
        const int t = it % SEQ, h = (it / SEQ) % 8, b = it / (SEQ * 8); const int m = b * SEQ + t, hk = h >> 2;
        v4u q[8];
#pragma unroll
        for (int i = 0; i < 8; ++i) q[i] = *(const v4u*)(AQ + (size_t)m * 512 + h * 64 + 8 * i);
        float o[64];
#pragma unroll
        for (int d = 0; d < 64; ++d) o[d] = 0.f;
        float mr = -1e30f, l = 0.f;
        const bf16_t* kb = AK + (size_t)b * SU * 128 + hk * 64; const bf16_t* vb = AV + (size_t)b * SU * 128 + hk * 64;
        for (int j = 0; j < SU; ++j) {
            float s = 0.f;
#pragma unroll
            for (int i = 0; i < 8; ++i) s = dot8(q[i], *(const v4u*)(kb + (size_t)j * 128 + 8 * i), s);
            const float mn = fmaxf(mr, s), corr = exp2f(mr - mn), pe = exp2f(s - mn);
            l = l * corr + pe; mr = mn;
#pragma unroll
            for (int i = 0; i < 8; ++i) { const v4u vv = *(const v4u*)(vb + (size_t)j * 128 + 8 * i);
                o[8 * i + 0] = fmaf(pe, bflo(vv.x), o[8 * i + 0] * corr); o[8 * i + 1] = fmaf(pe, bfhi(vv.x), o[8 * i + 1] * corr);
                o[8 * i + 2] = fmaf(pe, bflo(vv.y), o[8 * i + 2] * corr); o[8 * i + 3] = fmaf(pe, bfhi(vv.y), o[8 * i + 3] * corr);
                o[8 * i + 4] = fmaf(pe, bflo(vv.z), o[8 * i + 4] * corr); o[8 * i + 5] = fmaf(pe, bfhi(vv.z), o[8 * i + 5] * corr);
                o[8 * i + 6] = fmaf(pe, bflo(vv.w), o[8 * i + 6] * corr); o[8 * i + 7] = fmaf(pe, bfhi(vv.w), o[8 * i + 7] * corr); }
        }
        const float rl = 1.0f / l;
#pragma unroll
        for (int d = 0; d < 64; ++d) o[d] *= rl;
        store64(MIX + (size_t)m * DM + 512 + h * 64, o);
    }
}
__device__ __forceinline__ void p3_ret_scalar(const Args& a, Frame& F) {
    unsigned char* ws = a.ws;
    const bf16_t* RQ = (const bf16_t*)(ws + WS_RQ); const bf16_t* RK = (const bf16_t*)(ws + WS_RK); const bf16_t* RV = (const bf16_t*)(ws + WS_RV); const bf16_t* RG = (const bf16_t*)(ws + WS_RG);
    bf16_t* MIX = (bf16_t*)(ws + WS_MIX); float* YRET = (float*)(ws + WS_YRET);
    for (int it = F.gtid; it < BATCH * 4 * SEQ; it += F.nthreads) {
        const int t = it % SEQ, h = (it / SEQ) % 4, b = it / (SEQ * 4); const int m = b * SEQ + t;
        const float lgf = a.in[I_LDF][h] * 1.4426950408889634f, lgb = a.in[I_LDB][h] * 1.4426950408889634f;
        v4u q[8];
#pragma unroll
        for (int i = 0; i < 8; ++i) q[i] = *(const v4u*)(RQ + (size_t)m * 256 + h * 64 + 8 * i);
        const bf16_t* kb = RK + (size_t)b * SU * 256 + h * 64; const bf16_t* vb = RV + (size_t)b * SU * 512 + h * 128;
        float* yr = YRET + ((size_t)m * 4 + h) * 128;
        for (int dq = 0; dq < 4; ++dq) {
            float acc[32];
#pragma unroll
            for (int e = 0; e < 32; ++e) acc[e] = 0.f;
            for (int j = 0; j < SU; ++j) {
                float s = 0.f;
#pragma unroll
                for (int i = 0; i < 8; ++i) s = dot8(q[i], *(const v4u*)(kb + (size_t)j * 256 + 8 * i), s);
                float w;
                if (j < CTX) w = exp2f(lgf * (float)(t + CTX - j)) + exp2f(lgb * (float)(SEQ - t + j));
                else { const int tj = j - CTX; w = tj < t ? exp2f(lgf * (float)(t - tj)) : (tj > t ? exp2f(lgb * (float)(tj - t)) : 2.0f); }
                s *= w;
#pragma unroll
                for (int i = 0; i < 4; ++i) { const v4u vv = *(const v4u*)(vb + (size_t)j * 512 + dq * 32 + 8 * i);
                    acc[8 * i + 0] = fmaf(s, bflo(vv.x), acc[8 * i + 0]); acc[8 * i + 1] = fmaf(s, bfhi(vv.x), acc[8 * i + 1]);
                    acc[8 * i + 2] = fmaf(s, bflo(vv.y), acc[8 * i + 2]); acc[8 * i + 3] = fmaf(s, bfhi(vv.y), acc[8 * i + 3]);
                    acc[8 * i + 4] = fmaf(s, bflo(vv.z), acc[8 * i + 4]); acc[8 * i + 5] = fmaf(s, bfhi(vv.z), acc[8 * i + 5]);
                    acc[8 * i + 6] = fmaf(s, bflo(vv.w), acc[8 * i + 6]); acc[8 * i + 7] = fmaf(s, bfhi(vv.w), acc[8 * i + 7]); }
            }
#pragma unroll
            for (int e = 0; e < 32; ++e) yr[dq * 32 + e] = acc[e];
        }
        asm volatile("s_waitcnt vmcnt(0)" ::: "memory");
        float s1 = 0.f;
        for (int e = 0; e < 128; ++e) s1 += yr[e];
        const float mu = s1 * (1.0f / 128.0f); float s2 = 0.f;
        for (int e = 0; e < 128; ++e) { const float d = yr[e] - mu; s2 = fmaf(d, d, s2); }
        const float rs = 1.0f / sqrtf(s2 * (1.0f / 128.0f) + LN_EPS);
        const float* gg = a.in[I_GNG] + h * 128; const float* gb = a.in[I_GNB] + h * 128;
        for (int e = 0; e < 128; e += 2) {
            const unsigned gw = *(const unsigned*)(RG + (size_t)m * 512 + h * 128 + e);
            const float g0 = bflo(gw), g1 = bfhi(gw);
            const float y0 = ((yr[e] - mu) * rs * gg[e] + gb[e]) * (g0 / (1.0f + __expf(-g0)));
            const float y1 = ((yr[e + 1] - mu) * rs * gg[e + 1] + gb[e + 1]) * (g1 / (1.0f + __expf(-g1)));
            *(unsigned*)(MIX + (size_t)m * DM + h * 128 + e) = pk2(y0, y1);
        }
    }
}

__device__ __forceinline__ void p6_ln1_route(const Args& a, Frame& F) {
    typedef short bf16x8 __attribute__((ext_vector_type(8)));
    unsigned char* ws = a.ws;
    const float* ADA = (const float*)(ws + WS_ADA); const float* STATS = (const float*)(ws + WS_STATS); const bf16_t* Y1 = (const bf16_t*)(ws + WS_Y1); const bf16_t* RWT = (const bf16_t*)(ws + WS_RWT);
    float* X1 = (float*)(ws + WS_X1); bf16_t* H2 = (bf16_t*)(ws + WS_H2); unsigned* CNT = F.ctl + CW_CNT; v2u* LIST = (v2u*)(ws + WS_LIST);
    constexpr int HP = 1032;
    LAS bf16_t* HSH = (LAS bf16_t*)F.lds; LAS bf16_t* HSL = (LAS bf16_t*)(F.lds + 16 * HP * 2);
    LAS float* PP = (LAS float*)(F.lds + 2 * 16 * HP * 2);
    LAS float* PRM = PP + 8 * 16 * 32;
    LAS unsigned* SEL = (LAS unsigned*)(PRM + 7 * 1024);
    LAS unsigned* HIST = SEL + 512 * 4;
    const int fr = F.lane & 15, fq = F.lane >> 4;
    bf16x8 bh[2][4], bl[2][4];
#pragma unroll
    for (int eh = 0; eh < 2; ++eh)
#pragma unroll
        for (int ks = 0; ks < 4; ++ks) { const size_t o = (size_t)(16 * eh + fr) * 1024 + 128 * F.wave + 32 * ks + 8 * fq; bh[eh][ks] = *(const bf16x8*)(RWT + o); bl[eh][ks] = *(const bf16x8*)(RWT + 32768 + o); }
    for (int rb = blockIdx.x; rb < NTOK / 128; rb += F.G) {
        const int m0 = rb * 128, b = m0 / SEQ; const float* ad = ADA + b * 6144;
        __syncthreads();
        for (int i = F.tid; i < 1024; i += NTHR) {
            PRM[i] = a.in[I_LNING][i] * DN_ALPHA; PRM[1024 + i] = a.in[I_LNINB][i] * DN_ALPHA; PRM[2048 + i] = ad[2048 + i];
            PRM[3072 + i] = a.in[I_LN1G][i]; PRM[4096 + i] = a.in[I_LN1B][i]; PRM[5120 + i] = ad[4096 + i] + 1.0f; PRM[6144 + i] = ad[3072 + i]; }
        if (F.tid < 64) HIST[F.tid] = 0u;
        __syncthreads();
#define P6_FETCH(m_) do { const int _m = (m_); _Pragma("unroll") for (int j = 0; j < 4; ++j) { xn[j] = __builtin_nontemporal_load((const f32x4*)(a.in[I_X] + (size_t)_m * DM) + F.lane + 64 * j); \
            yn[j] = __builtin_nontemporal_load((const v2u*)(Y1 + (size_t)_m * DM) + F.lane + 64 * j); } mn = STATS[2 * _m]; rn = STATS[2 * _m + 1]; } while (0)
        f32x4 xn[4]; v2u yn[4]; float mn, rn;
        P6_FETCH(m0 + 2 * F.wave);
        for (int it = 0; it < 8; ++it) {
#pragma unroll 1
            for (int rr = 0; rr < 2; ++rr) {
                const int lr = 2 * F.wave + rr, m = m0 + 16 * it + lr; const float mean = mn, rstd = rn;
                f32x4 xc[4]; v2u yc[4];
#pragma unroll
                for (int j = 0; j < 4; ++j) { xc[j] = xn[j]; yc[j] = yn[j]; }
                { const int q = 2 * it + rr + 1; const int mnext = q < 16 ? m0 + 16 * (q >> 1) + 2 * F.wave + (q & 1) : m; P6_FETCH(mnext); }
                f32x4 z[4]; float s = 0.f;
#pragma unroll
                for (int j = 0; j < 4; ++j) {
                    const f32x4 xv = xc[j];
                    const v2u yw = yc[j];
                    const f32x4 y = {bflo(yw.x), bfhi(yw.x), bflo(yw.y), bfhi(yw.y)};
                    const f32x4 p0 = ((const LAS f32x4*)PRM + F.lane)[64 * j], p1 = ((const LAS f32x4*)(PRM + 1024) + F.lane)[64 * j], p2 = ((const LAS f32x4*)(PRM + 2048) + F.lane)[64 * j];
                    z[j] = (xv - mean) * rstd * p0 + p1 + p2 * y;
                    s += (z[j].x + z[j].y) + (z[j].z + z[j].w);
                }
                const float mz = wave_sum(s) * (1.f / DM); float s2 = 0.f;
#pragma unroll
                for (int j = 0; j < 4; ++j) { z[j] = z[j] - mz; s2 += (z[j].x * z[j].x + z[j].y * z[j].y) + (z[j].z * z[j].z + z[j].w * z[j].w); }
                const float rz = 1.f / sqrtf(wave_sum(s2) * (1.f / DM) + LN_EPS);
#pragma unroll
                for (int j = 0; j < 4; ++j) {
                    const f32x4 p3 = ((const LAS f32x4*)(PRM + 3072) + F.lane)[64 * j], p4 = ((const LAS f32x4*)(PRM + 4096) + F.lane)[64 * j], p5 = ((const LAS f32x4*)(PRM + 5120) + F.lane)[64 * j], p6 = ((const LAS f32x4*)(PRM + 6144) + F.lane)[64 * j];
                    const f32x4 x1 = z[j] * rz * p3 + p4; const f32x4 h2 = x1 * p5 + p6;
                    { v2u xw; xw.x = pk2(x1.x, x1.y); xw.y = pk2(x1.z, x1.w); ((v2u*)((bf16_t*)X1 + (size_t)m * DM) + F.lane)[64 * j] = xw; }
                    const unsigned h0 = f2bf(h2.x), h1 = f2bf(h2.y), h2b = f2bf(h2.z), h3 = f2bf(h2.w);
                    v2u w; w.x = h0 | (h1 << 16); w.y = h2b | (h3 << 16);
                    { unsigned q = 0u; q = __builtin_amdgcn_cvt_pk_fp8_f32(h2.x, h2.y, q, false); q = __builtin_amdgcn_cvt_pk_fp8_f32(h2.z, h2.w, q, true); ((unsigned*)((unsigned char*)H2 + (size_t)m * DM) + F.lane)[64 * j] = q; }
                    v2u lo; lo.x = pk2(h2.x - bf2f(h0), h2.y - bf2f(h1)); lo.y = pk2(h2.z - bf2f(h2b), h2.w - bf2f(h3));
                    *(LAS v2u*)(HSH + lr * HP + 4 * F.lane + 256 * j) = w; *(LAS v2u*)(HSL + lr * HP + 4 * F.lane + 256 * j) = lo;
                }
            }
            __syncthreads();
            f32x4 acc[2] = {(f32x4){0.f, 0.f, 0.f, 0.f}, (f32x4){0.f, 0.f, 0.f, 0.f}};
#pragma unroll
            for (int ks = 0; ks < 4; ++ks) {
                const bf16x8 ah = *(const LAS bf16x8*)(HSH + fr * HP + 128 * F.wave + 32 * ks + 8 * fq), al = *(const LAS bf16x8*)(HSL + fr * HP + 128 * F.wave + 32 * ks + 8 * fq);
#pragma unroll
                for (int eh = 0; eh < 2; ++eh) { acc[eh] = __builtin_amdgcn_mfma_f32_16x16x32_bf16(ah, bh[eh][ks], acc[eh], 0, 0, 0); acc[eh] = __builtin_amdgcn_mfma_f32_16x16x32_bf16(ah, bl[eh][ks], acc[eh], 0, 0, 0); acc[eh] = __builtin_amdgcn_mfma_f32_16x16x32_bf16(al, bh[eh][ks], acc[eh], 0, 0, 0); }
            }
#pragma unroll
            for (int eh = 0; eh < 2; ++eh)
#pragma unroll
                for (int r = 0; r < 4; ++r) PP[(F.wave * 16 + 4 * fq + r) * 32 + 16 * eh + fr] = acc[eh][r];
            __syncthreads();
            {
                const int lr = 2 * F.wave + (F.lane >> 5), ex = F.lane & 31;
                float mine = a.in[I_RB][ex];
#pragma unroll
                for (int wv = 0; wv < 8; ++wv) mine += PP[(wv * 16 + lr) * 32 + ex];
                float sv[4]; int si[4];
#pragma unroll
                for (int k = 0; k < 4; ++k) {
                    float v = mine; int ix = ex;
#pragma unroll
                    for (int o = 16; o >= 1; o >>= 1) { const float ov = __shfl_xor(v, o); const int oi = __shfl_xor(ix, o); if (ov > v || (ov == v && oi < ix)) { v = ov; ix = oi; } }
                    sv[k] = v; si[k] = ix; if (ex == ix) mine = -3.0e38f;
                }
                const float e1 = __expf(sv[1] - sv[0]), e2 = __expf(sv[2] - sv[0]), e3 = __expf(sv[3] - sv[0]);
                const float rs = 1.0f / (1.0f + e1 + e2 + e3);
                if (ex < 4) {
                    const int sel = ex == 0 ? si[0] : (ex == 1 ? si[1] : (ex == 2 ? si[2] : si[3]));
                    const float gt = (ex == 0 ? 1.0f : (ex == 1 ? e1 : (ex == 2 ? e2 : e3))) * rs;
                    const unsigned rank = atomicAdd((unsigned*)(HIST + sel), 1u);
                    const int slot = (16 * it + lr) * 4 + ex;
                    SEL[slot * 4] = (unsigned)sel; SEL[slot * 4 + 1] = rank; SEL[slot * 4 + 2] = (unsigned)((m0 + 16 * it + lr) * 4 + ex); SEL[slot * 4 + 3] = __float_as_uint(gt);
                }
            }
        }
        __syncthreads();
        if (F.tid < 32) HIST[32 + F.tid] = atomicAdd(CNT + F.tid, HIST[F.tid]);
        __syncthreads();
        { const unsigned ex = SEL[F.tid * 4], rank = SEL[F.tid * 4 + 1]; v2u ent; ent.x = SEL[F.tid * 4 + 2]; ent.y = SEL[F.tid * 4 + 3]; LIST[(size_t)ex * LISTCAP + HIST[32 + ex] + rank] = ent; }
    }
}

__device__ __forceinline__ void p9_final(const Args& a, Frame& F) {
    unsigned char* ws = a.ws;
    const float* ADA = (const float*)(ws + WS_ADA); const bf16_t* X1 = (const bf16_t*)(ws + WS_X1); const unsigned char* YE = (const unsigned char*)(ws + WS_YE);
    const int rpw = (NTOK + F.ngw - 1) / F.ngw, m0 = F.gw * rpw, m1 = (m0 + rpw < NTOK) ? m0 + rpw : NTOK;
    unsigned yn[4][4]; v2u xn[4];
    auto fetch = [&](int m) {
#pragma unroll
        for (int j = 0; j < 4; ++j) {
#pragma unroll
            for (int k = 0; k < 4; ++k) yn[j][k] = __builtin_nontemporal_load((const unsigned*)(YE + ((size_t)m * 4 + k) * DM) + F.lane + 64 * j);
            xn[j] = __builtin_nontemporal_load((const v2u*)(X1 + (size_t)m * DM) + F.lane + 64 * j); } };
    if (m0 < m1) fetch(m0);
    f32x4 G2[4], LG[4], LB[4]; int kind = -1;
    for (int m = m0; m < m1; ++m) {
        const int b = m / SEQ;
        if (b != kind) { kind = b; const float* ad = ADA + b * 6144;
#pragma unroll
            for (int j = 0; j < 4; ++j) { G2[j] = ((const f32x4*)(ad + 5120) + F.lane)[64 * j] * (1.0f / 64.0f); LG[j] = ((const f32x4*)a.in[I_LN2G] + F.lane)[64 * j]; LB[j] = ((const f32x4*)a.in[I_LN2B] + F.lane)[64 * j]; } }
        f32x4 z[4]; float s = 0.f;
#pragma unroll
        for (int j = 0; j < 4; ++j) {
            f32x4 f = {0.f, 0.f, 0.f, 0.f};
#pragma unroll
            for (int k = 0; k < 4; ++k) { const unsigned yw = yn[j][k];
                f += (f32x4){__builtin_amdgcn_cvt_f32_fp8(yw, 0), __builtin_amdgcn_cvt_f32_fp8(yw, 1), __builtin_amdgcn_cvt_f32_fp8(yw, 2), __builtin_amdgcn_cvt_f32_fp8(yw, 3)}; }
            const v2u xw = xn[j]; const f32x4 x1 = {bflo(xw.x), bfhi(xw.x), bflo(xw.y), bfhi(xw.y)};
            z[j] = x1 * DN_ALPHA + G2[j] * f;
            s += (z[j].x + z[j].y) + (z[j].z + z[j].w);
        }
        fetch((m + 1 < m1) ? m + 1 : m);
        const float mz = wave_sum(s) * (1.f / DM); float s2 = 0.f;
#pragma unroll
        for (int j = 0; j < 4; ++j) { z[j] = z[j] - mz; s2 += (z[j].x * z[j].x + z[j].y * z[j].y) + (z[j].z * z[j].z + z[j].w * z[j].w); }
        const float rz = 1.f / sqrtf(wave_sum(s2) * (1.f / DM) + LN_EPS);
#pragma unroll
        for (int j = 0; j < 4; ++j) __builtin_nontemporal_store(z[j] * rz * LG[j] + LB[j], (f32x4*)(a.out + (size_t)m * DM) + F.lane + 64 * j);
    }
}

constexpr int N_PHASES = 10;
constexpr int CONV_NIT = NEXP * (16 * 32 + 16 * 16), CONV_P2 = 64 * 8 * 4;
#ifndef MK_N_LAUNCHES
#define MK_N_LAUNCHES 1
#endif
__global__ void __launch_bounds__(NTHR, 2) fwd_kernel(Args a) {
    extern __shared__ __attribute__((aligned(16))) unsigned char lds[];
    Frame F;
    F.lds = (LAS unsigned char*)lds;
#define REFRESH() do { int _t = threadIdx.x; asm volatile("" : "+v"(_t)); F.tid = _t; F.lane = _t & 63; F.wave = __builtin_amdgcn_readfirstlane(_t >> 6); F.gtid = blockIdx.x * NTHR + _t; F.gw = blockIdx.x * NWAVES + F.wave; } while (0)
    F.G = gridDim.x; F.nthreads = F.G * NTHR; F.ngw = F.G * NWAVES; REFRESH();
    F.ctl = (unsigned*)(a.ws + WS_CTL);
    volatile LAS unsigned* MISC = (volatile LAS unsigned*)(F.lds + MISC_OFF);
    for (int u = F.tid; u < (LDS_BYTES - 131072) / 4; u += NTHR) ((LAS unsigned*)(F.lds + 131072))[u] = 0u;
    __syncthreads();
    XcdBarrier bar; bar.bar = F.ctl + CW_BAR + a.li * XCD_BAR_WORDS; bar.x = 0; bar.st = nullptr;
    if (MK_N_LAUNCHES == 1) bar = xcd_barrier_post(F.ctl + CW_BAR, MISC + 8);
    const int lo = a.ph_lo, hi = a.ph_hi;
#define IN(k) (lo <= (k) && (k) < hi)
#define SEAM(k) do { if (IN(k) && IN((k) + 1)) xcd_barrier(bar); } while (0)
    if (IN(0)) { REFRESH(); p0_prologue(a, F); } SEAM(0);
    if (IN(1)) { REFRESH(); p1_ln_mod(a, F); } SEAM(1);
    if (IN(2)) { REFRESH();
        pg8::SchedInProj S{F.G, (int)blockIdx.x}; pg8::EpiInProj E{a.ws, a.in[I_QNG], a.in[I_KNG], (const float*)(a.ws + WS_ROPE)};
        pg8::gemm_phase<pg8::EpiInProj, pg8::SchedInProj, false>(F.lds, (const bf16_t*)(a.ws + WS_H), (const bf16_t*)(a.ws + WS_WIN), S, E);
        if (F.G == 256) { if (blockIdx.x >= 192) { REFRESH(); __syncthreads(); moe_weights_convert(a, F, 0, CONV_P2, ((int)blockIdx.x - 192) * NWAVES + F.wave, 64 * NWAVES); } }
        else if (blockIdx.x == 0) {   }
    } SEAM(2);
    if (IN(3)) { REFRESH();
        const attn_body::AttnTensors AT{(const attn_body::bf16*)(a.ws + WS_AQ), (const attn_body::bf16*)(a.ws + WS_AK), (const attn_body::bf16*)(a.ws + WS_AV), (attn_body::bf16*)(a.ws + WS_MIX) + 512};
        const attn_body::StaticOrder S((int)F.G, (int)blockIdx.x);
        if ((F.G & 255) == 0) {
            float gqm = 0.f, gkm = 0.f;
            for (int i = 0; i < 64; ++i) { gqm = fmaxf(gqm, fabsf(a.in[I_QNG][i])); gkm = fmaxf(gkm, fabsf(a.in[I_KNG][i])); }
            const float refB = 1.02f * C2 * 64.0f * gqm * gkm;
            const int slot = (int)(blockIdx.x % 5u); attn_body::AttnUnit u;
            for (int i = 0; i < 5; ++i) {
                if (i == slot) { __syncthreads(); moe_weights_convert(a, F, CONV_P2, CONV_NIT, F.gw, F.ngw); __syncthreads(); }
                if (i < 4 && S.next(i, u)) attn_body::attn_unit<8>(u.b, u.h, u.qb, AT.Q, AT.K, AT.V, AT.O, (char*)lds, refB);
            }
        } else { p3_attn_scalar(a, F); __syncthreads(); moe_weights_convert(a, F, 0, CONV_NIT, F.gw, F.ngw); }
        __syncthreads();
        for (int u = blockIdx.x; u < 256; u += F.G) { const int dvh = u & 1, dir = (u >> 1) & 1, h = (u >> 2) & 3, b = u >> 4;
            ret::state_unit(b, h, dir, dvh, (const bf16_t*)(a.ws + WS_RK), (const bf16_t*)(a.ws + WS_RV), (bf16_t*)(a.ws + WS_ST), (dir ? a.in[I_LDB][h] : a.in[I_LDF][h]) * 1.4426950408889634f, F.lds); }
    } SEAM(3);
    if (IN(4)) { REFRESH();
        ret::OutRegs R; int u = blockIdx.x;
        if (u < 1024) ret::out_load(R, u, (const bf16_t*)(a.ws + WS_RQ), (const bf16_t*)(a.ws + WS_RK), (const bf16_t*)(a.ws + WS_RV), (const bf16_t*)(a.ws + WS_RG));
        for (; u < 1024; u += F.G) { const int un = (u + F.G < 1024) ? u + F.G : -1;
            ret::out_unit(R, u, un, (const bf16_t*)(a.ws + WS_RQ), (const bf16_t*)(a.ws + WS_RK), (const bf16_t*)(a.ws + WS_RV), (const bf16_t*)(a.ws + WS_RG), (const bf16_t*)(a.ws + WS_ST), a.in[I_GNG], a.in[I_GNB],
                          a.in[I_LDF], a.in[I_LDB], (bf16_t*)(a.ws + WS_MIX), F.lds); }
    } SEAM(4);
    if (IN(5)) { REFRESH();
        pg8::SchedDense S{NTOK / 256, DM / 256, F.G, (int)blockIdx.x}; pg8::EpiPlainBf16 E{(bf16_t*)(a.ws + WS_Y1), DM};
        pg8::gemm_phase<pg8::EpiPlainBf16, pg8::SchedDense, false>(F.lds, (const bf16_t*)(a.ws + WS_MIX), (const bf16_t*)(a.ws + WS_WO), S, E);
    } SEAM(5);
    if (IN(6)) { REFRESH(); p6_ln1_route(a, F); } SEAM(6);
    if (IN(7)) { REFRESH();
        LAS int* tab = (LAS int*)(F.lds + 131072 + 1024); pg8::moe_build_tab(tab, F.ctl + CW_CNT);
        pg8::SchedMoE S{8, 2048, F.G, (int)blockIdx.x, tab, (const v2u*)(a.ws + WS_LIST)}; pg8::EpiUp E{a.ws + WS_ACT, a.in[I_BUP]};
        pg8::gemm_phase<pg8::EpiUp, pg8::SchedMoE, true, true>(F.lds, (const bf16_t*)(a.ws + WS_H2), (const bf16_t*)(a.ws + WS_WUP), S, E);
    } SEAM(7);
    if (IN(8)) { REFRESH();
        LAS int* tab = (LAS int*)(F.lds + 131072 + 1024); pg8::moe_build_tab(tab, F.ctl + CW_CNT);
        pg8::SchedMoE S{4, 1024, F.G, (int)blockIdx.x, tab, (const v2u*)(a.ws + WS_LIST)}; pg8::EpiDown E{(bf16_t*)(a.ws + WS_YE), a.in[I_BDN], (const v2u*)(a.ws + WS_LIST)};
        pg8::gemm_phase<pg8::EpiDown, pg8::SchedMoE, false, true>(F.lds, (const bf16_t*)(a.ws + WS_ACT), (const bf16_t*)(a.ws + WS_WDN), S, E);
    } SEAM(8);
    if (IN(9)) { REFRESH(); p9_final(a, F); }
#undef IN
#undef SEAM
}

extern "C" void kernel_launch(void* const* d_in, const int* in_sizes, int n_in, void* d_out, int out_size, void* d_ws, size_t ws_size, hipStream_t stream) {
    static int grid = 0;
    if (grid == 0) {
        if (n_in != 26 || out_size != NTOK * DM || ws_size < WS_END) { fprintf(stderr, "kernel_launch: unexpected shapes (n_in %d, out %d, ws %zu); nothing launched\n", n_in, out_size, ws_size); grid = -1; return; }
        int dev = 0, cus = 0;
        if (hipGetDevice(&dev) != hipSuccess || hipDeviceGetAttribute(&cus, hipDeviceAttributeMultiprocessorCount, dev) != hipSuccess) { grid = -1; return; }
        if (hipFuncSetAttribute((const void*)fwd_kernel, hipFuncAttributeMaxDynamicSharedMemorySize, LDS_BYTES) != hipSuccess) { fprintf(stderr, "kernel_launch: hipFuncSetAttribute failed\n"); grid = -1; return; }
        (void)hipGetLastError();
        grid = cus;
    }
    if (grid < 0) return;
    if (hipMemsetAsync((char*)d_ws + WS_CTL, 0, CTL_ZERO_BYTES, stream) != hipSuccess) return;
    Args a{};
    for (int i = 0; i < 26; ++i) a.in[i] = (const float*)d_in[i];
    a.out = (float*)d_out; a.ws = (unsigned char*)d_ws;
    if (MK_N_LAUNCHES == 1) { a.ph_lo = 0; a.ph_hi = N_PHASES; a.li = 0; hipLaunchKernelGGL(fwd_kernel, dim3(grid), dim3(NTHR), LDS_BYTES, stream, a); }
    else for (int p = 0; p < N_PHASES; ++p) { a.ph_lo = p; a.ph_hi = p + 1; a.li = 0; hipLaunchKernelGGL(fwd_kernel, dim3(grid), dim3(NTHR), LDS_BYTES, stream, a); }
}
```

```cpp
#include <hip/hip_runtime.h>
#include <cstdio>
#include <cstdint>

constexpr int BATCH = 16, SEQ = 2048, DM = 1024, CTX = 256, SU = SEQ + CTX;
constexpr int NTOK = BATCH * SEQ, NROW = BATCH * SU;
constexpr int NIN = 2304, NEXP = 32, LISTCAP = 32768;
constexpr float LN_EPS = 1e-6f, DN_ALPHA = 1.189207115002721f;
constexpr float C2 = 0.125f * 1.4426950408889634f;
constexpr int NWAVES = 8, NTHR = 512;

constexpr size_t MiB = 1u << 20;
constexpr size_t WS_CTL = 0, CTL_ZERO_BYTES = 64 * 1024;
constexpr size_t WS_ADA = 1 * MiB, WS_ROPE = 1 * MiB + 512 * 1024, WS_STATS = 2 * MiB, WS_LIST = 4 * MiB;
constexpr size_t WS_RWT = 12 * MiB;
constexpr size_t WS_WIN = 16 * MiB, WS_WO = 22 * MiB, WS_WUP = 32 * MiB, WS_WDN = 160 * MiB;
constexpr size_t WS_X1 = 224 * MiB, WS_H2 = 352 * MiB, WS_ACT = 416 * MiB;
constexpr size_t WS_MIX = 416 * MiB, WS_Y1 = 480 * MiB, WS_YRET = 544 * MiB;
constexpr size_t WS_YE = 688 * MiB;
constexpr size_t WS_H = 688 * MiB, WS_RQ = 760 * MiB, WS_RK = 776 * MiB, WS_RV = 794 * MiB, WS_RG = 830 * MiB, WS_AQ = 862 * MiB, WS_AK = 894 * MiB, WS_AV = 903 * MiB;
constexpr size_t WS_ST = 912 * MiB;
constexpr size_t WS_END = 944 * MiB;
constexpr int CW_TMO = 0, CW_CNT = 256, CW_BAR = 4096;

#define GAS __attribute__((address_space(1)))
#define LAS __attribute__((address_space(3)))
typedef unsigned short bf16_t;
typedef unsigned v4u __attribute__((ext_vector_type(4)));
typedef unsigned v2u __attribute__((ext_vector_type(2)));
typedef float f32x4 __attribute__((ext_vector_type(4)));

__device__ __forceinline__ float bf2f(unsigned v) { return __uint_as_float(v << 16); }
__device__ __forceinline__ unsigned pk2(float lo, float hi) { unsigned r; asm("v_cvt_pk_bf16_f32 %0, %1, %2" : "=v"(r) : "v"(lo), "v"(hi)); return r; }
__device__ __forceinline__ unsigned f2bf(float f) { return pk2(f, f) & 0xffffu; }
__device__ __forceinline__ float bflo(unsigned w) { return __uint_as_float(w << 16); }
__device__ __forceinline__ float bfhi(unsigned w) { return __uint_as_float(w & 0xffff0000u); }
__device__ __forceinline__ float wave_sum(float v) {
#pragma unroll
    for (int o = 1; o < 64; o <<= 1) v += __shfl_xor(v, o);
    return v;
}
__device__ __forceinline__ float dot8(v4u a, v4u w, float acc) {
    acc = fmaf(bflo(a.x), bflo(w.x), acc); acc = fmaf(bfhi(a.x), bfhi(w.x), acc);
    acc = fmaf(bflo(a.y), bflo(w.y), acc); acc = fmaf(bfhi(a.y), bfhi(w.y), acc);
    acc = fmaf(bflo(a.z), bflo(w.z), acc); acc = fmaf(bfhi(a.z), bfhi(w.z), acc);
    acc = fmaf(bflo(a.w), bflo(w.w), acc); acc = fmaf(bfhi(a.w), bfhi(w.w), acc);
    return acc;
}

#define XB_TMO      128
#define XB_XCNT(j)  (256  + 64 * (j))
#define XB_XSUB(j)  (1280 + 64 * (j))
#define XB_XGEN(j)  (2304 + 64 * (j))
#define XB_TOP      3328
#define XB_TOPGEN   3392
#define XCD_BAR_WORDS 3456
#define XB_SPIN_CAP (1u << 24)
__device__ __forceinline__ unsigned xb_ld(unsigned* p)              { return __hip_atomic_load(p, __ATOMIC_RELAXED, __HIP_MEMORY_SCOPE_AGENT); }
__device__ __forceinline__ unsigned xb_add(unsigned* p, unsigned v) { return __hip_atomic_fetch_add(p, v, __ATOMIC_RELAXED, __HIP_MEMORY_SCOPE_AGENT); }
__device__ __forceinline__ unsigned xb_xcc_id() { return (unsigned)__builtin_amdgcn_s_getreg((3 << 11) | 20) & 0xFu; }
#define XB_SPIN(cond, bar) do { unsigned _sp = 0; while (cond) { __builtin_amdgcn_s_sleep(1); \
    if ((++_sp & 255u) == 0u) { if (xb_ld(&(bar)[XB_TMO])) break; if (_sp > XB_SPIN_CAP) { atomicAdd(&(bar)[XB_TMO], 1u); break; } } } } while (0)
struct XcdBarrier { unsigned* bar; unsigned x; volatile LAS unsigned* st; };
__device__ __forceinline__ XcdBarrier xcd_barrier_post(unsigned* bar, volatile LAS unsigned* st) {
    XcdBarrier b; b.bar = bar; b.x = xb_xcc_id(); b.st = st;
    if (threadIdx.x == 0) (void)xb_add(&bar[XB_XCNT(b.x)], 1u);
    return b;
}
__device__ __forceinline__ void xcd_barrier_complete(unsigned* bar, unsigned x, unsigned& nloc, unsigned& nx) {
    const unsigned G = gridDim.x * gridDim.y * gridDim.z;
    unsigned sum, cnt, mine, sp = 0u;
    for (;;) {
        sum = 0u; cnt = 0u; mine = 0u;
#pragma unroll
        for (unsigned j = 0; j < 16; ++j) { const unsigned c = xb_ld(&bar[XB_XCNT(j)]); sum += c; cnt += (c > 0u) ? 1u : 0u; mine = (j == x) ? c : mine; }
        if (sum == G) break;
        __builtin_amdgcn_s_sleep(1);
        if ((++sp & 255u) == 0u) { if (xb_ld(&bar[XB_TMO])) break; if (sp > XB_SPIN_CAP) { atomicAdd(&bar[XB_TMO], 1u); break; } }
    }
    nloc = mine > 0u ? mine : 1u; nx = cnt > 0u ? cnt : 1u;
}
__device__ __forceinline__ void xcd_barrier(const XcdBarrier& b) {
    asm volatile("s_waitcnt vmcnt(0)" ::: "memory");
    __syncthreads();
    if (threadIdx.x == 0) {
        unsigned* bar = b.bar;
        __builtin_amdgcn_s_waitcnt(0);
        unsigned nloc = b.st[0], nx = b.st[1];
        if (nloc == 0u) { xcd_barrier_complete(bar, b.x, nloc, nx); b.st[0] = nloc; b.st[1] = nx; }
        const unsigned old = xb_add(&bar[XB_XSUB(b.x)], 1u);
        const unsigned gen = old / nloc;
        if (old + 1u == (gen + 1u) * nloc) {
            __builtin_amdgcn_fence(__ATOMIC_RELEASE, "agent");
            asm volatile("s_waitcnt vmcnt(0)" ::: "memory");
            const unsigned og = xb_add(&bar[XB_TOP], 1u);
            const unsigned tg = og / nx;
            if (og + 1u == (tg + 1u) * nx) xb_add(&bar[XB_TOPGEN], 1u);
            else XB_SPIN(xb_ld(&bar[XB_TOPGEN]) == tg, bar);
            __builtin_amdgcn_fence(__ATOMIC_ACQUIRE, "agent");
            xb_add(&bar[XB_XGEN(b.x)], 1u);
            asm volatile("s_waitcnt vmcnt(0)" ::: "memory");
        } else {
            XB_SPIN(xb_ld(&bar[XB_XGEN(b.x)]) == gen, bar);
            __builtin_amdgcn_fence(__ATOMIC_ACQUIRE, "agent");
            asm volatile("s_waitcnt vmcnt(0)" ::: "memory");
        }
    }
    __syncthreads();
}

namespace pg8 {
typedef short bf16x8 __attribute__((ext_vector_type(8)));
typedef int v4i __attribute__((ext_vector_type(4)));
typedef int v8i __attribute__((ext_vector_type(8)));
constexpr int BM = 256, BK = 64, HALF = 128, HTB = HALF * BK * 2, NXCD = 8, WGM = 1, KD = 1024, NT = KD / BK;
__device__ __forceinline__ int lds_byte(int r, int c) { const int st = (r >> 4) * 2 + (c >> 5), rr = r & 15, cc = c & 31, ob = rr * 64 + cc * 2; return st * 1024 + (ob ^ (((ob >> 9) & 1) << 5)); }
__device__ __forceinline__ void stage_rc(int b, int& R, int& C) { const int st = b / 1024, sb = b % 1024, swz = sb ^ (((sb >> 9) & 1) << 5); R = (st >> 1) * 16 + swz / 64; C = (st & 1) * 32 + (swz % 64) / 2; }
__device__ __forceinline__ int perm32(int rho) { const int n = rho >> 4, i = rho & 15; return 8 * (i >> 2) + 4 * n + (i & 3); }
__device__ __forceinline__ unsigned cvt_pk_bf16(float lo, float hi) { unsigned r; asm volatile("v_cvt_pk_bf16_f32 %0, %1, %2" : "=v"(r) : "v"(lo), "v"(hi)); return r; }

struct Unit { int pm, pn, brow, e, r0, cnt; };

__device__ __forceinline__ void tile_order(int L, int nM, int nN, int& pm, int& pn) {
    const int nwg = nM * nN; int wgid = L; { const int q = nwg / NXCD, r = nwg % NXCD, xcd = wgid % NXCD, off = wgid / NXCD; wgid = (xcd < r ? xcd * (q + 1) : r * (q + 1) + (xcd - r) * q) + off; }
    const int nig = WGM * nN, gid = wgid / nig, fm = gid * WGM, gsz = (nM - fm) < WGM ? (nM - fm) : WGM;
    pm = fm + ((wgid % nig) % gsz); pn = (wgid % nig) / gsz;
}
struct SchedDense {
    int nM, nN, G, c;
    __device__ __forceinline__ bool next(int i, Unit& u) const { const long L = (long)i * G + c; if (L >= (long)nM * nN) return false; tile_order((int)L, nM, nN, u.pm, u.pn); u.brow = u.pn * BM; u.e = 0; u.r0 = 0; u.cnt = 0; return true; }
    __device__ __forceinline__ unsigned arow_tok(const Unit&, int) const { return 0u; }
};

template <class Epi, class Sched, bool GATHER, bool F8 = false>
__device__ __forceinline__ void gemm_phase(LAS unsigned char* lds, const bf16_t* A, const bf16_t* Bt, const Sched& S, const Epi& E) {
    const int tid = threadIdx.x, wid = __builtin_amdgcn_readfirstlane(tid >> 6), lane = tid & 63, wr = wid >> 2, wc = wid & 3, fr = lane & 15, fq = lane >> 4;
    constexpr int K = F8 ? KD / 2 : KD, nt = F8 ? NT / 2 : NT;
    unsigned voffA[2], voffB[2];
#pragma unroll
    for (int i = 0; i < 2; ++i) { int R, C; stage_rc(tid * 16 + i * 8192, R, C); const int Rb = Epi::PERM ? ((R & ~31) + perm32(R & 31)) : R;
        voffA[i] = GATHER ? (unsigned)(C * 2) : (unsigned)(R * K + C) * 2u; voffB[i] = (unsigned)(Rb * K + C) * 2u; }
    constexpr size_t kstep = (size_t)(BK * 2), hstep = (size_t)HALF * K * 2, tstep = 2 * hstep;
    const unsigned ldsw = (unsigned)wid * 1024u;
    const int aoff = lds_byte(wr * 64 + fr, fq * 8), boff = lds_byte(wc * 32 + fr, fq * 8);
#define PG8_SA(b, h) (((b) * 2 + (h)) * HTB)
#define PG8_SB(b, h) ((4 + (b) * 2 + (h)) * HTB)
#define PG8_STAGE_B(bufoff, gbase) do { _Pragma("unroll") for (int _i = 0; _i < 2; ++_i) \
        __builtin_amdgcn_global_load_lds((const unsigned*)((const char*)(gbase) + voffB[_i]), (LAS unsigned*)(lds + (bufoff) + ldsw + _i * 8192), 16, 0, 0); } while (0)
#define PG8_STAGE_A(bufoff, h, kb, nx) do { _Pragma("unroll") for (int _i = 0; _i < 2; ++_i) { \
        const char* _src = GATHER ? (const char*)A + (((((nx) ? ron[h] : roc[h]) >> (16 * _i)) & 0xffffu) << (F8 ? 10 : 11)) + voffA[0] + (kb) : ((nx) ? nA : cA) + (size_t)(h) * hstep + (kb) + voffA[_i]; \
        __builtin_amdgcn_global_load_lds((const unsigned*)_src, (LAS unsigned*)(lds + (bufoff) + ldsw + _i * 8192), 16, 0, 0); } } while (0)
#define PG8_LDA(dst, b, h) do { _Pragma("unroll") for (int m = 0; m < 4; ++m) { if constexpr (F8) { dst##8[m].lo = *(const LAS v4i*)(lds + PG8_SA(b, h) + aoff + m * 2048); dst##8[m].hi = *(const LAS v4i*)(lds + PG8_SA(b, h) + aoff + m * 2048 + 1024); } \
        else { _Pragma("unroll") for (int k = 0; k < 2; ++k) dst[m][k] = *(const LAS bf16x8*)(lds + PG8_SA(b, h) + aoff + m * 2048 + k * 1024); } } } while (0)
#define PG8_LDB(dst, b, h) do { _Pragma("unroll") for (int n = 0; n < 2; ++n) { if constexpr (F8) { dst##8[n].lo = *(const LAS v4i*)(lds + PG8_SB(b, h) + boff + n * 2048); dst##8[n].hi = *(const LAS v4i*)(lds + PG8_SB(b, h) + boff + n * 2048 + 1024); } \
        else { _Pragma("unroll") for (int k = 0; k < 2; ++k) dst[n][k] = *(const LAS bf16x8*)(lds + PG8_SB(b, h) + boff + n * 2048 + k * 1024); } } } while (0)
#define PG8_MMA(ai, bj, At, Bt_) do { __builtin_amdgcn_s_setprio(1); _Pragma("unroll") for (int m = 0; m < 4; ++m) _Pragma("unroll") for (int n = 0; n < 2; ++n) { \
        if constexpr (F8) { asm volatile("v_mfma_scale_f32_16x16x128_f8f6f4 %0, %1, %2, %0, %3, %3 op_sel_hi:[0,0,0]" : "+v"(acc[ai][bj][m][n]) : "v"(Bt_##8[n]), "v"(At##8[m]), "v"(sc8)); } \
        else { _Pragma("unroll") for (int k = 0; k < 2; ++k) acc[ai][bj][m][n] = __builtin_amdgcn_mfma_f32_16x16x32_bf16(Bt_[n][k], At[m][k], acc[ai][bj][m][n], 0, 0, 0); } } \
        __builtin_amdgcn_s_setprio(0); } while (0)
#define PG8_WAIT_V(n) asm volatile("s_waitcnt vmcnt(" #n ")" ::: "memory")
#define PG8_WAIT_L(n) asm volatile("s_waitcnt lgkmcnt(" #n ")" ::: "memory")
#define PG8_BAR __builtin_amdgcn_s_barrier()
#define PG8_SCHED __builtin_amdgcn_sched_barrier(0)
#define PG8_LOAD_RO(dst, unit) do { int _R, _C; stage_rc((int)threadIdx.x * 16, _R, _C); _Pragma("unroll") for (int _h = 0; _h < 2; ++_h) dst[_h] = S.arow_tok(unit, _h * HALF + _R) | (S.arow_tok(unit, _h * HALF + _R + 64) << 16); } while (0)
    Unit cur, nxt; int ui = 0;
    if (!S.next(0, cur)) return;
    f32x4 acc[2][2][4][2];
#pragma unroll
    for (int a = 0; a < 2; ++a)
#pragma unroll
        for (int b = 0; b < 2; ++b)
#pragma unroll
            for (int m = 0; m < 4; ++m)
#pragma unroll
                for (int n = 0; n < 2; ++n) acc[a][b][m][n] = (f32x4){0.f, 0.f, 0.f, 0.f};
    if (Epi::HAS_INIT) { const typename Epi::Init i0 = E.init(cur, wr, wc, fr, fq);
#pragma unroll
      for (int a = 0; a < 2; ++a)
#pragma unroll
        for (int b = 0; b < 2; ++b)
#pragma unroll
            for (int m = 0; m < 4; ++m)
#pragma unroll
                for (int n = 0; n < 2; ++n) acc[a][b][m][n] = i0.v[b][n]; }
    unsigned sc8 = 0x7c7c7c7cu; asm volatile("" : "+v"(sc8));
    bf16x8 At[4][2], B0[2][2], B1[2][2]; v8i At8[4], B08[2], B18[2];
    unsigned roc[2] = {0u, 0u}, ron[2] = {0u, 0u};
    bool has_next = S.next(1, nxt);
    if (GATHER) { PG8_LOAD_RO(roc, cur); if (has_next) { PG8_LOAD_RO(ron, nxt); } else { ron[0] = roc[0]; ron[1] = roc[1]; } }
    const char* cA = (const char*)A + (GATHER ? (size_t)0 : (size_t)cur.pm * tstep); const char* cB = (const char*)Bt + (size_t)cur.brow * K * 2;
    const char* nA = cA;
    PG8_STAGE_B(PG8_SB(0, 0), cB); PG8_STAGE_B(PG8_SB(0, 1), cB + hstep); PG8_STAGE_A(PG8_SA(0, 0), 0, 0, false); PG8_STAGE_A(PG8_SA(0, 1), 1, 0, false);
    if (wr == 1) PG8_BAR;
    PG8_WAIT_V(2); PG8_BAR;
    PG8_STAGE_B(PG8_SB(1, 0), cB + kstep); PG8_STAGE_A(PG8_SA(1, 0), 0, kstep, false); PG8_STAGE_B(PG8_SB(1, 1), cB + hstep + kstep);
    PG8_WAIT_V(6); PG8_BAR;
    for (;;) {
        nA = (has_next && !GATHER) ? (const char*)A + (size_t)nxt.pm * tstep : cA;
        const char* nB = has_next ? (const char*)Bt + (size_t)nxt.brow * K * 2 : cB;
        const typename Epi::Pre pre = E.pre(cur, wr, wc, fr, fq);
#pragma unroll 1
        for (int t = 0; t < nt; t += 2) {
            const bool last = (t == nt - 2);
            const size_t k1 = (size_t)(t + 1) * kstep, k2 = last ? (size_t)0 : (size_t)(t + 2) * kstep, k3 = k2 + kstep;
            const char* b2 = last ? nB : cB + (size_t)(t + 2) * kstep; const char* b3 = b2 + kstep;
            PG8_LDB(B0, 0, 0); PG8_LDB(B1, 0, 1); PG8_SCHED; PG8_LDA(At, 0, 0); PG8_STAGE_A(PG8_SA(1, 1), 1, k1, false);
            PG8_WAIT_V(8); PG8_WAIT_L(0); PG8_BAR; PG8_MMA(0, 0, At, B0); PG8_MMA(0, 1, At, B1); PG8_BAR; PG8_SCHED;
            PG8_LDA(At, 0, 1); PG8_STAGE_B(PG8_SB(0, 0), b2); PG8_STAGE_B(PG8_SB(0, 1), b2 + hstep); PG8_STAGE_A(PG8_SA(0, 0), 0, k2, last);
            PG8_WAIT_V(8); PG8_WAIT_L(0); PG8_BAR; PG8_MMA(1, 0, At, B0); PG8_MMA(1, 1, At, B1); PG8_BAR; PG8_SCHED;
            PG8_LDB(B0, 1, 0); PG8_LDB(B1, 1, 1); PG8_SCHED; PG8_LDA(At, 1, 0); PG8_STAGE_A(PG8_SA(0, 1), 1, k2, last);
            PG8_WAIT_V(8); PG8_WAIT_L(0); PG8_BAR; PG8_MMA(0, 0, At, B0); PG8_MMA(0, 1, At, B1); PG8_BAR; PG8_SCHED;
            PG8_LDA(At, 1, 1); PG8_STAGE_B(PG8_SB(1, 0), b3); PG8_STAGE_B(PG8_SB(1, 1), b3 + hstep); PG8_STAGE_A(PG8_SA(1, 0), 0, k3, last);
            PG8_WAIT_V(8); PG8_WAIT_L(0); PG8_BAR; PG8_MMA(1, 0, At, B0); PG8_MMA(1, 1, At, B1); PG8_BAR; PG8_SCHED;
        }
        typename Epi::Init inx = typename Epi::Init(); if (Epi::HAS_INIT && has_next) inx = E.init(nxt, wr, wc, fr, fq);
        Unit nn; bool has_nn = false; unsigned rnn[2] = {0u, 0u};
        if (has_next) { has_nn = S.next(ui + 2, nn); if (GATHER && has_nn) { PG8_LOAD_RO(rnn, nn); } }
        if (wr == 0) PG8_BAR;
        if constexpr (F8) asm volatile("s_nop 15\n\ts_nop 15" ::: "memory");
        E(acc, cur, wr, wc, fr, fq, pre);
        if (!has_next) break;
#pragma unroll
        for (int a = 0; a < 2; ++a)
#pragma unroll
            for (int b = 0; b < 2; ++b)
#pragma unroll
                for (int m = 0; m < 4; ++m)
#pragma unroll
                    for (int n = 0; n < 2; ++n) acc[a][b][m][n] = Epi::HAS_INIT ? inx.v[b][n] : (f32x4){0.f, 0.f, 0.f, 0.f};
        cur = nxt; cA = nA; cB = nB; ++ui;
        has_next = has_nn; nxt = nn;
        if (GATHER) { roc[0] = ron[0]; roc[1] = ron[1]; if (has_next) { ron[0] = rnn[0]; ron[1] = rnn[1]; } }
        if (wr == 1) PG8_BAR;
    }
    PG8_WAIT_V(0);
    PG8_BAR;
#undef PG8_SA
#undef PG8_SB
#undef PG8_STAGE_A
#undef PG8_STAGE_B
#undef PG8_LDA
#undef PG8_LDB
#undef PG8_MMA
#undef PG8_WAIT_V
#undef PG8_WAIT_L
#undef PG8_BAR
#undef PG8_SCHED
#undef PG8_LOAD_RO
}

struct EpiPlainBf16 {
    static constexpr bool PERM = true;
    bf16_t* O; int ldc;
    static constexpr bool HAS_INIT = false; struct Init { f32x4 v[2][2]; };
    __device__ __forceinline__ Init init(const Unit&, int, int, int, int) const { return Init(); }
    struct Pre {};
    __device__ __forceinline__ Pre pre(const Unit&, int, int, int, int) const { return Pre{}; }
    __device__ __forceinline__ void operator()(const f32x4 (&acc)[2][2][4][2], const Unit& u, int wr, int wc, int fr, int fq, const Pre&) const {
        const int row0 = u.pm * BM + wr * 64 + fr, col0 = u.pn * BM + wc * 32 + 8 * fq;
#pragma unroll
        for (int ai = 0; ai < 2; ++ai)
#pragma unroll
            for (int m = 0; m < 4; ++m) { bf16_t* rowp = O + (size_t)(row0 + ai * HALF + m * 16) * ldc + col0;
#pragma unroll
                for (int bj = 0; bj < 2; ++bj) { const f32x4 v0 = acc[ai][bj][m][0], v1 = acc[ai][bj][m][1];
                    v4u w; w.x = cvt_pk_bf16(v0[0], v0[1]); w.y = cvt_pk_bf16(v0[2], v0[3]); w.z = cvt_pk_bf16(v1[0], v1[1]); w.w = cvt_pk_bf16(v1[2], v1[3]);
                    *(v4u*)(rowp + bj * HALF) = w; } }
    }
};

struct SchedInProj {
    int G, c;
    __device__ __forceinline__ bool next(int i, Unit& u) const {
        const int L = i * G + c;
        if (L < 1152) { int lt, pn; tile_order(L, 128, 9, lt, pn); u.pm = (lt >> 3) * 9 + 1 + (lt & 7); u.pn = pn; }
        else if (L < 1216) { const int q = L - 1152, ct = q >> 2, j = q & 3; u.pm = ct * 9; u.pn = (j == 3) ? 8 : 1 + j; }
        else return false;
        u.brow = u.pn * BM; u.e = 0; u.r0 = 0; u.cnt = 0; return true;
    }
    __device__ __forceinline__ unsigned arow_tok(const Unit&, int) const { return 0u; }
};
struct EpiInProj {
    static constexpr bool PERM = false;
    unsigned char* ws; const float* qng; const float* kng; const float* rope;
    static constexpr bool HAS_INIT = false; struct Init { f32x4 v[2][2]; };
    __device__ __forceinline__ Init init(const Unit&, int, int, int, int) const { return Init(); }
    struct Pre {};
    __device__ __forceinline__ Pre pre(const Unit&, int, int, int, int) const { return Pre{}; }
    __device__ __forceinline__ void operator()(const f32x4 (&acc)[2][2][4][2], const Unit& u, int wr, int wc, int fr, int fq, const Pre&) const {
        const int g = u.pn * 4 + wc, bt = u.pm / 9, pt = u.pm % 9; const bool isctx = (pt == 0);
        const int blk = fq >> 1, f1 = fq & 1, dbase = 32 * blk + 8 * f1;
        const bool do_rms = (g >= 24 && g < 34), do_rope = !isctx && (g < 8 || (g >= 24 && g < 34)), latrows = (g < 4) || (g >= 16 && g < 32);
        const float scale = (g >= 4 && g < 8) ? 0.125f : ((g >= 24 && g < 32) ? C2 : 1.0f);
        bf16_t* dst; int pitch;
        if (g < 4) { dst = (bf16_t*)(ws + WS_RQ) + g * 64; pitch = 256; }
        else if (g < 8) { dst = (bf16_t*)(ws + WS_RK) + (g - 4) * 64; pitch = 256; }
        else if (g < 16) { dst = (bf16_t*)(ws + WS_RV) + (g - 8) * 64; pitch = 512; }
        else if (g < 24) { dst = (bf16_t*)(ws + WS_RG) + (g - 16) * 64; pitch = 512; }
        else if (g < 32) { dst = (bf16_t*)(ws + WS_AQ) + (g - 24) * 64; pitch = 512; }
        else if (g < 34) { dst = (bf16_t*)(ws + WS_AK) + (g - 32) * 64; pitch = 128; }
        else { dst = (bf16_t*)(ws + WS_AV) + (g - 34) * 64; pitch = 128; }
        const int rowbase = latrows ? bt * SEQ + (pt - 1) * 256 : u.pm * 256;
        dst += dbase;
        f32x4 gv[2][2];
#pragma unroll
        for (int bj = 0; bj < 2; ++bj)
#pragma unroll
            for (int n = 0; n < 2; ++n) gv[bj][n] = do_rms ? *(const f32x4*)((g < 32 ? qng : kng) + dbase + 16 * bj + 4 * n) : (f32x4){1.f, 1.f, 1.f, 1.f};
#pragma unroll
        for (int ai = 0; ai < 2; ++ai)
#pragma unroll
            for (int m = 0; m < 4; ++m) {
                const int r = ai * HALF + wr * 64 + m * 16 + fr;
                f32x4 v[2][2];
#pragma unroll
                for (int bj = 0; bj < 2; ++bj)
#pragma unroll
                    for (int n = 0; n < 2; ++n) v[bj][n] = acc[ai][bj][m][n];
                if (do_rms) {
                    float ss = 0.f;
#pragma unroll
                    for (int bj = 0; bj < 2; ++bj)
#pragma unroll
                        for (int n = 0; n < 2; ++n) ss += (v[bj][n][0] * v[bj][n][0] + v[bj][n][1] * v[bj][n][1]) + (v[bj][n][2] * v[bj][n][2] + v[bj][n][3] * v[bj][n][3]);
                    ss += __shfl_xor(ss, 16); ss += __shfl_xor(ss, 32);
                    const float rinv = 1.0f / sqrtf(ss * (1.0f / 64.0f) + LN_EPS);
#pragma unroll
                    for (int bj = 0; bj < 2; ++bj)
#pragma unroll
                        for (int n = 0; n < 2; ++n) v[bj][n] = v[bj][n] * rinv * gv[bj][n];
                }
                if (do_rope) {
                    const int t = (pt - 1) * 256 + r, pos = blk ? (t & 63) : (t >> 6);
                    const f32x4* rp = (const f32x4*)(rope + pos * 32 + 16 * f1);
#pragma unroll
                    for (int n = 0; n < 2; ++n) { const f32x4 p0 = rp[2 * n], p1 = rp[2 * n + 1];
                        const f32x4 lo = v[0][n], hi = v[1][n];
                        const f32x4 cs = {p0[0], p0[2], p1[0], p1[2]}, sn = {p0[1], p0[3], p1[1], p1[3]};
                        v[0][n] = lo * cs - hi * sn; v[1][n] = hi * cs + lo * sn; }
                }
                bf16_t* rowp = dst + (size_t)(rowbase + r) * pitch;
#pragma unroll
                for (int bj = 0; bj < 2; ++bj) { const f32x4 v0 = v[bj][0] * scale, v1 = v[bj][1] * scale;
                    v4u w; w.x = cvt_pk_bf16(v0[0], v0[1]); w.y = cvt_pk_bf16(v0[2], v0[3]); w.z = cvt_pk_bf16(v1[0], v1[1]); w.w = cvt_pk_bf16(v1[2], v1[3]);
                    *(v4u*)(rowp + 16 * bj) = w; }
            }
    }
};

struct SchedMoE {
    int nN, NB, G, c; const LAS int* tab; const v2u* LIST;
    __device__ __forceinline__ bool next(int i, Unit& u) const {
        const int ntiles = __builtin_amdgcn_readfirstlane(tab[32]); const long L = (long)i * G + c; if (L >= (long)ntiles * nN) return false;
        tile_order((int)L, ntiles, nN, u.pm, u.pn);
        const int ln = (int)(threadIdx.x & 63u); const int tq = (ln >= 1 && ln < 32) ? tab[ln] : 0x7fffffff;
        const int e = __builtin_popcountll(__ballot(u.pm >= tq));
        u.e = e; u.r0 = (u.pm - __builtin_amdgcn_readfirstlane(tab[e])) * 256; u.cnt = __builtin_amdgcn_readfirstlane(tab[33 + e]); u.brow = e * NB + u.pn * BM; return true;
    }
    __device__ __forceinline__ unsigned arow_tok(const Unit& u, int r) const { int rr = u.r0 + r; rr = rr < u.cnt ? rr : u.cnt - 1; return LIST[(size_t)u.e * LISTCAP + rr].x >> 2; }
};
__device__ __forceinline__ void moe_build_tab(LAS int* tab, const unsigned* CNT) {
    if (threadIdx.x == 0) { int st = 0; for (int e = 0; e < 32; ++e) { const int c = (int)CNT[e]; tab[e] = st; tab[33 + e] = c; st += (c + 255) >> 8; } tab[32] = st; }
    __syncthreads();
}
struct EpiUp {
    static constexpr bool PERM = true;
    unsigned char* ACT; const float* bup;
    static constexpr bool HAS_INIT = true; struct Init { f32x4 v[2][2]; };
    __device__ __forceinline__ Init init(const Unit& u, int wr, int wc, int fr, int fq) const {
        const float* bg = bup + (size_t)u.e * 2048 + u.pn * 128 + wc * 32 + 8 * fq; Init i; i.v[0][0] = *(const f32x4*)bg; i.v[0][1] = *(const f32x4*)(bg + 4); i.v[1][0] = *(const f32x4*)(bg + 1024) + 1.0f; i.v[1][1] = *(const f32x4*)(bg + 1028) + 1.0f; return i; }
    struct Pre {};
    __device__ __forceinline__ Pre pre(const Unit&, int, int, int, int) const { return Pre{}; }
    __device__ __forceinline__ void operator()(const f32x4 (&acc)[2][2][4][2], const Unit& u, int wr, int wc, int fr, int fq, const Pre&) const {
        const int colt = u.pn * 128 + wc * 32 + 8 * fq;
#pragma unroll
        for (int ai = 0; ai < 2; ++ai)
#pragma unroll
            for (int m = 0; m < 4; ++m) {
                const int row = u.pm * BM + ai * HALF + wr * 64 + m * 16 + fr;
                f32x4 ag[2] = {acc[ai][0][m][0], acc[ai][0][m][1]}, al[2] = {acc[ai][1][m][0], acc[ai][1][m][1]};
                asm volatile("" : "+v"(ag[0]), "+v"(ag[1]), "+v"(al[0]), "+v"(al[1]));
                float o[8];
#pragma unroll
                for (int n = 0; n < 2; ++n)
#pragma unroll
                    for (int j = 0; j < 4; ++j) { const float gl = __builtin_amdgcn_fmed3f(ag[n][j], -3.0e38f, 7.0f); const float l1 = __builtin_amdgcn_fmed3f(al[n][j], -6.0f, 8.0f);
                        o[4 * n + j] = (gl * l1) * __builtin_amdgcn_rcpf(1.0f + __builtin_amdgcn_exp2f(-1.702f * 1.4426950408889634f * gl)); }
                v2u w; w.x = 0u; w.y = 0u;
                w.x = __builtin_amdgcn_cvt_pk_fp8_f32(o[0], o[1], w.x, false); w.x = __builtin_amdgcn_cvt_pk_fp8_f32(o[2], o[3], w.x, true);
                w.y = __builtin_amdgcn_cvt_pk_fp8_f32(o[4], o[5], w.y, false); w.y = __builtin_amdgcn_cvt_pk_fp8_f32(o[6], o[7], w.y, true);
                *(v2u*)(ACT + (size_t)row * 1024 + colt) = w;
            }
    }
};
struct EpiDown {
    static constexpr bool PERM = true;
    bf16_t* YE; const float* bdn; const v2u* LIST;
    static constexpr bool HAS_INIT = true; struct Init { f32x4 v[2][2]; };
    __device__ __forceinline__ Init init(const Unit& u, int wr, int wc, int fr, int fq) const {
        Init i; const float* bb = bdn + (size_t)u.e * 1024 + u.pn * BM + wc * 64 + 16 * fq;
#pragma unroll
        for (int bj = 0; bj < 2; ++bj)
#pragma unroll
            for (int n = 0; n < 2; ++n) i.v[bj][n] = *(const f32x4*)(bb + 8 * bj + 4 * n);
        return i; }
    struct Pre { v2u ent[2][4]; };
    __device__ __forceinline__ Pre pre(const Unit& u, int wr, int wc, int fr, int fq) const {
        Pre p;
#pragma unroll
        for (int ai = 0; ai < 2; ++ai)
#pragma unroll
            for (int m = 0; m < 4; ++m) { const int rr = u.r0 + ai * HALF + wr * 64 + m * 16 + fr; p.ent[ai][m] = LIST[(size_t)u.e * LISTCAP + (rr < u.cnt ? rr : u.cnt - 1)]; }
        return p;
    }
    __device__ __forceinline__ void operator()(const f32x4 (&acc)[2][2][4][2], const Unit& u, int wr, int wc, int fr, int fq, const Pre& P) const {
        const int col0 = u.pn * BM + wc * 64 + 16 * fq;
#pragma unroll
        for (int ai = 0; ai < 2; ++ai)
#pragma unroll
            for (int m = 0; m < 4; ++m) {
                const int rr = u.r0 + ai * HALF + wr * 64 + m * 16 + fr; const bool valid = rr < u.cnt;
                const v2u ent = P.ent[ai][m]; const float gate = __uint_as_float(ent.y);
                unsigned char* rowp = (unsigned char*)YE + (size_t)ent.x * 1024 + col0;
                const float g64 = gate * 64.0f;
                f32x4 a0 = acc[ai][0][m][0], a1 = acc[ai][0][m][1], a2 = acc[ai][1][m][0], a3 = acc[ai][1][m][1]; asm volatile("" : "+v"(a0), "+v"(a1), "+v"(a2), "+v"(a3));
                const f32x4 v0 = a0 * g64, v1 = a1 * g64, v2 = a2 * g64, v3 = a3 * g64;
                v4u w; w.x = 0u; w.y = 0u; w.z = 0u; w.w = 0u;
                w.x = __builtin_amdgcn_cvt_pk_fp8_f32(v0[0], v0[1], w.x, false); w.x = __builtin_amdgcn_cvt_pk_fp8_f32(v0[2], v0[3], w.x, true);
                w.y = __builtin_amdgcn_cvt_pk_fp8_f32(v1[0], v1[1], w.y, false); w.y = __builtin_amdgcn_cvt_pk_fp8_f32(v1[2], v1[3], w.y, true);
                w.z = __builtin_amdgcn_cvt_pk_fp8_f32(v2[0], v2[1], w.z, false); w.z = __builtin_amdgcn_cvt_pk_fp8_f32(v2[2], v2[3], w.z, true);
                w.w = __builtin_amdgcn_cvt_pk_fp8_f32(v3[0], v3[1], w.w, false); w.w = __builtin_amdgcn_cvt_pk_fp8_f32(v3[2], v3[3], w.w, true);
                if (valid) *(v4u*)rowp = w;
            }
    }
};
}

#include <hip/hip_bf16.h>
#include <cmath>
namespace attn_body {
using bf16=__hip_bfloat16;
using bf16x8=__attribute__((ext_vector_type(8)))short;
using s16x4=__attribute__((ext_vector_type(4)))short;
using f32x16=__attribute__((ext_vector_type(16)))float;
using u32x4=__attribute__((ext_vector_type(4)))unsigned;
constexpr int D=64,QP=512,KP=128,OP=1024,SEQQ=2048,SEQK=2304;
constexpr int NW=8,QBLK=32,QB=QBLK*NW,KVBLK=64,NQB=SEQQ/QB;
constexpr int ATTN_UNIT_ROWS=QB;
__device__ __forceinline__ int crow(int r,int hi){return (r&3)+8*(r>>2)+4*hi;}
#define SBAR() __builtin_amdgcn_sched_barrier(0)
__device__ __forceinline__ void cmask(f32x16&p0,f32x16&p1,int jb,int qrel,int hi){
  const float NEG=-INFINITY; int kb=64*jb+4*hi;
  #pragma unroll
  for(int r=0;r<16;++r){int kv=kb+(r&3)+8*(r>>2); if(kv>qrel)p0[r]=NEG; if(kv+32>qrel)p1[r]=NEG;}
}

constexpr int NSLOT=3, SLOTB=8192;
constexpr int LDS_K=0, LDS_V=NSLOT*SLOTB, LDS_WS=2*NSLOT*SLOTB, LDS_OST=LDS_WS+NW*64*4, LDS_BYTES=LDS_OST+NW*4096;
constexpr float C2=0.125f*1.4426950408889634f;
__device__ __forceinline__ void glds16(const void*gsrc,unsigned lds_dst){unsigned keep;
  asm volatile("s_mov_b32 %0, m0\n\ts_mov_b32 m0, %2\n\ts_nop 0\n\tglobal_load_lds_dwordx4 %1, off\n\ts_mov_b32 m0, %0":"=&s"(keep):"v"(gsrc),"s"(lds_dst):"memory");}
__device__ __forceinline__ float max3f(float a,float b,float c){float r;asm("v_max3_f32 %0, %1, %2, %3":"=v"(r):"v"(a),"v"(b),"v"(c));return r;}
__device__ __forceinline__ float max2f(float a,float b){float r;asm("v_max_f32_e32 %0, %1, %2":"=v"(r):"v"(a),"v"(b));return r;}
__device__ __forceinline__ float fadd_s(float a,float b){float r;asm("v_add_f32_e32 %0, %1, %2":"=v"(r):"v"(a),"v"(b));return r;}
__device__ __forceinline__ float fsub_s(float a,float b){float r;asm("v_sub_f32_e32 %0, %1, %2":"=v"(r):"v"(a),"v"(b));return r;}
typedef float f32x2_t __attribute__((ext_vector_type(2))); typedef __bf16 bf16x2_t __attribute__((ext_vector_type(2)));
__device__ __forceinline__ unsigned cvtpk_s(float lo,float hi){f32x2_t v={lo,hi};bf16x2_t b=__builtin_convertvector(v,bf16x2_t);return __builtin_bit_cast(unsigned,b);}
#define WAIT_BAR(N) asm volatile("s_waitcnt vmcnt(" #N ") lgkmcnt(0)\n\ts_barrier":::"memory")

__device__ __forceinline__ void qkt(f32x16&p0,f32x16&p1,const char*Kslot,const bf16x8*qr,const f32x16&negm,int r32,int hi){
  const char*kb=Kslot+hi*1024+r32*16;
  #pragma unroll
  for(int d0=0;d0<4;++d0){
    const bf16x8 b0=*reinterpret_cast<const bf16x8*>(kb+d0*2048);
    const bf16x8 b1=*reinterpret_cast<const bf16x8*>(kb+d0*2048+512);
    if(d0==0){p0=__builtin_amdgcn_mfma_f32_32x32x16_bf16(b0,qr[0],negm,0,0,0);p1=__builtin_amdgcn_mfma_f32_32x32x16_bf16(b1,qr[0],negm,0,0,0);}
    else{p0=__builtin_amdgcn_mfma_f32_32x32x16_bf16(b0,qr[d0],p0,0,0,0);p1=__builtin_amdgcn_mfma_f32_32x32x16_bf16(b1,qr[d0],p1,0,0,0);}}
}
typedef __attribute__((address_space(3))) const char* lds_cptr;
typedef short v4i16_t __attribute__((ext_vector_type(4)));
__device__ __forceinline__ void kload8(bf16x8*kf,lds_cptr kp){
  kf[0]=*(const __attribute__((address_space(3))) bf16x8*)(kp);      kf[1]=*(const __attribute__((address_space(3))) bf16x8*)(kp+512);
  kf[2]=*(const __attribute__((address_space(3))) bf16x8*)(kp+2048); kf[3]=*(const __attribute__((address_space(3))) bf16x8*)(kp+2560);
  kf[4]=*(const __attribute__((address_space(3))) bf16x8*)(kp+4096); kf[5]=*(const __attribute__((address_space(3))) bf16x8*)(kp+4608);
  kf[6]=*(const __attribute__((address_space(3))) bf16x8*)(kp+6144); kf[7]=*(const __attribute__((address_space(3))) bf16x8*)(kp+6656);
}
__device__ __forceinline__ void kload2(bf16x8*kf,lds_cptr kp,int j){ kf[2*j]=*(const __attribute__((address_space(3))) bf16x8*)(kp+j*2048); kf[2*j+1]=*(const __attribute__((address_space(3))) bf16x8*)(kp+j*2048+512); }
__device__ __forceinline__ s16x4 vtr(lds_cptr p){ return __builtin_bit_cast(s16x4,__builtin_amdgcn_ds_read_tr16_b64_v4i16((__attribute__((address_space(3))) v4i16_t*)p)); }
__device__ __forceinline__ float rowmax(const f32x16&p0,const f32x16&p1){
  float a=max3f(p0[0],p0[1],p1[0]),b=max3f(p0[2],p0[3],p1[1]);a=max3f(a,p1[2],p1[3]);
  #pragma unroll
  for(int r=4;r<16;r+=4){a=max3f(a,p0[r],p0[r+1]);b=max3f(b,p0[r+2],p0[r+3]);a=max3f(a,p1[r],p1[r+1]);b=max3f(b,p1[r+2],p1[r+3]);}
  const float m=max2f(a,b);
  auto rr=__builtin_amdgcn_permlane32_swap(__float_as_uint(m),__float_as_uint(m),false,false);
  return max2f(__uint_as_float(rr[0]),__uint_as_float(rr[1]));
}
__device__ __forceinline__ void pv(f32x16*o,int vb,bf16x8 pa0,bf16x8 pa1,bf16x8 pa2,bf16x8 pa3){
  #pragma unroll
  for(int d0=0;d0<2;++d0){s16x4 lo[4],hi[4];
    #pragma unroll
    for(int ks=0;ks<4;++ks){
      asm volatile("ds_read_b64_tr_b16 %0,%1 offset:%c2":"=&v"(lo[ks]):"v"(vb),"i"(d0*4096+ks*1024):"memory");
      asm volatile("ds_read_b64_tr_b16 %0,%1 offset:%c2":"=&v"(hi[ks]):"v"(vb),"i"(d0*4096+ks*1024+512):"memory");}
    asm volatile("s_waitcnt lgkmcnt(0)":::"memory");SBAR();
    #define PK(k) (bf16x8){lo[k][0],lo[k][1],lo[k][2],lo[k][3],hi[k][0],hi[k][1],hi[k][2],hi[k][3]}
    o[d0]=__builtin_amdgcn_mfma_f32_32x32x16_bf16(pa0,PK(0),o[d0],0,0,0);
    o[d0]=__builtin_amdgcn_mfma_f32_32x32x16_bf16(pa1,PK(1),o[d0],0,0,0);
    o[d0]=__builtin_amdgcn_mfma_f32_32x32x16_bf16(pa2,PK(2),o[d0],0,0,0);
    o[d0]=__builtin_amdgcn_mfma_f32_32x32x16_bf16(pa3,PK(3),o[d0],0,0,0);
    #undef PK
  }
}

#ifndef ATTN_STORE16
#define ATTN_STORE16(p,v) (*(u32x4*)(p)=(v))
#endif
template<int THRL> __device__ __forceinline__ void attn_unit(int b,int h,int qb,const bf16*Q,const bf16*__restrict__ K,const bf16*__restrict__ V,bf16*O,char*shm,float refB){
  const int tid=threadIdx.x,lane=tid&63,r32=lane&31,hi=lane>>5; const int wid=__builtin_amdgcn_readfirstlane(tid>>6);
  const long rowq=(long)b*SEQQ,rowk=(long)b*SEQK; const int q0=qb*QB;
  const bf16*Qw=Q+(rowq+q0+wid*QBLK)*QP+h*D;
  const bf16*Kh=K+rowk*KP+(h>>2)*D,*Vh=V+rowk*KP+(h>>2)*D;
  const unsigned lds0=(unsigned)(uintptr_t)shm;
  float*wsf=(float*)(shm+LDS_WS)+wid*64;
  const bf16*ksrc=Kh+(long)lane*KP+wid*8;
  const bf16*vsrc=Vh+(long)(16*(wid&3)+(lane>>2))*KP+(wid>>2)*32+(lane&3)*8;
  const unsigned kdst=lds0+LDS_K+wid*1024, vdst=lds0+LDS_V+wid*1024;
  #define DMA_K(t,slot) glds16(ksrc+(long)(t)*KVBLK*KP,(unsigned)__builtin_amdgcn_readfirstlane(kdst+(slot)))
  #define DMA_V(t,slot) glds16(vsrc+(long)(t)*KVBLK*KP,(unsigned)__builtin_amdgcn_readfirstlane(vdst+(slot)))
  const int vb0=(int)(lds0+LDS_V)+((lane>>4)&1)*32+(lane&3)*8+(4*hi+((lane&15)>>2))*64;
  const char*Kbase=shm+LDS_K; bf16x8 kf[8];
  const lds_cptr shm3=(lds_cptr)shm; const lds_cptr kp0=shm3+LDS_K+hi*1024+r32*16; const lds_cptr vp0=shm3+LDS_V+((lane>>4)&1)*32+(lane&3)*8+(4*hi+((lane&15)>>2))*64;
  const int NT=SEQK/KVBLK;
  DMA_K(0,0);DMA_V(0,0);DMA_K(1,SLOTB);
  bf16x8 qr[4];
  #pragma unroll
  for(int d0=0;d0<4;++d0)qr[d0]=*reinterpret_cast<const bf16x8*>(&Qw[(long)r32*QP+d0*16+hi*8]);
  float mhat=refB,l_reg=0.f;f32x16 o[2];o[0]=f32x16{};o[1]=f32x16{};f32x16 negm; _Pragma("unroll") for(int r=0;r<16;++r)negm[r]=-refB; asm volatile("":"+v"(negm));

  #define CMASK(P0,P1,t) do{}while(0)
  bool resc=false;
  #define START(P0,P1) do{ resc=false; \
    _Pragma("unroll") for(int r=0;r<16;++r)P0[r]=__builtin_amdgcn_exp2f(P0[r]); }while(0)
  #define RESC() do{ if(resc){ asm volatile("s_waitcnt lgkmcnt(0)":::"memory"); \
      _Pragma("unroll") for(int d_=0;d_<2;++d_) _Pragma("unroll") for(int r=0;r<16;++r)o[d_][r]*=wsf[crow(r,hi)]; } }while(0)
  f32x16 pA0,pA1,pB0,pB1;
  int sl_prev=0,sl_cur=0,sl_next=SLOTB;
  #define ROT() do{sl_prev=sl_cur;sl_cur=sl_next;sl_next=(sl_next==(NSLOT-1)*SLOTB)?0:sl_next+SLOTB;}while(0)
  DMA_K(2,2*SLOTB);
  WAIT_BAR(3);
  qkt(pA0,pA1,Kbase,qr,negm,r32,hi);asm volatile("s_nop 15\n\ts_nop 7":"+v"(pA0),"+v"(pA1));CMASK(pA0,pA1,0);
  START(pA0,pA1);
  _Pragma("unroll") for(int r=0;r<16;++r)pA1[r]=__builtin_amdgcn_exp2f(pA1[r]);
  WAIT_BAR(0);
  DMA_K(3,0);DMA_V(1,SLOTB);
  ROT();
  kload8(kf,kp0+sl_cur);
  WAIT_BAR(2);
  s16x4 vlo[8],vhi[8]; u32x4 pw0,pw1,pw2,pw3;
  #define PKW(P,B) cvtpk_s(P[B],P[B+1])
  #define PAF(k) __builtin_bit_cast(bf16x8,pw##k)
  #define VFR(i) (bf16x8){vlo[i][0],vlo[i][1],vlo[i][2],vlo[i][3],vhi[i][0],vhi[i][1],vhi[i][2],vhi[i][3]}
  #define PIN(x) asm volatile("":"+v"(x))
  #define MX3(a,b,c) __builtin_fmaxf(__builtin_fmaxf((a),(b)),(c))
  #define GAPA(MF,A0,A1,A2,A3,W0,W1,PW) do{ MF; sacc+=A0; sacc+=A1; sacc+=A2; sacc+=A3; PIN(sacc); W0; W1; PIN(PW); SBAR(); }while(0)
  #define EX(v) __builtin_amdgcn_exp2f(v)
  #define GAPB(MF,X,B) do{ MF; X[B]=EX(X[B]); X[B+1]=EX(X[B+1]); X[B+2]=EX(X[B+2]); X[B+3]=EX(X[B+3]); PIN(X); SBAR(); }while(0)
  #define VRD(i) do{ vlo[i]=vtr(vp_+(((i)>>2)*4096+((i)&3)*1024)); vhi[i]=vtr(vp_+(((i)>>2)*4096+((i)&3)*1024+512)); }while(0)
  #define KRD(G,j) do{ if(G){ kload2(kf,kp0+sl_next,j); SBAR(); } }while(0)
  #define STEP(C0,C1,P0,P1,t,GK,GV,GL) do{ SBAR(); \
    const lds_cptr vp_=vp0+sl_prev; \
    VRD(0); SBAR(); float sacc=(P0[0]+P0[1]); \
    GAPA(C0=__builtin_amdgcn_mfma_f32_32x32x16_bf16(kf[0],qr[0],negm,0,0,0), P0[2],P0[3],P0[4],P0[5],     pw0[0]=PKW(P0,0), pw0[1]=PKW(P0,2), pw0); \
    VRD(4); SBAR(); GAPA(C1=__builtin_amdgcn_mfma_f32_32x32x16_bf16(kf[1],qr[0],negm,0,0,0), P0[6],P0[7],P0[8],P0[9],     pw0[2]=PKW(P0,4), pw0[3]=PKW(P0,6), pw0); \
    VRD(1); SBAR(); GAPA(C0=__builtin_amdgcn_mfma_f32_32x32x16_bf16(kf[2],qr[1],C0,0,0,0),   P0[10],P0[11],P0[12],P0[13], pw1[0]=PKW(P0,8), pw1[1]=PKW(P0,10), pw1); \
    VRD(5); SBAR(); GAPA(C1=__builtin_amdgcn_mfma_f32_32x32x16_bf16(kf[3],qr[1],C1,0,0,0),   P0[14],P0[15],P1[0],P1[1],   pw1[2]=PKW(P0,12),pw1[3]=PKW(P0,14), pw1); \
    VRD(2); SBAR(); GAPA(C0=__builtin_amdgcn_mfma_f32_32x32x16_bf16(kf[4],qr[2],C0,0,0,0),   P1[2],P1[3],P1[4],P1[5],     pw2[0]=PKW(P1,0), pw2[1]=PKW(P1,2), pw2); \
    VRD(6); SBAR(); GAPA(C1=__builtin_amdgcn_mfma_f32_32x32x16_bf16(kf[5],qr[2],C1,0,0,0),   P1[6],P1[7],P1[8],P1[9],     pw2[2]=PKW(P1,4), pw2[3]=PKW(P1,6), pw2); \
    VRD(3); SBAR(); GAPA(C0=__builtin_amdgcn_mfma_f32_32x32x16_bf16(kf[6],qr[3],C0,0,0,0),   P1[10],P1[11],P1[12],P1[13], pw3[0]=PKW(P1,8), pw3[1]=PKW(P1,10), pw3); \
    VRD(7); SBAR(); GAPA(C1=__builtin_amdgcn_mfma_f32_32x32x16_bf16(kf[7],qr[3],C1,0,0,0),   P1[14],P1[15],0.f,0.f,       pw3[2]=PKW(P1,12),pw3[3]=PKW(P1,14), pw3); \
    l_reg+=sacc; \
    if(GK){DMA_K((t)+3,sl_cur);} if(GV){DMA_V((t)+1,sl_next);} \
    CMASK(C0,C1,t); \
    resc=false; \
    SBAR(); \
    GAPB(o[0]=__builtin_amdgcn_mfma_f32_32x32x16_bf16(PAF(0),VFR(0),o[0],0,0,0), C0,0); \
    GAPB(o[1]=__builtin_amdgcn_mfma_f32_32x32x16_bf16(PAF(0),VFR(4),o[1],0,0,0), C0,4); \
    KRD(GL,0); GAPB(o[0]=__builtin_amdgcn_mfma_f32_32x32x16_bf16(PAF(1),VFR(1),o[0],0,0,0), C0,8); \
    KRD(GL,1); GAPB(o[1]=__builtin_amdgcn_mfma_f32_32x32x16_bf16(PAF(1),VFR(5),o[1],0,0,0), C0,12); \
    KRD(GL,2); GAPB(o[0]=__builtin_amdgcn_mfma_f32_32x32x16_bf16(PAF(2),VFR(2),o[0],0,0,0), C1,0); \
    KRD(GL,3); GAPB(o[1]=__builtin_amdgcn_mfma_f32_32x32x16_bf16(PAF(2),VFR(6),o[1],0,0,0), C1,4); \
    GAPB(o[0]=__builtin_amdgcn_mfma_f32_32x32x16_bf16(PAF(3),VFR(3),o[0],0,0,0), C1,8); \
    GAPB(o[1]=__builtin_amdgcn_mfma_f32_32x32x16_bf16(PAF(3),VFR(7),o[1],0,0,0), C1,12); \
    }while(0)
  int t=1;
  #undef CMASK
  #define CMASK(P0,P1,t) do{}while(0)
  for(;t+5<NT;t+=2){
    STEP(pB0,pB1,pA0,pA1,t,true,true,true);     WAIT_BAR(2); RESC(); ROT();
    STEP(pA0,pA1,pB0,pB1,t+1,true,true,true);   WAIT_BAR(2); RESC(); ROT();
  }
  #undef CMASK
  #define CMASK(P0,P1,t) do{}while(0)
  #define ENDW(tt) do{ if((tt)+3<NT){WAIT_BAR(2);} else if((tt)+2<NT){WAIT_BAR(1);} else {WAIT_BAR(0);} }while(0)
  for(;t+1<NT;t+=2){
    STEP(pB0,pB1,pA0,pA1,t,(t+3<NT),(t+1<NT),(t+1<NT));       ENDW(t);   RESC(); ROT();
    STEP(pA0,pA1,pB0,pB1,t+1,(t+4<NT),(t+2<NT),(t+2<NT));     ENDW(t+1); RESC(); ROT();
  }
  STEP(pB0,pB1,pA0,pA1,NT-1,false,false,false); RESC();
  { float sacc=pB0[0]+pB0[1]; _Pragma("unroll") for(int r=2;r<16;++r)sacc+=pB0[r]; _Pragma("unroll") for(int r=0;r<16;++r)sacc+=pB1[r]; l_reg+=sacc;
    pw0=(u32x4){PKW(pB0,0),PKW(pB0,2),PKW(pB0,4),PKW(pB0,6)};pw1=(u32x4){PKW(pB0,8),PKW(pB0,10),PKW(pB0,12),PKW(pB0,14)};pw2=(u32x4){PKW(pB1,0),PKW(pB1,2),PKW(pB1,4),PKW(pB1,6)};pw3=(u32x4){PKW(pB1,8),PKW(pB1,10),PKW(pB1,12),PKW(pB1,14)};
    SBAR(); pv(o,vb0+sl_cur,PAF(0),PAF(1),PAF(2),PAF(3)); }
  #undef PKW
  #undef PAF
  #undef VFR
  #undef PIN
  #undef MX3
  #undef GAPA
  #undef GAPB
  #undef EX
  #undef VRD
  #undef KRD
  #undef STEP
  #undef ENDW
  {auto rr=__builtin_amdgcn_permlane32_swap(__float_as_uint(l_reg),__float_as_uint(l_reg),false,false);l_reg=__uint_as_float(rr[0])+__uint_as_float(rr[1]);}
  if(hi==0)wsf[32+r32]=l_reg;asm volatile("s_waitcnt lgkmcnt(0)":::"memory");
  float rli[16];
  #pragma unroll
  for(int r=0;r<16;++r)rli[r]=__builtin_amdgcn_rcpf(wsf[32+crow(r,hi)]);
  bf16*Ow=O+(rowq+q0+wid*QBLK)*OP+h*D;
  { bf16*stg=(bf16*)(shm+LDS_OST)+wid*2048;
    #pragma unroll
    for(int r=0;r<16;++r){const int orow=crow(r,hi);
      #pragma unroll
      for(int d0=0;d0<2;++d0)stg[orow*64+d0*32+r32]=__float2bfloat16(o[d0][r]*rli[r]);}
    asm volatile("s_waitcnt lgkmcnt(0)":::"memory");
    #pragma unroll
    for(int i=0;i<4;++i){const int row=i*8+(lane>>3),ch=lane&7; const u32x4 v=*(const u32x4*)(stg+row*64+ch*8); ATTN_STORE16(Ow+(long)row*OP+ch*8,v);} }
  asm volatile("s_waitcnt lgkmcnt(0)\n\ts_barrier":::"memory");
  #undef DMA_K
  #undef DMA_V
  #undef CMASK
  #undef START
  #undef RESC
  #undef ROT
}
constexpr int ATTN_LDS_BYTES=LDS_BYTES;
struct AttnTensors { const bf16* Q; const bf16* K; const bf16* V; bf16* O; };
struct AttnUnit { int b, h, qb; };
struct StaticOrder {
  int vcu;
  __device__ __forceinline__ explicit StaticOrder(int grid,int block):vcu((block%8)*(grid/8)+block/8){}
  __device__ __forceinline__ bool next(int i,AttnUnit&u)const{ const int p=8*i+(vcu>>5); if(p>=32)return false; const int w=vcu&31; u.b=p>>1; u.h=(p&1)*4+(w>>3); u.qb=w&7; return true; }
};
template<class Sched,int THRL=8> __device__ __forceinline__ void attn_phase(char*lds,const AttnTensors&T,const Sched&S){
  AttnUnit u;
  for(int i=0;S.next(i,u);++i){ attn_unit<THRL>(u.b,u.h,u.qb,T.Q,T.K,T.V,T.O,lds,64.0f); }
}
#undef SBAR
#undef WAIT_BAR
}

namespace ret {
typedef short bf16x8 __attribute__((ext_vector_type(8)));
typedef short s16x4 __attribute__((ext_vector_type(4)));
typedef float f32x16 __attribute__((ext_vector_type(16)));
constexpr int VP = 160, KPT = 48;
constexpr int VB = 128 * VP * 2, KB = 128 * KPT * 2, BUF = VB + KB;
__device__ __forceinline__ int crow(int r, int hi) { return (r & 3) + 8 * (r >> 2) + 4 * hi; }
__device__ __forceinline__ s16x4 trd(const LAS unsigned char* p) { return __builtin_bit_cast(s16x4, __builtin_amdgcn_ds_read_tr16_b64_v4i16((LAS s16x4*)p)); }
__device__ __forceinline__ bf16x8 cat(s16x4 a, s16x4 b) { return (bf16x8){a[0], a[1], a[2], a[3], b[0], b[1], b[2], b[3]}; }
__device__ __forceinline__ v4u scale8(v4u w, float s) {
    v4u o; o.x = pk2(bflo(w.x) * s, bfhi(w.x) * s); o.y = pk2(bflo(w.y) * s, bfhi(w.y) * s); o.z = pk2(bflo(w.z) * s, bfhi(w.z) * s); o.w = pk2(bflo(w.w) * s, bfhi(w.w) * s); return o;
}
constexpr int RAP = 96, RAB = 128 * RAP * 2, RABUF = 2 * RAB;
__device__ __forceinline__ void state_unit(int b, int h, int dir, int dvh, const bf16_t* RK, const bf16_t* RV, bf16_t* ST, float lg2, LAS unsigned char* lds) {
    const int tid = threadIdx.x, lane = tid & 63, wid = __builtin_amdgcn_readfirstlane(tid >> 6), r32 = lane & 31, hi = lane >> 5, dvt = wid & 1, dkt = (wid >> 1) & 1;
    const float g128 = exp2f(lg2 * 128.0f);
    const int prow = tid >> 3, pc8 = tid & 7;
    const float kw0 = dir ? exp2f(lg2 * (float)prow) : exp2f(lg2 * (float)(127 - prow)), kw1 = dir ? exp2f(lg2 * (float)(prow + 64)) : exp2f(lg2 * (float)(63 - prow));
    v4u vreg[2], kreg[2];
    auto chunk_of = [&](int s) { return dir ? (s == 0 ? 1 : (s == 1 ? 0 : 19 - s)) : s; };
    auto load = [&](int s) {
        const size_t urow = (size_t)b * SU + (size_t)chunk_of(s) * 128;
#pragma unroll
        for (int i = 0; i < 2; ++i) { vreg[i] = *(const v4u*)(RV + (urow + prow + 64 * i) * 512 + h * 128 + dvh * 64 + pc8 * 8); kreg[i] = *(const v4u*)(RK + (urow + prow + 64 * i) * 256 + h * 64 + pc8 * 8); }
    };
    load(0);
    f32x16 acc = {};
    const int gq = lane >> 4, colblk = gq & 1, q4 = (lane >> 2) & 3, p4 = lane & 3;
    for (int s = 0; s < 18; ++s) {
        LAS unsigned char* buf = lds + (s & 1) * RABUF;
#pragma unroll
        for (int i = 0; i < 2; ++i) { *(LAS v4u*)(buf + (prow + 64 * i) * (RAP * 2) + pc8 * 16) = vreg[i]; *(LAS v4u*)(buf + RAB + (prow + 64 * i) * (RAP * 2) + pc8 * 16) = scale8(kreg[i], i ? kw1 : kw0); }
        __syncthreads();
        if (s + 1 < 18) load(s + 1);
        if (wid < 4) {
            if (s >= 2) {
                const int n = dir ? 17 - s : s - 2;
                bf16_t* st = ST + ((((size_t)b * 4 + h) * 2 + dir) * 16 + n) * (128 * 64) + dkt * 32 + r32;
#pragma unroll
                for (int r = 0; r < 16; ++r) st[(size_t)(64 * dvh + 32 * dvt + crow(r, hi)) * 64] = (bf16_t)f2bf(acc[r]);
            }
            if (s < 17) {
#pragma unroll
                for (int r = 0; r < 16; ++r) acc[r] *= g128;
                const LAS unsigned char* va = buf + (8 * hi + q4) * (RAP * 2) + (32 * dvt + 16 * colblk + 4 * p4) * 2;
                const LAS unsigned char* ka = buf + RAB + (8 * hi + q4) * (RAP * 2) + (32 * dkt + 16 * colblk + 4 * p4) * 2;
#pragma unroll
                for (int ks = 0; ks < 8; ++ks) {
                    const bf16x8 af = cat(trd(va + ks * 16 * RAP * 2), trd(va + (ks * 16 + 4) * RAP * 2));
                    const bf16x8 bfm = cat(trd(ka + ks * 16 * RAP * 2), trd(ka + (ks * 16 + 4) * RAP * 2));
                    acc = __builtin_amdgcn_mfma_f32_32x32x16_bf16(af, bfm, acc, 0, 0, 0);
                }
            }
        }
    }
    __syncthreads();
}
constexpr int QP2 = 72, GP2 = 136;
constexpr int OFF_Q = VB, OFF_K = OFF_Q + 128 * QP2 * 2, OFF_G = OFF_K + 128 * QP2 * 2, OFF_RED = OFF_G + 128 * GP2 * 2;
struct OutRegs { v4u vv[4], qq[2], kk[2]; };
__device__ __forceinline__ void out_load(OutRegs& R, int u, const bf16_t* RQ, const bf16_t* RK, const bf16_t* RV, const bf16_t* RG) {
    const int tid = threadIdx.x, n = u & 15, h = (u >> 4) & 3, b = u >> 6;
    const size_t m0 = (size_t)b * SEQ + 128 * n, u0 = (size_t)b * SU + CTX + 128 * n;
#pragma unroll
    for (int i = 0; i < 4; ++i) { const int pc = tid + 512 * i; R.vv[i] = *(const v4u*)(RV + (u0 + (pc >> 4)) * 512 + h * 128 + (pc & 15) * 8); }
#pragma unroll
    for (int i = 0; i < 2; ++i) { const int pc = tid + 512 * i; R.qq[i] = *(const v4u*)(RQ + (m0 + (pc >> 3)) * 256 + h * 64 + (pc & 7) * 8); R.kk[i] = *(const v4u*)(RK + (u0 + (pc >> 3)) * 256 + h * 64 + (pc & 7) * 8); }
}
__device__ __forceinline__ void out_unit(OutRegs& R, int u, int unext, const bf16_t* RQ, const bf16_t* RK, const bf16_t* RV, const bf16_t* RG, const bf16_t* ST, const float* gng, const float* gnb, const float* ldf, const float* ldb, bf16_t* MIX, LAS unsigned char* lds) {
    const int n = u & 15, h = (u >> 4) & 3, b = u >> 6; const float lgf = ldf[h] * 1.4426950408889634f, lgb = ldb[h] * 1.4426950408889634f;
    const int tid = threadIdx.x, lane = tid & 63, wid = __builtin_amdgcn_readfirstlane(tid >> 6), r32 = lane & 31, hi = lane >> 5, rg = wid & 3, dvh = wid >> 2;
    const size_t m0 = (size_t)b * SEQ + 128 * n, u0 = (size_t)b * SU + CTX + 128 * n;
    LAS float* red = (LAS float*)(lds + OFF_RED);
    {
        __syncthreads();
#pragma unroll
        for (int i = 0; i < 4; ++i) { const int pc = tid + 512 * i; *(LAS v4u*)(lds + (pc >> 4) * (VP * 2) + (pc & 15) * 16) = R.vv[i]; }
#pragma unroll
        for (int i = 0; i < 2; ++i) { const int pc = tid + 512 * i; *(LAS v4u*)(lds + OFF_Q + (pc >> 3) * (QP2 * 2) + (pc & 7) * 16) = R.qq[i]; *(LAS v4u*)(lds + OFF_K + (pc >> 3) * (QP2 * 2) + (pc & 7) * 16) = R.kk[i]; }
    }
    __syncthreads();
    out_load(R, unext >= 0 ? unext : u, RQ, RK, RV, RG);
    bf16x8 qf[4];
#pragma unroll
    for (int ks = 0; ks < 4; ++ks) qf[ks] = *(const LAS bf16x8*)(lds + OFF_Q + (32 * rg + r32) * (QP2 * 2) + (16 * ks + 8 * hi) * 2);
    f32x16 st[4];
#pragma unroll
    for (int kt = 0; kt < 4; ++kt) { st[kt] = (f32x16){};
#pragma unroll
        for (int ks = 0; ks < 4; ++ks) { const bf16x8 kf = *(const LAS bf16x8*)(lds + OFF_K + (32 * kt + r32) * (QP2 * 2) + (16 * ks + 8 * hi) * 2); st[kt] = __builtin_amdgcn_mfma_f32_32x32x16_bf16(kf, qf[ks], st[kt], 0, 0, 0); } }
    const int c = 32 * rg + r32; const float cf4 = (float)(c - 4 * hi), nlgb = -lgb;
    bf16x8 pa[4][2];
#pragma unroll
    for (int kt = 0; kt < 4; ++kt) {
#pragma unroll
        for (int r = 0; r < 16; ++r) { const float df = cf4 - (float)(32 * kt + crow(r, 0));
            float w = __builtin_amdgcn_exp2f((df > 0.0f ? lgf : nlgb) * df); w = (df == 0.0f) ? 2.0f : w; st[kt][r] *= w; }
#pragma unroll
        for (int s2 = 0; s2 < 2; ++s2) { v4u w; w.x = pk2(st[kt][8 * s2], st[kt][8 * s2 + 1]); w.y = pk2(st[kt][8 * s2 + 2], st[kt][8 * s2 + 3]); w.z = pk2(st[kt][8 * s2 + 4], st[kt][8 * s2 + 5]); w.w = pk2(st[kt][8 * s2 + 6], st[kt][8 * s2 + 7]); pa[kt][s2] = __builtin_bit_cast(bf16x8, w); }
    }
    asm volatile("" ::: "memory");
    v4u gg[4];
#pragma unroll
    for (int i = 0; i < 4; ++i) { const int pc = tid + 512 * i; gg[i] = *(const v4u*)(RG + (m0 + (pc >> 4)) * 512 + h * 128 + (pc & 15) * 8); }
    f32x16 ot[2] = {(f32x16){}, (f32x16){}};
    const int gq = lane >> 4, colblk = gq & 1, q4 = (lane >> 2) & 3, p4 = lane & 3;
#pragma unroll
    for (int dt = 0; dt < 2; ++dt) {
        const LAS unsigned char* va = lds + (4 * hi + q4) * (VP * 2) + (64 * dvh + 32 * dt + 16 * colblk + 4 * p4) * 2;
#pragma unroll
        for (int kt = 0; kt < 4; ++kt)
#pragma unroll
            for (int s2 = 0; s2 < 2; ++s2) { const int kb = 32 * kt + 16 * s2; const bf16x8 vf = cat(trd(va + kb * VP * 2), trd(va + (kb + 8) * VP * 2)); ot[dt] = __builtin_amdgcn_mfma_f32_32x32x16_bf16(vf, pa[kt][s2], ot[dt], 0, 0, 0); }
    }
    {
        const float decf = __builtin_amdgcn_exp2f(lgf * (float)(c + 1)), decb = __builtin_amdgcn_exp2f(lgb * (float)(128 - c));
        const bf16_t* sf = ST + ((((size_t)b * 4 + h) * 2 + 0) * 16 + n) * (128 * 64); const bf16_t* sb = sf + (size_t)16 * 128 * 64;
#pragma unroll
        for (int ks = 0; ks < 4; ++ks) {
            const v4u qw = __builtin_bit_cast(v4u, qf[ks]); const bf16x8 qdf = __builtin_bit_cast(bf16x8, scale8(qw, decf)), qdb = __builtin_bit_cast(bf16x8, scale8(qw, decb));
#pragma unroll
            for (int dt = 0; dt < 2; ++dt) { const size_t so = (size_t)(64 * dvh + 32 * dt + r32) * 64 + 16 * ks + 8 * hi;
                ot[dt] = __builtin_amdgcn_mfma_f32_32x32x16_bf16(*(const bf16x8*)(sf + so), qdf, ot[dt], 0, 0, 0);
                ot[dt] = __builtin_amdgcn_mfma_f32_32x32x16_bf16(*(const bf16x8*)(sb + so), qdb, ot[dt], 0, 0, 0); }
        }
    }
#pragma unroll
    for (int i = 0; i < 4; ++i) { const int pc = tid + 512 * i; *(LAS v4u*)(lds + OFF_G + (pc >> 4) * (GP2 * 2) + (pc & 15) * 16) = gg[i]; }
    float s1 = 0.f;
#pragma unroll
    for (int dt = 0; dt < 2; ++dt)
#pragma unroll
        for (int r = 0; r < 16; ++r) s1 += ot[dt][r];
    s1 += __shfl_xor(s1, 32);
    if (hi == 0) red[wid * 32 + r32] = s1;
    __syncthreads();
    const float mu = (red[wid * 32 + r32] + red[(wid ^ 4) * 32 + r32]) * (1.0f / 128.0f);
    float s2 = 0.f;
#pragma unroll
    for (int dt = 0; dt < 2; ++dt)
#pragma unroll
        for (int r = 0; r < 16; ++r) { const float d = ot[dt][r] - mu; s2 = fmaf(d, d, s2); }
    s2 += __shfl_xor(s2, 32);
    __syncthreads();
    if (hi == 0) red[wid * 32 + r32] = s2;
    __syncthreads();
    const float rs = 1.0f / sqrtf((red[wid * 32 + r32] + red[(wid ^ 4) * 32 + r32]) * (1.0f / 128.0f) + LN_EPS);
    LAS unsigned char* grow = lds + OFF_G + (32 * rg + r32) * (GP2 * 2);
#pragma unroll
    for (int dt = 0; dt < 2; ++dt)
#pragma unroll
        for (int rq = 0; rq < 4; ++rq) {
            const int dv = 64 * dvh + 32 * dt + 8 * rq + 4 * hi;
            const f32x4 gg = *(const f32x4*)(gng + h * 128 + dv), gb = *(const f32x4*)(gnb + h * 128 + dv);
            const v2u gw = *(const LAS v2u*)(grow + dv * 2);
            const float g0 = bflo(gw.x), g1 = bfhi(gw.x), g2 = bflo(gw.y), g3 = bfhi(gw.y);
            const float y0 = ((ot[dt][4 * rq] - mu) * rs * gg[0] + gb[0]) * (g0 * __builtin_amdgcn_rcpf(1.0f + __builtin_amdgcn_exp2f(-1.4426950408889634f * g0)));
            const float y1 = ((ot[dt][4 * rq + 1] - mu) * rs * gg[1] + gb[1]) * (g1 * __builtin_amdgcn_rcpf(1.0f + __builtin_amdgcn_exp2f(-1.4426950408889634f * g1)));
            const float y2 = ((ot[dt][4 * rq + 2] - mu) * rs * gg[2] + gb[2]) * (g2 * __builtin_amdgcn_rcpf(1.0f + __builtin_amdgcn_exp2f(-1.4426950408889634f * g2)));
            const float y3 = ((ot[dt][4 * rq + 3] - mu) * rs * gg[3] + gb[3]) * (g3 * __builtin_amdgcn_rcpf(1.0f + __builtin_amdgcn_exp2f(-1.4426950408889634f * g3)));
            v2u w; w.x = pk2(y0, y1); w.y = pk2(y2, y3);
            *(LAS v2u*)(grow + dv * 2) = w;
        }
    __syncthreads();
#pragma unroll
    for (int i = 0; i < 4; ++i) { const int pc = tid + 512 * i; *(v4u*)(MIX + (m0 + (pc >> 4)) * DM + h * 128 + (pc & 15) * 8) = *(const LAS v4u*)(lds + OFF_G + (pc >> 4) * (GP2 * 2) + (pc & 15) * 16); }
}
}

struct Args {
    const float* in[26]; float* out; unsigned char* ws; int ph_lo, ph_hi, li, pad;
};
enum { I_X = 0, I_C, I_CTX, I_CCTX, I_LNING, I_LNINB, I_WADA, I_BADA, I_WIN, I_LDF, I_LDB, I_GNG, I_GNB, I_QNG, I_KNG, I_WO, I_LN1G, I_LN1B, I_RW, I_RB, I_WUP, I_BUP, I_WDN, I_BDN, I_LN2G, I_LN2B };

struct Frame {
    LAS unsigned char* lds;
    unsigned* ctl;
    int tid, lane, wave, G, gtid, nthreads, gw, ngw;
};

constexpr int LDS_BYTES = 147456, MISC_OFF = 147456 - 1024;

__device__ __forceinline__ int phys_in(int lc) { const int pn = lc >> 8, wc = (lc >> 6) & 3, d = lc & 63; const int blk = d >> 5, bj = (d >> 4) & 1, f1 = (d >> 3) & 1, n = (d >> 2) & 1, j = d & 3;
    return pn * 256 + 128 * bj + 32 * wc + 16 * n + 4 * (2 * blk + f1) + j; }
__device__ __forceinline__ int phys_up(int c) { return 256 * ((c & 1023) >> 7) + 128 * (c >> 10) + (c & 127); }
__device__ __forceinline__ int phys_dn(int c) { const int cc = c & 255; return (c & ~255) + 128 * ((cc >> 3) & 1) + 32 * (cc >> 6) + 8 * ((cc >> 4) & 3) + (cc & 7); }

__device__ __forceinline__ void transpose_load(f32x4 (&v)[16], const float* W, int K, int N, int item, int lane) {
    const int nkb = K / 64, kb = item % nkb, nb = item / nkb, k0 = 64 * kb, n0 = 64 * nb;
    const float* src = W + (size_t)(k0 + (lane >> 4)) * N + n0 + (lane & 15) * 4;
#pragma unroll
    for (int i = 0; i < 16; ++i) v[i] = __builtin_nontemporal_load((const f32x4*)(src + (size_t)(4 * i) * N));
}
__device__ __forceinline__ void transpose_write(const f32x4 (&v)[16], LAS float* scr, int lane) {
#pragma unroll
    for (int i = 0; i < 16; ++i) { LAS float* d = scr + (4 * i + (lane >> 4)) * 65 + (lane & 15) * 4; d[0] = v[i][0]; d[1] = v[i][1]; d[2] = v[i][2]; d[3] = v[i][3]; }
    asm volatile("s_waitcnt lgkmcnt(0)" ::: "memory");
}
template <int MAP, bool F8> __device__ __forceinline__ void transpose_out(int K, void* WT, LAS float* scr, int item, int lane) {
    const int nkb = K / 64, kb = item % nkb, nb = item / nkb, k0 = 64 * kb, n0 = 64 * nb;
    const int c = lane & 7;
#pragma unroll
    for (int j = 0; j < 8; ++j) { const int n = (lane >> 3) + 8 * j; const LAS float* s = scr + (8 * c) * 65 + n;
        const int ln = n0 + n; const int pr = MAP == 1 ? phys_in(ln) : (MAP == 2 ? phys_up(ln) : ln);
        if constexpr (F8) { v2u q; q.x = 0u; q.y = 0u;
            q.x = __builtin_amdgcn_cvt_pk_fp8_f32(64.f * s[0 * 65], 64.f * s[1 * 65], q.x, false); q.x = __builtin_amdgcn_cvt_pk_fp8_f32(64.f * s[2 * 65], 64.f * s[3 * 65], q.x, true);
            q.y = __builtin_amdgcn_cvt_pk_fp8_f32(64.f * s[4 * 65], 64.f * s[5 * 65], q.y, false); q.y = __builtin_amdgcn_cvt_pk_fp8_f32(64.f * s[6 * 65], 64.f * s[7 * 65], q.y, true);
            *(v2u*)((unsigned char*)WT + (size_t)pr * K + k0 + 8 * c) = q; }
        else { v4u o; o.x = pk2(s[0 * 65], s[1 * 65]); o.y = pk2(s[2 * 65], s[3 * 65]); o.z = pk2(s[4 * 65], s[5 * 65]); o.w = pk2(s[6 * 65], s[7 * 65]);
            *(v4u*)((bf16_t*)WT + (size_t)pr * K + k0 + 8 * c) = o; } }
    asm volatile("s_waitcnt lgkmcnt(0)" ::: "memory");
}
__device__ __forceinline__ void transpose8_write(const f32x4 (&v)[16], LAS unsigned* T, int lane) {
#pragma unroll
    for (int i = 0; i < 16; ++i) { unsigned w = 0u; w = __builtin_amdgcn_cvt_pk_fp8_f32(64.f * v[i][0], 64.f * v[i][1], w, false); w = __builtin_amdgcn_cvt_pk_fp8_f32(64.f * v[i][2], 64.f * v[i][3], w, true);
        T[(4 * i + (lane >> 4)) * 17 + (lane & 15)] = w; }
    asm volatile("s_waitcnt lgkmcnt(0)" ::: "memory");
}
template <int MAP> __device__ __forceinline__ void transpose8_out(int K, unsigned char* WT, const LAS unsigned* T, int item, int lane) {
    const int nkb = K / 64, kb = item % nkb, nb = item / nkb, k0 = 64 * kb, n0 = 64 * nb;
    const int c = lane & 7, ng2 = lane >> 3;
#pragma unroll
    for (int j = 0; j < 2; ++j) { const int ng = ng2 + 8 * j; unsigned d[8];
#pragma unroll
        for (int i = 0; i < 8; ++i) d[i] = T[(8 * c + i) * 17 + ng];
        unsigned r[2][4];
#pragma unroll
        for (int h = 0; h < 2; ++h) { const unsigned d0 = d[4 * h], d1 = d[4 * h + 1], d2 = d[4 * h + 2], d3 = d[4 * h + 3];
            const unsigned t0 = __builtin_amdgcn_perm(d1, d0, 0x05010400u), t1 = __builtin_amdgcn_perm(d1, d0, 0x07030602u), t2 = __builtin_amdgcn_perm(d3, d2, 0x05010400u), t3 = __builtin_amdgcn_perm(d3, d2, 0x07030602u);
            r[h][0] = __builtin_amdgcn_perm(t2, t0, 0x05040100u); r[h][1] = __builtin_amdgcn_perm(t2, t0, 0x07060302u); r[h][2] = __builtin_amdgcn_perm(t3, t1, 0x05040100u); r[h][3] = __builtin_amdgcn_perm(t3, t1, 0x07060302u); }
#pragma unroll
        for (int q = 0; q < 4; ++q) { const int ln = n0 + 4 * ng + q; const int pr = MAP == 2 ? phys_up(ln) : (MAP == 3 ? phys_dn(ln) : ln); v2u o; o.x = r[0][q]; o.y = r[1][q];
            *(v2u*)(WT + (size_t)pr * K + k0 + 8 * c) = o; } }
    asm volatile("s_waitcnt lgkmcnt(0)" ::: "memory");
}
template <int MAP, bool F8> __device__ __forceinline__ void transpose_item(const float* W, int K, int N, void* WT, LAS float* scr, int item, int lane) {
    f32x4 v[16]; transpose_load(v, W, K, N, item, lane); transpose_write(v, scr, lane); transpose_out<MAP, F8>(K, WT, scr, item, lane);
}

__device__ __forceinline__ void p0_prologue(const Args& a, Frame& F) {
    unsigned char* ws = a.ws;
    float* ADA = (float*)(ws + WS_ADA); float* ROPE = (float*)(ws + WS_ROPE);
    for (int idx = F.gtid; idx < 64 * 16; idx += F.nthreads) {
        const int pos = idx >> 4, i = idx & 15;
        const float inv = exp2f(-(float)i * (13.287712379549449f / 16.0f));
        const float ang = (float)pos * inv;
        ROPE[idx * 2] = cosf(ang); ROPE[idx * 2 + 1] = sinf(ang);
    }
    { bf16_t* RWT = (bf16_t*)(ws + WS_RWT);
      for (int idx = F.gtid; idx < 32 * 1024; idx += F.nthreads) { const int e = idx >> 10, k = idx & 1023; const float w = a.in[I_RW][k * 32 + e]; const unsigned hi = f2bf(w); RWT[idx] = (bf16_t)hi; RWT[32768 + idx] = (bf16_t)f2bf(w - bf2f(hi)); } }
    for (int tile = blockIdx.x; tile < 192; tile += F.G) {
        LAS float* SL = (LAS float*)F.lds;
        LAS float* PT = (LAS float*)(F.lds + 17 * 4096);
        for (int i = F.tid; i < 17 * 1024; i += NTHR) { const int r = i >> 10, k = i & 1023; const float s = r < 16 ? a.in[I_C][r * 1024 + k] : a.in[I_CCTX][k]; SL[i] = s / (1.0f + __expf(-s)); }
        __syncthreads();
        const int col = F.lane & 31, kh = F.lane >> 5; const float* w = a.in[I_WADA] + tile * 32 + col; const int k0 = F.wave * 128 + 64 * kh;
        float acc[17];
#pragma unroll
        for (int r = 0; r < 17; ++r) acc[r] = 0.f;
#pragma unroll 1
        for (int kb = 0; kb < 64; kb += 32) {
            float wv[32];
#pragma unroll
            for (int q = 0; q < 32; ++q) wv[q] = __builtin_nontemporal_load(w + (size_t)(k0 + kb + q) * 6144);
#pragma unroll
            for (int k4 = 0; k4 < 32; k4 += 4)
#pragma unroll
                for (int r = 0; r < 17; ++r) { const f32x4 s4 = *(const LAS f32x4*)(SL + r * 1024 + k0 + kb + k4); acc[r] = fmaf(s4[0], wv[k4], acc[r]); acc[r] = fmaf(s4[1], wv[k4 + 1], acc[r]); acc[r] = fmaf(s4[2], wv[k4 + 2], acc[r]); acc[r] = fmaf(s4[3], wv[k4 + 3], acc[r]); }
        }
#pragma unroll
        for (int r = 0; r < 17; ++r) { acc[r] += __shfl_xor(acc[r], 32); if (kh == 0) PT[(F.wave * 17 + r) * 32 + col] = acc[r]; }
        __syncthreads();
        for (int i = F.tid; i < 17 * 32; i += NTHR) { const int r = i >> 5, c = i & 31; float s = a.in[I_BADA][tile * 32 + c];
#pragma unroll
            for (int wv = 0; wv < 8; ++wv) s += PT[(wv * 17 + r) * 32 + c];
            ADA[r * 6144 + tile * 32 + c] = s; }
        __syncthreads();
    }
    LAS float* scr = (LAS float*)(F.lds + F.wave * 16640);
    constexpr int I_IN = 16 * (NIN / 64), I_O = 16 * 16;
    for (int it = F.gw; it < I_IN + I_O; it += F.ngw) {
        if (it < I_IN) transpose_item<1, false>(a.in[I_WIN], 1024, NIN, ws + WS_WIN, scr, it, F.lane);
        else transpose_item<0, false>(a.in[I_WO], 1024, 1024, ws + WS_WO, scr, it - I_IN, F.lane);
    }
}
__device__ __forceinline__ void xd_issue(const float* W, int N, int item, int lane, LAS unsigned char* buf) {
    const int kb = item & 15, nb = item >> 4, r = lane >> 4, p = lane & 15;
    const float* base = W + (size_t)(64 * kb + r) * N + 64 * nb;
#pragma unroll
    for (int g = 0; g < 16; ++g)
        __builtin_amdgcn_global_load_lds((const unsigned*)(base + (size_t)(4 * g) * N + 4 * (p ^ (g >> 1))), (LAS unsigned*)(buf + g * 1024), 16, 0, 2);
}
__device__ __forceinline__ void xd_read(float (&v)[8][8], const LAS unsigned char* buf, int lane) {
    const int c = lane & 7, ns = lane >> 3;
#pragma unroll
    for (int j = 0; j < 8; ++j) { const int n = ns + 8 * j; const LAS float* s = (const LAS float*)(buf + c * 2048 + ((((n >> 2) ^ c) & 15) << 4) + 4 * (n & 3));
#pragma unroll
        for (int i = 0; i < 8; ++i) v[j][i] = s[i * 64]; }
    asm volatile("s_waitcnt lgkmcnt(0)" ::: "memory");
}
template <int MAP> __device__ __forceinline__ void xd_store(const float (&v)[8][8], unsigned char* WT, int item, int lane) {
    const int kb = item & 15, nb = item >> 4, c = lane & 7, ns = lane >> 3;
#pragma unroll
    for (int j = 0; j < 8; ++j) { const int n = ns + 8 * j;
        v2u o; o.x = 0u; o.y = 0u;
        o.x = __builtin_amdgcn_cvt_pk_fp8_f32(64.f * v[j][0], 64.f * v[j][1], o.x, false); o.x = __builtin_amdgcn_cvt_pk_fp8_f32(64.f * v[j][2], 64.f * v[j][3], o.x, true);
        o.y = __builtin_amdgcn_cvt_pk_fp8_f32(64.f * v[j][4], 64.f * v[j][5], o.y, false); o.y = __builtin_amdgcn_cvt_pk_fp8_f32(64.f * v[j][6], 64.f * v[j][7], o.y, true);
        const int ln = 64 * nb + n; const int pr = MAP == 2 ? phys_up(ln) : phys_dn(ln);
        *(v2u*)(WT + (size_t)pr * 1024 + 64 * kb + 8 * c) = o; }
}
__device__ __forceinline__ void moe_weights_convert(const Args& a, Frame& F, int first, int last, int wi, int nw) {
    unsigned char* ws = a.ws;
    LAS unsigned char* buf = F.lds + F.wave * 16384;
    constexpr int I_UP = 16 * 32, I_DN = 16 * 16, NIT = NEXP * (I_UP + I_DN);
    { int _l = F.lane; asm volatile("" : "+v"(_l)); F.lane = _l; }
#define XD_ISSUE(it_) do { const int _it = (it_); if (_it < NEXP * I_UP) { const int e = _it / I_UP; xd_issue(a.in[I_WUP] + (size_t)e * 1024 * 2048, 2048, _it % I_UP, F.lane, buf); } \
        else { const int r = _it - NEXP * I_UP, e = r / I_DN; xd_issue(a.in[I_WDN] + (size_t)e * 1024 * 1024, 1024, r % I_DN, F.lane, buf); } } while (0)
    if (first + wi >= last) return;
    XD_ISSUE(first + wi);
#pragma unroll 1
    for (int it = first + wi; it < last; it += nw) {
        float v[8][8];
        asm volatile("s_waitcnt vmcnt(0)" ::: "memory");
        xd_read(v, buf, F.lane);
        if (it + nw < last) XD_ISSUE(it + nw);
        if (it < NEXP * I_UP) { const int e = it / I_UP; xd_store<2>(v, ws + WS_WUP + (size_t)e * 2048 * 1024, it % I_UP, F.lane); }
        else { const int r = it - NEXP * I_UP, e = r / I_DN; xd_store<3>(v, ws + WS_WDN + (size_t)e * 1024 * 1024, r % I_DN, F.lane); }
    }
#undef XD_ISSUE
}

__device__ __forceinline__ void p1_ln_mod(const Args& a, Frame& F) {
    unsigned char* ws = a.ws;
    const float* ADA = (const float*)(ws + WS_ADA); float* STATS = (float*)(ws + WS_STATS); bf16_t* H = (bf16_t*)(ws + WS_H);
    const int rpw = (NROW + F.ngw - 1) / F.ngw, u0 = F.gw * rpw, u1 = (u0 + rpw < NROW) ? u0 + rpw : NROW;
    auto rowsrc = [&](int u) { const int b = u / SU, p = u % SU; return (const f32x4*)(p < CTX ? a.in[I_CTX] + ((size_t)b * CTX + p) * DM : a.in[I_X] + ((size_t)b * SEQ + (p - CTX)) * DM) + F.lane; };
    f32x4 vn[4], G[4], Bv[4]; int kind = -1;
    if (u0 < u1) { const f32x4* xr = rowsrc(u0);
#pragma unroll
        for (int j = 0; j < 4; ++j) vn[j] = __builtin_nontemporal_load(xr + 64 * j); }
    for (int u = u0; u < u1; ++u) {
        const int b = u / SU, p = u % SU, kd = p < CTX ? 16 : b;
        if (kd != kind) { kind = kd; const float* ad = ADA + kd * 6144;
#pragma unroll
            for (int j = 0; j < 4; ++j) { const f32x4 g = ((const f32x4*)a.in[I_LNING] + F.lane)[64 * j], bb = ((const f32x4*)a.in[I_LNINB] + F.lane)[64 * j], sh = ((const f32x4*)ad + F.lane)[64 * j], sc = ((const f32x4*)(ad + 1024) + F.lane)[64 * j] + 1.0f;
                G[j] = g * sc; Bv[j] = bb * sc + sh; } }
        f32x4 v[4]; float s = 0.f;
#pragma unroll
        for (int j = 0; j < 4; ++j) v[j] = vn[j];
        { const int un = (u + 1 < u1) ? u + 1 : u; const f32x4* xr = rowsrc(un);
#pragma unroll
            for (int j = 0; j < 4; ++j) vn[j] = __builtin_nontemporal_load(xr + 64 * j); }
#pragma unroll
        for (int j = 0; j < 4; ++j) s += (v[j].x + v[j].y) + (v[j].z + v[j].w);
        const float mean = wave_sum(s) * (1.f / DM); float s2 = 0.f;
#pragma unroll
        for (int j = 0; j < 4; ++j) { v[j] = v[j] - mean; s2 += (v[j].x * v[j].x + v[j].y * v[j].y) + (v[j].z * v[j].z + v[j].w * v[j].w); }
        const float rstd = 1.f / sqrtf(wave_sum(s2) * (1.f / DM) + LN_EPS);
        v2u* o8 = (v2u*)(H + (size_t)u * DM) + F.lane;
#pragma unroll
        for (int j = 0; j < 4; ++j) { const f32x4 h = v[j] * rstd * G[j] + Bv[j]; v2u w; w.x = pk2(h.x, h.y); w.y = pk2(h.z, h.w); o8[64 * j] = w; }
        if (p >= CTX && F.lane == 0) { const int m = b * SEQ + (p - CTX); STATS[2 * m] = mean; STATS[2 * m + 1] = rstd; }
    }
}

__device__ __forceinline__ void store64(bf16_t* dst, const float (&v)[64]) {
#pragma unroll
    for (int q = 0; q < 8; ++q) { v4u w; w.x = pk2(v[8 * q], v[8 * q + 1]); w.y = pk2(v[8 * q + 2], v[8 * q + 3]); w.z = pk2(v[8 * q + 4], v[8 * q + 5]); w.w = pk2(v[8 * q + 6], v[8 * q + 7]); *(v4u*)(dst + 8 * q) = w; }
}
__device__ __forceinline__ void rope64(float (&v)[64], const float* ROPE, int t) {
    const float* rr = ROPE + (t >> 6) * 32; const float* rc = ROPE + (t & 63) * 32;
#pragma unroll
    for (int i = 0; i < 16; ++i) {
        const float cr = rr[2 * i], sr = rr[2 * i + 1], cc = rc[2 * i], sc = rc[2 * i + 1];
        const float x1 = v[i], x2 = v[16 + i], x3 = v[32 + i], x4 = v[48 + i];
        v[i] = x1 * cr - x2 * sr; v[16 + i] = x2 * cr + x1 * sr; v[32 + i] = x3 * cc - x4 * sc; v[48 + i] = x4 * cc + x3 * sc;
    }
}
__device__ __forceinline__ void rms64(float (&v)[64], const float* g) {
    float ss = 0.f;
#pragma unroll
    for (int d = 0; d < 64; ++d) ss = fmaf(v[d], v[d], ss);
    const float r = 1.0f / sqrtf(ss * (1.0f / 64.0f) + LN_EPS);
#pragma unroll
    for (int d = 0; d < 64; ++d) v[d] = v[d] * r * g[d];
}
__device__ __forceinline__ void p3_attn_scalar(const Args& a, Frame& F) {
    unsigned char* ws = a.ws;
    const bf16_t* AQ = (const bf16_t*)(ws + WS_AQ); const bf16_t* AK = (const bf16_t*)(ws + WS_AK); const bf16_t* AV = (const bf16_t*)(ws + WS_AV); bf16_t* MIX = (bf16_t*)(ws + WS_MIX);
    for (int it = F.gtid; it < BATCH * 8 * SEQ; it += F.nthreads) {
        const int t = it % SEQ, h = (it / SEQ) % 8, b = it / (SEQ * 8); const int m = b * SEQ + t, hk = h >> 2;
        v4u q[8];
#pragma unroll
        for (int i = 0; i < 8; ++i) q[i] = *(const v4u*)(AQ + (size_t)m * 512 + h * 64 + 8 * i);
        float o[64];
#pragma unroll
        for (int d = 0; d < 64; ++d) o[d] = 0.f;
        float mr = -1e30f, l = 0.f;
        const bf16_t* kb = AK + (size_t)b * SU * 128 + hk * 64; const bf16_t* vb = AV + (size_t)b * SU * 128 + hk * 64;
        for (int j = 0; j < SU; ++j) {
            float s = 0.f;
#pragma unroll
            for (int i = 0; i < 8; ++i) s = dot8(q[i], *(const v4u*)(kb + (size_t)j * 128 + 8 * i), s);
            const float mn = fmaxf(mr, s), corr = exp2f(mr - mn), pe = exp2f(s - mn);
            l = l * corr + pe; mr = mn;
#pragma unroll
            for (int i = 0; i < 8; ++i) { const v4u vv = *(const v4u*)(vb + (size_t)j * 128 + 8 * i);
                o[8 * i + 0] = fmaf(pe, bflo(vv.x), o[8 * i + 0] * corr); o[8 * i + 1] = fmaf(pe, bfhi(vv.x), o[8 * i + 1] * corr);
                o[8 * i + 2] = fmaf(pe, bflo(vv.y), o[8 * i + 2] * corr); o[8 * i + 3] = fmaf(pe, bfhi(vv.y), o[8 * i + 3] * corr);
                o[8 * i + 4] = fmaf(pe, bflo(vv.z), o[8 * i + 4] * corr); o[8 * i + 5] = fmaf(pe, bfhi(vv.z), o[8 * i + 5] * corr);
                o[8 * i + 6] = fmaf(pe, bflo(vv.w), o[8 * i + 6] * corr); o[8 * i + 7] = fmaf(pe, bfhi(vv.w), o[8 * i + 7] * corr); }
        }
        const float rl = 1.0f / l;
#pragma unroll
        for (int d = 0; d < 64; ++d) o[d] *= rl;
        store64(MIX + (size_t)m * DM + 512 + h * 64, o);
    }
}
__device__ __forceinline__ void p3_ret_scalar(const Args& a, Frame& F) {
    unsigned char* ws = a.ws;
    const bf16_t* RQ = (const bf16_t*)(ws + WS_RQ); const bf16_t* RK = (const bf16_t*)(ws + WS_RK); const bf16_t* RV = (const bf16_t*)(ws + WS_RV); const bf16_t* RG = (const bf16_t*)(ws + WS_RG);
    bf16_t* MIX = (bf16_t*)(ws + WS_MIX); float* YRET = (float*)(ws + WS_YRET);
    for (int it = F.gtid; it < BATCH * 4 * SEQ; it += F.nthreads) {
        const int t = it % SEQ, h = (it / SEQ) % 4, b = it / (SEQ * 4); const int m = b * SEQ + t;
        const float lgf = a.in[I_LDF][h] * 1.4426950408889634f, lgb = a.in[I_LDB][h] * 1.4426950408889634f;
        v4u q[8];
#pragma unroll
        for (int i = 0; i < 8; ++i) q[i] = *(const v4u*)(RQ + (size_t)m * 256 + h * 64 + 8 * i);
        const bf16_t* kb = RK + (size_t)b * SU * 256 + h * 64; const bf16_t* vb = RV + (size_t)b * SU * 512 + h * 128;
        float* yr = YRET + ((size_t)m * 4 + h) * 128;
        for (int dq = 0; dq < 4; ++dq) {
            float acc[32];
#pragma unroll
            for (int e = 0; e < 32; ++e) acc[e] = 0.f;
            for (int j = 0; j < SU; ++j) {
                float s = 0.f;
#pragma unroll
                for (int i = 0; i < 8; ++i) s = dot8(q[i], *(const v4u*)(kb + (size_t)j * 256 + 8 * i), s);
                float w;
                if (j < CTX) w = exp2f(lgf * (float)(t + CTX - j)) + exp2f(lgb * (float)(SEQ - t + j));
                else { const int tj = j - CTX; w = tj < t ? exp2f(lgf * (float)(t - tj)) : (tj > t ? exp2f(lgb * (float)(tj - t)) : 2.0f); }
                s *= w;
#pragma unroll
                for (int i = 0; i < 4; ++i) { const v4u vv = *(const v4u*)(vb + (size_t)j * 512 + dq * 32 + 8 * i);
                    acc[8 * i + 0] = fmaf(s, bflo(vv.x), acc[8 * i + 0]); acc[8 * i + 1] = fmaf(s, bfhi(vv.x), acc[8 * i + 1]);
                    acc[8 * i + 2] = fmaf(s, bflo(vv.y), acc[8 * i + 2]); acc[8 * i + 3] = fmaf(s, bfhi(vv.y), acc[8 * i + 3]);
                    acc[8 * i + 4] = fmaf(s, bflo(vv.z), acc[8 * i + 4]); acc[8 * i + 5] = fmaf(s, bfhi(vv.z), acc[8 * i + 5]);
                    acc[8 * i + 6] = fmaf(s, bflo(vv.w), acc[8 * i + 6]); acc[8 * i + 7] = fmaf(s, bfhi(vv.w), acc[8 * i + 7]); }
            }
#pragma unroll
            for (int e = 0; e < 32; ++e) yr[dq * 32 + e] = acc[e];
        }
        asm volatile("s_waitcnt vmcnt(0)" ::: "memory");
        float s1 = 0.f;
        for (int e = 0; e < 128; ++e) s1 += yr[e];
        const float mu = s1 * (1.0f / 128.0f); float s2 = 0.f;
        for (int e = 0; e < 128; ++e) { const float d = yr[e] - mu; s2 = fmaf(d, d, s2); }
        const float rs = 1.0f / sqrtf(s2 * (1.0f / 128.0f) + LN_EPS);
        const float* gg = a.in[I_GNG] + h * 128; const float* gb = a.in[I_GNB] + h * 128;
        for (int e = 0; e < 128; e += 2) {
            const unsigned gw = *(const unsigned*)(RG + (size_t)m * 512 + h * 128 + e);
            const float g0 = bflo(gw), g1 = bfhi(gw);
            const float y0 = ((yr[e] - mu) * rs * gg[e] + gb[e]) * (g0 / (1.0f + __expf(-g0)));
            const float y1 = ((yr[e + 1] - mu) * rs * gg[e + 1] + gb[e + 1]) * (g1 / (1.0f + __expf(-g1)));
            *(unsigned*)(MIX + (size_t)m * DM + h * 128 + e) = pk2(y0, y1);
        }
    }
}

__device__ __forceinline__ void p6_ln1_route(const Args& a, Frame& F) {
    typedef short bf16x8 __attribute__((ext_vector_type(8)));
    unsigned char* ws = a.ws;
    const float* ADA = (const float*)(ws + WS_ADA); const float* STATS = (const float*)(ws + WS_STATS); const bf16_t* Y1 = (const bf16_t*)(ws + WS_Y1); const bf16_t* RWT = (const bf16_t*)(ws + WS_RWT);
    float* X1 = (float*)(ws + WS_X1); bf16_t* H2 = (bf16_t*)(ws + WS_H2); unsigned* CNT = F.ctl + CW_CNT; v2u* LIST = (v2u*)(ws + WS_LIST);
    constexpr int HP = 1032;
    LAS bf16_t* HSH = (LAS bf16_t*)F.lds; LAS bf16_t* HSL = (LAS bf16_t*)(F.lds + 16 * HP * 2);
    LAS float* PP = (LAS float*)(F.lds + 2 * 16 * HP * 2);
    LAS float* PRM = PP + 8 * 16 * 32;
    LAS unsigned* SEL = (LAS unsigned*)(PRM + 7 * 1024);
    LAS unsigned* HIST = SEL + 512 * 4;
    const int fr = F.lane & 15, fq = F.lane >> 4;
    bf16x8 bh[2][4], bl[2][4];
#pragma unroll
    for (int eh = 0; eh < 2; ++eh)
#pragma unroll
        for (int ks = 0; ks < 4; ++ks) { const size_t o = (size_t)(16 * eh + fr) * 1024 + 128 * F.wave + 32 * ks + 8 * fq; bh[eh][ks] = *(const bf16x8*)(RWT + o); bl[eh][ks] = *(const bf16x8*)(RWT + 32768 + o); }
    for (int rb = blockIdx.x; rb < NTOK / 128; rb += F.G) {
        const int m0 = rb * 128, b = m0 / SEQ; const float* ad = ADA + b * 6144;
        __syncthreads();
        for (int i = F.tid; i < 1024; i += NTHR) {
            PRM[i] = a.in[I_LNING][i] * DN_ALPHA; PRM[1024 + i] = a.in[I_LNINB][i] * DN_ALPHA; PRM[2048 + i] = ad[2048 + i];
            PRM[3072 + i] = a.in[I_LN1G][i]; PRM[4096 + i] = a.in[I_LN1B][i]; PRM[5120 + i] = ad[4096 + i] + 1.0f; PRM[6144 + i] = ad[3072 + i]; }
        if (F.tid < 64) HIST[F.tid] = 0u;
        __syncthreads();
#define P6_FETCH(m_) do { const int _m = (m_); _Pragma("unroll") for (int j = 0; j < 4; ++j) { xn[j] = __builtin_nontemporal_load((const f32x4*)(a.in[I_X] + (size_t)_m * DM) + F.lane + 64 * j); \
            yn[j] = __builtin_nontemporal_load((const v2u*)(Y1 + (size_t)_m * DM) + F.lane + 64 * j); } mn = STATS[2 * _m]; rn = STATS[2 * _m + 1]; } while (0)
        f32x4 xn[4]; v2u yn[4]; float mn, rn;
        P6_FETCH(m0 + 2 * F.wave);
        for (int it = 0; it < 8; ++it) {
#pragma unroll 1
            for (int rr = 0; rr < 2; ++rr) {
                const int lr = 2 * F.wave + rr, m = m0 + 16 * it + lr; const float mean = mn, rstd = rn;
                f32x4 xc[4]; v2u yc[4];
#pragma unroll
                for (int j = 0; j < 4; ++j) { xc[j] = xn[j]; yc[j] = yn[j]; }
                { const int q = 2 * it + rr + 1; const int mnext = q < 16 ? m0 + 16 * (q >> 1) + 2 * F.wave + (q & 1) : m; P6_FETCH(mnext); }
                f32x4 z[4]; float s = 0.f;
#pragma unroll
                for (int j = 0; j < 4; ++j) {
                    const f32x4 xv = xc[j];
                    const v2u yw = yc[j];
                    const f32x4 y = {bflo(yw.x), bfhi(yw.x), bflo(yw.y), bfhi(yw.y)};
                    const f32x4 p0 = ((const LAS f32x4*)PRM + F.lane)[64 * j], p1 = ((const LAS f32x4*)(PRM + 1024) + F.lane)[64 * j], p2 = ((const LAS f32x4*)(PRM + 2048) + F.lane)[64 * j];
                    z[j] = (xv - mean) * rstd * p0 + p1 + p2 * y;
                    s += (z[j].x + z[j].y) + (z[j].z + z[j].w);
                }
                const float mz = wave_sum(s) * (1.f / DM); float s2 = 0.f;
#pragma unroll
                for (int j = 0; j < 4; ++j) { z[j] = z[j] - mz; s2 += (z[j].x * z[j].x + z[j].y * z[j].y) + (z[j].z * z[j].z + z[j].w * z[j].w); }
                const float rz = 1.f / sqrtf(wave_sum(s2) * (1.f / DM) + LN_EPS);
#pragma unroll
                for (int j = 0; j < 4; ++j) {
                    const f32x4 p3 = ((const LAS f32x4*)(PRM + 3072) + F.lane)[64 * j], p4 = ((const LAS f32x4*)(PRM + 4096) + F.lane)[64 * j], p5 = ((const LAS f32x4*)(PRM + 5120) + F.lane)[64 * j], p6 = ((const LAS f32x4*)(PRM + 6144) + F.lane)[64 * j];
                    const f32x4 x1 = z[j] * rz * p3 + p4; const f32x4 h2 = x1 * p5 + p6;
                    { v2u xw; xw.x = pk2(x1.x, x1.y); xw.y = pk2(x1.z, x1.w); ((v2u*)((bf16_t*)X1 + (size_t)m * DM) + F.lane)[64 * j] = xw; }
                    const unsigned h0 = f2bf(h2.x), h1 = f2bf(h2.y), h2b = f2bf(h2.z), h3 = f2bf(h2.w);
                    v2u w; w.x = h0 | (h1 << 16); w.y = h2b | (h3 << 16);
                    { unsigned q = 0u; q = __builtin_amdgcn_cvt_pk_fp8_f32(h2.x, h2.y, q, false); q = __builtin_amdgcn_cvt_pk_fp8_f32(h2.z, h2.w, q, true); ((unsigned*)((unsigned char*)H2 + (size_t)m * DM) + F.lane)[64 * j] = q; }
                    v2u lo; lo.x = pk2(h2.x - bf2f(h0), h2.y - bf2f(h1)); lo.y = pk2(h2.z - bf2f(h2b), h2.w - bf2f(h3));
                    *(LAS v2u*)(HSH + lr * HP + 4 * F.lane + 256 * j) = w; *(LAS v2u*)(HSL + lr * HP + 4 * F.lane + 256 * j) = lo;
                }
            }
            __syncthreads();
            f32x4 acc[2] = {(f32x4){0.f, 0.f, 0.f, 0.f}, (f32x4){0.f, 0.f, 0.f, 0.f}};
#pragma unroll
            for (int ks = 0; ks < 4; ++ks) {
                const bf16x8 ah = *(const LAS bf16x8*)(HSH + fr * HP + 128 * F.wave + 32 * ks + 8 * fq), al = *(const LAS bf16x8*)(HSL + fr * HP + 128 * F.wave + 32 * ks + 8 * fq);
#pragma unroll
                for (int eh = 0; eh < 2; ++eh) { acc[eh] = __builtin_amdgcn_mfma_f32_16x16x32_bf16(ah, bh[eh][ks], acc[eh], 0, 0, 0); acc[eh] = __builtin_amdgcn_mfma_f32_16x16x32_bf16(ah, bl[eh][ks], acc[eh], 0, 0, 0); acc[eh] = __builtin_amdgcn_mfma_f32_16x16x32_bf16(al, bh[eh][ks], acc[eh], 0, 0, 0); }
            }
#pragma unroll
            for (int eh = 0; eh < 2; ++eh)
#pragma unroll
                for (int r = 0; r < 4; ++r) PP[(F.wave * 16 + 4 * fq + r) * 32 + 16 * eh + fr] = acc[eh][r];
            __syncthreads();
            {
                const int lr = 2 * F.wave + (F.lane >> 5), ex = F.lane & 31;
                float mine = a.in[I_RB][ex];
#pragma unroll
                for (int wv = 0; wv < 8; ++wv) mine += PP[(wv * 16 + lr) * 32 + ex];
                float sv[4]; int si[4];
#pragma unroll
                for (int k = 0; k < 4; ++k) {
                    float v = mine; int ix = ex;
#pragma unroll
                    for (int o = 16; o >= 1; o >>= 1) { const float ov = __shfl_xor(v, o); const int oi = __shfl_xor(ix, o); if (ov > v || (ov == v && oi < ix)) { v = ov; ix = oi; } }
                    sv[k] = v; si[k] = ix; if (ex == ix) mine = -3.0e38f;
                }
                const float e1 = __expf(sv[1] - sv[0]), e2 = __expf(sv[2] - sv[0]), e3 = __expf(sv[3] - sv[0]);
                const float rs = 1.0f / (1.0f + e1 + e2 + e3);
                if (ex < 4) {
                    const int sel = ex == 0 ? si[0] : (ex == 1 ? si[1] : (ex == 2 ? si[2] : si[3]));
                    const float gt = (ex == 0 ? 1.0f : (ex == 1 ? e1 : (ex == 2 ? e2 : e3))) * rs;
                    const unsigned rank = atomicAdd((unsigned*)(HIST + sel), 1u);
                    const int slot = (16 * it + lr) * 4 + ex;
                    SEL[slot * 4] = (unsigned)sel; SEL[slot * 4 + 1] = rank; SEL[slot * 4 + 2] = (unsigned)((m0 + 16 * it + lr) * 4 + ex); SEL[slot * 4 + 3] = __float_as_uint(gt);
                }
            }
        }
        __syncthreads();
        if (F.tid < 32) HIST[32 + F.tid] = atomicAdd(CNT + F.tid, HIST[F.tid]);
        __syncthreads();
        { const unsigned ex = SEL[F.tid * 4], rank = SEL[F.tid * 4 + 1]; v2u ent; ent.x = SEL[F.tid * 4 + 2]; ent.y = SEL[F.tid * 4 + 3]; LIST[(size_t)ex * LISTCAP + HIST[32 + ex] + rank] = ent; }
    }
}

__device__ __forceinline__ void p9_final(const Args& a, Frame& F) {
    unsigned char* ws = a.ws;
    const float* ADA = (const float*)(ws + WS_ADA); const bf16_t* X1 = (const bf16_t*)(ws + WS_X1); const unsigned char* YE = (const unsigned char*)(ws + WS_YE);
    const int rpw = (NTOK + F.ngw - 1) / F.ngw, m0 = F.gw * rpw, m1 = (m0 + rpw < NTOK) ? m0 + rpw : NTOK;
    unsigned yn[4][4]; v2u xn[4];
    auto fetch = [&](int m) {
#pragma unroll
        for (int j = 0; j < 4; ++j) {
#pragma unroll
            for (int k = 0; k < 4; ++k) yn[j][k] = __builtin_nontemporal_load((const unsigned*)(YE + ((size_t)m * 4 + k) * DM) + F.lane + 64 * j);
            xn[j] = __builtin_nontemporal_load((const v2u*)(X1 + (size_t)m * DM) + F.lane + 64 * j); } };
    if (m0 < m1) fetch(m0);
    f32x4 G2[4], LG[4], LB[4]; int kind = -1;
    for (int m = m0; m < m1; ++m) {
        const int b = m / SEQ;
        if (b != kind) { kind = b; const float* ad = ADA + b * 6144;
#pragma unroll
            for (int j = 0; j < 4; ++j) { G2[j] = ((const f32x4*)(ad + 5120) + F.lane)[64 * j] * (1.0f / 64.0f); LG[j] = ((const f32x4*)a.in[I_LN2G] + F.lane)[64 * j]; LB[j] = ((const f32x4*)a.in[I_LN2B] + F.lane)[64 * j]; } }
        f32x4 z[4]; float s = 0.f;
#pragma unroll
        for (int j = 0; j < 4; ++j) {
            f32x4 f = {0.f, 0.f, 0.f, 0.f};
#pragma unroll
            for (int k = 0; k < 4; ++k) { const unsigned yw = yn[j][k];
                f += (f32x4){__builtin_amdgcn_cvt_f32_fp8(yw, 0), __builtin_amdgcn_cvt_f32_fp8(yw, 1), __builtin_amdgcn_cvt_f32_fp8(yw, 2), __builtin_amdgcn_cvt_f32_fp8(yw, 3)}; }
            const v2u xw = xn[j]; const f32x4 x1 = {bflo(xw.x), bfhi(xw.x), bflo(xw.y), bfhi(xw.y)};
            z[j] = x1 * DN_ALPHA + G2[j] * f;
            s += (z[j].x + z[j].y) + (z[j].z + z[j].w);
        }
        fetch((m + 1 < m1) ? m + 1 : m);
        const float mz = wave_sum(s) * (1.f / DM); float s2 = 0.f;
#pragma unroll
        for (int j = 0; j < 4; ++j) { z[j] = z[j] - mz; s2 += (z[j].x * z[j].x + z[j].y * z[j].y) + (z[j].z * z[j].z + z[j].w * z[j].w); }
        const float rz = 1.f / sqrtf(wave_sum(s2) * (1.f / DM) + LN_EPS);
#pragma unroll
        for (int j = 0; j < 4; ++j) __builtin_nontemporal_store(z[j] * rz * LG[j] + LB[j], (f32x4*)(a.out + (size_t)m * DM) + F.lane + 64 * j);
    }
}

constexpr int N_PHASES = 10;
constexpr int CONV_NIT = NEXP * (16 * 32 + 16 * 16), CONV_P2 = 64 * 8 * 4;
#ifndef MK_N_LAUNCHES
#define MK_N_LAUNCHES 1
#endif
__global__ void __launch_bounds__(NTHR, 2) fwd_kernel(Args a) {
    extern __shared__ __attribute__((aligned(16))) unsigned char lds[];
    Frame F;
    F.lds = (LAS unsigned char*)lds;
#define REFRESH() do { int _t = threadIdx.x; asm volatile("" : "+v"(_t)); F.tid = _t; F.lane = _t & 63; F.wave = __builtin_amdgcn_readfirstlane(_t >> 6); F.gtid = blockIdx.x * NTHR + _t; F.gw = blockIdx.x * NWAVES + F.wave; } while (0)
    F.G = gridDim.x; F.nthreads = F.G * NTHR; F.ngw = F.G * NWAVES; REFRESH();
    F.ctl = (unsigned*)(a.ws + WS_CTL);
    volatile LAS unsigned* MISC = (volatile LAS unsigned*)(F.lds + MISC_OFF);
    for (int u = F.tid; u < (LDS_BYTES - 131072) / 4; u += NTHR) ((LAS unsigned*)(F.lds + 131072))[u] = 0u;
    __syncthreads();
    XcdBarrier bar; bar.bar = F.ctl + CW_BAR + a.li * XCD_BAR_WORDS; bar.x = 0; bar.st = nullptr;
    if (MK_N_LAUNCHES == 1) bar = xcd_barrier_post(F.ctl + CW_BAR, MISC + 8);
    const int lo = a.ph_lo, hi = a.ph_hi;
#define IN(k) (lo <= (k) && (k) < hi)
#define SEAM(k) do { if (IN(k) && IN((k) + 1)) xcd_barrier(bar); } while (0)
    if (IN(0)) { REFRESH(); p0_prologue(a, F); } SEAM(0);
    if (IN(1)) { REFRESH(); p1_ln_mod(a, F); } SEAM(1);
    if (IN(2)) { REFRESH();
        pg8::SchedInProj S{F.G, (int)blockIdx.x}; pg8::EpiInProj E{a.ws, a.in[I_QNG], a.in[I_KNG], (const float*)(a.ws + WS_ROPE)};
        pg8::gemm_phase<pg8::EpiInProj, pg8::SchedInProj, false>(F.lds, (const bf16_t*)(a.ws + WS_H), (const bf16_t*)(a.ws + WS_WIN), S, E);
        if (F.G == 256) { if (blockIdx.x >= 192) { REFRESH(); __syncthreads(); moe_weights_convert(a, F, 0, CONV_P2, ((int)blockIdx.x - 192) * NWAVES + F.wave, 64 * NWAVES); } }
        else if (blockIdx.x == 0) {   }
    } SEAM(2);
    if (IN(3)) { REFRESH();
        const attn_body::AttnTensors AT{(const attn_body::bf16*)(a.ws + WS_AQ), (const attn_body::bf16*)(a.ws + WS_AK), (const attn_body::bf16*)(a.ws + WS_AV), (attn_body::bf16*)(a.ws + WS_MIX) + 512};
        const attn_body::StaticOrder S((int)F.G, (int)blockIdx.x);
        if ((F.G & 255) == 0) {
            float gqm = 0.f, gkm = 0.f;
            for (int i = 0; i < 64; ++i) { gqm = fmaxf(gqm, fabsf(a.in[I_QNG][i])); gkm = fmaxf(gkm, fabsf(a.in[I_KNG][i])); }
            const float refB = 1.02f * C2 * 64.0f * gqm * gkm;
            const int slot = (int)(blockIdx.x % 5u); attn_body::AttnUnit u;
            for (int i = 0; i < 5; ++i) {
                if (i == slot) { __syncthreads(); moe_weights_convert(a, F, CONV_P2, CONV_NIT, F.gw, F.ngw); __syncthreads(); }
                if (i < 4 && S.next(i, u)) attn_body::attn_unit<8>(u.b, u.h, u.qb, AT.Q, AT.K, AT.V, AT.O, (char*)lds, refB);
            }
        } else { p3_attn_scalar(a, F); __syncthreads(); moe_weights_convert(a, F, 0, CONV_NIT, F.gw, F.ngw); }
        __syncthreads();
        for (int u = blockIdx.x; u < 256; u += F.G) { const int dvh = u & 1, dir = (u >> 1) & 1, h = (u >> 2) & 3, b = u >> 4;
            ret::state_unit(b, h, dir, dvh, (const bf16_t*)(a.ws + WS_RK), (const bf16_t*)(a.ws + WS_RV), (bf16_t*)(a.ws + WS_ST), (dir ? a.in[I_LDB][h] : a.in[I_LDF][h]) * 1.4426950408889634f, F.lds); }
    } SEAM(3);
    if (IN(4)) { REFRESH();
        ret::OutRegs R; int u = blockIdx.x;
        if (u < 1024) ret::out_load(R, u, (const bf16_t*)(a.ws + WS_RQ), (const bf16_t*)(a.ws + WS_RK), (const bf16_t*)(a.ws + WS_RV), (const bf16_t*)(a.ws + WS_RG));
        for (; u < 1024; u += F.G) { const int un = (u + F.G < 1024) ? u + F.G : -1;
            ret::out_unit(R, u, un, (const bf16_t*)(a.ws + WS_RQ), (const bf16_t*)(a.ws + WS_RK), (const bf16_t*)(a.ws + WS_RV), (const bf16_t*)(a.ws + WS_RG), (const bf16_t*)(a.ws + WS_ST), a.in[I_GNG], a.in[I_GNB],
                          a.in[I_LDF], a.in[I_LDB], (bf16_t*)(a.ws + WS_MIX), F.lds); }
    } SEAM(4);
    if (IN(5)) { REFRESH();
        pg8::SchedDense S{NTOK / 256, DM / 256, F.G, (int)blockIdx.x}; pg8::EpiPlainBf16 E{(bf16_t*)(a.ws + WS_Y1), DM};
        pg8::gemm_phase<pg8::EpiPlainBf16, pg8::SchedDense, false>(F.lds, (const bf16_t*)(a.ws + WS_MIX), (const bf16_t*)(a.ws + WS_WO), S, E);
    } SEAM(5);
    if (IN(6)) { REFRESH(); p6_ln1_route(a, F); } SEAM(6);
    if (IN(7)) { REFRESH();
        LAS int* tab = (LAS int*)(F.lds + 131072 + 1024); pg8::moe_build_tab(tab, F.ctl + CW_CNT);
        pg8::SchedMoE S{8, 2048, F.G, (int)blockIdx.x, tab, (const v2u*)(a.ws + WS_LIST)}; pg8::EpiUp E{a.ws + WS_ACT, a.in[I_BUP]};
        pg8::gemm_phase<pg8::EpiUp, pg8::SchedMoE, true, true>(F.lds, (const bf16_t*)(a.ws + WS_H2), (const bf16_t*)(a.ws + WS_WUP), S, E);
    } SEAM(7);
    if (IN(8)) { REFRESH();
        LAS int* tab = (LAS int*)(F.lds + 131072 + 1024); pg8::moe_build_tab(tab, F.ctl + CW_CNT);
        pg8::SchedMoE S{4, 1024, F.G, (int)blockIdx.x, tab, (const v2u*)(a.ws + WS_LIST)}; pg8::EpiDown E{(bf16_t*)(a.ws + WS_YE), a.in[I_BDN], (const v2u*)(a.ws + WS_LIST)};
        pg8::gemm_phase<pg8::EpiDown, pg8::SchedMoE, false, true>(F.lds, (const bf16_t*)(a.ws + WS_ACT), (const bf16_t*)(a.ws + WS_WDN), S, E);
    } SEAM(8);
    if (IN(9)) { REFRESH(); p9_final(a, F); }
#undef IN
#undef SEAM
}

extern "C" void kernel_launch(void* const* d_in, const int* in_sizes, int n_in, void* d_out, int out_size, void* d_ws, size_t ws_size, hipStream_t stream) {
    static int grid = 0;
    if (grid == 0) {
        if (n_in != 26 || out_size != NTOK * DM || ws_size < WS_END) { fprintf(stderr, "kernel_launch: unexpected shapes (n_in %d, out %d, ws %zu); nothing launched\n", n_in, out_size, ws_size); grid = -1; return; }
        int dev = 0, cus = 0;
        if (hipGetDevice(&dev) != hipSuccess || hipDeviceGetAttribute(&cus, hipDeviceAttributeMultiprocessorCount, dev) != hipSuccess) { grid = -1; return; }
        if (hipFuncSetAttribute((const void*)fwd_kernel, hipFuncAttributeMaxDynamicSharedMemorySize, LDS_BYTES) != hipSuccess) { fprintf(stderr, "kernel_launch: hipFuncSetAttribute failed\n"); grid = -1; return; }
        (void)hipGetLastError();
        grid = cus;
    }
    if (grid < 0) return;
    if (hipMemsetAsync((char*)d_ws + WS_CTL, 0, CTL_ZERO_BYTES, stream) != hipSuccess) return;
    Args a{};
    for (int i = 0; i < 26; ++i) a.in[i] = (const float*)d_in[i];
    a.out = (float*)d_out; a.ws = (unsigned char*)d_ws;
    if (MK_N_LAUNCHES == 1) { a.ph_lo = 0; a.ph_hi = N_PHASES; a.li = 0; hipLaunchKernelGGL(fwd_kernel, dim3(grid), dim3(NTHR), LDS_BYTES, stream, a); }
    else for (int p = 0; p < N_PHASES; ++p) { a.ph_lo = p; a.ph_hi = p + 1; a.li = 0; hipLaunchKernelGGL(fwd_kernel, dim3(grid), dim3(NTHR), LDS_BYTES, stream, a); }
}
```

```cpp
#include <hip/hip_runtime.h>
#include <cstdio>
#include <cstdint>

constexpr int BATCH = 16, SEQ = 2048, DM = 1024, CTX = 256, SU = SEQ + CTX;
constexpr int NTOK = BATCH * SEQ, NROW = BATCH * SU;
constexpr int NIN = 2304, NEXP = 32, LISTCAP = 32768;
constexpr float LN_EPS = 1e-6f, DN_ALPHA = 1.189207115002721f;
constexpr float SWK = -1.702f * 1.4426950408889634f;
constexpr float C2 = 0.125f * 1.4426950408889634f;
constexpr int NWAVES = 8, NTHR = 512;

constexpr size_t MiB = 1u << 20;
constexpr size_t WS_CTL = 0, CTL_ZERO_BYTES = 64 * 1024;
constexpr size_t WS_ADA = 1 * MiB, WS_ROPE = 1 * MiB + 512 * 1024, WS_STATS = 2 * MiB, WS_LIST = 4 * MiB;
constexpr size_t WS_RWT = 12 * MiB;
constexpr size_t WS_WIN = 16 * MiB, WS_WO = 22 * MiB, WS_WUP = 32 * MiB, WS_WDN = 160 * MiB;
constexpr size_t WS_X1 = 224 * MiB, WS_H2 = 352 * MiB, WS_ACT = 416 * MiB;
constexpr size_t WS_MIX = 416 * MiB, WS_Y1 = 480 * MiB, WS_YRET = 544 * MiB;
constexpr size_t WS_YE = 688 * MiB;
constexpr size_t WS_H = 688 * MiB, WS_RQ = 760 * MiB, WS_RK = 776 * MiB, WS_RV = 794 * MiB, WS_RG = 830 * MiB, WS_AQ = 862 * MiB, WS_AK = 894 * MiB, WS_AV = 903 * MiB;
constexpr size_t WS_ST = 912 * MiB;
constexpr size_t WS_END = 944 * MiB;
constexpr int CW_TMO = 0, CW_CNT = 256, CW_BAR = 4096;

#define GAS __attribute__((address_space(1)))
#define LAS __attribute__((address_space(3)))
typedef unsigned short bf16_t;
typedef unsigned v4u __attribute__((ext_vector_type(4)));
typedef unsigned v2u __attribute__((ext_vector_type(2)));
typedef float f32x4 __attribute__((ext_vector_type(4)));

__device__ __forceinline__ float bf2f(unsigned v) { return __uint_as_float(v << 16); }
__device__ __forceinline__ unsigned pk2(float lo, float hi) { unsigned r; asm("v_cvt_pk_bf16_f32 %0, %1, %2" : "=v"(r) : "v"(lo), "v"(hi)); return r; }
__device__ __forceinline__ unsigned f2bf(float f) { return pk2(f, f) & 0xffffu; }
__device__ __forceinline__ float bflo(unsigned w) { return __uint_as_float(w << 16); }
__device__ __forceinline__ float bfhi(unsigned w) { return __uint_as_float(w & 0xffff0000u); }
template <int CTRL> __device__ __forceinline__ int dppi(int v) { return __builtin_amdgcn_update_dpp(0, v, CTRL, 0xf, 0xf, false); }
template <int CTRL> __device__ __forceinline__ float dppf(float v) { return __int_as_float(__builtin_amdgcn_update_dpp(0, __float_as_int(v), CTRL, 0xf, 0xf, false)); }
__device__ __forceinline__ float xor16_sum(float v) { const auto r = __builtin_amdgcn_permlane16_swap(__float_as_uint(v), __float_as_uint(v), false, false); return __uint_as_float(r[0]) + __uint_as_float(r[1]); }
__device__ __forceinline__ float xor32_sum(float v) { const auto r = __builtin_amdgcn_permlane32_swap(__float_as_uint(v), __float_as_uint(v), false, false); return __uint_as_float(r[0]) + __uint_as_float(r[1]); }
__device__ __forceinline__ float wave_sum(float v) {
    v += dppf<0xB1>(v);
    v += dppf<0x4E>(v);
    v += dppf<0x141>(v);
    v += dppf<0x140>(v);
    return xor32_sum(xor16_sum(v));
}
__device__ __forceinline__ float dot8(v4u a, v4u w, float acc) {
    acc = fmaf(bflo(a.x), bflo(w.x), acc); acc = fmaf(bfhi(a.x), bfhi(w.x), acc);
    acc = fmaf(bflo(a.y), bflo(w.y), acc); acc = fmaf(bfhi(a.y), bfhi(w.y), acc);
    acc = fmaf(bflo(a.z), bflo(w.z), acc); acc = fmaf(bfhi(a.z), bfhi(w.z), acc);
    acc = fmaf(bflo(a.w), bflo(w.w), acc); acc = fmaf(bfhi(a.w), bfhi(w.w), acc);
    return acc;
}

#define XB_TMO      128
#define XB_XCNT(j)  (256  + 64 * (j))
#define XB_XSUB(j)  (1280 + 64 * (j))
#define XB_XGEN(j)  (2304 + 64 * (j))
#define XB_TOP      3328
#define XB_TOPGEN   3392
#define XCD_BAR_WORDS 3456
#define XB_SPIN_CAP (1u << 24)
__device__ __forceinline__ unsigned xb_ld(unsigned* p)              { return __hip_atomic_load(p, __ATOMIC_RELAXED, __HIP_MEMORY_SCOPE_AGENT); }
__device__ __forceinline__ unsigned xb_add(unsigned* p, unsigned v) { return __hip_atomic_fetch_add(p, v, __ATOMIC_RELAXED, __HIP_MEMORY_SCOPE_AGENT); }
__device__ __forceinline__ unsigned xb_xcc_id() { return (unsigned)__builtin_amdgcn_s_getreg((3 << 11) | 20) & 0xFu; }
#define XB_SPIN(cond, bar) do { unsigned _sp = 0; while (cond) { __builtin_amdgcn_s_sleep(1); \
    if ((++_sp & 255u) == 0u) { if (xb_ld(&(bar)[XB_TMO])) break; if (_sp > XB_SPIN_CAP) { atomicAdd(&(bar)[XB_TMO], 1u); break; } } } } while (0)
__device__ __forceinline__ void xb_spin_ne(unsigned* p, unsigned stale) {
    unsigned a, b, c, d, n;
    asm volatile(
        "s_mov_b32 %4, 0\n\t"
        "global_load_dword %0, %5, off sc1\n\ts_sleep 10\n\t"
        "global_load_dword %1, %5, off sc1\n\ts_sleep 10\n\t"
        "global_load_dword %2, %5, off sc1\n\ts_sleep 10\n\t"
        "global_load_dword %3, %5, off sc1\n"
        "1:\n\t"
        "s_waitcnt vmcnt(3)\n\tv_cmp_ne_u32_e32 vcc, %0, %6\n\ts_cbranch_vccnz 2f\n\tglobal_load_dword %0, %5, off sc1\n\t"
        "s_waitcnt vmcnt(3)\n\tv_cmp_ne_u32_e32 vcc, %1, %6\n\ts_cbranch_vccnz 2f\n\tglobal_load_dword %1, %5, off sc1\n\t"
        "s_waitcnt vmcnt(3)\n\tv_cmp_ne_u32_e32 vcc, %2, %6\n\ts_cbranch_vccnz 2f\n\tglobal_load_dword %2, %5, off sc1\n\t"
        "s_waitcnt vmcnt(3)\n\tv_cmp_ne_u32_e32 vcc, %3, %6\n\ts_cbranch_vccnz 2f\n\tglobal_load_dword %3, %5, off sc1\n\t"
        "s_add_u32 %4, %4, 1\n\ts_cmp_lt_u32 %4, 0x400000\n\ts_cbranch_scc1 1b\n"
        "2:\n\ts_waitcnt vmcnt(0)"
        : "=&v"(a), "=&v"(b), "=&v"(c), "=&v"(d), "=&s"(n) : "v"(p), "v"(stale) : "vcc", "scc", "memory");
}
struct XcdBarrier { unsigned* bar; unsigned x; volatile LAS unsigned* st; };
__device__ __forceinline__ XcdBarrier xcd_barrier_post(unsigned* bar, volatile LAS unsigned* st) {
    XcdBarrier b; b.bar = bar; b.x = xb_xcc_id(); b.st = st;
    if (threadIdx.x == 0) (void)xb_add(&bar[XB_XCNT(b.x)], 1u);
    return b;
}
__device__ __forceinline__ void xcd_barrier_complete(unsigned* bar, unsigned x, unsigned& nloc, unsigned& nx) {
    const unsigned G = gridDim.x * gridDim.y * gridDim.z;
    unsigned sum, cnt, mine, sp = 0u;
    for (;;) {
        sum = 0u; cnt = 0u; mine = 0u;
#pragma unroll
        for (unsigned j = 0; j < 16; ++j) { const unsigned c = xb_ld(&bar[XB_XCNT(j)]); sum += c; cnt += (c > 0u) ? 1u : 0u; mine = (j == x) ? c : mine; }
        if (sum == G) break;
        __builtin_amdgcn_s_sleep(1);
        if ((++sp & 255u) == 0u) { if (xb_ld(&bar[XB_TMO])) break; if (sp > XB_SPIN_CAP) { atomicAdd(&bar[XB_TMO], 1u); break; } }
    }
    nloc = mine > 0u ? mine : 1u; nx = cnt > 0u ? cnt : 1u;
}
__device__ __forceinline__ void xcd_barrier(const XcdBarrier& b) {
    asm volatile("s_waitcnt vmcnt(0)" ::: "memory");
    __syncthreads();
    if (threadIdx.x == 0) {
        unsigned* bar = b.bar;
        __builtin_amdgcn_s_waitcnt(0);
        unsigned nloc = b.st[0], nx = b.st[1];
        if (nloc == 0u) { xcd_barrier_complete(bar, b.x, nloc, nx); b.st[0] = nloc; b.st[1] = nx; }
        const unsigned old = xb_add(&bar[XB_XSUB(b.x)], 1u);
        const unsigned gen = old / nloc;
        if (old + 1u == (gen + 1u) * nloc) {
            __builtin_amdgcn_fence(__ATOMIC_RELEASE, "agent");
            asm volatile("s_waitcnt vmcnt(0)" ::: "memory");
            const unsigned og = xb_add(&bar[XB_TOP], 1u);
            const unsigned tg = og / nx;
            if (og + 1u == (tg + 1u) * nx) xb_add(&bar[XB_TOPGEN], 1u);
            else xb_spin_ne(&bar[XB_TOPGEN], tg);
            __builtin_amdgcn_fence(__ATOMIC_ACQUIRE, "agent");
            xb_add(&bar[XB_XGEN(b.x)], 1u);
            asm volatile("s_waitcnt vmcnt(0)" ::: "memory");
        } else {
            xb_spin_ne(&bar[XB_XGEN(b.x)], gen);
            __builtin_amdgcn_fence(__ATOMIC_ACQUIRE, "agent");
            asm volatile("s_waitcnt vmcnt(0)" ::: "memory");
        }
    }
    __syncthreads();
}

__device__ __forceinline__ void pair_sync(unsigned* flags, unsigned* bar, int c, const unsigned* xcc_of) {
    asm volatile("s_waitcnt vmcnt(0)" ::: "memory");
    __syncthreads();
    if (threadIdx.x == 0) {
        const bool same = (xb_ld((unsigned*)&xcc_of[c ^ 8]) == xb_xcc_id() + 1u);
        if (!same) { __builtin_amdgcn_fence(__ATOMIC_RELEASE, "agent"); asm volatile("s_waitcnt vmcnt(0)" ::: "memory"); }
        (void)xb_add(&flags[c], 1u);
        xb_spin_ne(&flags[c ^ 8], 0u);
        if (!same) { __builtin_amdgcn_fence(__ATOMIC_ACQUIRE, "agent"); asm volatile("s_waitcnt vmcnt(0)" ::: "memory"); }
    }
    __syncthreads();
}

namespace pg8 {
typedef short bf16x8 __attribute__((ext_vector_type(8)));
typedef int v4i __attribute__((ext_vector_type(4)));
typedef int v8i __attribute__((ext_vector_type(8)));
constexpr int BM = 256, BK = 64, HALF = 128, HTB = HALF * BK * 2, NXCD = 8, WGM = 1, KD = 1024, NT = KD / BK;
__device__ __forceinline__ int lds_byte(int r, int c) { const int st = (r >> 4) * 2 + (c >> 5), rr = r & 15, cc = c & 31, ob = rr * 64 + cc * 2; return st * 1024 + (ob ^ (((ob >> 9) & 1) << 5)); }
__device__ __forceinline__ void stage_rc(int b, int& R, int& C) { const int st = b / 1024, sb = b % 1024, swz = sb ^ (((sb >> 9) & 1) << 5); R = (st >> 1) * 16 + swz / 64; C = (st & 1) * 32 + (swz % 64) / 2; }
__device__ __forceinline__ int perm32(int rho) { const int n = rho >> 4, i = rho & 15; return 8 * (i >> 2) + 4 * n + (i & 3); }
__device__ __forceinline__ unsigned cvt_pk_bf16(float lo, float hi) { unsigned r; asm volatile("v_cvt_pk_bf16_f32 %0, %1, %2" : "=v"(r) : "v"(lo), "v"(hi)); return r; }

struct Unit { int pm, pn, brow, e, r0, cnt; };

__device__ __forceinline__ void tile_order(int L, int nM, int nN, int& pm, int& pn) {
    const int nwg = nM * nN; int wgid = L; { const int q = nwg / NXCD, r = nwg % NXCD, xcd = wgid % NXCD, off = wgid / NXCD; wgid = (xcd < r ? xcd * (q + 1) : r * (q + 1) + (xcd - r) * q) + off; }
    const int nig = WGM * nN, gid = wgid / nig, fm = gid * WGM, gsz = (nM - fm) < WGM ? (nM - fm) : WGM;
    pm = fm + ((wgid % nig) % gsz); pn = (wgid % nig) / gsz;
}
struct SchedPair {
    int c;
    __device__ __forceinline__ bool next(int i, Unit& u) const { if (i >= 2) return false; u.pm = (c & 7) | ((c >> 4) << 3); u.pn = 2 * ((c >> 3) & 1) + i; u.brow = u.pn * BM; u.e = 0; u.r0 = 0; u.cnt = 0; return true; }
    __device__ __forceinline__ unsigned arow_tok(const Unit&, int) const { return 0u; }
    __device__ __forceinline__ const unsigned* arow_ptr(const Unit&, int) const { return nullptr; }
};
struct SchedDense {
    int nM, nN, G, c;
    __device__ __forceinline__ bool next(int i, Unit& u) const { const long L = (long)i * G + c; if (L >= (long)nM * nN) return false; tile_order((int)L, nM, nN, u.pm, u.pn); u.brow = u.pn * BM; u.e = 0; u.r0 = 0; u.cnt = 0; return true; }
    __device__ __forceinline__ unsigned arow_tok(const Unit&, int) const { return 0u; }
    __device__ __forceinline__ const unsigned* arow_ptr(const Unit&, int) const { return nullptr; }
};

template <class Epi, class Sched, bool GATHER, bool F8 = false>
__device__ __forceinline__ void gemm_phase(LAS unsigned char* lds, const bf16_t* A, const bf16_t* Bt, const Sched& S, const Epi& E) {
    const int tid = threadIdx.x, wid = __builtin_amdgcn_readfirstlane(tid >> 6), lane = tid & 63, wr = wid >> 2, wc = wid & 3, fr = lane & 15, fq = lane >> 4;
    constexpr int K = F8 ? KD / 2 : KD, nt = F8 ? NT / 2 : NT;
    unsigned voffA[2], voffB[2];
#pragma unroll
    for (int i = 0; i < 2; ++i) { int R, C; stage_rc(tid * 16 + i * 8192, R, C); const int Rb = Epi::PERM ? ((R & ~31) + perm32(R & 31)) : R;
        voffA[i] = GATHER ? (unsigned)(C * 2) : (unsigned)(R * K + C) * 2u; voffB[i] = (unsigned)(Rb * K + C) * 2u; }
    constexpr size_t kstep = (size_t)(BK * 2), hstep = (size_t)HALF * K * 2, tstep = 2 * hstep;
    const unsigned ldsw = (unsigned)wid * 1024u;
    const int aoff = lds_byte(wr * 64 + fr, fq * 8), boff = lds_byte(wc * 32 + fr, fq * 8);
#define PG8_SA(b, h) (((b) * 2 + (h)) * HTB)
#define PG8_SB(b, h) ((4 + (b) * 2 + (h)) * HTB)
#define PG8_STAGE_B(bufoff, gbase) do { _Pragma("unroll") for (int _i = 0; _i < 2; ++_i) \
        __builtin_amdgcn_global_load_lds((const unsigned*)((const char*)(gbase) + voffB[_i]), (LAS unsigned*)(lds + (bufoff) + ldsw + _i * 8192), 16, 0, 0); } while (0)
#define PG8_STAGE_A(bufoff, h, kb, nx) do { _Pragma("unroll") for (int _i = 0; _i < 2; ++_i) { \
        const char* _src = GATHER ? (const char*)A + (((((nx) ? ron[h] : roc[h]) >> (16 * _i)) & 0xffffu) << (F8 ? 10 : 11)) + voffA[0] + (kb) : ((nx) ? nA : cA) + (size_t)(h) * hstep + (kb) + voffA[_i]; \
        __builtin_amdgcn_global_load_lds((const unsigned*)_src, (LAS unsigned*)(lds + (bufoff) + ldsw + _i * 8192), 16, 0, 0); } } while (0)
#define PG8_LDA(dst, b, h) do { _Pragma("unroll") for (int m = 0; m < 4; ++m) { if constexpr (F8) { dst##8[m].lo = *(const LAS v4i*)(lds + PG8_SA(b, h) + aoff + m * 2048); dst##8[m].hi = *(const LAS v4i*)(lds + PG8_SA(b, h) + aoff + m * 2048 + 1024); } \
        else { _Pragma("unroll") for (int k = 0; k < 2; ++k) dst[m][k] = *(const LAS bf16x8*)(lds + PG8_SA(b, h) + aoff + m * 2048 + k * 1024); } } } while (0)
#define PG8_LDB(dst, b, h) do { _Pragma("unroll") for (int n = 0; n < 2; ++n) { if constexpr (F8) { dst##8[n].lo = *(const LAS v4i*)(lds + PG8_SB(b, h) + boff + n * 2048); dst##8[n].hi = *(const LAS v4i*)(lds + PG8_SB(b, h) + boff + n * 2048 + 1024); } \
        else { _Pragma("unroll") for (int k = 0; k < 2; ++k) dst[n][k] = *(const LAS bf16x8*)(lds + PG8_SB(b, h) + boff + n * 2048 + k * 1024); } } } while (0)
#define PG8_MMA(ai, bj, At, Bt_) do { if (!F8) __builtin_amdgcn_s_setprio(1); _Pragma("unroll") for (int m = 0; m < 4; ++m) _Pragma("unroll") for (int n = 0; n < 2; ++n) { \
        if constexpr (F8) { asm volatile("v_mfma_scale_f32_16x16x128_f8f6f4 %0, %1, %2, %0, %3, %3 op_sel_hi:[0,0,0]" : "+v"(acc[ai][bj][m][n]) : "v"(Bt_##8[n]), "v"(At##8[m]), "v"(sc8)); } \
        else { _Pragma("unroll") for (int k = 0; k < 2; ++k) acc[ai][bj][m][n] = __builtin_amdgcn_mfma_f32_16x16x32_bf16(Bt_[n][k], At[m][k], acc[ai][bj][m][n], 0, 0, 0); } } \
        if (!F8) __builtin_amdgcn_s_setprio(0); } while (0)
#define PG8_WAIT_V(n) asm volatile("s_waitcnt vmcnt(" #n ")" ::: "memory")
#define PG8_WAIT_L(n) asm volatile("s_waitcnt lgkmcnt(" #n ")" ::: "memory")
#define PG8_BAR __builtin_amdgcn_s_barrier()
#define PG8_SCHED __builtin_amdgcn_sched_barrier(0)
#define PG8_LOAD_RAW(dst4, unit) do { int _R, _C; stage_rc((int)threadIdx.x * 16, _R, _C); _Pragma("unroll") for (int _h = 0; _h < 2; ++_h) { \
        asm volatile("global_load_dword %0, %1, off" : "=v"(dst4[2 * _h]) : "v"(S.arow_ptr(unit, _h * HALF + _R)) : "memory"); \
        asm volatile("global_load_dword %0, %1, off" : "=v"(dst4[2 * _h + 1]) : "v"(S.arow_ptr(unit, _h * HALF + _R + 64)) : "memory"); } } while (0)
#define PG8_PIN_RAW(src4) asm volatile("" : "+v"(src4[0]), "+v"(src4[1]), "+v"(src4[2]), "+v"(src4[3]))
#define PG8_PACK_RO(dst, src4) do { _Pragma("unroll") for (int _h = 0; _h < 2; ++_h) dst[_h] = (src4[2 * _h] >> 2) | ((src4[2 * _h + 1] >> 2) << 16); } while (0)
#define PG8_LOAD_RO(dst, unit) do { int _R, _C; stage_rc((int)threadIdx.x * 16, _R, _C); _Pragma("unroll") for (int _h = 0; _h < 2; ++_h) dst[_h] = S.arow_tok(unit, _h * HALF + _R) | (S.arow_tok(unit, _h * HALF + _R + 64) << 16); } while (0)
    Unit cur, nxt; int ui = 0;
    if (!S.next(0, cur)) return;
    f32x4 acc[2][2][4][2];
#pragma unroll
    for (int a = 0; a < 2; ++a)
#pragma unroll
        for (int b = 0; b < 2; ++b)
#pragma unroll
            for (int m = 0; m < 4; ++m)
#pragma unroll
                for (int n = 0; n < 2; ++n) acc[a][b][m][n] = (f32x4){0.f, 0.f, 0.f, 0.f};
    if (Epi::HAS_INIT) { const typename Epi::Init i0 = E.init(cur, wr, wc, fr, fq);
#pragma unroll
      for (int a = 0; a < 2; ++a)
#pragma unroll
        for (int b = 0; b < 2; ++b)
#pragma unroll
            for (int m = 0; m < 4; ++m)
#pragma unroll
                for (int n = 0; n < 2; ++n) acc[a][b][m][n] = (i0.v[b][n] + Epi::init_add(b)) * Epi::init_mul(b); }
    unsigned sc8 = 0x7c7c7c7cu; asm volatile("" : "+v"(sc8));
    bf16x8 At[4][2], B0[2][2], B1[2][2]; v8i At8[4], B08[2], B18[2];
    unsigned roc[2] = {0u, 0u}, ron[2] = {0u, 0u};
    bool has_next = S.next(1, nxt);
    if (GATHER) { PG8_LOAD_RO(roc, cur); if (has_next) { PG8_LOAD_RO(ron, nxt); } else { ron[0] = roc[0]; ron[1] = roc[1]; } }
    const char* cA = (const char*)A + (GATHER ? (size_t)0 : (size_t)cur.pm * tstep); const char* cB = (const char*)Bt + (size_t)cur.brow * K * 2;
    const char* nA = cA;
    int rc = (2 * cur.pn) & (nt - 1);
    { const size_t r0 = (size_t)rc * kstep;
    PG8_STAGE_B(PG8_SB(0, 0), cB + r0); PG8_STAGE_B(PG8_SB(0, 1), cB + hstep + r0); PG8_STAGE_A(PG8_SA(0, 0), 0, r0, false); PG8_STAGE_A(PG8_SA(0, 1), 1, r0, false);
    if (wr == 1) PG8_BAR;
    PG8_WAIT_V(2); PG8_BAR;
    PG8_STAGE_B(PG8_SB(1, 0), cB + r0 + kstep); PG8_STAGE_A(PG8_SA(1, 0), 0, r0 + kstep, false); PG8_STAGE_B(PG8_SB(1, 1), cB + hstep + r0 + kstep); }
    PG8_WAIT_V(6); PG8_BAR;
    for (;;) {
        nA = (has_next && !GATHER) ? (const char*)A + (size_t)nxt.pm * tstep : cA;
        const char* nB = has_next ? (const char*)Bt + (size_t)nxt.brow * K * 2 : cB;
        const int rn = has_next ? ((2 * nxt.pn) & (nt - 1)) : rc;
        const typename Epi::Pre pre = E.pre(cur, wr, wc, fr, fq);
        Unit nn; bool has_nn = false; unsigned rnn[2] = {0u, 0u}, rraw[4] = {0u, 0u, 0u, 0u};
        LAS float* ibuf = (LAS float*)(lds + 131072 + 4096) + ((ui + 1) & 1) * 256;
        if constexpr (GATHER) { if (has_next) { has_nn = S.next(ui + 2, nn); if (has_nn) { PG8_LOAD_RAW(rraw, nn); }
                if (Epi::HAS_INIT && wid == 0) __builtin_amdgcn_global_load_lds((const unsigned*)E.init_src(nxt, lane), (LAS unsigned*)ibuf, 16, 0, 0); } }
#pragma unroll 1
        for (int t = 0; t < nt; t += 2) {
            const bool last = (t == nt - 2);
            const size_t k1 = (size_t)(((t + rc) & (nt - 1)) + 1) * kstep, k2 = last ? (size_t)rn * kstep : (size_t)((t + 2 + rc) & (nt - 1)) * kstep, k3 = k2 + kstep;
            const char* b2 = (last ? nB : cB) + k2; const char* b3 = b2 + kstep;
            PG8_LDB(B0, 0, 0); PG8_LDB(B1, 0, 1); PG8_SCHED; PG8_LDA(At, 0, 0); PG8_STAGE_A(PG8_SA(1, 1), 1, k1, false);
            PG8_WAIT_V(8); PG8_WAIT_L(0); PG8_BAR; PG8_MMA(0, 0, At, B0); PG8_MMA(0, 1, At, B1); PG8_BAR; PG8_SCHED;
            PG8_LDA(At, 0, 1); PG8_STAGE_B(PG8_SB(0, 0), b2); PG8_STAGE_B(PG8_SB(0, 1), b2 + hstep); PG8_STAGE_A(PG8_SA(0, 0), 0, k2, last);
            PG8_WAIT_V(8); PG8_WAIT_L(0); PG8_BAR; PG8_MMA(1, 0, At, B0); PG8_MMA(1, 1, At, B1); PG8_BAR; PG8_SCHED;
            PG8_LDB(B0, 1, 0); PG8_LDB(B1, 1, 1); PG8_SCHED; PG8_LDA(At, 1, 0); PG8_STAGE_A(PG8_SA(0, 1), 1, k2, last);
            PG8_WAIT_V(8); PG8_WAIT_L(0); PG8_BAR; PG8_MMA(0, 0, At, B0); PG8_MMA(0, 1, At, B1); PG8_BAR; PG8_SCHED;
            PG8_LDA(At, 1, 1); PG8_STAGE_B(PG8_SB(1, 0), b3); PG8_STAGE_B(PG8_SB(1, 1), b3 + hstep); PG8_STAGE_A(PG8_SA(1, 0), 0, k3, last);
            PG8_WAIT_V(8); PG8_WAIT_L(0); PG8_BAR; PG8_MMA(1, 0, At, B0); PG8_MMA(1, 1, At, B1); PG8_BAR; PG8_SCHED;
        }
        typename Epi::Init inx = typename Epi::Init();
        if constexpr (!GATHER) { if (Epi::HAS_INIT && has_next) inx = E.init(nxt, wr, wc, fr, fq);
            if (has_next) has_nn = S.next(ui + 2, nn); }
        else { if (has_nn) { PG8_PIN_RAW(rraw); PG8_PACK_RO(rnn, rraw); } }
        if (wr == 0) PG8_BAR;
        if constexpr (F8) asm volatile("s_nop 15\n\ts_nop 15" ::: "memory");
        E(acc, cur, wr, wc, fr, fq, pre);
        if (!has_next) break;
        if constexpr (GATHER) { if (Epi::HAS_INIT) inx = E.init_lds(ibuf, wc, fq); }
#pragma unroll
        for (int a = 0; a < 2; ++a)
#pragma unroll
            for (int b = 0; b < 2; ++b)
#pragma unroll
                for (int m = 0; m < 4; ++m)
#pragma unroll
                    for (int n = 0; n < 2; ++n) acc[a][b][m][n] = Epi::HAS_INIT ? (inx.v[b][n] + Epi::init_add(b)) * Epi::init_mul(b) : (f32x4){0.f, 0.f, 0.f, 0.f};
        cur = nxt; cA = nA; cB = nB; ++ui; rc = rn;
        has_next = has_nn; nxt = nn;
        if (GATHER) { roc[0] = ron[0]; roc[1] = ron[1]; if (has_next) { ron[0] = rnn[0]; ron[1] = rnn[1]; } }
        if (wr == 1) PG8_BAR;
    }
    PG8_WAIT_V(0);
    PG8_BAR;
#undef PG8_SA
#undef PG8_SB
#undef PG8_STAGE_A
#undef PG8_STAGE_B
#undef PG8_LDA
#undef PG8_LDB
#undef PG8_MMA
#undef PG8_WAIT_V
#undef PG8_WAIT_L
#undef PG8_BAR
#undef PG8_SCHED
#undef PG8_LOAD_RO
#undef PG8_LOAD_RAW
#undef PG8_PIN_RAW
#undef PG8_PACK_RO
}

struct EpiPlainBf16 {
    static constexpr bool PERM = true;
    static __device__ __forceinline__ float init_add(int) { return 0.0f; }
    static __device__ __forceinline__ float init_mul(int) { return 1.0f; }
    __device__ __forceinline__ const float* init_src(const Unit&, int) const { return nullptr; }
    bf16_t* O; int ldc;
    static constexpr bool HAS_INIT = false; struct Init { f32x4 v[2][2]; };
    __device__ __forceinline__ Init init_lds(const LAS float*, int, int) const { return Init(); }
    __device__ __forceinline__ Init init(const Unit&, int, int, int, int) const { return Init(); }
    struct Pre {};
    __device__ __forceinline__ Pre pre(const Unit&, int, int, int, int) const { return Pre{}; }
    __device__ __forceinline__ void operator()(const f32x4 (&acc)[2][2][4][2], const Unit& u, int wr, int wc, int fr, int fq, const Pre&) const {
        const int row0 = u.pm * BM + wr * 64 + fr, col0 = u.pn * BM + wc * 32 + 8 * fq;
#pragma unroll
        for (int ai = 0; ai < 2; ++ai)
#pragma unroll
            for (int m = 0; m < 4; ++m) { bf16_t* rowp = O + (size_t)(row0 + ai * HALF + m * 16) * ldc + col0;
#pragma unroll
                for (int bj = 0; bj < 2; ++bj) { const f32x4 v0 = acc[ai][bj][m][0], v1 = acc[ai][bj][m][1];
                    v4u w; w.x = cvt_pk_bf16(v0[0], v0[1]); w.y = cvt_pk_bf16(v0[2], v0[3]); w.z = cvt_pk_bf16(v1[0], v1[1]); w.w = cvt_pk_bf16(v1[2], v1[3]);
                    *(v4u*)(rowp + bj * HALF) = w; } }
    }
};

struct SchedInProj {
    int G, c;
    __device__ __forceinline__ bool next(int i, Unit& u) const {
        const int L = i * G + c;
        if (L < 1152) { int lt, pn; tile_order(L, 128, 9, lt, pn); u.pm = (lt >> 3) * 9 + 1 + (lt & 7); u.pn = pn; }
        else if (L < 1216) { const int q = L - 1152, ct = q >> 2, j = q & 3; u.pm = ct * 9; u.pn = (j == 3) ? 8 : 1 + j; }
        else return false;
        u.brow = u.pn * BM; u.e = 0; u.r0 = 0; u.cnt = 0; return true;
    }
    __device__ __forceinline__ unsigned arow_tok(const Unit&, int) const { return 0u; }
    __device__ __forceinline__ const unsigned* arow_ptr(const Unit&, int) const { return nullptr; }
};
struct EpiInProj {
    static constexpr bool PERM = false;
    static __device__ __forceinline__ float init_add(int) { return 0.0f; }
    static __device__ __forceinline__ float init_mul(int) { return 1.0f; }
    __device__ __forceinline__ const float* init_src(const Unit&, int) const { return nullptr; }
    unsigned char* ws; const float* qng; const float* kng; const float* rope;
    static constexpr bool HAS_INIT = false; struct Init { f32x4 v[2][2]; };
    __device__ __forceinline__ Init init_lds(const LAS float*, int, int) const { return Init(); }
    __device__ __forceinline__ Init init(const Unit&, int, int, int, int) const { return Init(); }
    struct Pre {};
    __device__ __forceinline__ Pre pre(const Unit&, int, int, int, int) const { return Pre{}; }
    __device__ __forceinline__ void operator()(const f32x4 (&acc)[2][2][4][2], const Unit& u, int wr, int wc, int fr, int fq, const Pre&) const {
        const int g = u.pn * 4 + wc, bt = u.pm / 9, pt = u.pm % 9; const bool isctx = (pt == 0);
        const int blk = fq >> 1, f1 = fq & 1, dbase = 32 * blk + 8 * f1;
        const bool do_rms = (g >= 24 && g < 34), do_rope = !isctx && (g < 8 || (g >= 24 && g < 34)), latrows = (g < 4) || (g >= 16 && g < 32);
        const float scale = (g >= 4 && g < 8) ? 0.125f : ((g >= 24 && g < 32) ? C2 : 1.0f);
        bf16_t* dst; int pitch;
        if (g < 4) { dst = (bf16_t*)(ws + WS_RQ) + g * 64; pitch = 256; }
        else if (g < 8) { dst = (bf16_t*)(ws + WS_RK) + (g - 4) * 64; pitch = 256; }
        else if (g < 16) { dst = (bf16_t*)(ws + WS_RV) + (g - 8) * 64; pitch = 512; }
        else if (g < 24) { dst = (bf16_t*)(ws + WS_RG) + (g - 16) * 64; pitch = 512; }
        else if (g < 32) { dst = (bf16_t*)(ws + WS_AQ) + (g - 24) * 64; pitch = 512; }
        else if (g < 34) { dst = (bf16_t*)(ws + WS_AK) + (g - 32) * 64; pitch = 128; }
        else { dst = (bf16_t*)(ws + WS_AV) + (g - 34) * 64; pitch = 128; }
        const int rowbase = latrows ? bt * SEQ + (pt - 1) * 256 : u.pm * 256;
        dst += dbase;
        f32x4 gv[2][2];
#pragma unroll
        for (int bj = 0; bj < 2; ++bj)
#pragma unroll
            for (int n = 0; n < 2; ++n) gv[bj][n] = do_rms ? *(const f32x4*)((g < 32 ? qng : kng) + dbase + 16 * bj + 4 * n) : (f32x4){1.f, 1.f, 1.f, 1.f};
        f32x4 rcur[4] = {}, rnxt[4] = {};
#define INPROJ_ROPE_LD(dst, ai_, m_) do { const int r_ = (ai_) * HALF + wr * 64 + (m_) * 16 + fr, t_ = (pt - 1) * 256 + r_, pos_ = blk ? (t_ & 63) : (t_ >> 6); const f32x4* rp_ = (const f32x4*)(rope + pos_ * 32 + 16 * f1); \
            dst[0] = rp_[0]; dst[1] = rp_[1]; dst[2] = rp_[2]; dst[3] = rp_[3]; } while (0)
        if (do_rope) INPROJ_ROPE_LD(rcur, 0, 0);
#pragma unroll
        for (int ai = 0; ai < 2; ++ai)
#pragma unroll
            for (int m = 0; m < 4; ++m) {
                const int r = ai * HALF + wr * 64 + m * 16 + fr;
                if (do_rope && (ai * 4 + m) < 7) INPROJ_ROPE_LD(rnxt, (ai * 4 + m + 1) >> 2, (ai * 4 + m + 1) & 3);
                f32x4 v[2][2];
#pragma unroll
                for (int bj = 0; bj < 2; ++bj)
#pragma unroll
                    for (int n = 0; n < 2; ++n) v[bj][n] = acc[ai][bj][m][n];
                if (do_rms) {
                    float ss = 0.f;
#pragma unroll
                    for (int bj = 0; bj < 2; ++bj)
#pragma unroll
                        for (int n = 0; n < 2; ++n) ss += (v[bj][n][0] * v[bj][n][0] + v[bj][n][1] * v[bj][n][1]) + (v[bj][n][2] * v[bj][n][2] + v[bj][n][3] * v[bj][n][3]);
                    ss = xor32_sum(xor16_sum(ss));
                    const float rinv = __builtin_amdgcn_rsqf(ss * (1.0f / 64.0f) + LN_EPS);
#pragma unroll
                    for (int bj = 0; bj < 2; ++bj)
#pragma unroll
                        for (int n = 0; n < 2; ++n) v[bj][n] = v[bj][n] * rinv * gv[bj][n];
                }
                if (do_rope) {
#pragma unroll
                    for (int n = 0; n < 2; ++n) { const f32x4 p0 = rcur[2 * n], p1 = rcur[2 * n + 1];
                        const f32x4 lo = v[0][n], hi = v[1][n];
                        const f32x4 cs = {p0[0], p0[2], p1[0], p1[2]}, sn = {p0[1], p0[3], p1[1], p1[3]};
                        v[0][n] = lo * cs - hi * sn; v[1][n] = hi * cs + lo * sn; }
                }
                bf16_t* rowp = dst + (size_t)(rowbase + r) * pitch;
#pragma unroll
                for (int bj = 0; bj < 2; ++bj) { const f32x4 v0 = v[bj][0] * scale, v1 = v[bj][1] * scale;
                    v4u w; w.x = cvt_pk_bf16(v0[0], v0[1]); w.y = cvt_pk_bf16(v0[2], v0[3]); w.z = cvt_pk_bf16(v1[0], v1[1]); w.w = cvt_pk_bf16(v1[2], v1[3]);
                    *(v4u*)(rowp + 16 * bj) = w; }
#pragma unroll
                for (int q = 0; q < 4; ++q) rcur[q] = rnxt[q];
            }
#undef INPROJ_ROPE_LD
    }
};

struct SchedMoE {
    int nN, NB, G, c; const LAS int* tab; const v2u* LIST;
    __device__ __forceinline__ bool next(int i, Unit& u) const {
        const int ntiles = __builtin_amdgcn_readfirstlane(tab[32]); const long L = (long)i * G + c; if (L >= (long)ntiles * nN) return false;
        tile_order((int)L, ntiles, nN, u.pm, u.pn);
        const int ln = (int)(threadIdx.x & 63u); const int tq = (ln >= 1 && ln < 32) ? tab[ln] : 0x7fffffff;
        const int e = __builtin_popcountll(__ballot(u.pm >= tq));
        u.e = e; u.r0 = (u.pm - __builtin_amdgcn_readfirstlane(tab[e])) * 256; u.cnt = __builtin_amdgcn_readfirstlane(tab[33 + e]); u.brow = e * NB + u.pn * BM; return true;
    }
    __device__ __forceinline__ unsigned arow_tok(const Unit& u, int r) const { int rr = u.r0 + r; rr = rr < u.cnt ? rr : u.cnt - 1; return LIST[(size_t)u.e * LISTCAP + rr].x >> 2; }
    __device__ __forceinline__ const unsigned* arow_ptr(const Unit& u, int r) const { int rr = u.r0 + r; rr = rr < u.cnt ? rr : u.cnt - 1; return (const unsigned*)(LIST + (size_t)u.e * LISTCAP + rr); }
};
__device__ __forceinline__ void moe_build_tab(LAS int* tab, const unsigned* CNT) {
    if (threadIdx.x == 0) { int st = 0; for (int e = 0; e < 32; ++e) { const int c = (int)CNT[e]; tab[e] = st; tab[33 + e] = c; st += (c + 255) >> 8; } tab[32] = st; }
    __syncthreads();
}
struct EpiUp {
    static constexpr bool PERM = true;
    static __device__ __forceinline__ float init_add(int bj) { return bj ? 1.0f : 0.0f; }
    static __device__ __forceinline__ float init_mul(int bj) { return bj ? 1.0f / SWK : SWK; }
    unsigned char* ACT; const float* bup;
    static constexpr bool HAS_INIT = true; struct Init { f32x4 v[2][2]; };
    __device__ __forceinline__ Init init(const Unit& u, int wr, int wc, int fr, int fq) const {
        const float* bg = bup + (size_t)u.e * 2048 + u.pn * 128 + wc * 32 + 8 * fq; Init i; i.v[0][0] = *(const f32x4*)bg; i.v[0][1] = *(const f32x4*)(bg + 4); i.v[1][0] = *(const f32x4*)(bg + 1024); i.v[1][1] = *(const f32x4*)(bg + 1028); return i; }
    __device__ __forceinline__ const float* init_src(const Unit& u, int lane) const { return bup + (size_t)u.e * 2048 + u.pn * 128 + (lane < 32 ? 4 * lane : 1024 + 4 * (lane - 32)); }
    __device__ __forceinline__ Init init_lds(const LAS float* S, int wc, int fq) const { Init i; const LAS float* p = S + wc * 32 + 8 * fq; i.v[0][0] = *(const LAS f32x4*)p; i.v[0][1] = *(const LAS f32x4*)(p + 4); i.v[1][0] = *(const LAS f32x4*)(p + 128); i.v[1][1] = *(const LAS f32x4*)(p + 132); return i; }
    struct Pre {};
    __device__ __forceinline__ Pre pre(const Unit&, int, int, int, int) const { return Pre{}; }
    __device__ __forceinline__ void operator()(const f32x4 (&acc)[2][2][4][2], const Unit& u, int wr, int wc, int fr, int fq, const Pre&) const {
        const int colt = u.pn * 128 + wc * 32 + 8 * fq;
#pragma unroll
        for (int ai = 0; ai < 2; ++ai)
#pragma unroll
            for (int m = 0; m < 4; ++m) {
                const int row = u.pm * BM + ai * HALF + wr * 64 + m * 16 + fr;
                f32x4 ag[2] = {acc[ai][0][m][0], acc[ai][0][m][1]}, al[2] = {acc[ai][1][m][0], acc[ai][1][m][1]};
                asm volatile("" : "+v"(ag[0]), "+v"(ag[1]), "+v"(al[0]), "+v"(al[1]));
                float o[8];
#pragma unroll
                for (int n = 0; n < 2; ++n)
#pragma unroll
                    for (int j = 0; j < 4; ++j) { const float gl = __builtin_amdgcn_fmed3f(ag[n][j], 3.0e38f, 7.0f * SWK); const float l1 = __builtin_amdgcn_fmed3f(al[n][j], -6.0f / SWK, 8.0f / SWK);
                        o[4 * n + j] = (gl * l1) * __builtin_amdgcn_rcpf(1.0f + __builtin_amdgcn_exp2f(gl)); }
                v2u w; w.x = 0u; w.y = 0u;
                w.x = __builtin_amdgcn_cvt_pk_fp8_f32(o[0], o[1], w.x, false); w.x = __builtin_amdgcn_cvt_pk_fp8_f32(o[2], o[3], w.x, true);
                w.y = __builtin_amdgcn_cvt_pk_fp8_f32(o[4], o[5], w.y, false); w.y = __builtin_amdgcn_cvt_pk_fp8_f32(o[6], o[7], w.y, true);
                *(v2u*)(ACT + (size_t)row * 1024 + colt) = w;
            }
    }
};
struct EpiDown {
    static constexpr bool PERM = true;
    static __device__ __forceinline__ float init_add(int) { return 0.0f; }
    static __device__ __forceinline__ float init_mul(int) { return 1.0f; }
    __device__ __forceinline__ const float* init_src(const Unit&, int) const { return nullptr; }
    bf16_t* YE; const float* bdn; const v2u* LIST;
    static constexpr bool HAS_INIT = true; struct Init { f32x4 v[2][2]; };
    __device__ __forceinline__ Init init_lds(const LAS float*, int, int) const { return Init(); }
    __device__ __forceinline__ Init init(const Unit& u, int wr, int wc, int fr, int fq) const {
        Init i; const float* bb = bdn + (size_t)u.e * 1024 + u.pn * BM + wc * 64 + 16 * fq;
#pragma unroll
        for (int bj = 0; bj < 2; ++bj)
#pragma unroll
            for (int n = 0; n < 2; ++n) i.v[bj][n] = *(const f32x4*)(bb + 8 * bj + 4 * n);
        return i; }
    struct Pre { v2u ent[2][4]; };
    __device__ __forceinline__ Pre pre(const Unit& u, int wr, int wc, int fr, int fq) const {
        Pre p;
#pragma unroll
        for (int ai = 0; ai < 2; ++ai)
#pragma unroll
            for (int m = 0; m < 4; ++m) { const int rr = u.r0 + ai * HALF + wr * 64 + m * 16 + fr; p.ent[ai][m] = LIST[(size_t)u.e * LISTCAP + (rr < u.cnt ? rr : u.cnt - 1)]; }
        return p;
    }
    __device__ __forceinline__ void operator()(const f32x4 (&acc)[2][2][4][2], const Unit& u, int wr, int wc, int fr, int fq, const Pre& P) const {
        const int col0 = u.pn * BM + wc * 64 + 16 * fq;
#pragma unroll
        for (int ai = 0; ai < 2; ++ai)
#pragma unroll
            for (int m = 0; m < 4; ++m) {
                const int rr = u.r0 + ai * HALF + wr * 64 + m * 16 + fr; const bool valid = rr < u.cnt;
                const v2u ent = P.ent[ai][m]; const float gate = __uint_as_float(ent.y);
                unsigned char* rowp = (unsigned char*)YE + (size_t)ent.x * 1024 + col0;
                const float g64 = gate * 64.0f;
                f32x4 a0 = acc[ai][0][m][0], a1 = acc[ai][0][m][1], a2 = acc[ai][1][m][0], a3 = acc[ai][1][m][1]; asm volatile("" : "+v"(a0), "+v"(a1), "+v"(a2), "+v"(a3));
                const f32x4 v0 = a0 * g64, v1 = a1 * g64, v2 = a2 * g64, v3 = a3 * g64;
                v4u w; w.x = 0u; w.y = 0u; w.z = 0u; w.w = 0u;
                w.x = __builtin_amdgcn_cvt_pk_fp8_f32(v0[0], v0[1], w.x, false); w.x = __builtin_amdgcn_cvt_pk_fp8_f32(v0[2], v0[3], w.x, true);
                w.y = __builtin_amdgcn_cvt_pk_fp8_f32(v1[0], v1[1], w.y, false); w.y = __builtin_amdgcn_cvt_pk_fp8_f32(v1[2], v1[3], w.y, true);
                w.z = __builtin_amdgcn_cvt_pk_fp8_f32(v2[0], v2[1], w.z, false); w.z = __builtin_amdgcn_cvt_pk_fp8_f32(v2[2], v2[3], w.z, true);
                w.w = __builtin_amdgcn_cvt_pk_fp8_f32(v3[0], v3[1], w.w, false); w.w = __builtin_amdgcn_cvt_pk_fp8_f32(v3[2], v3[3], w.w, true);
                if (valid) *(v4u*)rowp = w;
            }
    }
};
}

#include <hip/hip_bf16.h>
#include <cmath>
namespace attn_body {
using bf16=__hip_bfloat16;
using bf16x8=__attribute__((ext_vector_type(8)))short;
using s16x4=__attribute__((ext_vector_type(4)))short;
using f32x16=__attribute__((ext_vector_type(16)))float;
using u32x4=__attribute__((ext_vector_type(4)))unsigned;
constexpr int D=64,QP=512,KP=128,OP=1024,SEQQ=2048,SEQK=2304;
constexpr int NW=8,QBLK=32,QB=QBLK*NW,KVBLK=64,NQB=SEQQ/QB;
constexpr int ATTN_UNIT_ROWS=QB;
__device__ __forceinline__ int crow(int r,int hi){return (r&3)+8*(r>>2)+4*hi;}
#define SBAR() __builtin_amdgcn_sched_barrier(0)
__device__ __forceinline__ void cmask(f32x16&p0,f32x16&p1,int jb,int qrel,int hi){
  const float NEG=-INFINITY; int kb=64*jb+4*hi;
  #pragma unroll
  for(int r=0;r<16;++r){int kv=kb+(r&3)+8*(r>>2); if(kv>qrel)p0[r]=NEG; if(kv+32>qrel)p1[r]=NEG;}
}

constexpr int NSLOT=3, SLOTB=8192;
constexpr int LDS_K=0, LDS_V=NSLOT*SLOTB, LDS_WS=2*NSLOT*SLOTB, LDS_OST=LDS_WS+NW*64*4, LDS_BYTES=LDS_OST+NW*4096;
constexpr float C2=0.125f*1.4426950408889634f;
__device__ __forceinline__ void glds16(const void*gsrc,unsigned lds_dst){unsigned keep;
  asm volatile("s_mov_b32 %0, m0\n\ts_mov_b32 m0, %2\n\ts_nop 0\n\tglobal_load_lds_dwordx4 %1, off\n\ts_mov_b32 m0, %0":"=&s"(keep):"v"(gsrc),"s"(lds_dst):"memory");}
__device__ __forceinline__ float max3f(float a,float b,float c){float r;asm("v_max3_f32 %0, %1, %2, %3":"=v"(r):"v"(a),"v"(b),"v"(c));return r;}
__device__ __forceinline__ float max2f(float a,float b){float r;asm("v_max_f32_e32 %0, %1, %2":"=v"(r):"v"(a),"v"(b));return r;}
__device__ __forceinline__ float fadd_s(float a,float b){float r;asm("v_add_f32_e32 %0, %1, %2":"=v"(r):"v"(a),"v"(b));return r;}
__device__ __forceinline__ float fsub_s(float a,float b){float r;asm("v_sub_f32_e32 %0, %1, %2":"=v"(r):"v"(a),"v"(b));return r;}
typedef float f32x2_t __attribute__((ext_vector_type(2))); typedef __bf16 bf16x2_t __attribute__((ext_vector_type(2)));
__device__ __forceinline__ unsigned cvtpk_s(float lo,float hi){f32x2_t v={lo,hi};bf16x2_t b=__builtin_convertvector(v,bf16x2_t);return __builtin_bit_cast(unsigned,b);}
#define WAIT_BAR(N) asm volatile("s_waitcnt vmcnt(" #N ") lgkmcnt(0)\n\ts_barrier":::"memory")

__device__ __forceinline__ void qkt(f32x16&p0,f32x16&p1,const char*Kslot,const bf16x8*qr,const f32x16&negm,int r32,int hi){
  const char*kb=Kslot+hi*1024+r32*16;
  #pragma unroll
  for(int d0=0;d0<4;++d0){
    const bf16x8 b0=*reinterpret_cast<const bf16x8*>(kb+d0*2048);
    const bf16x8 b1=*reinterpret_cast<const bf16x8*>(kb+d0*2048+512);
    if(d0==0){p0=__builtin_amdgcn_mfma_f32_32x32x16_bf16(b0,qr[0],negm,0,0,0);p1=__builtin_amdgcn_mfma_f32_32x32x16_bf16(b1,qr[0],negm,0,0,0);}
    else{p0=__builtin_amdgcn_mfma_f32_32x32x16_bf16(b0,qr[d0],p0,0,0,0);p1=__builtin_amdgcn_mfma_f32_32x32x16_bf16(b1,qr[d0],p1,0,0,0);}}
}
typedef __attribute__((address_space(3))) const char* lds_cptr;
typedef short v4i16_t __attribute__((ext_vector_type(4)));
__device__ __forceinline__ void kload8(bf16x8*kf,lds_cptr kp){
  kf[0]=*(const __attribute__((address_space(3))) bf16x8*)(kp);      kf[1]=*(const __attribute__((address_space(3))) bf16x8*)(kp+512);
  kf[2]=*(const __attribute__((address_space(3))) bf16x8*)(kp+2048); kf[3]=*(const __attribute__((address_space(3))) bf16x8*)(kp+2560);
  kf[4]=*(const __attribute__((address_space(3))) bf16x8*)(kp+4096); kf[5]=*(const __attribute__((address_space(3))) bf16x8*)(kp+4608);
  kf[6]=*(const __attribute__((address_space(3))) bf16x8*)(kp+6144); kf[7]=*(const __attribute__((address_space(3))) bf16x8*)(kp+6656);
}
__device__ __forceinline__ void kload2(bf16x8*kf,lds_cptr kp,int j){ kf[2*j]=*(const __attribute__((address_space(3))) bf16x8*)(kp+j*2048); kf[2*j+1]=*(const __attribute__((address_space(3))) bf16x8*)(kp+j*2048+512); }
__device__ __forceinline__ s16x4 vtr(lds_cptr p){ return __builtin_bit_cast(s16x4,__builtin_amdgcn_ds_read_tr16_b64_v4i16((__attribute__((address_space(3))) v4i16_t*)p)); }
__device__ __forceinline__ float rowmax(const f32x16&p0,const f32x16&p1){
  float a=max3f(p0[0],p0[1],p1[0]),b=max3f(p0[2],p0[3],p1[1]);a=max3f(a,p1[2],p1[3]);
  #pragma unroll
  for(int r=4;r<16;r+=4){a=max3f(a,p0[r],p0[r+1]);b=max3f(b,p0[r+2],p0[r+3]);a=max3f(a,p1[r],p1[r+1]);b=max3f(b,p1[r+2],p1[r+3]);}
  const float m=max2f(a,b);
  auto rr=__builtin_amdgcn_permlane32_swap(__float_as_uint(m),__float_as_uint(m),false,false);
  return max2f(__uint_as_float(rr[0]),__uint_as_float(rr[1]));
}
__device__ __forceinline__ void pv(f32x16*o,int vb,bf16x8 pa0,bf16x8 pa1,bf16x8 pa2,bf16x8 pa3){
  #pragma unroll
  for(int d0=0;d0<2;++d0){s16x4 lo[4],hi[4];
    #pragma unroll
    for(int ks=0;ks<4;++ks){
      asm volatile("ds_read_b64_tr_b16 %0,%1 offset:%c2":"=&v"(lo[ks]):"v"(vb),"i"(d0*4096+ks*1024):"memory");
      asm volatile("ds_read_b64_tr_b16 %0,%1 offset:%c2":"=&v"(hi[ks]):"v"(vb),"i"(d0*4096+ks*1024+512):"memory");}
    asm volatile("s_waitcnt lgkmcnt(0)":::"memory");SBAR();
    #define PK(k) (bf16x8){lo[k][0],lo[k][1],lo[k][2],lo[k][3],hi[k][0],hi[k][1],hi[k][2],hi[k][3]}
    o[d0]=__builtin_amdgcn_mfma_f32_32x32x16_bf16(pa0,PK(0),o[d0],0,0,0);
    o[d0]=__builtin_amdgcn_mfma_f32_32x32x16_bf16(pa1,PK(1),o[d0],0,0,0);
    o[d0]=__builtin_amdgcn_mfma_f32_32x32x16_bf16(pa2,PK(2),o[d0],0,0,0);
    o[d0]=__builtin_amdgcn_mfma_f32_32x32x16_bf16(pa3,PK(3),o[d0],0,0,0);
    #undef PK
  }
}

#ifndef ATTN_STORE16
#define ATTN_STORE16(p,v) (*(u32x4*)(p)=(v))
#endif
template<int THRL> __device__ __forceinline__ void attn_unit(int b,int h,int qb,const bf16*Q,const bf16*__restrict__ K,const bf16*__restrict__ V,bf16*O,char*shm,float refB,bool pf_in=false,bool pf_out=false,int nb=0,int nh=0,int nqb=0){
  const int tid=threadIdx.x,lane=tid&63,r32=lane&31,hi=lane>>5; const int wid=__builtin_amdgcn_readfirstlane(tid>>6);
  const long rowq=(long)b*SEQQ,rowk=(long)b*SEQK; const int q0=qb*QB;
  const bf16*Qw=Q+(rowq+q0+wid*QBLK)*QP+h*D;
  const bf16*Kh=K+rowk*KP+(h>>2)*D,*Vh=V+rowk*KP+(h>>2)*D;
  const unsigned lds0=(unsigned)(uintptr_t)shm;
  float*wsf=(float*)(shm+LDS_WS)+wid*64;
  const bf16*ksrc=Kh+(long)lane*KP+wid*8;
  const bf16*vsrc=Vh+(long)(16*(wid&3)+(lane>>2))*KP+(wid>>2)*32+(lane&3)*8;
  const unsigned kdst=lds0+LDS_K+wid*1024, vdst=lds0+LDS_V+wid*1024;
  #define DMA_K(t,slot) glds16(ksrc+(long)(t)*KVBLK*KP,(unsigned)__builtin_amdgcn_readfirstlane(kdst+(slot)))
  #define DMA_V(t,slot) glds16(vsrc+(long)(t)*KVBLK*KP,(unsigned)__builtin_amdgcn_readfirstlane(vdst+(slot)))
  const int vb0=(int)(lds0+LDS_V)+((lane>>4)&1)*32+(lane&3)*8+(4*hi+((lane&15)>>2))*64;
  const char*Kbase=shm+LDS_K; bf16x8 kf[8];
  const lds_cptr shm3=(lds_cptr)shm; const lds_cptr kp0=shm3+LDS_K+hi*1024+r32*16; const lds_cptr vp0=shm3+LDS_V+((lane>>4)&1)*32+(lane&3)*8+(4*hi+((lane&15)>>2))*64;
  const int NT=SEQK/KVBLK;
  const unsigned qdst=lds0+LDS_BYTES+wid*4096;
  if(!pf_in){DMA_K(0,0);DMA_V(0,0);DMA_K(1,SLOTB);}
  bf16x8 qr[4];
  #pragma unroll
  for(int d0=0;d0<4;++d0)qr[d0]=pf_in?bf16x8{}:*reinterpret_cast<const bf16x8*>(&Qw[(long)r32*QP+d0*16+hi*8]);
  float mhat=refB,l_reg=0.f;f32x16 o[2];o[0]=f32x16{};o[1]=f32x16{};f32x16 negm; _Pragma("unroll") for(int r=0;r<16;++r)negm[r]=-refB; asm volatile("":"+v"(negm));

  #define CMASK(P0,P1,t) do{}while(0)
  bool resc=false;
  #define START(P0,P1) do{ resc=false; \
    _Pragma("unroll") for(int r=0;r<16;++r)P0[r]=__builtin_amdgcn_exp2f(P0[r]); }while(0)
  #define RESC() do{ if(resc){ asm volatile("s_waitcnt lgkmcnt(0)":::"memory"); \
      _Pragma("unroll") for(int d_=0;d_<2;++d_) _Pragma("unroll") for(int r=0;r<16;++r)o[d_][r]*=wsf[crow(r,hi)]; } }while(0)
  f32x16 pA0,pA1,pB0,pB1;
  int sl_prev=0,sl_cur=0,sl_next=SLOTB;
  #define ROT() do{sl_prev=sl_cur;sl_cur=sl_next;sl_next=(sl_next==(NSLOT-1)*SLOTB)?0:sl_next+SLOTB;}while(0)
  DMA_K(2,2*SLOTB);
  if(pf_in){ asm volatile("s_waitcnt vmcnt(1)":::"memory");
    _Pragma("unroll") for(int d0=0;d0<4;++d0)qr[d0]=*(const __attribute__((address_space(3))) bf16x8*)(shm3+LDS_BYTES+wid*4096+d0*1024+lane*16);
    WAIT_BAR(1); }
  else WAIT_BAR(3);
  qkt(pA0,pA1,Kbase,qr,negm,r32,hi);asm volatile("s_nop 15\n\ts_nop 7":"+v"(pA0),"+v"(pA1));CMASK(pA0,pA1,0);
  START(pA0,pA1);
  _Pragma("unroll") for(int r=0;r<16;++r)pA1[r]=__builtin_amdgcn_exp2f(pA1[r]);
  WAIT_BAR(0);
  DMA_K(3,0);DMA_V(1,SLOTB);
  ROT();
  kload8(kf,kp0+sl_cur);
  WAIT_BAR(2);
  s16x4 vlo[8],vhi[8]; u32x4 pw0,pw1,pw2,pw3;
  #define PKW(P,B) cvtpk_s(P[B],P[B+1])
  #define PAF(k) __builtin_bit_cast(bf16x8,pw##k)
  #define VFR(i) (bf16x8){vlo[i][0],vlo[i][1],vlo[i][2],vlo[i][3],vhi[i][0],vhi[i][1],vhi[i][2],vhi[i][3]}
  #define PIN(x) asm volatile("":"+v"(x))
  #define MX3(a,b,c) __builtin_fmaxf(__builtin_fmaxf((a),(b)),(c))
  #define GAPA(MF,A0,A1,A2,A3,W0,W1,PW) do{ MF; sacc+=A0; sacc+=A1; sacc+=A2; sacc+=A3; PIN(sacc); W0; W1; PIN(PW); SBAR(); }while(0)
  #define EX(v) __builtin_amdgcn_exp2f(v)
  #define GAPB(MF,X,B) do{ MF; X[B]=EX(X[B]); X[B+1]=EX(X[B+1]); X[B+2]=EX(X[B+2]); X[B+3]=EX(X[B+3]); PIN(X); SBAR(); }while(0)
  #define VRD(i) do{ vlo[i]=vtr(vp_+(((i)>>2)*4096+((i)&3)*1024)); vhi[i]=vtr(vp_+(((i)>>2)*4096+((i)&3)*1024+512)); }while(0)
  #define KRD(G,j) do{ if(G){ kload2(kf,kp0+sl_next,j); SBAR(); } }while(0)
  #define STEP(C0,C1,P0,P1,t,GK,GV,GL) do{ SBAR(); \
    const lds_cptr vp_=vp0+sl_prev; \
    VRD(0); SBAR(); float sacc=(P0[0]+P0[1]); \
    GAPA(C0=__builtin_amdgcn_mfma_f32_32x32x16_bf16(kf[0],qr[0],negm,0,0,0), P0[2],P0[3],P0[4],P0[5],     pw0[0]=PKW(P0,0), pw0[1]=PKW(P0,2), pw0); \
    VRD(4); SBAR(); GAPA(C1=__builtin_amdgcn_mfma_f32_32x32x16_bf16(kf[1],qr[0],negm,0,0,0), P0[6],P0[7],P0[8],P0[9],     pw0[2]=PKW(P0,4), pw0[3]=PKW(P0,6), pw0); \
    VRD(1); SBAR(); GAPA(C0=__builtin_amdgcn_mfma_f32_32x32x16_bf16(kf[2],qr[1],C0,0,0,0),   P0[10],P0[11],P0[12],P0[13], pw1[0]=PKW(P0,8), pw1[1]=PKW(P0,10), pw1); \
    VRD(5); SBAR(); GAPA(C1=__builtin_amdgcn_mfma_f32_32x32x16_bf16(kf[3],qr[1],C1,0,0,0),   P0[14],P0[15],P1[0],P1[1],   pw1[2]=PKW(P0,12),pw1[3]=PKW(P0,14), pw1); \
    VRD(2); SBAR(); GAPA(C0=__builtin_amdgcn_mfma_f32_32x32x16_bf16(kf[4],qr[2],C0,0,0,0),   P1[2],P1[3],P1[4],P1[5],     pw2[0]=PKW(P1,0), pw2[1]=PKW(P1,2), pw2); \
    VRD(6); SBAR(); GAPA(C1=__builtin_amdgcn_mfma_f32_32x32x16_bf16(kf[5],qr[2],C1,0,0,0),   P1[6],P1[7],P1[8],P1[9],     pw2[2]=PKW(P1,4), pw2[3]=PKW(P1,6), pw2); \
    VRD(3); SBAR(); GAPA(C0=__builtin_amdgcn_mfma_f32_32x32x16_bf16(kf[6],qr[3],C0,0,0,0),   P1[10],P1[11],P1[12],P1[13], pw3[0]=PKW(P1,8), pw3[1]=PKW(P1,10), pw3); \
    VRD(7); SBAR(); GAPA(C1=__builtin_amdgcn_mfma_f32_32x32x16_bf16(kf[7],qr[3],C1,0,0,0),   P1[14],P1[15],0.f,0.f,       pw3[2]=PKW(P1,12),pw3[3]=PKW(P1,14), pw3); \
    l_reg+=sacc; \
    if(GK){DMA_K((t)+3,sl_cur);} if(GV){DMA_V((t)+1,sl_next);} \
    CMASK(C0,C1,t); \
    resc=false; \
    SBAR(); \
    GAPB(o[0]=__builtin_amdgcn_mfma_f32_32x32x16_bf16(PAF(0),VFR(0),o[0],0,0,0), C0,0); \
    GAPB(o[1]=__builtin_amdgcn_mfma_f32_32x32x16_bf16(PAF(0),VFR(4),o[1],0,0,0), C0,4); \
    KRD(GL,0); GAPB(o[0]=__builtin_amdgcn_mfma_f32_32x32x16_bf16(PAF(1),VFR(1),o[0],0,0,0), C0,8); \
    KRD(GL,1); GAPB(o[1]=__builtin_amdgcn_mfma_f32_32x32x16_bf16(PAF(1),VFR(5),o[1],0,0,0), C0,12); \
    KRD(GL,2); GAPB(o[0]=__builtin_amdgcn_mfma_f32_32x32x16_bf16(PAF(2),VFR(2),o[0],0,0,0), C1,0); \
    KRD(GL,3); GAPB(o[1]=__builtin_amdgcn_mfma_f32_32x32x16_bf16(PAF(2),VFR(6),o[1],0,0,0), C1,4); \
    GAPB(o[0]=__builtin_amdgcn_mfma_f32_32x32x16_bf16(PAF(3),VFR(3),o[0],0,0,0), C1,8); \
    GAPB(o[1]=__builtin_amdgcn_mfma_f32_32x32x16_bf16(PAF(3),VFR(7),o[1],0,0,0), C1,12); \
    }while(0)
  int t=1;
  #undef CMASK
  #define CMASK(P0,P1,t) do{}while(0)
  for(;t+5<NT;t+=2){
    STEP(pB0,pB1,pA0,pA1,t,true,true,true);     WAIT_BAR(2); RESC(); ROT();
    STEP(pA0,pA1,pB0,pB1,t+1,true,true,true);   WAIT_BAR(2); RESC(); ROT();
  }
  #undef CMASK
  #define CMASK(P0,P1,t) do{}while(0)
  #define ENDW(tt) do{ if((tt)+3<NT){WAIT_BAR(2);} else if((tt)+2<NT){WAIT_BAR(1);} else {WAIT_BAR(0);} }while(0)
  for(;t+1<NT;t+=2){
    STEP(pB0,pB1,pA0,pA1,t,(t+3<NT),(t+1<NT),(t+1<NT));       ENDW(t);   RESC(); ROT();
    STEP(pA0,pA1,pB0,pB1,t+1,(t+4<NT),(t+2<NT),(t+2<NT));     ENDW(t+1); RESC(); ROT();
  }
  if(pf_out){
    const long nrk=(long)nb*SEQK; const bf16*nKh=K+nrk*KP+(nh>>2)*D,*nVh=V+nrk*KP+(nh>>2)*D;
    const bf16*nks=nKh+(long)lane*KP+wid*8; const bf16*nvs=nVh+(long)(16*(wid&3)+(lane>>2))*KP+(wid>>2)*32+(lane&3)*8;
    glds16(nks,(unsigned)__builtin_amdgcn_readfirstlane(kdst)); glds16(nvs,(unsigned)__builtin_amdgcn_readfirstlane(vdst)); glds16(nks+(long)KVBLK*KP,(unsigned)__builtin_amdgcn_readfirstlane(kdst+SLOTB));
    const bf16*nQw=Q+((long)nb*SEQQ+nqb*QB+wid*QBLK)*QP+nh*D;
    _Pragma("unroll") for(int d0=0;d0<4;++d0)glds16(nQw+(long)r32*QP+d0*16+hi*8,(unsigned)__builtin_amdgcn_readfirstlane(qdst+d0*1024)); }
  STEP(pB0,pB1,pA0,pA1,NT-1,false,false,false); RESC();
  { float sacc=pB0[0]+pB0[1]; _Pragma("unroll") for(int r=2;r<16;++r)sacc+=pB0[r]; _Pragma("unroll") for(int r=0;r<16;++r)sacc+=pB1[r]; l_reg+=sacc;
    pw0=(u32x4){PKW(pB0,0),PKW(pB0,2),PKW(pB0,4),PKW(pB0,6)};pw1=(u32x4){PKW(pB0,8),PKW(pB0,10),PKW(pB0,12),PKW(pB0,14)};pw2=(u32x4){PKW(pB1,0),PKW(pB1,2),PKW(pB1,4),PKW(pB1,6)};pw3=(u32x4){PKW(pB1,8),PKW(pB1,10),PKW(pB1,12),PKW(pB1,14)};
    SBAR(); pv(o,vb0+sl_cur,PAF(0),PAF(1),PAF(2),PAF(3)); }
  #undef PKW
  #undef PAF
  #undef VFR
  #undef PIN
  #undef MX3
  #undef GAPA
  #undef GAPB
  #undef EX
  #undef VRD
  #undef KRD
  #undef STEP
  #undef ENDW
  {auto rr=__builtin_amdgcn_permlane32_swap(__float_as_uint(l_reg),__float_as_uint(l_reg),false,false);l_reg=__uint_as_float(rr[0])+__uint_as_float(rr[1]);}
  if(hi==0)wsf[32+r32]=l_reg;asm volatile("s_waitcnt lgkmcnt(0)":::"memory");
  float rli[16];
  #pragma unroll
  for(int r=0;r<16;++r)rli[r]=__builtin_amdgcn_rcpf(wsf[32+crow(r,hi)]);
  bf16*Ow=O+(rowq+q0+wid*QBLK)*OP+h*D;
  { bf16*stg=(bf16*)(shm+LDS_OST)+wid*2048;
    #pragma unroll
    for(int r=0;r<16;++r){const int orow=crow(r,hi);
      #pragma unroll
      for(int d0=0;d0<2;++d0)stg[orow*64+d0*32+r32]=__float2bfloat16(o[d0][r]*rli[r]);}
    asm volatile("s_waitcnt lgkmcnt(0)":::"memory");
    #pragma unroll
    for(int i=0;i<4;++i){const int row=i*8+(lane>>3),ch=lane&7; const u32x4 v=*(const u32x4*)(stg+row*64+ch*8); ATTN_STORE16(Ow+(long)row*OP+ch*8,v);} }
  asm volatile("s_waitcnt lgkmcnt(0)\n\ts_barrier":::"memory");
  #undef DMA_K
  #undef DMA_V
  #undef CMASK
  #undef START
  #undef RESC
  #undef ROT
}
constexpr int ATTN_LDS_BYTES=LDS_BYTES;
struct AttnTensors { const bf16* Q; const bf16* K; const bf16* V; bf16* O; };
struct AttnUnit { int b, h, qb; };
struct StaticOrder {
  int vcu;
  __device__ __forceinline__ explicit StaticOrder(int grid,int block):vcu((block%8)*(grid/8)+block/8){}
  __device__ __forceinline__ bool next(int i,AttnUnit&u)const{ const int p=8*i+(vcu>>5); if(p>=32)return false; const int w=vcu&31; u.b=p>>1; u.h=(p&1)*4+(w>>3); u.qb=w&7; return true; }
};
template<class Sched,int THRL=8> __device__ __forceinline__ void attn_phase(char*lds,const AttnTensors&T,const Sched&S){
  AttnUnit u;
  for(int i=0;S.next(i,u);++i){ attn_unit<THRL>(u.b,u.h,u.qb,T.Q,T.K,T.V,T.O,lds,64.0f); }
}
#undef SBAR
#undef WAIT_BAR
}

namespace ret {
typedef short bf16x8 __attribute__((ext_vector_type(8)));
typedef short s16x4 __attribute__((ext_vector_type(4)));
typedef float f32x16 __attribute__((ext_vector_type(16)));
constexpr int VP = 160, KPT = 48;
constexpr int VB = 128 * VP * 2, KB = 128 * KPT * 2, BUF = VB + KB;
__device__ __forceinline__ int crow(int r, int hi) { return (r & 3) + 8 * (r >> 2) + 4 * hi; }
__device__ __forceinline__ s16x4 trd(const LAS unsigned char* p) { return __builtin_bit_cast(s16x4, __builtin_amdgcn_ds_read_tr16_b64_v4i16((LAS s16x4*)p)); }
__device__ __forceinline__ bf16x8 cat(s16x4 a, s16x4 b) { return (bf16x8){a[0], a[1], a[2], a[3], b[0], b[1], b[2], b[3]}; }
__device__ __forceinline__ v4u scale8(v4u w, float s) {
    v4u o; o.x = pk2(bflo(w.x) * s, bfhi(w.x) * s); o.y = pk2(bflo(w.y) * s, bfhi(w.y) * s); o.z = pk2(bflo(w.z) * s, bfhi(w.z) * s); o.w = pk2(bflo(w.w) * s, bfhi(w.w) * s); return o;
}
constexpr int RAP = 96, RAB = 128 * RAP * 2, RABUF = 2 * RAB;
__device__ __forceinline__ void state_unit(int b, int h, int dir, int dvh, const bf16_t* RK, const bf16_t* RV, bf16_t* ST, float lg2, LAS unsigned char* lds) {
    const int tid = threadIdx.x, lane = tid & 63, wid = __builtin_amdgcn_readfirstlane(tid >> 6), r32 = lane & 31, hi = lane >> 5, dvt = wid & 1, dkt = (wid >> 1) & 1;
    const float g128 = exp2f(lg2 * 128.0f);
    const int prow = tid >> 3, pc8 = tid & 7;
    const float kw0 = dir ? exp2f(lg2 * (float)prow) : exp2f(lg2 * (float)(127 - prow)), kw1 = dir ? exp2f(lg2 * (float)(prow + 64)) : exp2f(lg2 * (float)(63 - prow));
    v4u vreg[2], kreg[2];
    auto chunk_of = [&](int s) { return dir ? (s == 0 ? 1 : (s == 1 ? 0 : 19 - s)) : s; };
    auto load = [&](int s) {
        const size_t urow = (size_t)b * SU + (size_t)chunk_of(s) * 128;
#pragma unroll
        for (int i = 0; i < 2; ++i) { vreg[i] = *(const v4u*)(RV + (urow + prow + 64 * i) * 512 + h * 128 + dvh * 64 + pc8 * 8); kreg[i] = *(const v4u*)(RK + (urow + prow + 64 * i) * 256 + h * 64 + pc8 * 8); }
    };
    load(0);
    f32x16 acc = {};
    const int gq = lane >> 4, colblk = gq & 1, q4 = (lane >> 2) & 3, p4 = lane & 3;
    for (int s = 0; s < 18; ++s) {
        LAS unsigned char* buf = lds + (s & 1) * RABUF;
#pragma unroll
        for (int i = 0; i < 2; ++i) { *(LAS v4u*)(buf + (prow + 64 * i) * (RAP * 2) + pc8 * 16) = vreg[i]; *(LAS v4u*)(buf + RAB + (prow + 64 * i) * (RAP * 2) + pc8 * 16) = scale8(kreg[i], i ? kw1 : kw0); }
        __syncthreads();
        if (s + 1 < 18) load(s + 1);
        if (wid < 4) {
            if (s >= 2) {
                const int n = dir ? 17 - s : s - 2;
                bf16_t* st = ST + ((((size_t)b * 4 + h) * 2 + dir) * 16 + n) * (128 * 64) + dkt * 32 + r32;
#pragma unroll
                for (int r = 0; r < 16; ++r) st[(size_t)(64 * dvh + 32 * dvt + crow(r, hi)) * 64] = (bf16_t)f2bf(acc[r]);
            }
            if (s < 17) {
#pragma unroll
                for (int r = 0; r < 16; ++r) acc[r] *= g128;
                const LAS unsigned char* va = buf + (8 * hi + q4) * (RAP * 2) + (32 * dvt + 16 * colblk + 4 * p4) * 2;
                const LAS unsigned char* ka = buf + RAB + (8 * hi + q4) * (RAP * 2) + (32 * dkt + 16 * colblk + 4 * p4) * 2;
#pragma unroll
                for (int ks = 0; ks < 8; ++ks) {
                    const bf16x8 af = cat(trd(va + ks * 16 * RAP * 2), trd(va + (ks * 16 + 4) * RAP * 2));
                    const bf16x8 bfm = cat(trd(ka + ks * 16 * RAP * 2), trd(ka + (ks * 16 + 4) * RAP * 2));
                    acc = __builtin_amdgcn_mfma_f32_32x32x16_bf16(af, bfm, acc, 0, 0, 0);
                }
            }
        }
    }
    __syncthreads();
}
constexpr int QP2 = 72, GP2 = 136;
constexpr int OFF_Q = VB, OFF_K = OFF_Q + 128 * QP2 * 2, OFF_G = OFF_K + 128 * QP2 * 2, OFF_RED = OFF_G + 128 * GP2 * 2;
constexpr int OFF_XCH = OFF_RED + 2048;
struct OutRegs { v4u vv[4], qq[2], kk[2]; };
__device__ __forceinline__ void out_load(OutRegs& R, int u, const bf16_t* RQ, const bf16_t* RK, const bf16_t* RV, const bf16_t* RG) {
    const int tid = threadIdx.x, n = u & 15, h = (u >> 4) & 3, b = u >> 6;
    const size_t m0 = (size_t)b * SEQ + 128 * n, u0 = (size_t)b * SU + CTX + 128 * n;
#pragma unroll
    for (int i = 0; i < 4; ++i) { const int pc = tid + 512 * i; R.vv[i] = *(const v4u*)(RV + (u0 + (pc >> 4)) * 512 + h * 128 + (pc & 15) * 8); }
#pragma unroll
    for (int i = 0; i < 2; ++i) { const int pc = tid + 512 * i; R.qq[i] = *(const v4u*)(RQ + (m0 + (pc >> 3)) * 256 + h * 64 + (pc & 7) * 8); R.kk[i] = *(const v4u*)(RK + (u0 + (pc >> 3)) * 256 + h * 64 + (pc & 7) * 8); }
}
__device__ __forceinline__ void out_unit(OutRegs& R, int u, int unext, const bf16_t* RQ, const bf16_t* RK, const bf16_t* RV, const bf16_t* RG, const bf16_t* ST, const float* gng, const float* gnb, const float* ldf, const float* ldb, bf16_t* MIX, LAS unsigned char* lds) {
    const int n = u & 15, h = (u >> 4) & 3, b = u >> 6; const float lgf = ldf[h] * 1.4426950408889634f, lgb = ldb[h] * 1.4426950408889634f;
    const int tid = threadIdx.x, lane = tid & 63, wid = __builtin_amdgcn_readfirstlane(tid >> 6), r32 = lane & 31, hi = lane >> 5, rg = wid & 3, dvh = wid >> 2;
    const size_t m0 = (size_t)b * SEQ + 128 * n, u0 = (size_t)b * SU + CTX + 128 * n;
    LAS float* red = (LAS float*)(lds + OFF_RED);
    {
        __syncthreads();
#pragma unroll
        for (int i = 0; i < 4; ++i) { const int pc = tid + 512 * i; *(LAS v4u*)(lds + (pc >> 4) * (VP * 2) + (pc & 15) * 16) = R.vv[i]; }
#pragma unroll
        for (int i = 0; i < 2; ++i) { const int pc = tid + 512 * i; *(LAS v4u*)(lds + OFF_Q + (pc >> 3) * (QP2 * 2) + (pc & 7) * 16) = R.qq[i]; *(LAS v4u*)(lds + OFF_K + (pc >> 3) * (QP2 * 2) + (pc & 7) * 16) = R.kk[i]; }
    }
    __syncthreads();
    out_load(R, unext >= 0 ? unext : u, RQ, RK, RV, RG);
    bf16x8 qf[4];
#pragma unroll
    for (int ks = 0; ks < 4; ++ks) qf[ks] = *(const LAS bf16x8*)(lds + OFF_Q + (32 * rg + r32) * (QP2 * 2) + (16 * ks + 8 * hi) * 2);
    const int c = 32 * rg + r32; const float cf4 = (float)(c - 4 * hi), nlgb = -lgb;
    LAS unsigned char* xch = lds + OFF_XCH + rg * 8192 + lane * 16;
#pragma unroll
    for (int kk = 0; kk < 2; ++kk) { const int kt = 2 * dvh + kk; f32x16 st = (f32x16){};
#pragma unroll
        for (int ks = 0; ks < 4; ++ks) { const bf16x8 kf = *(const LAS bf16x8*)(lds + OFF_K + (32 * kt + r32) * (QP2 * 2) + (16 * ks + 8 * hi) * 2); st = __builtin_amdgcn_mfma_f32_32x32x16_bf16(kf, qf[ks], st, 0, 0, 0); }
        const float cfk = cf4 - (float)(32 * kt);
#pragma unroll
        for (int r = 0; r < 16; ++r) { const float df = cfk - (float)crow(r, 0);
            float w = __builtin_amdgcn_exp2f((df > 0.0f ? lgf : nlgb) * df); w = (df == 0.0f) ? 2.0f : w; st[r] *= w; }
#pragma unroll
        for (int s2 = 0; s2 < 2; ++s2) { v4u w; w.x = pk2(st[8 * s2], st[8 * s2 + 1]); w.y = pk2(st[8 * s2 + 2], st[8 * s2 + 3]); w.z = pk2(st[8 * s2 + 4], st[8 * s2 + 5]); w.w = pk2(st[8 * s2 + 6], st[8 * s2 + 7]);
            *(LAS v4u*)(xch + (kt * 2 + s2) * 1024) = w; }
    }
    __syncthreads();
    bf16x8 pa[4][2];
#pragma unroll
    for (int kt = 0; kt < 4; ++kt)
#pragma unroll
        for (int s2 = 0; s2 < 2; ++s2) pa[kt][s2] = *(const LAS bf16x8*)(xch + (kt * 2 + s2) * 1024);
    asm volatile("" ::: "memory");
    v4u gg[4];
#pragma unroll
    for (int i = 0; i < 4; ++i) { const int pc = tid + 512 * i; gg[i] = *(const v4u*)(RG + (m0 + (pc >> 4)) * 512 + h * 128 + (pc & 15) * 8); }
    f32x16 ot[2] = {(f32x16){}, (f32x16){}};
    const int gq = lane >> 4, colblk = gq & 1, q4 = (lane >> 2) & 3, p4 = lane & 3;
#pragma unroll
    for (int dt = 0; dt < 2; ++dt) {
        const LAS unsigned char* va = lds + (4 * hi + q4) * (VP * 2) + (64 * dvh + 32 * dt + 16 * colblk + 4 * p4) * 2;
#pragma unroll
        for (int kt = 0; kt < 4; ++kt)
#pragma unroll
            for (int s2 = 0; s2 < 2; ++s2) { const int kb = 32 * kt + 16 * s2; const bf16x8 vf = cat(trd(va + kb * VP * 2), trd(va + (kb + 8) * VP * 2)); ot[dt] = __builtin_amdgcn_mfma_f32_32x32x16_bf16(vf, pa[kt][s2], ot[dt], 0, 0, 0); }
    }
    {
        const float decf = __builtin_amdgcn_exp2f(lgf * (float)(c + 1)), decb = __builtin_amdgcn_exp2f(lgb * (float)(128 - c));
        const bf16_t* sf = ST + ((((size_t)b * 4 + h) * 2 + 0) * 16 + n) * (128 * 64); const bf16_t* sb = sf + (size_t)16 * 128 * 64;
#pragma unroll
        for (int ks = 0; ks < 4; ++ks) {
            const v4u qw = __builtin_bit_cast(v4u, qf[ks]); const bf16x8 qdf = __builtin_bit_cast(bf16x8, scale8(qw, decf)), qdb = __builtin_bit_cast(bf16x8, scale8(qw, decb));
#pragma unroll
            for (int dt = 0; dt < 2; ++dt) { const size_t so = (size_t)(64 * dvh + 32 * dt + r32) * 64 + 16 * ks + 8 * hi;
                ot[dt] = __builtin_amdgcn_mfma_f32_32x32x16_bf16(*(const bf16x8*)(sf + so), qdf, ot[dt], 0, 0, 0);
                ot[dt] = __builtin_amdgcn_mfma_f32_32x32x16_bf16(*(const bf16x8*)(sb + so), qdb, ot[dt], 0, 0, 0); }
        }
    }
#pragma unroll
    for (int i = 0; i < 4; ++i) { const int pc = tid + 512 * i; *(LAS v4u*)(lds + OFF_G + (pc >> 4) * (GP2 * 2) + (pc & 15) * 16) = gg[i]; }
    float s1 = 0.f;
#pragma unroll
    for (int dt = 0; dt < 2; ++dt)
#pragma unroll
        for (int r = 0; r < 16; ++r) s1 += ot[dt][r];
    const float mw = xor32_sum(s1) * (1.0f / 64.0f);
    float s2 = 0.f;
#pragma unroll
    for (int dt = 0; dt < 2; ++dt)
#pragma unroll
        for (int r = 0; r < 16; ++r) { const float d = ot[dt][r] - mw; s2 = fmaf(d, d, s2); }
    s2 = xor32_sum(s2);
    if (hi == 0) { red[wid * 32 + r32] = mw; red[256 + wid * 32 + r32] = s2; }
    __syncthreads();
    const float mo = red[(wid ^ 4) * 32 + r32], mu = 0.5f * (mw + mo);
    const float rs = __builtin_amdgcn_rsqf((s2 + red[256 + (wid ^ 4) * 32 + r32] + 32.0f * (mw - mo) * (mw - mo)) * (1.0f / 128.0f) + LN_EPS);
    LAS unsigned char* grow = lds + OFF_G + (32 * rg + r32) * (GP2 * 2);
#pragma unroll
    for (int dt = 0; dt < 2; ++dt)
#pragma unroll
        for (int rq = 0; rq < 4; ++rq) {
            const int dv = 64 * dvh + 32 * dt + 8 * rq + 4 * hi;
            const f32x4 gg = *(const f32x4*)(gng + h * 128 + dv), gb = *(const f32x4*)(gnb + h * 128 + dv);
            const v2u gw = *(const LAS v2u*)(grow + dv * 2);
            const float g0 = bflo(gw.x), g1 = bfhi(gw.x), g2 = bflo(gw.y), g3 = bfhi(gw.y);
            const float y0 = ((ot[dt][4 * rq] - mu) * rs * gg[0] + gb[0]) * (g0 * __builtin_amdgcn_rcpf(1.0f + __builtin_amdgcn_exp2f(-1.4426950408889634f * g0)));
            const float y1 = ((ot[dt][4 * rq + 1] - mu) * rs * gg[1] + gb[1]) * (g1 * __builtin_amdgcn_rcpf(1.0f + __builtin_amdgcn_exp2f(-1.4426950408889634f * g1)));
            const float y2 = ((ot[dt][4 * rq + 2] - mu) * rs * gg[2] + gb[2]) * (g2 * __builtin_amdgcn_rcpf(1.0f + __builtin_amdgcn_exp2f(-1.4426950408889634f * g2)));
            const float y3 = ((ot[dt][4 * rq + 3] - mu) * rs * gg[3] + gb[3]) * (g3 * __builtin_amdgcn_rcpf(1.0f + __builtin_amdgcn_exp2f(-1.4426950408889634f * g3)));
            v2u w; w.x = pk2(y0, y1); w.y = pk2(y2, y3);
            *(LAS v2u*)(grow + dv * 2) = w;
        }
    __syncthreads();
#pragma unroll
    for (int i = 0; i < 4; ++i) { const int pc = tid + 512 * i; *(v4u*)(MIX + (m0 + (pc >> 4)) * DM + h * 128 + (pc & 15) * 8) = *(const LAS v4u*)(lds + OFF_G + (pc >> 4) * (GP2 * 2) + (pc & 15) * 16); }
}
}

struct Args {
    const float* in[26]; float* out; unsigned char* ws; int ph_lo, ph_hi, li, pad;
};
enum { I_X = 0, I_C, I_CTX, I_CCTX, I_LNING, I_LNINB, I_WADA, I_BADA, I_WIN, I_LDF, I_LDB, I_GNG, I_GNB, I_QNG, I_KNG, I_WO, I_LN1G, I_LN1B, I_RW, I_RB, I_WUP, I_BUP, I_WDN, I_BDN, I_LN2G, I_LN2B };

struct Frame {
    LAS unsigned char* lds;
    unsigned* ctl;
    int tid, lane, wave, G, gtid, nthreads, gw, ngw;
};

constexpr int LDS_BYTES = 149504, MISC_OFF = LDS_BYTES - 1024;

__device__ __forceinline__ int phys_in(int lc) { const int pn = lc >> 8, wc = (lc >> 6) & 3, d = lc & 63; const int blk = d >> 5, bj = (d >> 4) & 1, f1 = (d >> 3) & 1, n = (d >> 2) & 1, j = d & 3;
    return pn * 256 + 128 * bj + 32 * wc + 16 * n + 4 * (2 * blk + f1) + j; }
__device__ __forceinline__ int phys_up(int c) { return 256 * ((c & 1023) >> 7) + 128 * (c >> 10) + (c & 127); }
__device__ __forceinline__ int phys_dn(int c) { const int cc = c & 255; return (c & ~255) + 128 * ((cc >> 3) & 1) + 32 * (cc >> 6) + 8 * ((cc >> 4) & 3) + (cc & 7); }

__device__ __forceinline__ void transpose_load(f32x4 (&v)[16], const float* W, int K, int N, int item, int lane) {
    const int nkb = K / 64, kb = item % nkb, nb = item / nkb, k0 = 64 * kb, n0 = 64 * nb;
    const float* src = W + (size_t)(k0 + (lane >> 4)) * N + n0 + (lane & 15) * 4;
#pragma unroll
    for (int i = 0; i < 16; ++i) v[i] = __builtin_nontemporal_load((const f32x4*)(src + (size_t)(4 * i) * N));
}
__device__ __forceinline__ void transpose_write(const f32x4 (&v)[16], LAS float* scr, int lane) {
#pragma unroll
    for (int i = 0; i < 16; ++i) { LAS float* d = scr + (4 * i + (lane >> 4)) * 65 + (lane & 15) * 4; d[0] = v[i][0]; d[1] = v[i][1]; d[2] = v[i][2]; d[3] = v[i][3]; }
    asm volatile("s_waitcnt lgkmcnt(0)" ::: "memory");
}
template <int MAP, bool F8> __device__ __forceinline__ void transpose_out(int K, void* WT, LAS float* scr, int item, int lane) {
    const int nkb = K / 64, kb = item % nkb, nb = item / nkb, k0 = 64 * kb, n0 = 64 * nb;
    const int c = lane & 7;
#pragma unroll
    for (int j = 0; j < 8; ++j) { const int n = (lane >> 3) + 8 * j; const LAS float* s = scr + (8 * c) * 65 + n;
        const int ln = n0 + n; const int pr = MAP == 1 ? phys_in(ln) : (MAP == 2 ? phys_up(ln) : ln);
        if constexpr (F8) { v2u q; q.x = 0u; q.y = 0u;
            q.x = __builtin_amdgcn_cvt_pk_fp8_f32(64.f * s[0 * 65], 64.f * s[1 * 65], q.x, false); q.x = __builtin_amdgcn_cvt_pk_fp8_f32(64.f * s[2 * 65], 64.f * s[3 * 65], q.x, true);
            q.y = __builtin_amdgcn_cvt_pk_fp8_f32(64.f * s[4 * 65], 64.f * s[5 * 65], q.y, false); q.y = __builtin_amdgcn_cvt_pk_fp8_f32(64.f * s[6 * 65], 64.f * s[7 * 65], q.y, true);
            *(v2u*)((unsigned char*)WT + (size_t)pr * K + k0 + 8 * c) = q; }
        else { v4u o; o.x = pk2(s[0 * 65], s[1 * 65]); o.y = pk2(s[2 * 65], s[3 * 65]); o.z = pk2(s[4 * 65], s[5 * 65]); o.w = pk2(s[6 * 65], s[7 * 65]);
            *(v4u*)((bf16_t*)WT + (size_t)pr * K + k0 + 8 * c) = o; } }
    asm volatile("s_waitcnt lgkmcnt(0)" ::: "memory");
}
__device__ __forceinline__ void transpose8_write(const f32x4 (&v)[16], LAS unsigned* T, int lane) {
#pragma unroll
    for (int i = 0; i < 16; ++i) { unsigned w = 0u; w = __builtin_amdgcn_cvt_pk_fp8_f32(64.f * v[i][0], 64.f * v[i][1], w, false); w = __builtin_amdgcn_cvt_pk_fp8_f32(64.f * v[i][2], 64.f * v[i][3], w, true);
        T[(4 * i + (lane >> 4)) * 17 + (lane & 15)] = w; }
    asm volatile("s_waitcnt lgkmcnt(0)" ::: "memory");
}
template <int MAP> __device__ __forceinline__ void transpose8_out(int K, unsigned char* WT, const LAS unsigned* T, int item, int lane) {
    const int nkb = K / 64, kb = item % nkb, nb = item / nkb, k0 = 64 * kb, n0 = 64 * nb;
    const int c = lane & 7, ng2 = lane >> 3;
#pragma unroll
    for (int j = 0; j < 2; ++j) { const int ng = ng2 + 8 * j; unsigned d[8];
#pragma unroll
        for (int i = 0; i < 8; ++i) d[i] = T[(8 * c + i) * 17 + ng];
        unsigned r[2][4];
#pragma unroll
        for (int h = 0; h < 2; ++h) { const unsigned d0 = d[4 * h], d1 = d[4 * h + 1], d2 = d[4 * h + 2], d3 = d[4 * h + 3];
            const unsigned t0 = __builtin_amdgcn_perm(d1, d0, 0x05010400u), t1 = __builtin_amdgcn_perm(d1, d0, 0x07030602u), t2 = __builtin_amdgcn_perm(d3, d2, 0x05010400u), t3 = __builtin_amdgcn_perm(d3, d2, 0x07030602u);
            r[h][0] = __builtin_amdgcn_perm(t2, t0, 0x05040100u); r[h][1] = __builtin_amdgcn_perm(t2, t0, 0x07060302u); r[h][2] = __builtin_amdgcn_perm(t3, t1, 0x05040100u); r[h][3] = __builtin_amdgcn_perm(t3, t1, 0x07060302u); }
#pragma unroll
        for (int q = 0; q < 4; ++q) { const int ln = n0 + 4 * ng + q; const int pr = MAP == 2 ? phys_up(ln) : (MAP == 3 ? phys_dn(ln) : ln); v2u o; o.x = r[0][q]; o.y = r[1][q];
            *(v2u*)(WT + (size_t)pr * K + k0 + 8 * c) = o; } }
    asm volatile("s_waitcnt lgkmcnt(0)" ::: "memory");
}
template <int MAP, bool F8> __device__ __forceinline__ void transpose_item(const float* W, int K, int N, void* WT, LAS float* scr, int item, int lane) {
    f32x4 v[16]; transpose_load(v, W, K, N, item, lane); transpose_write(v, scr, lane); transpose_out<MAP, F8>(K, WT, scr, item, lane);
}

__device__ __forceinline__ void p0_prologue(const Args& a, Frame& F) {
    unsigned char* ws = a.ws;
    float* ADA = (float*)(ws + WS_ADA); float* ROPE = (float*)(ws + WS_ROPE);
    const int sg = (F.G == 256) ? F.gtid - 192 * NTHR : F.gtid, sn = (F.G == 256) ? 64 * NTHR : F.nthreads;
    if (sg >= 0) for (int idx = sg; idx < 64 * 16; idx += sn) {
        const int pos = idx >> 4, i = idx & 15;
        const float inv = exp2f(-(float)i * (13.287712379549449f / 16.0f));
        const float ang = (float)pos * inv;
        ROPE[idx * 2] = cosf(ang); ROPE[idx * 2 + 1] = sinf(ang);
    }
    { bf16_t* RWT = (bf16_t*)(ws + WS_RWT);
      if (sg >= 0) for (int idx = sg; idx < 32 * 1024; idx += sn) { const int e = idx >> 10, k = idx & 1023; const float w = a.in[I_RW][k * 32 + e]; const unsigned hi = f2bf(w); RWT[idx] = (bf16_t)hi; RWT[32768 + idx] = (bf16_t)f2bf(w - bf2f(hi)); } }
    for (int tile = blockIdx.x; tile < 192; tile += F.G) {
        LAS float* SL = (LAS float*)F.lds;
        LAS float* PT = (LAS float*)(F.lds + 17 * 4096);
        const int col = F.lane & 31, kh = F.lane >> 5; const float* w = a.in[I_WADA]; const int k0 = F.wave * 128 + 64 * kh;
        unsigned wo = (unsigned)k0 * 6144u + (unsigned)(tile * 32 + col); asm volatile("" : "+v"(wo));
        const float bias_c = a.in[I_BADA][tile * 32 + (F.tid & 31)];
        float wv[64];
#pragma unroll
        for (int q = 0; q < 64; ++q) wv[q] = __builtin_nontemporal_load(w + (wo + (unsigned)q * 6144u));
        {
            float sv[34];
#pragma unroll
            for (int j = 0; j < 34; ++j) { const int k = (F.tid + NTHR * j) & 1023; sv[j] = (j < 32) ? a.in[I_C][(j >> 1) * 1024 + k] : a.in[I_CCTX][k]; }
#pragma unroll
            for (int j = 0; j < 34; ++j) SL[F.tid + NTHR * j] = sv[j] / (1.0f + __expf(-sv[j]));
        }
        __syncthreads();
        float acc[17];
#pragma unroll
        for (int r = 0; r < 17; ++r) acc[r] = 0.f;
#pragma unroll
        for (int k4 = 0; k4 < 64; k4 += 4) {
#pragma unroll
            for (int r = 0; r < 17; ++r) { const f32x4 s4 = *(const LAS f32x4*)(SL + r * 1024 + k0 + k4); acc[r] = fmaf(s4[0], wv[k4], acc[r]); acc[r] = fmaf(s4[1], wv[k4 + 1], acc[r]); acc[r] = fmaf(s4[2], wv[k4 + 2], acc[r]); acc[r] = fmaf(s4[3], wv[k4 + 3], acc[r]); }
            asm volatile("" : "+v"(acc[0]), "+v"(acc[1]), "+v"(acc[2]), "+v"(acc[3]), "+v"(acc[4]), "+v"(acc[5]), "+v"(acc[6]), "+v"(acc[7]), "+v"(acc[8]), "+v"(acc[9]), "+v"(acc[10]), "+v"(acc[11]), "+v"(acc[12]), "+v"(acc[13]), "+v"(acc[14]), "+v"(acc[15]), "+v"(acc[16]) :: "memory");
        }
#pragma unroll
        for (int r = 0; r < 17; ++r) { acc[r] = xor32_sum(acc[r]); if (kh == 0) PT[(F.wave * 17 + r) * 32 + col] = acc[r]; }
        __syncthreads();
        for (int i = F.tid; i < 17 * 32; i += NTHR) { const int r = i >> 5, c = i & 31; float s = bias_c;
#pragma unroll
            for (int wq = 0; wq < 8; ++wq) s += PT[(wq * 17 + r) * 32 + c];
            ADA[r * 6144 + tile * 32 + c] = s; }
        __syncthreads();
    }
    LAS float* scr = (LAS float*)(F.lds + F.wave * 16640);
    constexpr int I_IN = 16 * (NIN / 64), I_O = 16 * 16;
    const int tw = (F.G == 256) ? ((int)blockIdx.x - 192) * NWAVES + F.wave : F.gw, tn = (F.G == 256) ? 64 * NWAVES : F.ngw;
    if (tw >= 0) for (int it = tw; it < I_IN + I_O; it += tn) {
        if (it < I_IN) transpose_item<1, false>(a.in[I_WIN], 1024, NIN, ws + WS_WIN, scr, it, F.lane);
        else transpose_item<0, false>(a.in[I_WO], 1024, 1024, ws + WS_WO, scr, it - I_IN, F.lane);
    }
}
__device__ __forceinline__ void xd_issue(const float* W, int N, int item, int lane, LAS unsigned char* buf) {
    const int kb = item & 15, nb = item >> 4, r = lane >> 4, p = lane & 15;
    const float* base = W + (size_t)(64 * kb + r) * N + 64 * nb;
#pragma unroll
    for (int g = 0; g < 16; ++g)
        __builtin_amdgcn_global_load_lds((const unsigned*)(base + (size_t)(4 * g) * N + 4 * (p ^ (g >> 1))), (LAS unsigned*)(buf + g * 1024), 16, 0, 2);
}
__device__ __forceinline__ void xd_read(float (&v)[8][8], const LAS unsigned char* buf, int lane) {
    const int c = lane & 7, ns = lane >> 3;
#pragma unroll
    for (int j = 0; j < 8; ++j) { const int n = ns + 8 * j; const LAS float* s = (const LAS float*)(buf + c * 2048 + ((((n >> 2) ^ c) & 15) << 4) + 4 * (n & 3));
#pragma unroll
        for (int i = 0; i < 8; ++i) v[j][i] = s[i * 64]; }
    asm volatile("s_waitcnt lgkmcnt(0)" ::: "memory");
}
template <int MAP> __device__ __forceinline__ void xd_store(const float (&v)[8][8], unsigned char* WT, int item, int lane) {
    const int kb = item & 15, nb = item >> 4, c = lane & 7, ns = lane >> 3;
    const float sc = (MAP == 2) ? (nb < 16 ? 64.f * SWK : 64.f / SWK) : 64.f;
#pragma unroll
    for (int j = 0; j < 8; ++j) { const int n = ns + 8 * j;
        v2u o; o.x = 0u; o.y = 0u;
        o.x = __builtin_amdgcn_cvt_pk_fp8_f32(sc * v[j][0], sc * v[j][1], o.x, false); o.x = __builtin_amdgcn_cvt_pk_fp8_f32(sc * v[j][2], sc * v[j][3], o.x, true);
        o.y = __builtin_amdgcn_cvt_pk_fp8_f32(sc * v[j][4], sc * v[j][5], o.y, false); o.y = __builtin_amdgcn_cvt_pk_fp8_f32(sc * v[j][6], sc * v[j][7], o.y, true);
        const int ln = 64 * nb + n; const int pr = MAP == 2 ? phys_up(ln) : phys_dn(ln);
        *(v2u*)(WT + (size_t)pr * 1024 + 64 * kb + 8 * c) = o; }
}
__device__ __forceinline__ void moe_weights_convert(const Args& a, Frame& F, int first, int last, int wi, int nw) {
    unsigned char* ws = a.ws;
    LAS unsigned char* buf = F.lds + F.wave * 16384;
    constexpr int I_UP = 16 * 32, I_DN = 16 * 16, NIT = NEXP * (I_UP + I_DN);
    { int _l = F.lane; asm volatile("" : "+v"(_l)); F.lane = _l; }
#define XD_ISSUE(it_) do { const int _it = (it_); if (_it < NEXP * I_UP) { const int e = _it / I_UP; xd_issue(a.in[I_WUP] + (size_t)e * 1024 * 2048, 2048, _it % I_UP, F.lane, buf); } \
        else { const int r = _it - NEXP * I_UP, e = r / I_DN; xd_issue(a.in[I_WDN] + (size_t)e * 1024 * 1024, 1024, r % I_DN, F.lane, buf); } } while (0)
    if (first + wi >= last) return;
    XD_ISSUE(first + wi);
#pragma unroll 1
    for (int it = first + wi; it < last; it += nw) {
        float v[8][8];
        asm volatile("s_waitcnt vmcnt(0)" ::: "memory");
        xd_read(v, buf, F.lane);
        if (it + nw < last) XD_ISSUE(it + nw);
        if (it < NEXP * I_UP) { const int e = it / I_UP; xd_store<2>(v, ws + WS_WUP + (size_t)e * 2048 * 1024, it % I_UP, F.lane); }
        else { const int r = it - NEXP * I_UP, e = r / I_DN; xd_store<3>(v, ws + WS_WDN + (size_t)e * 1024 * 1024, r % I_DN, F.lane); }
    }
#undef XD_ISSUE
}

__device__ __forceinline__ void p1_ln_mod(const Args& a, Frame& F) {
    unsigned char* ws = a.ws;
    const float* ADA = (const float*)(ws + WS_ADA); float* STATS = (float*)(ws + WS_STATS); bf16_t* H = (bf16_t*)(ws + WS_H);
    const int rpw = (NROW + F.ngw - 1) / F.ngw, u0 = F.gw * rpw, u1 = (u0 + rpw < NROW) ? u0 + rpw : NROW;
    auto rowsrc = [&](int u) { const int b = u / SU, p = u % SU; return (const f32x4*)(p < CTX ? a.in[I_CTX] + ((size_t)b * CTX + p) * DM : a.in[I_X] + ((size_t)b * SEQ + (p - CTX)) * DM) + F.lane; };
    f32x4 vn[4], vm[4], G[4], Bv[4]; int kind = -1;
    if (u0 < u1) { const f32x4* xr = rowsrc(u0);
#pragma unroll
        for (int j = 0; j < 4; ++j) vn[j] = __builtin_nontemporal_load(xr + 64 * j); }
    if (u0 + 1 < u1) { const f32x4* xr = rowsrc(u0 + 1);
#pragma unroll
        for (int j = 0; j < 4; ++j) vm[j] = __builtin_nontemporal_load(xr + 64 * j); }
    for (int u = u0; u < u1; ++u) {
        const int b = u / SU, p = u % SU, kd = p < CTX ? 16 : b;
        if (kd != kind) { kind = kd; const float* ad = ADA + kd * 6144;
#pragma unroll
            for (int j = 0; j < 4; ++j) { const f32x4 g = ((const f32x4*)a.in[I_LNING] + F.lane)[64 * j], bb = ((const f32x4*)a.in[I_LNINB] + F.lane)[64 * j], sh = ((const f32x4*)ad + F.lane)[64 * j], sc = ((const f32x4*)(ad + 1024) + F.lane)[64 * j] + 1.0f;
                G[j] = g * sc; Bv[j] = bb * sc + sh; } }
        f32x4 v[4]; float s = 0.f;
#pragma unroll
        for (int j = 0; j < 4; ++j) { v[j] = vn[j]; vn[j] = vm[j]; }
        if (u + 2 < u1) { const f32x4* xr = rowsrc(u + 2);
#pragma unroll
            for (int j = 0; j < 4; ++j) vm[j] = __builtin_nontemporal_load(xr + 64 * j); }
#pragma unroll
        for (int j = 0; j < 4; ++j) s += (v[j].x + v[j].y) + (v[j].z + v[j].w);
        const float mean = wave_sum(s) * (1.f / DM); float s2 = 0.f;
#pragma unroll
        for (int j = 0; j < 4; ++j) { v[j] = v[j] - mean; s2 += (v[j].x * v[j].x + v[j].y * v[j].y) + (v[j].z * v[j].z + v[j].w * v[j].w); }
        const float rstd = 1.f / sqrtf(wave_sum(s2) * (1.f / DM) + LN_EPS);
        v2u* o8 = (v2u*)(H + (size_t)u * DM) + F.lane;
#pragma unroll
        for (int j = 0; j < 4; ++j) { const f32x4 h = v[j] * rstd * G[j] + Bv[j]; v2u w; w.x = pk2(h.x, h.y); w.y = pk2(h.z, h.w); o8[64 * j] = w; }
        if (p >= CTX && F.lane == 0) { const int m = b * SEQ + (p - CTX); STATS[2 * m] = mean; STATS[2 * m + 1] = rstd; }
    }
}

__device__ __forceinline__ void store64(bf16_t* dst, const float (&v)[64]) {
#pragma unroll
    for (int q = 0; q < 8; ++q) { v4u w; w.x = pk2(v[8 * q], v[8 * q + 1]); w.y = pk2(v[8 * q + 2], v[8 * q + 3]); w.z = pk2(v[8 * q + 4], v[8 * q + 5]); w.w = pk2(v[8 * q + 6], v[8 * q + 7]); *(v4u*)(dst + 8 * q) = w; }
}
__device__ __forceinline__ void rope64(float (&v)[64], const float* ROPE, int t) {
    const float* rr = ROPE + (t >> 6) * 32; const float* rc = ROPE + (t & 63) * 32;
#pragma unroll
    for (int i = 0; i < 16; ++i) {
        const float cr = rr[2 * i], sr = rr[2 * i + 1], cc = rc[2 * i], sc = rc[2 * i + 1];
        const float x1 = v[i], x2 = v[16 + i], x3 = v[32 + i], x4 = v[48 + i];
        v[i] = x1 * cr - x2 * sr; v[16 + i] = x2 * cr + x1 * sr; v[32 + i] = x3 * cc - x4 * sc; v[48 + i] = x4 * cc + x3 * sc;
    }
}
__device__ __forceinline__ void rms64(float (&v)[64], const float* g) {
    float ss = 0.f;
#pragma unroll
    for (int d = 0; d < 64; ++d) ss = fmaf(v[d], v[d], ss);
    const float r = 1.0f / sqrtf(ss * (1.0f / 64.0f) + LN_EPS);
#pragma unroll
    for (int d = 0; d < 64; ++d) v[d] = v[d] * r * g[d];
}
__device__ __forceinline__ void p3_attn_scalar(const Args& a, Frame& F) {
    unsigned char* ws = a.ws;
    const bf16_t* AQ = (const bf16_t*)(ws + WS_AQ); const bf16_t* AK = (const bf16_t*)(ws + WS_AK); const bf16_t* AV = (const bf16_t*)(ws + WS_AV); bf16_t* MIX = (bf16_t*)(ws + WS_MIX);
    for (int it = F.gtid; it < BATCH * 8 * SEQ; it += F.nthreads) {
        const int t = it % SEQ, h = (it / SEQ) % 8, b = it / (SEQ * 8); const int m = b * SEQ + t, hk = h >> 2;
        v4u q[8];
#pragma unroll
        for (int i = 0; i < 8; ++i) q[i] = *(const v4u*)(AQ + (size_t)m * 512 + h * 64 + 8 * i);
        float o[64];
#pragma unroll
        for (int d = 0; d < 64; ++d) o[d] = 0.f;
        float mr = -1e30f, l = 0.f;
        const bf16_t* kb = AK + (size_t)b * SU * 128 + hk * 64; const bf16_t* vb = AV + (size_t)b * SU * 128 + hk * 64;
        for (int j = 0; j < SU; ++j) {
            float s = 0.f;
#pragma unroll
            for (int i = 0; i < 8; ++i) s = dot8(q[i], *(const v4u*)(kb + (size_t)j * 128 + 8 * i), s);
            const float mn = fmaxf(mr, s), corr = exp2f(mr - mn), pe = exp2f(s - mn);
            l = l * corr + pe; mr = mn;
#pragma unroll
            for (int i = 0; i < 8; ++i) { const v4u vv = *(const v4u*)(vb + (size_t)j * 128 + 8 * i);
                o[8 * i + 0] = fmaf(pe, bflo(vv.x), o[8 * i + 0] * corr); o[8 * i + 1] = fmaf(pe, bfhi(vv.x), o[8 * i + 1] * corr);
                o[8 * i + 2] = fmaf(pe, bflo(vv.y), o[8 * i + 2] * corr); o[8 * i + 3] = fmaf(pe, bfhi(vv.y), o[8 * i + 3] * corr);
                o[8 * i + 4] = fmaf(pe, bflo(vv.z), o[8 * i + 4] * corr); o[8 * i + 5] = fmaf(pe, bfhi(vv.z), o[8 * i + 5] * corr);
                o[8 * i + 6] = fmaf(pe, bflo(vv.w), o[8 * i + 6] * corr); o[8 * i + 7] = fmaf(pe, bfhi(vv.w), o[8 * i + 7] * corr); }
        }
        const float rl = 1.0f / l;
#pragma unroll
        for (int d = 0; d < 64; ++d) o[d] *= rl;
        store64(MIX + (size_t)m * DM + 512 + h * 64, o);
    }
}
__device__ __forceinline__ void p3_ret_scalar(const Args& a, Frame& F) {
    unsigned char* ws = a.ws;
    const bf16_t* RQ = (const bf16_t*)(ws + WS_RQ); const bf16_t* RK = (const bf16_t*)(ws + WS_RK); const bf16_t* RV = (const bf16_t*)(ws + WS_RV); const bf16_t* RG = (const bf16_t*)(ws + WS_RG);
    bf16_t* MIX = (bf16_t*)(ws + WS_MIX); float* YRET = (float*)(ws + WS_YRET);
    for (int it = F.gtid; it < BATCH * 4 * SEQ; it += F.nthreads) {
        const int t = it % SEQ, h = (it / SEQ) % 4, b = it / (SEQ * 4); const int m = b * SEQ + t;
        const float lgf = a.in[I_LDF][h] * 1.4426950408889634f, lgb = a.in[I_LDB][h] * 1.4426950408889634f;
        v4u q[8];
#pragma unroll
        for (int i = 0; i < 8; ++i) q[i] = *(const v4u*)(RQ + (size_t)m * 256 + h * 64 + 8 * i);
        const bf16_t* kb = RK + (size_t)b * SU * 256 + h * 64; const bf16_t* vb = RV + (size_t)b * SU * 512 + h * 128;
        float* yr = YRET + ((size_t)m * 4 + h) * 128;
        for (int dq = 0; dq < 4; ++dq) {
            float acc[32];
#pragma unroll
            for (int e = 0; e < 32; ++e) acc[e] = 0.f;
            for (int j = 0; j < SU; ++j) {
                float s = 0.f;
#pragma unroll
                for (int i = 0; i < 8; ++i) s = dot8(q[i], *(const v4u*)(kb + (size_t)j * 256 + 8 * i), s);
                float w;
                if (j < CTX) w = exp2f(lgf * (float)(t + CTX - j)) + exp2f(lgb * (float)(SEQ - t + j));
                else { const int tj = j - CTX; w = tj < t ? exp2f(lgf * (float)(t - tj)) : (tj > t ? exp2f(lgb * (float)(tj - t)) : 2.0f); }
                s *= w;
#pragma unroll
                for (int i = 0; i < 4; ++i) { const v4u vv = *(const v4u*)(vb + (size_t)j * 512 + dq * 32 + 8 * i);
                    acc[8 * i + 0] = fmaf(s, bflo(vv.x), acc[8 * i + 0]); acc[8 * i + 1] = fmaf(s, bfhi(vv.x), acc[8 * i + 1]);
                    acc[8 * i + 2] = fmaf(s, bflo(vv.y), acc[8 * i + 2]); acc[8 * i + 3] = fmaf(s, bfhi(vv.y), acc[8 * i + 3]);
                    acc[8 * i + 4] = fmaf(s, bflo(vv.z), acc[8 * i + 4]); acc[8 * i + 5] = fmaf(s, bfhi(vv.z), acc[8 * i + 5]);
                    acc[8 * i + 6] = fmaf(s, bflo(vv.w), acc[8 * i + 6]); acc[8 * i + 7] = fmaf(s, bfhi(vv.w), acc[8 * i + 7]); }
            }
#pragma unroll
            for (int e = 0; e < 32; ++e) yr[dq * 32 + e] = acc[e];
        }
        asm volatile("s_waitcnt vmcnt(0)" ::: "memory");
        float s1 = 0.f;
        for (int e = 0; e < 128; ++e) s1 += yr[e];
        const float mu = s1 * (1.0f / 128.0f); float s2 = 0.f;
        for (int e = 0; e < 128; ++e) { const float d = yr[e] - mu; s2 = fmaf(d, d, s2); }
        const float rs = 1.0f / sqrtf(s2 * (1.0f / 128.0f) + LN_EPS);
        const float* gg = a.in[I_GNG] + h * 128; const float* gb = a.in[I_GNB] + h * 128;
        for (int e = 0; e < 128; e += 2) {
            const unsigned gw = *(const unsigned*)(RG + (size_t)m * 512 + h * 128 + e);
            const float g0 = bflo(gw), g1 = bfhi(gw);
            const float y0 = ((yr[e] - mu) * rs * gg[e] + gb[e]) * (g0 / (1.0f + __expf(-g0)));
            const float y1 = ((yr[e + 1] - mu) * rs * gg[e + 1] + gb[e + 1]) * (g1 / (1.0f + __expf(-g1)));
            *(unsigned*)(MIX + (size_t)m * DM + h * 128 + e) = pk2(y0, y1);
        }
    }
}

__device__ __forceinline__ void p6_ln1_route(const Args& a, Frame& F) {
    typedef short bf16x8 __attribute__((ext_vector_type(8)));
    unsigned char* ws = a.ws;
    const float* ADA = (const float*)(ws + WS_ADA); const float* STATS = (const float*)(ws + WS_STATS); const bf16_t* Y1 = (const bf16_t*)(ws + WS_Y1); const bf16_t* RWT = (const bf16_t*)(ws + WS_RWT);
    float* X1 = (float*)(ws + WS_X1); bf16_t* H2 = (bf16_t*)(ws + WS_H2); unsigned* CNT = F.ctl + CW_CNT; v2u* LIST = (v2u*)(ws + WS_LIST);
    constexpr int HP = 1032;
    LAS bf16_t* HSH = (LAS bf16_t*)F.lds; LAS bf16_t* HSL = (LAS bf16_t*)(F.lds + 16 * HP * 2);
    LAS float* PP = (LAS float*)(F.lds + 2 * 16 * HP * 2);
    LAS float* PRM = PP + 8 * 16 * 32;
    LAS unsigned* SEL = (LAS unsigned*)(PRM + 7 * 1024);
    LAS unsigned* HIST = SEL + 512 * 4;
    const int fr = F.lane & 15, fq = F.lane >> 4;
    bf16x8 bh[2][4], bl[2][4];
#pragma unroll
    for (int eh = 0; eh < 2; ++eh)
#pragma unroll
        for (int ks = 0; ks < 4; ++ks) { const size_t o = (size_t)(16 * eh + fr) * 1024 + 128 * F.wave + 32 * ks + 8 * fq; bh[eh][ks] = *(const bf16x8*)(RWT + o); bl[eh][ks] = *(const bf16x8*)(RWT + 32768 + o); }
    const int rb0 = (F.G == 256) ? 2 * ((int)(blockIdx.x & 7u) | ((int)(blockIdx.x >> 4) << 3)) + (int)((blockIdx.x >> 3) & 1u) : (int)blockIdx.x;
    for (int rb = rb0; rb < NTOK / 128; rb += F.G) {
        const int m0 = rb * 128, b = m0 / SEQ; const float* ad = ADA + b * 6144;
        __syncthreads();
        for (int i = F.tid; i < 1024; i += NTHR) {
            PRM[i] = a.in[I_LNING][i] * DN_ALPHA; PRM[1024 + i] = a.in[I_LNINB][i] * DN_ALPHA; PRM[2048 + i] = ad[2048 + i];
            PRM[3072 + i] = a.in[I_LN1G][i]; PRM[4096 + i] = a.in[I_LN1B][i]; PRM[5120 + i] = ad[4096 + i] + 1.0f; PRM[6144 + i] = ad[3072 + i]; }
        if (F.tid < 64) HIST[F.tid] = 0u;
        __syncthreads();
#define P6_FETCH(m_) do { const int _m = (m_); _Pragma("unroll") for (int j = 0; j < 4; ++j) { xn[j] = __builtin_nontemporal_load((const f32x4*)(a.in[I_X] + (size_t)_m * DM) + F.lane + 64 * j); \
            yn[j] = __builtin_nontemporal_load((const v2u*)(Y1 + (size_t)_m * DM) + F.lane + 64 * j); } mn = STATS[2 * _m]; rn = STATS[2 * _m + 1]; } while (0)
        f32x4 xn[4]; v2u yn[4]; float mn, rn;
        P6_FETCH(m0 + 2 * F.wave);
        for (int it = 0; it < 8; ++it) {
#pragma unroll 1
            for (int rr = 0; rr < 2; ++rr) {
                const int lr = 2 * F.wave + rr, m = m0 + 16 * it + lr; const float mean = mn, rstd = rn;
                f32x4 xc[4]; v2u yc[4];
#pragma unroll
                for (int j = 0; j < 4; ++j) { xc[j] = xn[j]; yc[j] = yn[j]; }
                { const int q = 2 * it + rr + 1; if (q < 16) P6_FETCH(m0 + 16 * (q >> 1) + 2 * F.wave + (q & 1)); }
                f32x4 z[4]; float s = 0.f;
#pragma unroll
                for (int j = 0; j < 4; ++j) {
                    const f32x4 xv = xc[j];
                    const v2u yw = yc[j];
                    const f32x4 y = {bflo(yw.x), bfhi(yw.x), bflo(yw.y), bfhi(yw.y)};
                    const f32x4 p0 = ((const LAS f32x4*)PRM + F.lane)[64 * j], p1 = ((const LAS f32x4*)(PRM + 1024) + F.lane)[64 * j], p2 = ((const LAS f32x4*)(PRM + 2048) + F.lane)[64 * j];
                    z[j] = (xv - mean) * rstd * p0 + p1 + p2 * y;
                    s += (z[j].x + z[j].y) + (z[j].z + z[j].w);
                }
                const float mz = wave_sum(s) * (1.f / DM); float s2 = 0.f;
#pragma unroll
                for (int j = 0; j < 4; ++j) { z[j] = z[j] - mz; s2 += (z[j].x * z[j].x + z[j].y * z[j].y) + (z[j].z * z[j].z + z[j].w * z[j].w); }
                const float rz = 1.f / sqrtf(wave_sum(s2) * (1.f / DM) + LN_EPS);
#pragma unroll
                for (int j = 0; j < 4; ++j) {
                    const f32x4 p3 = ((const LAS f32x4*)(PRM + 3072) + F.lane)[64 * j], p4 = ((const LAS f32x4*)(PRM + 4096) + F.lane)[64 * j], p5 = ((const LAS f32x4*)(PRM + 5120) + F.lane)[64 * j], p6 = ((const LAS f32x4*)(PRM + 6144) + F.lane)[64 * j];
                    const f32x4 x1 = z[j] * rz * p3 + p4; const f32x4 h2 = x1 * p5 + p6;
                    { v2u xw; xw.x = pk2(x1.x, x1.y); xw.y = pk2(x1.z, x1.w); ((v2u*)((bf16_t*)X1 + (size_t)m * DM) + F.lane)[64 * j] = xw; }
                    const unsigned h0 = f2bf(h2.x), h1 = f2bf(h2.y), h2b = f2bf(h2.z), h3 = f2bf(h2.w);
                    v2u w; w.x = h0 | (h1 << 16); w.y = h2b | (h3 << 16);
                    { unsigned q = 0u; q = __builtin_amdgcn_cvt_pk_fp8_f32(h2.x, h2.y, q, false); q = __builtin_amdgcn_cvt_pk_fp8_f32(h2.z, h2.w, q, true); ((unsigned*)((unsigned char*)H2 + (size_t)m * DM) + F.lane)[64 * j] = q; }
                    v2u lo; lo.x = pk2(h2.x - bf2f(h0), h2.y - bf2f(h1)); lo.y = pk2(h2.z - bf2f(h2b), h2.w - bf2f(h3));
                    *(LAS v2u*)(HSH + lr * HP + 4 * F.lane + 256 * j) = w; *(LAS v2u*)(HSL + lr * HP + 4 * F.lane + 256 * j) = lo;
                }
            }
            __syncthreads();
            f32x4 acc[2] = {(f32x4){0.f, 0.f, 0.f, 0.f}, (f32x4){0.f, 0.f, 0.f, 0.f}};
#pragma unroll
            for (int ks = 0; ks < 4; ++ks) {
                const bf16x8 ah = *(const LAS bf16x8*)(HSH + fr * HP + 128 * F.wave + 32 * ks + 8 * fq), al = *(const LAS bf16x8*)(HSL + fr * HP + 128 * F.wave + 32 * ks + 8 * fq);
#pragma unroll
                for (int eh = 0; eh < 2; ++eh) { acc[eh] = __builtin_amdgcn_mfma_f32_16x16x32_bf16(ah, bh[eh][ks], acc[eh], 0, 0, 0); acc[eh] = __builtin_amdgcn_mfma_f32_16x16x32_bf16(ah, bl[eh][ks], acc[eh], 0, 0, 0); acc[eh] = __builtin_amdgcn_mfma_f32_16x16x32_bf16(al, bh[eh][ks], acc[eh], 0, 0, 0); }
            }
#pragma unroll
            for (int eh = 0; eh < 2; ++eh)
#pragma unroll
                for (int r = 0; r < 4; ++r) PP[(F.wave * 16 + 4 * fq + r) * 32 + 16 * eh + fr] = acc[eh][r];
            __syncthreads();
            {
                const int lr = 2 * F.wave + (F.lane >> 5), ex = F.lane & 31;
                float mine = a.in[I_RB][ex];
#pragma unroll
                for (int wv = 0; wv < 8; ++wv) mine += PP[(wv * 16 + lr) * 32 + ex];
                float sv[4]; int si[4];
#pragma unroll
                for (int k = 0; k < 4; ++k) {
                    float v = mine; int ix = ex;
#pragma unroll
#define P6_AMAX(ov_, oi_) do { const float ov = (ov_); const int oi = (oi_); if (ov > v || (ov == v && oi < ix)) { v = ov; ix = oi; } } while (0)
                    P6_AMAX(dppf<0xB1>(v), dppi<0xB1>(ix)); P6_AMAX(dppf<0x4E>(v), dppi<0x4E>(ix)); P6_AMAX(dppf<0x141>(v), dppi<0x141>(ix)); P6_AMAX(dppf<0x140>(v), dppi<0x140>(ix));
                    { const unsigned uv = __float_as_uint(v), ui = (unsigned)ix; const auto rv = __builtin_amdgcn_permlane16_swap(uv, uv, false, false); const auto ri = __builtin_amdgcn_permlane16_swap(ui, ui, false, false);
                      P6_AMAX(__uint_as_float(rv[0] ^ rv[1] ^ uv), (int)(ri[0] ^ ri[1] ^ ui)); }
#undef P6_AMAX
                    sv[k] = v; si[k] = ix; if (ex == ix) mine = -3.0e38f;
                }
                const float e1 = __expf(sv[1] - sv[0]), e2 = __expf(sv[2] - sv[0]), e3 = __expf(sv[3] - sv[0]);
                const float rs = 1.0f / (1.0f + e1 + e2 + e3);
                if (ex < 4) {
                    const int sel = ex == 0 ? si[0] : (ex == 1 ? si[1] : (ex == 2 ? si[2] : si[3]));
                    const float gt = (ex == 0 ? 1.0f : (ex == 1 ? e1 : (ex == 2 ? e2 : e3))) * rs;
                    const unsigned rank = atomicAdd((unsigned*)(HIST + sel), 1u);
                    const int slot = (16 * it + lr) * 4 + ex;
                    SEL[slot * 4] = (unsigned)sel; SEL[slot * 4 + 1] = rank; SEL[slot * 4 + 2] = (unsigned)((m0 + 16 * it + lr) * 4 + ex); SEL[slot * 4 + 3] = __float_as_uint(gt);
                }
            }
        }
        __syncthreads();
        if (F.tid < 32) HIST[32 + F.tid] = atomicAdd(CNT + F.tid, HIST[F.tid]);
        __syncthreads();
        { const unsigned ex = SEL[F.tid * 4], rank = SEL[F.tid * 4 + 1]; v2u ent; ent.x = SEL[F.tid * 4 + 2]; ent.y = SEL[F.tid * 4 + 3]; LIST[(size_t)ex * LISTCAP + HIST[32 + ex] + rank] = ent; }
    }
}

__device__ __forceinline__ void p9_final(const Args& a, Frame& F) {
    unsigned char* ws = a.ws;
    const float* ADA = (const float*)(ws + WS_ADA); const bf16_t* X1 = (const bf16_t*)(ws + WS_X1); const unsigned char* YE = (const unsigned char*)(ws + WS_YE);
    const int rpw = (NTOK + F.ngw - 1) / F.ngw, m0 = F.gw * rpw, m1 = (m0 + rpw < NTOK) ? m0 + rpw : NTOK;
    unsigned yn[4][4]; v2u xn[4];
    auto fetch = [&](int m) {
#pragma unroll
        for (int j = 0; j < 4; ++j) {
#pragma unroll
            for (int k = 0; k < 4; ++k) yn[j][k] = __builtin_nontemporal_load((const unsigned*)(YE + ((size_t)m * 4 + k) * DM) + F.lane + 64 * j);
            xn[j] = __builtin_nontemporal_load((const v2u*)(X1 + (size_t)m * DM) + F.lane + 64 * j); } };
    if (m0 < m1) fetch(m0);
    f32x4 G2[4], LG[4], LB[4]; int kind = -1;
    for (int m = m0; m < m1; ++m) {
        const int b = m / SEQ;
        if (b != kind) { kind = b; const float* ad = ADA + b * 6144;
#pragma unroll
            for (int j = 0; j < 4; ++j) { G2[j] = ((const f32x4*)(ad + 5120) + F.lane)[64 * j] * (1.0f / 64.0f); LG[j] = ((const f32x4*)a.in[I_LN2G] + F.lane)[64 * j]; LB[j] = ((const f32x4*)a.in[I_LN2B] + F.lane)[64 * j]; } }
        f32x4 z[4]; float s = 0.f;
#pragma unroll
        for (int j = 0; j < 4; ++j) {
            f32x4 f = {0.f, 0.f, 0.f, 0.f};
#pragma unroll
            for (int k = 0; k < 4; ++k) { const unsigned yw = yn[j][k];
                f += (f32x4){__builtin_amdgcn_cvt_f32_fp8(yw, 0), __builtin_amdgcn_cvt_f32_fp8(yw, 1), __builtin_amdgcn_cvt_f32_fp8(yw, 2), __builtin_amdgcn_cvt_f32_fp8(yw, 3)}; }
            const v2u xw = xn[j]; const f32x4 x1 = {bflo(xw.x), bfhi(xw.x), bflo(xw.y), bfhi(xw.y)};
            z[j] = x1 * DN_ALPHA + G2[j] * f;
            s += (z[j].x + z[j].y) + (z[j].z + z[j].w);
        }
        if (m + 1 < m1) fetch(m + 1);
        const float mz = wave_sum(s) * (1.f / DM); float s2 = 0.f;
#pragma unroll
        for (int j = 0; j < 4; ++j) { z[j] = z[j] - mz; s2 += (z[j].x * z[j].x + z[j].y * z[j].y) + (z[j].z * z[j].z + z[j].w * z[j].w); }
        const float rz = 1.f / sqrtf(wave_sum(s2) * (1.f / DM) + LN_EPS);
#pragma unroll
        for (int j = 0; j < 4; ++j) __builtin_nontemporal_store(z[j] * rz * LG[j] + LB[j], (f32x4*)(a.out + (size_t)m * DM) + F.lane + 64 * j);
    }
}

constexpr int N_PHASES = 10;
constexpr int CONV_P7 = 2048;
constexpr int CONV_NIT = NEXP * (16 * 32 + 16 * 16), CONV_P2 = 64 * 8 * 4;
#ifndef MK_N_LAUNCHES
#define MK_N_LAUNCHES 1
#endif
__global__ void __launch_bounds__(NTHR, 2) fwd_kernel(Args a) {
    extern __shared__ __attribute__((aligned(16))) unsigned char lds[];
    Frame F;
    F.lds = (LAS unsigned char*)lds;
#define REFRESH() do { int _t = threadIdx.x; asm volatile("" : "+v"(_t)); F.tid = _t; F.lane = _t & 63; F.wave = __builtin_amdgcn_readfirstlane(_t >> 6); F.gtid = blockIdx.x * NTHR + _t; F.gw = blockIdx.x * NWAVES + F.wave; } while (0)
    F.G = gridDim.x; F.nthreads = F.G * NTHR; F.ngw = F.G * NWAVES; REFRESH();
    F.ctl = (unsigned*)(a.ws + WS_CTL);
    volatile LAS unsigned* MISC = (volatile LAS unsigned*)(F.lds + MISC_OFF);
    for (int u = F.tid; u < (LDS_BYTES - 131072) / 4; u += NTHR) ((LAS unsigned*)(F.lds + 131072))[u] = 0u;
    __syncthreads();
    XcdBarrier bar; bar.bar = F.ctl + CW_BAR + a.li * XCD_BAR_WORDS; bar.x = 0; bar.st = nullptr;
    if (MK_N_LAUNCHES == 1) bar = xcd_barrier_post(F.ctl + CW_BAR, MISC + 8);
    if (F.tid == 0) F.ctl[8704 + blockIdx.x] = xb_xcc_id() + 1u;
    const int lo = a.ph_lo, hi = a.ph_hi;
#define IN(k) (lo <= (k) && (k) < hi)
#define SEAM(k) do { if (IN(k) && IN((k) + 1)) xcd_barrier(bar); } while (0)
    if (IN(0)) { REFRESH(); p0_prologue(a, F); } SEAM(0);
    if (IN(1)) { REFRESH(); p1_ln_mod(a, F); } SEAM(1);
    if (IN(2)) { REFRESH();
        pg8::SchedInProj S{F.G, (int)blockIdx.x}; pg8::EpiInProj E{a.ws, a.in[I_QNG], a.in[I_KNG], (const float*)(a.ws + WS_ROPE)};
        pg8::gemm_phase<pg8::EpiInProj, pg8::SchedInProj, false>(F.lds, (const bf16_t*)(a.ws + WS_H), (const bf16_t*)(a.ws + WS_WIN), S, E);
        if (F.G == 256) { if (blockIdx.x >= 192) { REFRESH(); __syncthreads(); moe_weights_convert(a, F, 0, CONV_P2, ((int)blockIdx.x - 192) * NWAVES + F.wave, 64 * NWAVES); } }
        else if (blockIdx.x == 0) {   }
    } SEAM(2);
    if (IN(3)) { REFRESH();
        const attn_body::AttnTensors AT{(const attn_body::bf16*)(a.ws + WS_AQ), (const attn_body::bf16*)(a.ws + WS_AK), (const attn_body::bf16*)(a.ws + WS_AV), (attn_body::bf16*)(a.ws + WS_MIX) + 512};
        const attn_body::StaticOrder S((int)F.G, (int)blockIdx.x);
        if ((F.G & 255) == 0) {
            float gqm = fabsf(a.in[I_QNG][F.lane]), gkm = fabsf(a.in[I_KNG][F.lane]);
#pragma unroll
            for (int o = 32; o >= 1; o >>= 1) { gqm = fmaxf(gqm, __shfl_xor(gqm, o)); gkm = fmaxf(gkm, __shfl_xor(gkm, o)); }
            gqm = __int_as_float(__builtin_amdgcn_readfirstlane(__float_as_int(gqm))); gkm = __int_as_float(__builtin_amdgcn_readfirstlane(__float_as_int(gkm)));
            const float refB = 1.02f * C2 * 64.0f * gqm * gkm;
            const int slot = (int)(blockIdx.x % 5u); attn_body::AttnUnit u;
            for (int i = 0; i < 5; ++i) {
                if (i == slot) { __syncthreads(); moe_weights_convert(a, F, CONV_P2, CONV_NIT - CONV_P7, F.gw, F.ngw); __syncthreads(); }
                if (i < 4 && S.next(i, u)) { attn_body::AttnUnit un; un.b = 0; un.h = 0; un.qb = 0;
                    const bool pin = (i >= 1) && (slot != i), pout = (i + 1 < 4) && (slot != i + 1) && S.next(i + 1, un);
                    attn_body::attn_unit<8>(u.b, u.h, u.qb, AT.Q, AT.K, AT.V, AT.O, (char*)lds, refB, pin, pout, un.b, un.h, un.qb); }
            }
        } else { p3_attn_scalar(a, F); __syncthreads(); moe_weights_convert(a, F, 0, CONV_NIT, F.gw, F.ngw); }
        __syncthreads();
        for (int u = blockIdx.x; u < 256; u += F.G) { const int dvh = u & 1, dir = (u >> 1) & 1, h = (u >> 2) & 3, b = u >> 4;
            ret::state_unit(b, h, dir, dvh, (const bf16_t*)(a.ws + WS_RK), (const bf16_t*)(a.ws + WS_RV), (bf16_t*)(a.ws + WS_ST), (dir ? a.in[I_LDB][h] : a.in[I_LDF][h]) * 1.4426950408889634f, F.lds); }
    } SEAM(3);
    if (IN(4)) { REFRESH();
        ret::OutRegs R; int u = blockIdx.x;
        if (u < 1024) ret::out_load(R, u, (const bf16_t*)(a.ws + WS_RQ), (const bf16_t*)(a.ws + WS_RK), (const bf16_t*)(a.ws + WS_RV), (const bf16_t*)(a.ws + WS_RG));
        for (; u < 1024; u += F.G) { const int un = (u + F.G < 1024) ? u + F.G : -1;
            ret::out_unit(R, u, un, (const bf16_t*)(a.ws + WS_RQ), (const bf16_t*)(a.ws + WS_RK), (const bf16_t*)(a.ws + WS_RV), (const bf16_t*)(a.ws + WS_RG), (const bf16_t*)(a.ws + WS_ST), a.in[I_GNG], a.in[I_GNB],
                          a.in[I_LDF], a.in[I_LDB], (bf16_t*)(a.ws + WS_MIX), F.lds); }
    } SEAM(4);
    if (IN(5)) { REFRESH();
        pg8::EpiPlainBf16 E{(bf16_t*)(a.ws + WS_Y1), DM};
        if (F.G == 256) { pg8::SchedPair S{(int)blockIdx.x}; pg8::gemm_phase<pg8::EpiPlainBf16, pg8::SchedPair, false>(F.lds, (const bf16_t*)(a.ws + WS_MIX), (const bf16_t*)(a.ws + WS_WO), S, E); }
        else { pg8::SchedDense S{NTOK / 256, DM / 256, F.G, (int)blockIdx.x}; pg8::gemm_phase<pg8::EpiPlainBf16, pg8::SchedDense, false>(F.lds, (const bf16_t*)(a.ws + WS_MIX), (const bf16_t*)(a.ws + WS_WO), S, E); }
    }
    if (IN(5) && IN(6)) { if (F.G == 256) pair_sync(F.ctl + 8192, bar.bar, (int)blockIdx.x, F.ctl + 8704); else xcd_barrier(bar); }
    if (IN(6)) { REFRESH(); p6_ln1_route(a, F); } SEAM(6);
    if (IN(7)) { REFRESH();
        LAS int* tab = (LAS int*)(F.lds + 131072 + 1024); pg8::moe_build_tab(tab, F.ctl + CW_CNT);
        pg8::SchedMoE S{8, 2048, F.G, (int)blockIdx.x, tab, (const v2u*)(a.ws + WS_LIST)}; pg8::EpiUp E{a.ws + WS_ACT, a.in[I_BUP]};
        pg8::gemm_phase<pg8::EpiUp, pg8::SchedMoE, true, true>(F.lds, (const bf16_t*)(a.ws + WS_H2), (const bf16_t*)(a.ws + WS_WUP), S, E);
        {
            REFRESH(); __syncthreads();
            const int U7 = ((LAS int*)(F.lds + 131072 + 1024))[32] * 8, tail7 = U7 % (int)F.G, idle7 = (int)F.G - tail7;
            if (tail7 != 0 && idle7 >= 64) { if ((int)blockIdx.x >= tail7) moe_weights_convert(a, F, CONV_NIT - CONV_P7, CONV_NIT, ((int)blockIdx.x - tail7) * NWAVES + F.wave, idle7 * NWAVES); }
            else moe_weights_convert(a, F, CONV_NIT - CONV_P7, CONV_NIT, F.gw, F.ngw);
        }
    } SEAM(7);
    if (IN(8)) { REFRESH();
        LAS int* tab = (LAS int*)(F.lds + 131072 + 1024); pg8::moe_build_tab(tab, F.ctl + CW_CNT);
        pg8::SchedMoE S{4, 1024, F.G, (int)blockIdx.x, tab, (const v2u*)(a.ws + WS_LIST)}; pg8::EpiDown E{(bf16_t*)(a.ws + WS_YE), a.in[I_BDN], (const v2u*)(a.ws + WS_LIST)};
        pg8::gemm_phase<pg8::EpiDown, pg8::SchedMoE, false, true>(F.lds, (const bf16_t*)(a.ws + WS_ACT), (const bf16_t*)(a.ws + WS_WDN), S, E);
    } SEAM(8);
    if (IN(9)) { REFRESH(); p9_final(a, F); }
#undef IN
#undef SEAM
}

extern "C" void kernel_launch(void* const* d_in, const int* in_sizes, int n_in, void* d_out, int out_size, void* d_ws, size_t ws_size, hipStream_t stream) {
    static int grid = 0;
    if (grid == 0) {
        if (n_in != 26 || out_size != NTOK * DM || ws_size < WS_END) { fprintf(stderr, "kernel_launch: unexpected shapes (n_in %d, out %d, ws %zu); nothing launched\n", n_in, out_size, ws_size); grid = -1; return; }
        int dev = 0, cus = 0;
        if (hipGetDevice(&dev) != hipSuccess || hipDeviceGetAttribute(&cus, hipDeviceAttributeMultiprocessorCount, dev) != hipSuccess) { grid = -1; return; }
        if (hipFuncSetAttribute((const void*)fwd_kernel, hipFuncAttributeMaxDynamicSharedMemorySize, LDS_BYTES) != hipSuccess) { fprintf(stderr, "kernel_launch: hipFuncSetAttribute failed\n"); grid = -1; return; }
        (void)hipGetLastError();
        grid = cus;
    }
    if (grid < 0) return;
    if (hipMemsetAsync((char*)d_ws + WS_CTL, 0, CTL_ZERO_BYTES, stream) != hipSuccess) return;
    Args a{};
    for (int i = 0; i < 26; ++i) a.in[i] = (const float*)d_in[i];
    a.out = (float*)d_out; a.ws = (unsigned char*)d_ws;
    if (MK_N_LAUNCHES == 1) { a.ph_lo = 0; a.ph_hi = N_PHASES; a.li = 0; hipLaunchKernelGGL(fwd_kernel, dim3(grid), dim3(NTHR), LDS_BYTES, stream, a); }
    else for (int p = 0; p < N_PHASES; ++p) { a.ph_lo = p; a.ph_hi = p + 1; a.li = 0; hipLaunchKernelGGL(fwd_kernel, dim3(grid), dim3(NTHR), LDS_BYTES, stream, a); }
}
```
